# Optimizing an MI355X kernel written in HIP

```python
import functools
import jax, jax.numpy as jnp
from jax import lax
import numpy as np

D_MODEL = 1024
BATCH = 8
SEQ = 2048
DEPTH = 2
DEC_BATCH = 8
DEC_SEQ = 32
PAST_LEN = 4096

CHUNK = 64
HEAD_DIM = 64
H_RET = 4
H_GLA = 4
H_ATT = 8
W_RET = H_RET * HEAD_DIM
W_GLA = H_GLA * HEAD_DIM
W_ATT = H_ATT * HEAD_DIM
MIX_WIDTH = W_RET + W_GLA + W_ATT
GLA_RANK = 16
GLA_TAU = 16.0
BAND_CHUNKS = 8
ATT_REACH = BAND_CHUNKS * CHUNK
REL_MAX = 256
N_REL = CHUNK + REL_MAX
D_FF = 4 * D_MODEL
ROPE_BASE = 10000.0
EPS = 1e-6
IN_COLS = 4 * W_RET + 4 * W_GLA + GLA_RANK + 3 * W_ATT

kernel_name = 'hybrid_stream_encoder_step'


def rmsnorm(x, w):
    xf = x.astype(jnp.float32)
    y = xf * lax.rsqrt(jnp.mean(xf * xf, axis=-1, keepdims=True) + EPS)
    return (y * w.astype(jnp.float32)).astype(x.dtype)


def rotary(x, pos):
    half = HEAD_DIM // 2
    inv_freq = ROPE_BASE ** (-jnp.arange(half, dtype=jnp.float32) / half)
    ang = pos.astype(jnp.float32)[:, None] * inv_freq[None, :]
    cos = jnp.cos(ang)[None, :, None, :]
    sin = jnp.sin(ang)[None, :, None, :]
    x1, x2 = x[..., :half], x[..., half:]
    return jnp.concatenate([x1 * cos - x2 * sin, x1 * sin + x2 * cos], axis=-1)


def retention_log_decay():
    return jnp.log1p(-jnp.exp2(-5.0 - jnp.arange(H_RET, dtype=jnp.float32)))


def project(hn, w_in_l, w_a2_l, b_a_l, pos):
    B, L, _ = hn.shape
    proj = (hn @ w_in_l).astype(jnp.float32)
    sizes = (W_RET,) * 4 + (W_GLA,) * 4 + (GLA_RANK,) + (W_ATT,) * 3
    offsets, acc = [], 0
    for s in sizes[:-1]:
        acc += s
        offsets.append(acc)
    qa, ka, va, ga, qb, kb, vb, gb, low, qc, kc, vc = jnp.split(proj, offsets, axis=-1)
    heads = lambda t: t.reshape(B, L, -1, HEAD_DIM)
    scale = HEAD_DIM ** -0.5
    qa = rotary(heads(qa), pos)
    ka = rotary(heads(ka), pos) * scale
    qb = heads(qb) * scale
    log_f = jax.nn.log_sigmoid(low @ w_a2_l.astype(jnp.float32) + b_a_l.astype(jnp.float32)) / GLA_TAU
    return (qa, ka, heads(va), ga, qb, heads(kb), heads(vb), gb, heads(log_f),
            heads(qc), heads(kc), heads(vc))


def retention_chunk(S, q, k, v, log_gamma):
    L = q.shape[1]
    idx = jnp.arange(L)
    diff = idx[:, None] - idx[None, :]
    causal = diff >= 0
    dpos = jnp.where(causal, diff, 0).astype(jnp.float32)
    decay = jnp.where(causal[None], jnp.exp(dpos[None] * log_gamma[:, None, None]), 0.0)
    scores = jnp.einsum('bthd,bshd->bhts', q, k) * decay[None]
    intra = jnp.einsum('bhts,bshv->bthv', scores, v)
    q_decay = jnp.exp((idx + 1).astype(jnp.float32)[:, None] * log_gamma[None, :])
    inter = jnp.einsum('bthd,bhdv->bthv', q, S) * q_decay[None, :, :, None]
    k_decay = jnp.exp((L - 1 - idx).astype(jnp.float32)[:, None] * log_gamma[None, :])
    S_new = (jnp.exp(L * log_gamma)[None, :, None, None] * S
             + jnp.einsum('bshd,bshv->bhdv', k * k_decay[None, :, :, None], v))
    return S_new, intra + inter


def gla_chunk(S, q, k, v, log_f):
    L = q.shape[1]
    idx = jnp.arange(L)
    b = jnp.cumsum(log_f, axis=1)
    mask = (idx[:, None] >= idx[None, :])[None, :, :, None, None]
    diff = b[:, :, None] - b[:, None, :]
    w = jnp.where(mask, jnp.exp(jnp.where(mask, diff, 0.0)), 0.0)
    scores = jnp.sum(q[:, :, None] * k[:, None, :] * w, axis=-1)
    intra = jnp.einsum('btsh,bshv->bthv', scores, v)
    inter = jnp.einsum('bthd,bhdv->bthv', q * jnp.exp(b), S)
    b_last = b[:, -1]
    S_new = (jnp.exp(b_last)[..., None] * S
             + jnp.einsum('bshd,bshv->bhdv', k * jnp.exp(b_last[:, None] - b), v))
    return S_new, intra + inter


def scan_chunks(step, S0, *seqs):
    B, L = seqs[0].shape[:2]
    n = L // CHUNK
    xs = tuple(jnp.moveaxis(t.reshape(B, n, CHUNK, *t.shape[2:]), 1, 0) for t in seqs)
    S, outs = lax.scan(lambda c, xt: step(c, *xt), S0, xs)
    return S, jnp.moveaxis(outs, 0, 1).reshape(B, L, *outs.shape[3:])


def band_attention(q, k, v, q_pos, k_pos, k_valid, rel_bias_l):
    s = jnp.einsum('bnqhd,bnkhd->bhnqk', q, k) * (HEAD_DIM ** -0.5)
    dist = q_pos[:, :, None] - k_pos[:, None, :]
    ridx = jnp.clip(dist, -(CHUNK - 1), REL_MAX) + (CHUNK - 1)
    s = s + rel_bias_l.astype(jnp.float32)[:, ridx][None]
    s = jnp.where(k_valid[None, None, :, None, :], s, -1e30)
    p = jax.nn.softmax(s, axis=-1)
    return jnp.einsum('bhnqk,bnkhd->bnqhd', p, v)


def prompt_band_attention(q, k, v, rel_bias_l):
    B, L, H, d = q.shape
    n = L // CHUNK

    def band(t):
        tp = jnp.pad(t, ((0, 0), (ATT_REACH, 0), (0, 0), (0, 0))).reshape(B, n + BAND_CHUNKS, CHUNK, H, d)
        return jnp.concatenate([tp[:, j:j + n] for j in range(BAND_CHUNKS + 1)], axis=2)

    q_pos = jnp.arange(L).reshape(n, CHUNK)
    k_pos = (jnp.arange(n)[:, None] - BAND_CHUNKS) * CHUNK + jnp.arange((BAND_CHUNKS + 1) * CHUNK)[None, :]
    out = band_attention(q.reshape(B, n, CHUNK, H, d), band(k), band(v), q_pos, k_pos, k_pos >= 0, rel_bias_l)
    return out.reshape(B, L, H, d)


def sample_band_attention(q, k_new, v_new, k_cache, v_cache, rel_bias_l):
    B, L, H, d = q.shape
    R = k_cache.shape[1]
    k_all = jnp.concatenate([k_cache.astype(jnp.float32), k_new], axis=1)[:, None]
    v_all = jnp.concatenate([v_cache.astype(jnp.float32), v_new], axis=1)[:, None]
    q_pos = (PAST_LEN + jnp.arange(L))[None]
    k_pos = jnp.concatenate([PAST_LEN - R + jnp.arange(R), PAST_LEN + jnp.arange(L)])[None]
    out = band_attention(q[:, None], k_all, v_all, q_pos, k_pos, k_pos >= 0, rel_bias_l)
    return out[:, 0]


def merge_heads(oa, ga, ob, gb, oc, gn_w, gla_w, w_out_l, dtype):
    B, L = oa.shape[:2]
    mu = jnp.mean(oa, axis=-1, keepdims=True)
    var = jnp.mean(jnp.square(oa - mu), axis=-1, keepdims=True)
    a = ((oa - mu) * lax.rsqrt(var + EPS)).reshape(B, L, W_RET) * gn_w.astype(jnp.float32) * jax.nn.silu(ga)
    b = (ob * lax.rsqrt(jnp.mean(ob * ob, axis=-1, keepdims=True) + EPS)).reshape(B, L, W_GLA)
    b = b * gla_w.astype(jnp.float32) * jax.nn.silu(gb)
    cat = jnp.concatenate([a, b, oc.reshape(B, L, W_ATT)], axis=-1)
    return (cat.astype(dtype) @ w_out_l).astype(dtype)


def channel_mix(h, n2, w_up_l, w_down_l):
    u = rmsnorm(h, n2) @ w_up_l
    return (jnp.square(jax.nn.relu(u)) @ w_down_l).astype(h.dtype)


def setup_inputs(seed: int = 0) -> dict:
    key = jax.random.key(seed)
    ks = jax.random.split(key, 20)
    f32 = jnp.float32
    nrm = lambda k, shape, s: jax.random.normal(k, shape, f32) * s
    cache_rows = min(ATT_REACH, PAST_LEN)
    return {
        'x_prompt': nrm(ks[0], (BATCH, SEQ, D_MODEL), 1.0),
        'x_sample': nrm(ks[1], (DEC_BATCH, DEC_SEQ, D_MODEL), 1.0),
        'state_ret': nrm(ks[2], (DEPTH, DEC_BATCH, H_RET, HEAD_DIM, HEAD_DIM), 0.5),
        'state_gla': nrm(ks[3], (DEPTH, DEC_BATCH, H_GLA, HEAD_DIM, HEAD_DIM), 0.5),
        'cache_attn_k': nrm(ks[4], (DEPTH, DEC_BATCH, cache_rows, H_ATT, HEAD_DIM), 1.0),
        'cache_attn_v': nrm(ks[5], (DEPTH, DEC_BATCH, cache_rows, H_ATT, HEAD_DIM), 1.0),
        'norm1_w': 1.0 + nrm(ks[6], (DEPTH, D_MODEL), 0.02),
        'norm2_w': 1.0 + nrm(ks[7], (DEPTH, D_MODEL), 0.02),
        'final_norm_w': 1.0 + nrm(ks[8], (D_MODEL,), 0.02),
        'w_in': nrm(ks[9], (DEPTH, D_MODEL, IN_COLS), D_MODEL ** -0.5),
        'w_gla_a2': nrm(ks[10], (DEPTH, GLA_RANK, W_GLA), GLA_RANK ** -0.5),
        'b_gla_a': nrm(ks[11], (DEPTH, W_GLA), 0.1),
        'ret_gn_w': 1.0 + nrm(ks[12], (DEPTH, W_RET), 0.02),
        'gla_norm_w': 1.0 + nrm(ks[13], (DEPTH, W_GLA), 0.02),
        'rel_bias': nrm(ks[14], (DEPTH, H_ATT, N_REL), 0.1),
        'w_out': nrm(ks[15], (DEPTH, MIX_WIDTH, D_MODEL), MIX_WIDTH ** -0.5),
        'w_up': nrm(ks[16], (DEPTH, D_MODEL, D_FF), D_MODEL ** -0.5),
        'w_down': nrm(ks[17], (DEPTH, D_FF, D_MODEL), D_FF ** -0.5),
    }


def reference(x_prompt, x_sample, state_ret, state_gla, cache_attn_k, cache_attn_v,
              norm1_w, norm2_w, final_norm_w, w_in, w_gla_a2, b_gla_a, ret_gn_w,
              gla_norm_w, rel_bias, w_out, w_up, w_down):
    f32 = jnp.float32
    log_gamma = retention_log_decay()
    ret_step = functools.partial(retention_chunk, log_gamma=log_gamma)
    bp, lp = x_prompt.shape[0], x_prompt.shape[1]
    pos_p = jnp.arange(lp)
    pos_s = PAST_LEN + jnp.arange(x_sample.shape[1])
    keep = min(ATT_REACH, lp)
    hp, hs = x_prompt, x_sample
    ret_p, gla_p, kp, vp, ret_s, gla_s, k_s, v_s = [], [], [], [], [], [], [], []
    for l in range(DEPTH):
        qa, ka, va, ga, qb, kb, vb, gb, lf, qc, kc, vc = project(
            rmsnorm(hp, norm1_w[l]), w_in[l], w_gla_a2[l], b_gla_a[l], pos_p)
        Sa, oa = scan_chunks(ret_step, jnp.zeros((bp, H_RET, HEAD_DIM, HEAD_DIM), f32), qa, ka, va)
        Sb, ob = scan_chunks(gla_chunk, jnp.zeros((bp, H_GLA, HEAD_DIM, HEAD_DIM), f32), qb, kb, vb, lf)
        oc = prompt_band_attention(qc, kc, vc, rel_bias[l])
        hp = hp + merge_heads(oa, ga, ob, gb, oc, ret_gn_w[l], gla_norm_w[l], w_out[l], hp.dtype)
        hp = hp + channel_mix(hp, norm2_w[l], w_up[l], w_down[l])
        ret_p.append(Sa)
        gla_p.append(Sb)
        kp.append(kc[:, lp - keep:])
        vp.append(vc[:, lp - keep:])
        qa, ka, va, ga, qb, kb, vb, gb, lf, qc, kc, vc = project(
            rmsnorm(hs, norm1_w[l]), w_in[l], w_gla_a2[l], b_gla_a[l], pos_s)
        Sa, oa = retention_chunk(state_ret[l].astype(f32), qa, ka, va, log_gamma)
        Sb, ob = gla_chunk(state_gla[l].astype(f32), qb, kb, vb, lf)
        oc = sample_band_attention(qc, kc, vc, cache_attn_k[l], cache_attn_v[l], rel_bias[l])
        hs = hs + merge_heads(oa, ga, ob, gb, oc, ret_gn_w[l], gla_norm_w[l], w_out[l], hs.dtype)
        hs = hs + channel_mix(hs, norm2_w[l], w_up[l], w_down[l])
        ret_s.append(Sa)
        gla_s.append(Sb)
        k_s.append(kc)
        v_s.append(vc)
    y_prompt = rmsnorm(hp, final_norm_w)
    y_sample = rmsnorm(hs, final_norm_w)
    return (y_prompt, y_sample, jnp.stack(ret_p), jnp.stack(gla_p), jnp.stack(kp), jnp.stack(vp),
            jnp.stack(ret_s), jnp.stack(gla_s), jnp.stack(k_s), jnp.stack(v_s))
```

```cpp
#include <hip/hip_runtime.h>
#include <hip/hip_cooperative_groups.h>
#include <cstdio>
#include <cstdint>
namespace cg = cooperative_groups;
#ifndef PROBE_UP2
#define PROBE_UP2 0
#endif
#ifndef PROBE_M1X2
#define PROBE_M1X2 0
#endif
#ifndef PROBE_P0X2
#define PROBE_P0X2 0
#endif
#ifndef PROBE_SYNCS
#define PROBE_SYNCS 0
#endif
#ifndef PROBE_IN2
#define PROBE_IN2 0
#endif
#ifndef PROBE_DN2
#define PROBE_DN2 0
#endif
#ifndef PROBE_UP2B
#define PROBE_UP2B 0
#endif
#ifndef PROBE_KVX2
#define PROBE_KVX2 0
#endif
#ifndef PROBE_ATX2
#define PROBE_ATX2 0
#endif
#ifndef PROBE_M3X2
#define PROBE_M3X2 0
#endif
namespace pg8 {
#define PG8_LAS __attribute__((address_space(3)))
typedef unsigned short bf16_t;
typedef short bf16x8 __attribute__((ext_vector_type(8)));
typedef float f32x4 __attribute__((ext_vector_type(4)));
typedef unsigned u32x4 __attribute__((ext_vector_type(4)));
constexpr int BM = 256, BK = 64, HALF = 128, HTB = HALF * BK * 2  , STAGE_BYTES = 8 * HTB, NXCD = 8, WGM = 8;

__host__ __device__ __forceinline__ int lds_byte(int r, int c) { const int st = (r >> 4) * 2 + (c >> 5), rr = r & 15, cc = c & 31, ob = rr * 64 + cc * 2; return st * 1024 + (ob ^ (((ob >> 9) & 1) << 5)); }
__host__ __device__ __forceinline__ void stage_rc(int b, int& R, int& C) { const int st = b / 1024, sb = b % 1024, swz = sb ^ (((sb >> 9) & 1) << 5); R = (st >> 1) * 16 + swz / 64; C = (st & 1) * 32 + (swz % 64) / 2; }
__host__ __device__ __forceinline__ int perm32(int rho) { const int n = rho >> 4, i = rho & 15; return 8 * (i >> 2) + 4 * n + (i & 3); }

struct Unit { int pm, pn; };
struct Gemm { const bf16_t* A; const bf16_t* Bt; int M, N, K; };

struct StaticOrder {
    int nM, nN, nwg, G, c;
    __host__ __device__ __forceinline__ void init(int M, int N, int G_, int c_) { nM = M / BM; nN = N / BM; nwg = nM * nN; G = G_; c = c_; }
    __host__ __device__ __forceinline__ bool next(int i, Unit& u) const {
        const long L = (long)i * G + c; if (L >= nwg) return false;
        int wgid = (int)L; { const int q = nwg / NXCD, r = nwg % NXCD, xcd = wgid % NXCD, off = wgid / NXCD; wgid = (xcd < r ? xcd * (q + 1) : r * (q + 1) + (xcd - r) * q) + off; }
        const int nig = WGM * nN, gid = wgid / nig, fm = gid * WGM, gsz = (nM - fm) < WGM ? (nM - fm) : WGM;
        u.pm = fm + ((wgid % nig) % gsz); u.pn = (wgid % nig) / gsz; return true;
    }
    __device__ __forceinline__ void a_ready(const Unit&) const {}
    __device__ __forceinline__ void done(const Unit&) const {}
};

__device__ __forceinline__ unsigned cvt_pk_bf16(float lo, float hi) { unsigned r; asm volatile("v_cvt_pk_bf16_f32 %0, %1, %2" : "=v"(r) : "v"(lo), "v"(hi)); return r; }
typedef float f32x2 __attribute__((ext_vector_type(2)));

typedef unsigned u32x2 __attribute__((ext_vector_type(2)));
constexpr int E_MP = 16384;
struct EpiIn {
    static constexpr bool PERM = true, AFTER_DRAIN = false;
    bf16_t* proj; float* lowf; const float* ss; float* out; long long okp, ovp, oks, ovs;
    __device__ __forceinline__ void operator()(const f32x4 (&acc)[2][2][4][2], const Unit& u, int wr, int wc, int fr, int fq) const {
        const int row0 = u.pm * BM + wr * 64 + fr, col0 = u.pn * BM + wc * 32 + 8 * fq;
        float* kv = nullptr; int rsub = 0, cbase = 0;
        if (u.pn >= 10 && u.pn < 14) {
            const bool isk = u.pn < 12; cbase = isk ? 2560 : 3072;
            if (u.pm >= 64) { kv = out + (isk ? oks : ovs); rsub = E_MP; }
            else if ((u.pm & 7) >= 6) { kv = out + (isk ? okp : ovp); rsub = 1536 * ((u.pm >> 3) + 1); }
        }
        const bool lowt = (u.pn == 14) && (wc == 0) && (fq < 2);
#pragma unroll
        for (int ai = 0; ai < 2; ++ai)
#pragma unroll
            for (int m = 0; m < 4; ++m) {
                const int r = row0 + ai * HALF + m * 16;
                const float rs = 1.0f / sqrtf(ss[r] * (1.0f / 1024.0f) + 1e-6f);
                bf16_t* rowp = proj + (size_t)r * 3840 + col0;
#pragma unroll
                for (int bj = 0; bj < 2; ++bj) {
                    const f32x4 v0 = acc[ai][bj][m][0] * rs, v1 = acc[ai][bj][m][1] * rs;
                    u32x4 w; w.x = cvt_pk_bf16(v0[0], v0[1]); w.y = cvt_pk_bf16(v0[2], v0[3]); w.z = cvt_pk_bf16(v1[0], v1[1]); w.w = cvt_pk_bf16(v1[2], v1[3]);
                    *(u32x4*)(rowp + bj * HALF) = w;
                    if (kv) { float* d = kv + (size_t)(r - rsub) * 512 + (col0 + bj * HALF - cbase); *(f32x4*)d = v0; *(f32x4*)(d + 4) = v1; }
                    if (lowt && bj == 0) { float* d = lowf + (size_t)r * 16 + 8 * fq; *(f32x4*)d = v0; *(f32x4*)(d + 4) = v1; }
                }
            }
    }
};
struct EpiRes {
    static constexpr bool PERM = true, AFTER_DRAIN = false;
    const float* xold_p; long long sdelta; float* xr; bf16_t* xb; float* ss;
    __device__ __forceinline__ void operator()(const f32x4 (&acc)[2][2][4][2], const Unit& u, int wr, int wc, int fr, int fq) const {
        const int row0 = u.pm * BM + wr * 64 + fr, col0 = u.pn * BM + wc * 32 + 8 * fq;
#pragma unroll
        for (int ai = 0; ai < 2; ++ai)
#pragma unroll
            for (int m = 0; m < 4; ++m) {
                const int r = row0 + ai * HALF + m * 16;
                const long long xoff = (u.pm < 64) ? (long long)r * 4096 : sdelta + (long long)(r - E_MP) * 4096;
                const float* xo = (const float*)((const char*)xold_p + xoff) + col0;
                float* xn = xr + (size_t)r * 1024 + col0;
                float sq = 0.f;
#pragma unroll
                for (int bj = 0; bj < 2; ++bj) {
                    const f32x4 v0 = acc[ai][bj][m][0] + *(const f32x4*)(xo + bj * HALF), v1 = acc[ai][bj][m][1] + *(const f32x4*)(xo + bj * HALF + 4);
                    *(f32x4*)(xn + bj * HALF) = v0; *(f32x4*)(xn + bj * HALF + 4) = v1;
                    sq += (v0[0] * v0[0] + v0[1] * v0[1]) + (v0[2] * v0[2] + v0[3] * v0[3]) + (v1[0] * v1[0] + v1[1] * v1[1]) + (v1[2] * v1[2] + v1[3] * v1[3]);
                    if (xb) { u32x4 w; w.x = cvt_pk_bf16(v0[0], v0[1]); w.y = cvt_pk_bf16(v0[2], v0[3]); w.z = cvt_pk_bf16(v1[0], v1[1]); w.w = cvt_pk_bf16(v1[2], v1[3]);
                        *(u32x4*)(xb + (size_t)r * 1024 + col0 + bj * HALF) = w; }
                }
                sq += __shfl_xor(sq, 16); sq += __shfl_xor(sq, 32);
                if (fq == 0) atomicAdd(ss + r, sq);
            }
    }
};
struct EpiUp {
    static constexpr bool PERM = true, AFTER_DRAIN = false;
    bf16_t* U; const float* ss; int ldu;
    __device__ __forceinline__ void operator()(const f32x4 (&acc)[2][2][4][2], const Unit& u, int wr, int wc, int fr, int fq) const {
        const int row0 = u.pm * BM + wr * 64 + fr, col0 = u.pn * BM + wc * 32 + 8 * fq;
#pragma unroll
        for (int ai = 0; ai < 2; ++ai)
#pragma unroll
            for (int m = 0; m < 4; ++m) {
                const int r = row0 + ai * HALF + m * 16;
                const float rs = 1.0f / sqrtf(ss[r] * (1.0f / 1024.0f) + 1e-6f);
                bf16_t* rowp = U + (size_t)r * ldu + col0;
#pragma unroll
                for (int bj = 0; bj < 2; ++bj) {
                    f32x4 v0 = acc[ai][bj][m][0] * rs, v1 = acc[ai][bj][m][1] * rs;
#pragma unroll
                    for (int e = 0; e < 4; ++e) { const float a = fmaxf(v0[e], 0.f), b = fmaxf(v1[e], 0.f); v0[e] = a * a; v1[e] = b * b; }
                    u32x4 w; w.x = cvt_pk_bf16(v0[0], v0[1]); w.y = cvt_pk_bf16(v0[2], v0[3]); w.z = cvt_pk_bf16(v1[0], v1[1]); w.w = cvt_pk_bf16(v1[2], v1[3]);
                    *(u32x4*)(rowp + bj * HALF) = w;
                }
            }
    }
};

template <class Epi, class Sched, bool ALIGN_EPI = false, bool SP2 = false>
__device__ __forceinline__ void gemm_phase(PG8_LAS unsigned char* lds, const Gemm g, const Sched& S, const Epi& E, const int tid_in) {
    int tid_ = tid_in; asm volatile("" : "+v"(tid_));
    const int tid = tid_, wid = __builtin_amdgcn_readfirstlane(tid >> 6), lane = tid & 63, wr = wid >> 2, wc = wid & 3, fr = lane & 15, fq = lane >> 4;
    const int K = g.K, nt = K / BK;
    unsigned voffA[2], voffB[2];
#pragma unroll
    for (int i = 0; i < 2; ++i) { int R, C; stage_rc(tid * 16 + i * 8192, R, C); const int Rb = Epi::PERM ? ((R & ~31) + perm32(R & 31)) : R;
        voffA[i] = (unsigned)(R * K + C) * 2u; voffB[i] = (unsigned)(Rb * K + C) * 2u; }
    const size_t kstep = (size_t)(BK * 2);
    const size_t hstep = (size_t)HALF * K * 2;
    const size_t tstep = 2 * hstep;
    const unsigned ldsw = (unsigned)wid * 1024u;
    const int aoff = lds_byte(wr * 64 + fr, fq * 8), boff = lds_byte(wc * 32 + fr, fq * 8);
#define PG8_SA(b, h) (((b) * 2 + (h)) * HTB)
#define PG8_SB(b, h) ((4 + (b) * 2 + (h)) * HTB)
#define PG8_STAGE(bufoff, gbase, voff) do { _Pragma("unroll") for (int _i = 0; _i < 2; ++_i) \
        __builtin_amdgcn_global_load_lds((const unsigned*)((const char*)(gbase) + (voff)[_i]), (PG8_LAS unsigned*)(lds + (bufoff) + ldsw + _i * 8192), 16, 0, 0); } while (0)
#define PG8_LDA(dst, b, h) do { _Pragma("unroll") for (int m = 0; m < 4; ++m) _Pragma("unroll") for (int k = 0; k < 2; ++k) dst[m][k] = *(const PG8_LAS bf16x8*)(lds + PG8_SA(b, h) + aoff + m * 2048 + k * 1024); } while (0)
#define PG8_LDB(dst, b, h) do { _Pragma("unroll") for (int n = 0; n < 2; ++n) _Pragma("unroll") for (int k = 0; k < 2; ++k) dst[n][k] = *(const PG8_LAS bf16x8*)(lds + PG8_SB(b, h) + boff + n * 2048 + k * 1024); } while (0)
#define PG8_MMA(ai, bj, At, Bt) do { __builtin_amdgcn_s_setprio(1); _Pragma("unroll") for (int m = 0; m < 4; ++m) _Pragma("unroll") for (int n = 0; n < 2; ++n) _Pragma("unroll") for (int k = 0; k < 2; ++k) \
        acc[ai][bj][m][n] = __builtin_amdgcn_mfma_f32_16x16x32_bf16(Bt[n][k], At[m][k], acc[ai][bj][m][n], 0, 0, 0); __builtin_amdgcn_s_setprio(0); } while (0)
#define PG8_WAIT_V(n) asm volatile("s_waitcnt vmcnt(" #n ")" ::: "memory")
#define PG8_WAIT_L(n) asm volatile("s_waitcnt lgkmcnt(" #n ")" ::: "memory")
#define PG8_BAR __builtin_amdgcn_s_barrier()
#define PG8_SCHED __builtin_amdgcn_sched_barrier(0)
    Unit cur, nxt; int ui = 0;
    if (!S.next(0, cur)) return;
    f32x4 acc[2][2][4][2];
#pragma unroll
    for (int a = 0; a < 2; ++a)
#pragma unroll
        for (int b = 0; b < 2; ++b)
#pragma unroll
            for (int m = 0; m < 4; ++m)
#pragma unroll
                for (int n = 0; n < 2; ++n) acc[a][b][m][n] = (f32x4){0.f, 0.f, 0.f, 0.f};
    bf16x8 At[4][2], B0[2][2], B1[2][2];
    const char* cA = (const char*)g.A + (size_t)cur.pm * tstep; const char* cB = (const char*)g.Bt + (size_t)cur.pn * tstep;
    S.a_ready(cur);
    if constexpr (SP2) {
        PG8_STAGE(PG8_SB(0, 0), cB, voffB); PG8_STAGE(PG8_SB(0, 1), cB + hstep, voffB); PG8_STAGE(PG8_SA(0, 0), cA, voffA); PG8_STAGE(PG8_SA(0, 1), cA + hstep, voffA);
        if (wr == 1) PG8_BAR;
        PG8_WAIT_V(2); PG8_BAR;
        PG8_STAGE(PG8_SB(1, 0), cB + kstep, voffB); PG8_STAGE(PG8_SA(1, 0), cA + kstep, voffA); PG8_STAGE(PG8_SB(1, 1), cB + hstep + kstep, voffB);
        PG8_WAIT_V(6); PG8_BAR;
    } else {
        PG8_STAGE(PG8_SB(0, 0), cB, voffB); PG8_STAGE(PG8_SA(0, 0), cA, voffA); PG8_STAGE(PG8_SB(0, 1), cB + hstep, voffB); PG8_STAGE(PG8_SA(0, 1), cA + hstep, voffA);
        if (wr == 1) PG8_BAR;
        PG8_WAIT_V(4); PG8_BAR;
        PG8_STAGE(PG8_SB(1, 0), cB + kstep, voffB); PG8_STAGE(PG8_SA(1, 0), cA + kstep, voffA); PG8_STAGE(PG8_SB(1, 1), cB + hstep + kstep, voffB);
        PG8_WAIT_V(6); PG8_BAR;
    }
    for (;;) {
        const bool has_next = S.next(ui + 1, nxt);
        const char* nA = has_next ? (const char*)g.A + (size_t)nxt.pm * tstep : cA; const char* nB = has_next ? (const char*)g.Bt + (size_t)nxt.pn * tstep : cB;
        for (int t = 0; t < nt; t += 2) {
            const bool last = (t == nt - 2);
            const char* a1 = cA + (size_t)(t + 1) * kstep;
            const char* a2 = last ? nA : cA + (size_t)(t + 2) * kstep; const char* b2 = last ? nB : cB + (size_t)(t + 2) * kstep;
            const char* a3 = a2 + kstep; const char* b3 = b2 + kstep;
            if (last && has_next) S.a_ready(nxt);
            if constexpr (SP2) {
            PG8_LDB(B0, 0, 0); PG8_LDB(B1, 0, 1); PG8_SCHED; PG8_LDA(At, 0, 0); PG8_STAGE(PG8_SA(1, 1), a1 + hstep, voffA);
            PG8_WAIT_V(8); PG8_WAIT_L(0); PG8_BAR; PG8_MMA(0, 0, At, B0); PG8_MMA(0, 1, At, B1); PG8_BAR; PG8_SCHED;
            PG8_LDA(At, 0, 1); PG8_STAGE(PG8_SB(0, 0), b2, voffB); PG8_STAGE(PG8_SB(0, 1), b2 + hstep, voffB); PG8_STAGE(PG8_SA(0, 0), a2, voffA);
            PG8_WAIT_V(8); PG8_WAIT_L(0); PG8_BAR; PG8_MMA(1, 0, At, B0); PG8_MMA(1, 1, At, B1); PG8_BAR; PG8_SCHED;
            PG8_LDB(B0, 1, 0); PG8_LDB(B1, 1, 1); PG8_SCHED; PG8_LDA(At, 1, 0); PG8_STAGE(PG8_SA(0, 1), a2 + hstep, voffA);
            PG8_WAIT_V(8); PG8_WAIT_L(0); PG8_BAR; PG8_MMA(0, 0, At, B0); PG8_MMA(0, 1, At, B1); PG8_BAR; PG8_SCHED;
            PG8_LDA(At, 1, 1); PG8_STAGE(PG8_SB(1, 0), b3, voffB); PG8_STAGE(PG8_SB(1, 1), b3 + hstep, voffB); PG8_STAGE(PG8_SA(1, 0), a3, voffA);
            PG8_WAIT_V(8); PG8_WAIT_L(0); PG8_BAR; PG8_MMA(1, 0, At, B0); PG8_MMA(1, 1, At, B1); PG8_BAR; PG8_SCHED;
            } else {
            PG8_LDB(B0, 0, 0); PG8_SCHED; PG8_LDA(At, 0, 0); PG8_STAGE(PG8_SA(1, 1), a1 + hstep, voffA);
            PG8_WAIT_L(8); PG8_BAR; PG8_WAIT_L(0); PG8_MMA(0, 0, At, B0); PG8_BAR; PG8_SCHED;
            PG8_LDB(B1, 0, 1); PG8_STAGE(PG8_SB(0, 0), b2, voffB);
            PG8_BAR; PG8_WAIT_L(0); PG8_MMA(0, 1, At, B1); PG8_BAR;
            PG8_LDA(At, 0, 1); PG8_STAGE(PG8_SA(0, 0), a2, voffA);
            PG8_BAR; PG8_WAIT_L(0); PG8_MMA(1, 0, At, B0); PG8_BAR; PG8_SCHED;
            PG8_STAGE(PG8_SB(0, 1), b2 + hstep, voffB);
            PG8_WAIT_V(6); PG8_BAR; PG8_MMA(1, 1, At, B1); PG8_BAR;
            PG8_LDB(B0, 1, 0); PG8_SCHED; PG8_LDA(At, 1, 0); PG8_STAGE(PG8_SA(0, 1), a2 + hstep, voffA);
            PG8_WAIT_L(8); PG8_BAR; PG8_WAIT_L(0); PG8_MMA(0, 0, At, B0); PG8_BAR; PG8_SCHED;
            PG8_LDB(B1, 1, 1); PG8_STAGE(PG8_SB(1, 0), b3, voffB);
            PG8_BAR; PG8_WAIT_L(0); PG8_MMA(0, 1, At, B1); PG8_BAR;
            PG8_LDA(At, 1, 1); PG8_STAGE(PG8_SA(1, 0), a3, voffA);
            PG8_BAR; PG8_WAIT_L(0); PG8_MMA(1, 0, At, B0); PG8_BAR; PG8_SCHED;
            PG8_STAGE(PG8_SB(1, 1), b3 + hstep, voffB);
            PG8_WAIT_V(6); PG8_BAR; PG8_MMA(1, 1, At, B1); PG8_BAR;
            }
        }
        if constexpr (ALIGN_EPI) { if (wr == 0) PG8_BAR; }
        if constexpr (!Epi::AFTER_DRAIN) { E(acc, cur, wr, wc, fr, fq); S.done(cur); }
        if (!has_next) break;
#pragma unroll
        for (int a = 0; a < 2; ++a)
#pragma unroll
            for (int b = 0; b < 2; ++b)
#pragma unroll
                for (int m = 0; m < 4; ++m)
#pragma unroll
                    for (int n = 0; n < 2; ++n) acc[a][b][m][n] = (f32x4){0.f, 0.f, 0.f, 0.f};
        cur = nxt; cA = nA; cB = nB; ++ui;
        if constexpr (ALIGN_EPI) { if (wr == 1) PG8_BAR; }
    }
    PG8_WAIT_V(0);
    if constexpr (!ALIGN_EPI) { if (wr == 0) PG8_BAR; }
    PG8_BAR;
    if constexpr (Epi::AFTER_DRAIN) { E.fused(acc, cur, wr, wc, fr, fq, lds, wid, lane); S.done(cur); }
#undef PG8_SA
#undef PG8_SB
#undef PG8_STAGE
#undef PG8_LDA
#undef PG8_LDB
#undef PG8_MMA
#undef PG8_WAIT_V
#undef PG8_WAIT_L
#undef PG8_BAR
#undef PG8_SCHED
}
}


#define LAS __attribute__((address_space(3)))
typedef unsigned short bf16_t;
typedef short bf16x8 __attribute__((ext_vector_type(8)));
typedef short s16x4 __attribute__((ext_vector_type(4)));
typedef short v4i16_t __attribute__((ext_vector_type(4)));
typedef float f32x4 __attribute__((ext_vector_type(4)));
typedef float f32x2 __attribute__((ext_vector_type(2)));
typedef float f32x16 __attribute__((ext_vector_type(16)));
typedef unsigned u32x4 __attribute__((ext_vector_type(4)));
typedef unsigned u32x2 __attribute__((ext_vector_type(2)));

constexpr int DM = 1024, NB = 8, SEQ = 2048, MP = NB * SEQ, SL = 32, MS = NB * SL, MT = MP + MS;
constexpr int PS = 3840, DFF = 4096, INCOLS = 3600;
constexpr int C_QA = 0, C_KA = 256, C_VA = 512, C_GA = 768, C_QB = 1024, C_KB = 1280, C_VB = 1536, C_GB = 1792, C_QC = 2048, C_KC = 2560, C_VC = 3072, C_LOW = 3584;
constexpr int NREL = 320;
constexpr float EPS = 1e-6f;
constexpr size_t WS_A = 0;
constexpr size_t WS_B = WS_A + (size_t)MT * DFF * 2;
constexpr size_t WS_C = WS_B + (size_t)MT * DM * 2;
constexpr size_t WS_WIN = WS_C + (size_t)MT * DM * 2;
constexpr size_t WS_WOUT = WS_WIN + (size_t)2 * PS * DM * 2;
constexpr size_t WS_WUP = WS_WOUT + (size_t)2 * DM * DM * 2;
constexpr size_t WS_WDN = WS_WUP + (size_t)2 * DFF * DM * 2;
constexpr size_t WS_LOWF = WS_WDN + (size_t)2 * DFF * DM * 2;
constexpr size_t WS_SS = WS_LOWF + (size_t)MT * 16 * 4;
constexpr size_t WS_G = WS_SS + (size_t)5 * MT * 4;
constexpr size_t WS_ROPE = WS_G + (size_t)1024 * 64 * 4;
constexpr size_t WS_CTL = WS_ROPE + (size_t)2080 * 64 * 4;
constexpr size_t CTL_BYTES = 16384;
constexpr size_t WS_END = WS_CTL + CTL_BYTES;
static_assert((size_t)2048 * 4096 * 4 <= (size_t)MT * DM * 2, "KVT fits region C");
constexpr size_t WS_CKB = WS_A + (size_t)MT * PS * 2;
constexpr size_t CACHE_ELEMS = (size_t)8 * 512 * 512;
static_assert(WS_CKB + 2 * CACHE_ELEMS * 2 <= WS_B, "cache copies fit behind PROJ");
static_assert(WS_END <= (size_t)256 * 1024 * 1024, "d_ws map");
constexpr size_t O_Y = 0, O_RETP = (size_t)MT * DM, O_GLAP = O_RETP + 262144, O_KP = O_GLAP + 262144, O_VP = O_KP + 4194304, O_RETS = O_VP + 4194304, O_GLAS = O_RETS + 262144,
                 O_KS = O_GLAS + 262144, O_VS = O_KS + 262144, O_END = O_VS + 262144;
constexpr int TS = 144;
constexpr int TILE_B = 64 * TS;
constexpr int WAVE_LDS = 2 * TILE_B;
constexpr int LDS_BIAS = 8 * WAVE_LDS;
constexpr int NREV = 384;
constexpr int LDS_BARST = LDS_BIAS + 8 * NREV * 4;
constexpr int LDS_BYTES = LDS_BARST + 16;
static_assert(LDS_BYTES <= 160 * 1024 && pg8::STAGE_BYTES <= LDS_BIAS, "LDS map");

struct Params { const float* in[18]; float* out; unsigned char* ws; };
__device__ __forceinline__ int lane_id_asm() { int l; asm volatile("v_mbcnt_lo_u32_b32 %0, -1, 0\n\tv_mbcnt_hi_u32_b32 %0, -1, %0" : "=v"(l)); return l; }
typedef const __attribute__((address_space(4))) char* kaptr_t;
__device__ __forceinline__ kaptr_t karg_base() { kaptr_t ka = (kaptr_t)__builtin_amdgcn_kernarg_segment_ptr(); asm volatile("" : "+s"(ka)); return ka; }
__device__ __forceinline__ const float* in_ptr(int i) { return *(const float* const __attribute__((address_space(4)))*)(karg_base() + 8 * i); }
__device__ __forceinline__ float* out_ptr() { return *(float* const __attribute__((address_space(4)))*)(karg_base() + 8 * 18); }
__device__ __forceinline__ unsigned char* ws_ptr() { return *(unsigned char* const __attribute__((address_space(4)))*)(karg_base() + 8 * 19); }

typedef float f32x2_t __attribute__((ext_vector_type(2))); typedef __bf16 bf16x2_t __attribute__((ext_vector_type(2)));
__device__ __forceinline__ unsigned pk2(float lo, float hi) { const f32x2_t v = {lo, hi}; const bf16x2_t b = __builtin_convertvector(v, bf16x2_t); return __builtin_bit_cast(unsigned, b); }
__device__ __forceinline__ float bflo(unsigned u) { return __uint_as_float(u << 16); }
__device__ __forceinline__ float bfhi(unsigned u) { return __uint_as_float(u & 0xffff0000u); }
__device__ __forceinline__ float bf2f(bf16_t h) { return __uint_as_float((unsigned)h << 16); }
__device__ __forceinline__ bf16_t f2bf(float f) { return (bf16_t)(pk2(f, 0.f) & 0xffffu); }
__device__ __forceinline__ int crow(int r, int hi) { return (r & 3) + 8 * (r >> 2) + 4 * hi; }
__device__ __forceinline__ float silu(float x) { return x / (1.0f + __expf(-x)); }
__device__ __forceinline__ f32x16 mfma32(bf16x8 a, bf16x8 b, f32x16 c) { return __builtin_amdgcn_mfma_f32_32x32x16_bf16(a, b, c, 0, 0, 0); }
__device__ __forceinline__ bf16x8 as_bf16x8(u32x4 v) { return __builtin_bit_cast(bf16x8, v); }
__device__ __forceinline__ f32x16 zero16() { f32x16 z;
#pragma unroll
    for (int i = 0; i < 16; ++i) z[i] = 0.f; return z; }
__device__ __forceinline__ s16x4 ds_tr(LAS const unsigned char* p) { return __builtin_bit_cast(s16x4, __builtin_amdgcn_ds_read_tr16_b64_v4i16((LAS v4i16_t*)p)); }
__device__ __forceinline__ bf16x8 tr_nat(LAS const unsigned char* tile, int k0, int cb, int lane) {
    const int kq = lane >> 5, g = (lane >> 4) & 1, q = (lane & 15) >> 2, p = lane & 3;
    LAS const unsigned char* a = tile + (k0 + 8 * kq + q) * TS + (cb + 16 * g + 4 * p) * 2;
    const s16x4 lo = ds_tr(a), hi = ds_tr(a + 4 * TS);
    return (bf16x8){lo[0], lo[1], lo[2], lo[3], hi[0], hi[1], hi[2], hi[3]};
}
template <int STR = TS> __device__ __forceinline__ bf16x8 tr_perm(LAS const unsigned char* tile, int k0, int cb, int lane) {
    const int kq = lane >> 5, g = (lane >> 4) & 1, q = (lane & 15) >> 2, p = lane & 3;
    LAS const unsigned char* a = tile + (k0 + 4 * kq + q) * STR + (cb + 16 * g + 4 * p) * 2;
    const s16x4 lo = ds_tr(a), hi = ds_tr(a + 8 * STR);
    return (bf16x8){lo[0], lo[1], lo[2], lo[3], hi[0], hi[1], hi[2], hi[3]};
}
__device__ __forceinline__ bf16x8 row_frag(LAS const unsigned char* tile, int r0, int ks, int lane) {
    return *(LAS const bf16x8*)(tile + (r0 + (lane & 31)) * TS + (16 * ks + 8 * (lane >> 5)) * 2);
}
__device__ __forceinline__ bf16x8 pack_step(const f32x16& x, int s) {
    u32x4 w; w.x = pk2(x[8 * s + 0], x[8 * s + 1]); w.y = pk2(x[8 * s + 2], x[8 * s + 3]); w.z = pk2(x[8 * s + 4], x[8 * s + 5]); w.w = pk2(x[8 * s + 6], x[8 * s + 7]);
    return as_bf16x8(w);
}
__device__ __forceinline__ void load_tile(LAS unsigned char* tile, const bf16_t* src, int pitch, int nvalid, int lane) {
#pragma unroll
    for (int it = 0; it < 8; ++it) {
        const int id = it * 64 + lane, row = id >> 3, ch = id & 7;
        u32x4 v = (u32x4){0u, 0u, 0u, 0u};
        if (row < nvalid) v = *(const u32x4*)(src + (size_t)row * pitch + ch * 8);
        *(LAS u32x4*)(tile + row * TS + ch * 16) = v;
    }
}
__device__ __forceinline__ void load_tile_f32(LAS unsigned char* tile, const float* src, int pitch, int lane) {
#pragma unroll
    for (int it = 0; it < 16; ++it) {
        const int id = it * 64 + lane, row = id >> 4, c4 = id & 15;
        const f32x4 v = *(const f32x4*)(src + (size_t)row * pitch + c4 * 4);
        u32x2 w; w.x = pk2(v[0], v[1]); w.y = pk2(v[2], v[3]);
        *(LAS u32x2*)(tile + row * TS + c4 * 8) = w;
    }
}
__device__ __forceinline__ void load_rot(const bf16_t* rp, const float* cs, int kq, float scale, bool valid, bf16x8 (&fr)[4]) {
    u32x4 c[4];
#pragma unroll
    for (int ks = 0; ks < 4; ++ks) c[ks] = valid ? *(const u32x4*)(rp + 16 * ks + 8 * kq) : (u32x4){0u, 0u, 0u, 0u};
#pragma unroll
    for (int g = 0; g < 2; ++g) {
        const float* cp = cs + 16 * g + 8 * kq;
        const f32x4 ca = *(const f32x4*)cp, cb = *(const f32x4*)(cp + 4), sa = *(const f32x4*)(cp + 32), sb = *(const f32x4*)(cp + 36);
        float o1[8], o2[8];
#pragma unroll
        for (int e = 0; e < 8; ++e) {
            const unsigned w1 = c[g][e >> 1], w2 = c[g + 2][e >> 1];
            const float x1 = (e & 1) ? bfhi(w1) : bflo(w1), x2 = (e & 1) ? bfhi(w2) : bflo(w2);
            const float cc = (e < 4) ? ca[e & 3] : cb[e & 3], sn = (e < 4) ? sa[e & 3] : sb[e & 3];
            o1[e] = (x1 * cc - x2 * sn) * scale; o2[e] = (x1 * sn + x2 * cc) * scale;
        }
        u32x4 a, b;
        a.x = pk2(o1[0], o1[1]); a.y = pk2(o1[2], o1[3]); a.z = pk2(o1[4], o1[5]); a.w = pk2(o1[6], o1[7]);
        b.x = pk2(o2[0], o2[1]); b.y = pk2(o2[2], o2[3]); b.z = pk2(o2[4], o2[5]); b.w = pk2(o2[6], o2[7]);
        fr[g] = as_bf16x8(a); fr[g + 2] = as_bf16x8(b);
    }
}

struct Ctx {
    int l, lane, kq, li;
    const bf16_t* proj; const float* lowf; const float* rope; bf16_t* cat; float* kvt; float* gdec; float* out;
    const float* wa2; const float* ba; const float* nw; const float* st; const bf16_t* ckb; const bf16_t* cvb;
};
__device__ __forceinline__ float ret_lg2(int h) { return __log2f(1.0f - exp2f(-5.0f - (float)h)); }

struct GlaGate {
    f32x4 lw[4]; float w[16]; float bias, run;
    template <int L> __device__ __forceinline__ void init(const Ctx& C, int m0, int h) {
#pragma unroll
        for (int q = 0; q < 4; ++q) lw[q] = (C.lane < L) ? *(const f32x4*)(C.lowf + (size_t)(m0 + C.lane) * 16 + 4 * q) : (f32x4){0.f, 0.f, 0.f, 0.f};
#pragma unroll
        for (int j = 0; j < 16; ++j) w[j] = C.wa2[j * 256 + h * 64 + C.lane];
        bias = C.ba[h * 64 + C.lane]; run = 0.f;
    }
    __device__ __forceinline__ float step(int s) {
        float z0 = bias, z1 = 0.f;
#pragma unroll
        for (int j = 0; j < 16; j += 2) {
            z0 += __int_as_float(__builtin_amdgcn_readlane(__float_as_int(lw[j >> 2][j & 3]), s)) * w[j];
            z1 += __int_as_float(__builtin_amdgcn_readlane(__float_as_int(lw[(j + 1) >> 2][(j + 1) & 3]), s)) * w[j + 1];
        }
        const float z = z0 + z1;
        const float lf = fminf(z, 0.f) - __logf(1.0f + __expf(-fabsf(z)));
        run += lf * (1.0f / 16.0f);
        return run;
    }
};

template <bool SAMPLE> __device__ __forceinline__ void kv_local(const Ctx& C, int type, int b, int n, int h, LAS unsigned char* wl) {
    constexpr int L = SAMPLE ? 32 : 64, NKS = L / 16;
    const int m0 = SAMPLE ? MP + b * SL : b * SEQ + n * 64;
    const int pidx0 = SAMPLE ? 2048 : n * 64;
    LAS unsigned char* tK = wl; LAS unsigned char* tV = wl + TILE_B;
    const int lane = C.lane, kq = C.kq, li = C.li;
    float gdk = 0.f;
    if (type == 0) {
        const float lg = ret_lg2(h);
#pragma unroll
        for (int rb = 0; rb < L / 32; ++rb) {
            const int s = 32 * rb + li;
            bf16x8 fr[4];
            load_rot(C.proj + (size_t)(m0 + s) * PS + C_KA + h * 64, C.rope + (size_t)(pidx0 + s) * 64, kq, 0.125f * __builtin_amdgcn_exp2f(lg * (float)(L - 1 - s)), true, fr);
#pragma unroll
            for (int ks = 0; ks < 4; ++ks) *(LAS bf16x8*)(tK + s * TS + (16 * ks + 8 * kq) * 2) = fr[ks];
        }
        load_tile(tV, C.proj + (size_t)m0 * PS + C_VA + h * 64, PS, L, lane);
    } else {
        load_tile(tK, C.proj + (size_t)m0 * PS + C_KB + h * 64, PS, L, lane);
        load_tile(tV, C.proj + (size_t)m0 * PS + C_VB + h * 64, PS, L, lane);
        GlaGate gg; gg.init<L>(C, m0, h);
#pragma unroll 4
        for (int s = 0; s < L; ++s) {
            const float bs = gg.step(s);
            LAS bf16_t* kp = (LAS bf16_t*)(tK + s * TS + lane * 2);
            *kp = f2bf(bf2f(*kp) * __expf(-bs));
        }
        gdk = __expf(gg.run);
    }
    f32x16 kv[2][2];
#pragma unroll
    for (int db = 0; db < 2; ++db)
#pragma unroll
        for (int kb = 0; kb < 2; ++kb) kv[db][kb] = zero16();
#pragma unroll
    for (int ks = 0; ks < NKS; ++ks) {
        bf16x8 a[2], bb[2];
#pragma unroll
        for (int db = 0; db < 2; ++db) a[db] = tr_nat(tV, 16 * ks, 32 * db, lane);
#pragma unroll
        for (int kb = 0; kb < 2; ++kb) bb[kb] = tr_nat(tK, 16 * ks, 32 * kb, lane);
#pragma unroll
        for (int db = 0; db < 2; ++db)
#pragma unroll
            for (int kb = 0; kb < 2; ++kb) kv[db][kb] = mfma32(a[db], bb[kb], kv[db][kb]);
    }
    if (type == 1) {
#pragma unroll
        for (int kb = 0; kb < 2; ++kb) { const float cs = __int_as_float(__builtin_amdgcn_ds_bpermute((32 * kb + li) * 4, __float_as_int(gdk)));
#pragma unroll
            for (int db = 0; db < 2; ++db) kv[db][kb] = kv[db][kb] * cs; }
    }
    if (!SAMPLE) {
        const int uidx = ((type * 8 + b) * 4 + h) * 32 + n;
        float* dst = C.kvt + (size_t)uidx * 4096;
#pragma unroll
        for (int db = 0; db < 2; ++db)
#pragma unroll
            for (int kb = 0; kb < 2; ++kb)
#pragma unroll
                for (int r = 0; r < 16; ++r) dst[(32 * db + crow(r, kq)) * 64 + 32 * kb + li] = kv[db][kb][r];
        if (type == 1) C.gdec[(size_t)(((b * 4 + h) * 32 + n)) * 64 + lane] = gdk;
    } else {
        const float* s0 = C.st + (size_t)((C.l * 8 + b) * 4 + h) * 4096;
        float* so = C.out + (type == 0 ? O_RETS : O_GLAS) + (size_t)((C.l * 8 + b) * 4 + h) * 4096;
        const float dret = exp2f(ret_lg2(h) * (float)L);
#pragma unroll
        for (int kb = 0; kb < 2; ++kb) {
            const int dk = 32 * kb + li;
            const float dec = (type == 0) ? dret : __int_as_float(__builtin_amdgcn_ds_bpermute(dk * 4, __float_as_int(gdk)));
#pragma unroll
            for (int db = 0; db < 2; ++db)
#pragma unroll
                for (int rr = 0; rr < 4; ++rr) {
                    const int dv = 32 * db + 8 * rr + 4 * kq;
                    const f32x4 o = *(const f32x4*)(s0 + dk * 64 + dv);
                    f32x4 nv;
#pragma unroll
                    for (int e = 0; e < 4; ++e) nv[e] = dec * o[e] + kv[db][kb][4 * rr + e];
                    *(f32x4*)(so + dk * 64 + dv) = nv;
                }
        }
    }
}

template <bool SAMPLE> __device__ __forceinline__ void mix_out(const Ctx& C, int type, int b, int n, int h, LAS unsigned char* wl) {
    constexpr int L = SAMPLE ? 32 : 64, NTB = L / 32;
    const int m0 = SAMPLE ? MP + b * SL : b * SEQ + n * 64;
    const int pidx0 = SAMPLE ? 2048 : n * 64;
    LAS unsigned char* t0 = wl; LAS unsigned char* t1 = wl + TILE_B;
    const int lane = C.lane, kq = C.kq, li = C.li;
    bf16x8 qfr[NTB][4];
    const float lg = ret_lg2(h);
    if (type == 0) {
#pragma unroll
        for (int tb = 0; tb < NTB; ++tb) {
            const int s = 32 * tb + li;
            load_rot(C.proj + (size_t)(m0 + s) * PS + C_QA + h * 64, C.rope + (size_t)(pidx0 + s) * 64, kq, __builtin_amdgcn_exp2f(lg * (float)(s + 1)), true, qfr[tb]);
        }
        load_tile(t0, C.proj + (size_t)m0 * PS + C_VA + h * 64, PS, L, lane);
    } else {
        load_tile(t0, C.proj + (size_t)m0 * PS + C_QB + h * 64, PS, L, lane);
        load_tile(t1, C.proj + (size_t)m0 * PS + C_KB + h * 64, PS, L, lane);
        {
            GlaGate gg; gg.init<L>(C, m0, h);
#pragma unroll 4
            for (int s = 0; s < L; ++s) {
                const float e = __expf(gg.step(s));
                LAS bf16_t* qp = (LAS bf16_t*)(t0 + s * TS + lane * 2); LAS bf16_t* kp = (LAS bf16_t*)(t1 + s * TS + lane * 2);
                *qp = f2bf(bf2f(*qp) * 0.125f * e); *kp = f2bf(bf2f(*kp) / e);
            }
        }
        __builtin_amdgcn_sched_barrier(0);
#pragma unroll
        for (int tb = 0; tb < NTB; ++tb)
#pragma unroll
            for (int ks = 0; ks < 4; ++ks) qfr[tb][ks] = row_frag(t0, 32 * tb, ks, lane);
        asm volatile("s_waitcnt lgkmcnt(0)" ::: "memory");
        __builtin_amdgcn_sched_barrier(0);
        load_tile(t0, C.proj + (size_t)m0 * PS + C_VB + h * 64, PS, L, lane);
    }
    __builtin_amdgcn_sched_barrier(0);
    f32x16 o[2][NTB];
#pragma unroll
    for (int db = 0; db < 2; ++db)
#pragma unroll
        for (int tb = 0; tb < NTB; ++tb) o[db][tb] = zero16();
    {
        const int uidx = ((type * 8 + b) * 4 + h) * 32 + n;
        const float* sT = C.kvt + (size_t)uidx * 4096;
        const float* s0 = C.st + (size_t)((C.l * 8 + b) * 4 + h) * 4096;
#pragma unroll
        for (int db = 0; db < 2; ++db)
#pragma unroll
            for (int ks = 0; ks < 4; ++ks) {
                const int dv = 32 * db + li, dk0 = 16 * ks + 8 * kq;
                float sv[8];
                if (!SAMPLE) { const f32x4 x = *(const f32x4*)(sT + dv * 64 + dk0), y = *(const f32x4*)(sT + dv * 64 + dk0 + 4);
#pragma unroll
                    for (int e = 0; e < 4; ++e) { sv[e] = x[e]; sv[4 + e] = y[e]; } }
                else {
#pragma unroll
                    for (int e = 0; e < 8; ++e) sv[e] = s0[(dk0 + e) * 64 + dv]; }
                u32x4 w; w.x = pk2(sv[0], sv[1]); w.y = pk2(sv[2], sv[3]); w.z = pk2(sv[4], sv[5]); w.w = pk2(sv[6], sv[7]);
                const bf16x8 sa = as_bf16x8(w);
#pragma unroll
                for (int tb = 0; tb < NTB; ++tb) o[db][tb] = mfma32(sa, qfr[tb][ks], o[db][tb]);
            }
    }
    __builtin_amdgcn_sched_barrier(0);
#pragma unroll
    for (int sb = 0; sb < NTB; ++sb) {
        bf16x8 kfr[4];
        if (type == 0) load_rot(C.proj + (size_t)(m0 + 32 * sb + li) * PS + C_KA + h * 64, C.rope + (size_t)(pidx0 + 32 * sb + li) * 64, kq, 0.125f * __builtin_amdgcn_exp2f(-lg * (float)(32 * sb + li + 1)), true, kfr);
        else {
#pragma unroll
            for (int ks = 0; ks < 4; ++ks) kfr[ks] = row_frag(t1, 32 * sb, ks, lane);
        }
        f32x16 st[NTB];
#pragma unroll
        for (int tb = sb; tb < NTB; ++tb) {
            f32x16 a = zero16();
#pragma unroll
            for (int ks = 0; ks < 4; ++ks) a = mfma32(kfr[ks], qfr[tb][ks], a);
#pragma unroll
            for (int r = 0; r < 16; ++r) {
                const int s = 32 * sb + crow(r, kq), t = 32 * tb + li;
                a[r] = (t >= s) ? a[r] : 0.0f;
            }
            st[tb] = a;
        }
#pragma unroll
        for (int half = 0; half < 2; ++half) {
            bf16x8 va[2];
#pragma unroll
            for (int db = 0; db < 2; ++db) va[db] = tr_perm(t0, 32 * sb + 16 * half, 32 * db, lane);
#pragma unroll
            for (int tb = sb; tb < NTB; ++tb) {
                const bf16x8 pf = pack_step(st[tb], half);
#pragma unroll
                for (int db = 0; db < 2; ++db) o[db][tb] = mfma32(va[db], pf, o[db][tb]);
            }
        }
        __builtin_amdgcn_sched_barrier(0);
    }
    const float* nw = C.nw + h * 64;
    const int gcol = (type == 0 ? C_GA : C_GB) + h * 64;
#pragma unroll
    for (int tb = 0; tb < NTB; ++tb) {
        const int t = 32 * tb + li;
        float s1 = 0.f, s2 = 0.f;
#pragma unroll
        for (int db = 0; db < 2; ++db)
#pragma unroll
            for (int r = 0; r < 16; ++r) { const float x = o[db][tb][r]; s1 += x; s2 += x * x; }
        s1 += __shfl_xor(s1, 32); s2 += __shfl_xor(s2, 32);
        float mu = 0.f, rstd;
        if (type == 0) { mu = s1 * (1.0f / 64.0f); const float var = fmaxf(s2 * (1.0f / 64.0f) - mu * mu, 0.f); rstd = 1.0f / sqrtf(var + EPS); }
        else rstd = 1.0f / sqrtf(s2 * (1.0f / 64.0f) + EPS);
        const bf16_t* grow = C.proj + (size_t)(m0 + t) * PS + gcol;
        bf16_t* orow = C.cat + (size_t)(m0 + t) * DM + type * 256 + h * 64;
#pragma unroll
        for (int db = 0; db < 2; ++db)
#pragma unroll
            for (int rr = 0; rr < 4; ++rr) {
                const int dv = 32 * db + 8 * rr + 4 * kq;
                const u32x2 gw = *(const u32x2*)(grow + dv);
                const f32x4 wv = *(const f32x4*)(nw + dv);
                const float g0 = bflo(gw.x), g1 = bfhi(gw.x), g2 = bflo(gw.y), g3 = bfhi(gw.y);
                const float y0 = (o[db][tb][4 * rr + 0] - mu) * rstd * wv[0] * silu(g0), y1 = (o[db][tb][4 * rr + 1] - mu) * rstd * wv[1] * silu(g1);
                const float y2 = (o[db][tb][4 * rr + 2] - mu) * rstd * wv[2] * silu(g2), y3 = (o[db][tb][4 * rr + 3] - mu) * rstd * wv[3] * silu(g3);
                u32x2 w; w.x = pk2(y0, y1); w.y = pk2(y2, y3);
                *(u32x2*)(orow + dv) = w;
            }
    }
}

template <bool SAMPLE> __device__ __forceinline__ void attn_wave(const Ctx& C, int b, int n, int h, LAS unsigned char* wl, LAS const float* revT, float cb2) {
    constexpr int NTB = SAMPLE ? 1 : 2;
    constexpr float SC = 0.125f * 1.4426950408889634f;
    const int m0 = SAMPLE ? MP + b * SL : b * SEQ + n * 64;
    const int lane = C.lane, kq = C.kq, li = C.li;
    const int jt0 = SAMPLE ? 0 : (n < 8 ? 8 - n : 0);
#define ATT_SRC(jt, kp, vp, pitch, rmask) const bf16_t* kp; const bf16_t* vp; int pitch; int rmask = 63; \
    if (SAMPLE && (jt) < 8) { kp = C.ckb + (size_t)(b * 512 + 64 * (jt)) * 512 + h * 64; vp = C.cvb + (size_t)(b * 512 + 64 * (jt)) * 512 + h * 64; pitch = 512; } \
    else { const int kr0 = SAMPLE ? m0 : b * SEQ + (n - 8 + (jt)) * 64; kp = C.proj + (size_t)kr0 * PS + C_KC + h * 64; vp = kp + (C_VC - C_KC); pitch = PS; if (SAMPLE) rmask = 31; }
#define ATT_ISSUE(jt, kdst, vbuf) do { ATT_SRC(jt, kp_, vp_, pitch_, rmask_); \
    _Pragma("unroll") for (int sb = 0; sb < 2; ++sb) _Pragma("unroll") for (int ks = 0; ks < 4; ++ks) kdst[sb][ks] = *(const u32x4*)(kp_ + (size_t)((32 * sb + li) & rmask_) * pitch_ + 16 * ks + 8 * kq); \
    _Pragma("unroll") for (int it = 0; it < 8; ++it) __builtin_amdgcn_global_load_lds((const unsigned*)(vp_ + (size_t)((it * 8 + (lane >> 3)) & rmask_) * pitch_ + (lane & 7) * 8), (LAS unsigned*)((vbuf) + it * 1024), 16, 0, 0); } while (0)
    bf16x8 qfr[NTB][4];
#pragma unroll
    for (int tb = 0; tb < NTB; ++tb)
#pragma unroll
        for (int ks = 0; ks < 4; ++ks) qfr[tb][ks] = as_bf16x8(*(const u32x4*)(C.proj + (size_t)(m0 + 32 * tb + li) * PS + C_QC + h * 64 + 16 * ks + 8 * kq));
    f32x16 o[2][NTB]; float mrun[NTB], lrun[NTB];
#pragma unroll
    for (int tb = 0; tb < NTB; ++tb) { mrun[tb] = -1e30f; lrun[tb] = 0.f;
#pragma unroll
        for (int db = 0; db < 2; ++db) o[db][tb] = zero16(); }
    u32x4 kcur[2][4], knext[2][4];
    ATT_ISSUE(jt0, kcur, wl + ((jt0 & 1) ? TILE_B : 0));
    for (int jt = jt0; jt <= 8; ++jt) {
        asm volatile("s_waitcnt vmcnt(0)" ::: "memory");
        __builtin_amdgcn_sched_barrier(0);
        LAS unsigned char* tV = wl + ((jt & 1) ? TILE_B : 0);
        if (jt < 8) { ATT_ISSUE(jt + 1, knext, wl + (((jt + 1) & 1) ? TILE_B : 0)); }
        __builtin_amdgcn_sched_barrier(0);
        const bool cst = jt <= 3;
#pragma unroll
        for (int sb = 0; sb < 2; ++sb) {
            if (SAMPLE && jt == 8 && sb == 1) continue;
#pragma unroll
            for (int tb = 0; tb < NTB; ++tb) {
                f32x16 a = zero16();
#pragma unroll
                for (int ks = 0; ks < 4; ++ks) a = mfma32(as_bf16x8(kcur[sb][ks]), qfr[tb][ks], a);
                if (!cst) {
                    const int dbase = (8 - jt) * 64 + 63 + 32 * tb + li - 32 * sb;
                    LAS const float* rp = revT + (382 - dbase + 4 * kq);
#pragma unroll
                    for (int r = 0; r < 16; ++r) a[r] = a[r] * SC + rp[(r & 3) + 8 * (r >> 2)];
                }
                float mx = -1e30f;
#pragma unroll
                for (int r = 0; r < 16; ++r) mx = fmaxf(mx, a[r]);
                if (cst) mx = mx * SC + cb2;
                mx = fmaxf(mx, __shfl_xor(mx, 32));
                const float mnew = fmaxf(mrun[tb], mx);
                const bool moved = __builtin_amdgcn_ballot_w64(mnew != mrun[tb]) != 0ull;
                const float alpha = __builtin_amdgcn_exp2f(mrun[tb] - mnew);
                mrun[tb] = mnew;
                float ps = 0.f;
                if (cst) { const float off = cb2 - mnew;
#pragma unroll
                    for (int r = 0; r < 16; ++r) { const float pp = __builtin_amdgcn_exp2f(a[r] * SC + off); a[r] = pp; ps += pp; } }
                else {
#pragma unroll
                    for (int r = 0; r < 16; ++r) { const float pp = __builtin_amdgcn_exp2f(a[r] - mnew); a[r] = pp; ps += pp; } }
                lrun[tb] = lrun[tb] * alpha + ps;
                if (moved) {
#pragma unroll
                    for (int db = 0; db < 2; ++db) o[db][tb] = o[db][tb] * alpha;
                }
#pragma unroll
                for (int half = 0; half < 2; ++half) {
                    const bf16x8 pf = pack_step(a, half);
#pragma unroll
                    for (int db = 0; db < 2; ++db) o[db][tb] = mfma32(tr_perm<128>(tV, 32 * sb + 16 * half, 32 * db, lane), pf, o[db][tb]);
                }
            }
        }
#pragma unroll
        for (int sb = 0; sb < 2; ++sb)
#pragma unroll
            for (int ks = 0; ks < 4; ++ks) kcur[sb][ks] = knext[sb][ks];
    }
#pragma unroll
    for (int tb = 0; tb < NTB; ++tb) {
        const float lt = lrun[tb] + __shfl_xor(lrun[tb], 32), inv = 1.0f / lt;
        bf16_t* orow = C.cat + (size_t)(m0 + 32 * tb + li) * DM + 512 + h * 64;
#pragma unroll
        for (int db = 0; db < 2; ++db)
#pragma unroll
            for (int rr = 0; rr < 4; ++rr) {
                u32x2 w; w.x = pk2(o[db][tb][4 * rr] * inv, o[db][tb][4 * rr + 1] * inv); w.y = pk2(o[db][tb][4 * rr + 2] * inv, o[db][tb][4 * rr + 3] * inv);
                *(u32x2*)(orow + 32 * db + 8 * rr + 4 * kq) = w;
            }
    }
#undef ATT_ISSUE
#undef ATT_SRC
}

__device__ __forceinline__ void conv_cache(const float* ck, const float* cv, bf16_t* dst, int l, int gt, int NGT) {
    for (int i = gt; i < (int)(2 * CACHE_ELEMS / 8); i += NGT) {
        const bool isv = i >= (int)(CACHE_ELEMS / 8); const int j = isv ? i - (int)(CACHE_ELEMS / 8) : i;
        const float* s = (isv ? cv : ck) + (size_t)l * CACHE_ELEMS + (size_t)j * 8;
        const f32x4 x = *(const f32x4*)s, y = *(const f32x4*)(s + 4);
        u32x4 w; w.x = pk2(x[0], x[1]); w.y = pk2(x[2], x[3]); w.z = pk2(y[0], y[1]); w.w = pk2(y[2], y[3]);
        *(u32x4*)(dst + (size_t)i * 8) = w;
    }
}

__device__ __forceinline__ int win_src(int n) { return n < 2048 ? n : (n < 3584 ? n + 16 : (n < 3600 ? n - 1536 : -1)); }
__device__ __forceinline__ void tr_item(const float* W, int K, int Nsrc, bf16_t* WT, int kb, int nb, bool inmap, const float* kscale, LAS float* scr, int lane) {
    const int k0 = 64 * kb, n0 = 32 * nb, n = n0 + (lane & 31), sc = inmap ? win_src(n) : n;
    float wv[32];
#pragma unroll
    for (int i = 0; i < 32; ++i) { const int kk = 2 * i + (lane >> 5); wv[i] = (sc >= 0) ? W[(size_t)(k0 + kk) * Nsrc + sc] : 0.f; }
    if (kscale) {
#pragma unroll
        for (int i = 0; i < 32; ++i) wv[i] *= kscale[k0 + 2 * i + (lane >> 5)];
    }
#pragma unroll
    for (int i = 0; i < 32; ++i) scr[(2 * i + (lane >> 5)) * 33 + (lane & 31)] = wv[i];
    asm volatile("s_waitcnt lgkmcnt(0)" ::: "memory");
    const int c = lane & 7;
#pragma unroll
    for (int j = 0; j < 4; ++j) { const int nn = (lane >> 3) + 8 * j; const LAS float* s = scr + (8 * c) * 33 + nn;
        u32x4 o; o.x = pk2(s[0 * 33], s[1 * 33]); o.y = pk2(s[2 * 33], s[3 * 33]); o.z = pk2(s[4 * 33], s[5 * 33]); o.w = pk2(s[6 * 33], s[7 * 33]);
        *(u32x4*)(WT + (size_t)(n0 + nn) * K + k0 + 8 * c) = o; }
    asm volatile("s_waitcnt lgkmcnt(0)" ::: "memory");
}


enum { SK_IN = 0, SK_RES = 1, SK_UP = 2 };
struct SArgs {
    const bf16_t* A; const bf16_t* Bt; int K, nunits;
    bf16_t* obf; int ldo;
    const float* ss_in; float* ss_out;
    const float* xold; float* xr;
    float* lowf; float* ksout; float* vsout;
};
template <int KIND> __device__ __forceinline__ void sample_gemm(LAS unsigned char* lds, const SArgs& a, int ubeg, int ustep, int wave, int lane) {
    const int kq = lane >> 5, li = lane & 31, K = a.K, kw = K >> 3, kbeg = wave * kw;
    for (int u = ubeg; u < a.nunits; u += ustep) {
        const int row0 = 64 * (u & 3), col0 = 64 * (u >> 2);
        f32x16 acc[2][2];
#pragma unroll
        for (int rb = 0; rb < 2; ++rb)
#pragma unroll
            for (int cb = 0; cb < 2; ++cb) acc[rb][cb] = zero16();
        const bf16_t* ap = a.A + (size_t)(row0 + li) * K + kbeg + 8 * kq;
        const bf16_t* bp = a.Bt + (size_t)(col0 + li) * K + kbeg + 8 * kq;
        u32x4 af[4][2], bv[4][2], an[4][2], bn[4][2];
#define SG_LOAD(dsta, dstb, k) _Pragma("unroll") for (int s = 0; s < 4; ++s) _Pragma("unroll") for (int h = 0; h < 2; ++h) { dsta[s][h] = *(const u32x4*)(ap + (size_t)(32 * h) * K + (k) + 16 * s); dstb[s][h] = *(const u32x4*)(bp + (size_t)(32 * h) * K + (k) + 16 * s); }
        SG_LOAD(af, bv, 0);
        for (int k = 0; k < kw; k += 64) {
            if (k + 64 < kw) { SG_LOAD(an, bn, k + 64); }
#pragma unroll
            for (int s = 0; s < 4; ++s)
#pragma unroll
                for (int rb = 0; rb < 2; ++rb)
#pragma unroll
                    for (int cb = 0; cb < 2; ++cb) acc[rb][cb] = mfma32(as_bf16x8(af[s][rb]), as_bf16x8(bv[s][cb]), acc[rb][cb]);
#pragma unroll
            for (int s = 0; s < 4; ++s)
#pragma unroll
                for (int h = 0; h < 2; ++h) { af[s][h] = an[s][h]; bv[s][h] = bn[s][h]; }
        }
#undef SG_LOAD
        LAS float* wp = (LAS float*)(lds + wave * WAVE_LDS);
#pragma unroll
        for (int rb = 0; rb < 2; ++rb)
#pragma unroll
            for (int cb = 0; cb < 2; ++cb)
#pragma unroll
                for (int r = 0; r < 16; ++r) wp[(32 * rb + crow(r, kq)) * 64 + 32 * cb + li] = acc[rb][cb][r];
        __syncthreads();
        const int t = wave * 64 + lane, row = t >> 3, c8 = (t & 7) * 8;
        float v[8];
#pragma unroll
        for (int e = 0; e < 8; ++e) v[e] = 0.f;
#pragma unroll
        for (int w = 0; w < 8; ++w) {
            const f32x4 x = *(LAS const f32x4*)(lds + w * WAVE_LDS + (row * 64 + c8) * 4), y = *(LAS const f32x4*)(lds + w * WAVE_LDS + (row * 64 + c8) * 4 + 16);
#pragma unroll
            for (int e = 0; e < 4; ++e) { v[e] += x[e]; v[4 + e] += y[e]; }
        }
        const int r = row0 + row, c = col0 + c8;
        if (KIND == SK_IN || KIND == SK_UP) {
            const float rs = 1.0f / sqrtf(a.ss_in[r] * (1.0f / 1024.0f) + EPS);
#pragma unroll
            for (int e = 0; e < 8; ++e) { v[e] *= rs; if (KIND == SK_UP) { const float q = fmaxf(v[e], 0.f); v[e] = q * q; } }
        }
        if (KIND == SK_RES) {
            const float* xo = a.xold + (size_t)r * 1024 + c;
            const f32x4 x = *(const f32x4*)xo, y = *(const f32x4*)(xo + 4);
            float sq = 0.f;
#pragma unroll
            for (int e = 0; e < 4; ++e) { v[e] += x[e]; v[4 + e] += y[e]; }
#pragma unroll
            for (int e = 0; e < 8; ++e) sq += v[e] * v[e];
            float* xn = a.xr + (size_t)r * 1024 + c;
            *(f32x4*)xn = (f32x4){v[0], v[1], v[2], v[3]}; *(f32x4*)(xn + 4) = (f32x4){v[4], v[5], v[6], v[7]};
            sq += __shfl_xor(sq, 1); sq += __shfl_xor(sq, 2); sq += __shfl_xor(sq, 4);
            if ((t & 7) == 0) atomicAdd(a.ss_out + r, sq);
        }
        if (a.obf) { u32x4 w; w.x = pk2(v[0], v[1]); w.y = pk2(v[2], v[3]); w.z = pk2(v[4], v[5]); w.w = pk2(v[6], v[7]); *(u32x4*)(a.obf + (size_t)r * a.ldo + c) = w; }
        if (KIND == SK_IN) {
            float* d = nullptr;
            if (c >= C_KC && c < C_VC) d = a.ksout + (size_t)r * 512 + (c - C_KC);
            else if (c >= C_VC && c < C_LOW) d = a.vsout + (size_t)r * 512 + (c - C_VC);
            else if (c >= C_LOW && c < C_LOW + 16) d = a.lowf + (size_t)r * 16 + (c - C_LOW);
            if (d) { *(f32x4*)d = (f32x4){v[0], v[1], v[2], v[3]}; *(f32x4*)(d + 4) = (f32x4){v[4], v[5], v[6], v[7]}; }
        }
        __syncthreads();
    }
}
__device__ __forceinline__ void sample_share(int nwg, int G, int bx, int& ubeg, int& ustep) { const int nfull = nwg % G; if (nfull == 0) { ubeg = bx; ustep = G; } else if (bx >= nfull) { ubeg = bx - nfull; ustep = G - nfull; } else { ubeg = 1 << 30; ustep = 1; } }

#define XB_TMO      128
#define XB_XCNT(j)  (256  + 64 * (j))
#define XB_XSUB(j)  (1280 + 64 * (j))
#define XB_XGEN(j)  (2304 + 64 * (j))
#define XB_TOP      3328
#define XB_TOPGEN   3392
#define XCD_BAR_WORDS 3456
#define XB_SPIN_CAP (1u << 18)

__device__ __forceinline__ unsigned xb_ld(unsigned* p)              { return __hip_atomic_load(p, __ATOMIC_RELAXED, __HIP_MEMORY_SCOPE_AGENT); }
__device__ __forceinline__ unsigned xb_add(unsigned* p, unsigned v) { return __hip_atomic_fetch_add(p, v, __ATOMIC_RELAXED, __HIP_MEMORY_SCOPE_AGENT); }
__device__ __forceinline__ unsigned xb_xcc_id() { return (unsigned)__builtin_amdgcn_s_getreg((3 << 11) | 20) & 0xFu; }
#define XB_SPIN(cond, bar) do { unsigned _sp = 0; while (cond) { __builtin_amdgcn_s_sleep(1); \
    if ((++_sp & 255u) == 0u) { if (xb_ld(&(bar)[XB_TMO])) break; if (_sp > XB_SPIN_CAP) { atomicAdd(&(bar)[XB_TMO], 1u); break; } } } } while (0)

struct XcdBarrier {
    unsigned* bar; unsigned x; bool wave0;
    volatile LAS unsigned* st;
};

__device__ __forceinline__ XcdBarrier xcd_barrier_post(unsigned* bar, volatile LAS unsigned* st) {
    XcdBarrier b; b.bar = bar; b.x = xb_xcc_id(); b.st = st;
    if (threadIdx.x == 0) (void)xb_add(&bar[XB_XCNT(b.x)], 1u);
    return b;
}
__device__ __forceinline__ void xcd_barrier_complete(unsigned* bar, unsigned x, unsigned& nloc, unsigned& nx) {
    const unsigned G = gridDim.x * gridDim.y * gridDim.z;
    unsigned sum, cnt, mine, sp = 0u;
    for (;;) {
        sum = 0u; cnt = 0u; mine = 0u;
#pragma unroll
        for (unsigned j = 0; j < 16; ++j) { const unsigned c = xb_ld(&bar[XB_XCNT(j)]); sum += c; cnt += (c > 0u) ? 1u : 0u; mine = (j == x) ? c : mine; }
        if (sum == G) break;
        __builtin_amdgcn_s_sleep(1);
        if ((++sp & 255u) == 0u) { if (xb_ld(&bar[XB_TMO])) break; if (sp > XB_SPIN_CAP) { atomicAdd(&bar[XB_TMO], 1u); break; } }
    }
    nloc = mine > 0u ? mine : 1u; nx = cnt > 0u ? cnt : 1u;
}

__device__ __forceinline__ void xcd_barrier(const XcdBarrier& b) {
    asm volatile("s_waitcnt vmcnt(0)" ::: "memory");
    __syncthreads();
    if (b.wave0 && lane_id_asm() == 0) {
        unsigned* bar = b.bar;
        __builtin_amdgcn_s_waitcnt(0);
        unsigned nloc = b.st[0], nx = b.st[1];
        if (nloc == 0u) { xcd_barrier_complete(bar, b.x, nloc, nx); b.st[0] = nloc; b.st[1] = nx; }
        const unsigned old = xb_add(&bar[XB_XSUB(b.x)], 1u);
        const unsigned gen = old / nloc;
        if (old + 1u == (gen + 1u) * nloc) {
            __builtin_amdgcn_fence(__ATOMIC_RELEASE, "agent");
            asm volatile("s_waitcnt vmcnt(0)" ::: "memory");
            const unsigned og = xb_add(&bar[XB_TOP], 1u);
            const unsigned tg = og / nx;
            if (og + 1u == (tg + 1u) * nx) xb_add(&bar[XB_TOPGEN], 1u);
            else XB_SPIN(xb_ld(&bar[XB_TOPGEN]) == tg, bar);
            __builtin_amdgcn_fence(__ATOMIC_ACQUIRE, "agent");
            xb_add(&bar[XB_XGEN(b.x)], 1u);
            asm volatile("s_waitcnt vmcnt(0)" ::: "memory");
        } else {
            XB_SPIN(xb_ld(&bar[XB_XGEN(b.x)]) == gen, bar);
            __builtin_amdgcn_fence(__ATOMIC_ACQUIRE, "agent");
            asm volatile("s_waitcnt vmcnt(0)" ::: "memory");
        }
    }
    __syncthreads();
}


__device__ __forceinline__ void tr_item128(const float* W, int K, int Nsrc, bf16_t* WT, int kb, int nb, const float* kscale, LAS float* scr, int lane) {
    const int k0 = 32 * kb, n0 = 128 * nb, n4 = (lane & 31) * 4;
    f32x4 wv[16];
#pragma unroll
    for (int i = 0; i < 16; ++i) wv[i] = *(const f32x4*)(W + (size_t)(k0 + 2 * i + (lane >> 5)) * Nsrc + n0 + n4);
    if (kscale) {
#pragma unroll
        for (int i = 0; i < 16; ++i) wv[i] = wv[i] * kscale[k0 + 2 * i + (lane >> 5)];
    }
#pragma unroll
    for (int i = 0; i < 16; ++i) { LAS float* d = scr + (2 * i + (lane >> 5)) * 129 + n4; d[0] = wv[i][0]; d[1] = wv[i][1]; d[2] = wv[i][2]; d[3] = wv[i][3]; }
    asm volatile("s_waitcnt lgkmcnt(0)" ::: "memory");
#pragma unroll
    for (int j = 0; j < 8; ++j) { const int id = j * 64 + lane, n = id >> 2, c = id & 3; const LAS float* s = scr + (8 * c) * 129 + n;
        u32x4 o; o.x = pk2(s[0 * 129], s[1 * 129]); o.y = pk2(s[2 * 129], s[3 * 129]); o.z = pk2(s[4 * 129], s[5 * 129]); o.w = pk2(s[6 * 129], s[7 * 129]);
        *(u32x4*)(WT + (size_t)(n0 + n) * K + k0 + 8 * c) = o; }
    asm volatile("s_waitcnt lgkmcnt(0)" ::: "memory");
}
constexpr int CONV_WGS = 16;

__global__ void __launch_bounds__(512, 2) hybrid_fwd(Params p) {
    extern __shared__ __attribute__((aligned(16))) unsigned char lds_raw[];
    cg::grid_group grid = cg::this_grid();
    LAS unsigned char* lds = (LAS unsigned char*)lds_raw;
    const int wave = __builtin_amdgcn_readfirstlane((int)threadIdx.x >> 6);
    const int G = gridDim.x, bx = blockIdx.x;
#define WSP(off) (ws_ptr() + (off))
#define LANE_TID() const int lane = lane_id_asm(); const int tid = wave * 64 + lane; (void)tid; int Gq = G, bxq = bx; asm volatile("" : "+s"(Gq), "+s"(bxq)); (void)Gq; (void)bxq
    LAS unsigned char* wl = lds + wave * WAVE_LDS;
    LAS float* biasT = (LAS float*)(lds + LDS_BIAS);
    if (threadIdx.x < 4) ((LAS unsigned*)(lds + LDS_BARST))[threadIdx.x] = 0u;
    __syncthreads();
    XcdBarrier xbar = xcd_barrier_post((unsigned*)WSP(WS_CTL), (volatile LAS unsigned*)(lds + LDS_BARST)); xbar.wave0 = (wave == 0);

    for (int rep = 0; rep < 1 + PROBE_P0X2; ++rep) {
        LANE_TID();
        unsigned char* ws = ws_ptr();
        bf16_t* XB = (bf16_t*)(ws + WS_B); bf16_t* WIN = (bf16_t*)(ws + WS_WIN); bf16_t* WOUT = (bf16_t*)(ws + WS_WOUT); bf16_t* WUP = (bf16_t*)(ws + WS_WUP); bf16_t* WDN = (bf16_t*)(ws + WS_WDN);
        float* SS = (float*)(ws + WS_SS); float* ROPE = (float*)(ws + WS_ROPE);
        const int gw = bx * 8 + wave, NGW = G * 8;
        LAS float* scr = (LAS float*)wl;
        constexpr int I_IN = 16 * (PS / 32), I_OUT = 16 * 32, I_UP = 16 * 128, I_DN = 64 * 32, I_L = I_IN + I_OUT + I_UP + I_DN;
        const bool split = (G == 256);
        for (int it = gw; it < 2 * I_L; it += NGW) {
            const int l = it / I_L; int r = it % I_L;
            if (split && r >= I_IN) continue;
            if (r < I_IN) { tr_item(in_ptr(9) + (size_t)l * DM * INCOLS, DM, INCOLS, WIN + (size_t)l * PS * DM, r / (PS / 32), r % (PS / 32), true, in_ptr(6) + l * DM, scr, lane); continue; } r -= I_IN;
            if (r < I_OUT) { tr_item(in_ptr(15) + (size_t)l * DM * DM, DM, DM, WOUT + (size_t)l * DM * DM, r / 32, r % 32, false, nullptr, scr, lane); continue; } r -= I_OUT;
            if (r < I_UP) { tr_item(in_ptr(16) + (size_t)l * DM * DFF, DM, DFF, WUP + (size_t)l * DFF * DM, r / 128, r % 128, false, in_ptr(7) + l * DM, scr, lane); continue; } r -= I_UP;
            tr_item(in_ptr(17) + (size_t)l * DFF * DM, DFF, DM, WDN + (size_t)l * DM * DFF, r / 32, r % 32, false, nullptr, scr, lane);
        }
        const float* x_prompt = in_ptr(0); const float* x_sample = in_ptr(1);
        for (int m0 = gw; m0 < MT; m0 += 2 * NGW) {
            f32x4 v[2][4]; float s[2];
#pragma unroll
            for (int q = 0; q < 2; ++q) {
                const int m = m0 + q * NGW; s[q] = 0.f;
                if (m < MT) {
                    const float* xrow = (m < MP) ? x_prompt + (size_t)m * DM : x_sample + (size_t)(m - MP) * DM;
                    const f32x4* xr = (const f32x4*)xrow + lane;
#pragma unroll
                    for (int j = 0; j < 4; ++j) v[q][j] = xr[64 * j];
                }
            }
#pragma unroll
            for (int q = 0; q < 2; ++q) {
                const int m = m0 + q * NGW;
                if (m < MT) {
#pragma unroll
                    for (int j = 0; j < 4; ++j) s[q] += (v[q][j][0] * v[q][j][0] + v[q][j][1] * v[q][j][1]) + (v[q][j][2] * v[q][j][2] + v[q][j][3] * v[q][j][3]);
#pragma unroll
                    for (int o = 1; o < 64; o <<= 1) s[q] += __shfl_xor(s[q], o);
                    u32x2* o8 = (u32x2*)(XB + (size_t)m * DM) + lane;
#pragma unroll
                    for (int j = 0; j < 4; ++j) { u32x2 w; w.x = pk2(v[q][j][0], v[q][j][1]); w.y = pk2(v[q][j][2], v[q][j][3]); o8[64 * j] = w; }
                    if (lane == 0) SS[m] = s[q];
                }
            }
        }
        const int gt = bx * 512 + tid, NGT = G * 512;
        for (int i = gt; i < 4 * MT; i += NGT) SS[MT + i] = 0.f;
        conv_cache(in_ptr(4), in_ptr(5), (bf16_t*)(ws + WS_CKB), 0, gt, NGT);
        for (int i = gt; i < 2080 * 32; i += NGT) {
            const int pi = i >> 5, f = i & 31; const int pos = pi < 2048 ? pi : 4096 + (pi - 2048);
            const float inv_freq = (float)exp(-(double)f * (9.210340371976184 / 32.0));
            const float ang = (float)pos * inv_freq;
            double rev = (double)ang * 0.15915494309189535; rev -= rint(rev);
            const float rf = (float)rev;
            ROPE[(size_t)pi * 64 + f] = __builtin_amdgcn_cosf(rf); ROPE[(size_t)pi * 64 + 32 + f] = __builtin_amdgcn_sinf(rf);
        }
    }
    if (G == 0x7fffffff) grid.sync();
    xcd_barrier(xbar);

    for (int l = 0; l < 2; ++l) {
        {
            LANE_TID();
            unsigned char* ws = ws_ptr();
            const bool split = (Gq == 256); const int GG = split ? Gq - CONV_WGS : Gq;
            if (split && bxq >= GG) {
                LAS float* scr = (LAS float*)(lds + wave * WAVE_LDS);
                constexpr int J_OUT = 32 * 8, J_UP = 32 * 32;
                for (int it = (bxq - GG) * 8 + wave; it < J_OUT + J_UP; it += CONV_WGS * 8) {
                    if (it < J_OUT) tr_item128(in_ptr(15) + (size_t)l * DM * DM, DM, DM, (bf16_t*)(ws + WS_WOUT) + (size_t)l * DM * DM, it / 8, it % 8, nullptr, scr, lane);
                    else { const int r = it - J_OUT; tr_item128(in_ptr(16) + (size_t)l * DM * DFF, DM, DFF, (bf16_t*)(ws + WS_WUP) + (size_t)l * DFF * DM, r / 32, r % 32, in_ptr(7) + l * DM, scr, lane); }
                }
            } else {
            pg8::Gemm g{(const bf16_t*)(ws + WS_B), (const bf16_t*)(ws + WS_WIN) + (size_t)l * PS * DM, MP, PS, DM}; pg8::StaticOrder S; S.init(MP, PS, GG, bxq);
            pg8::EpiIn E{(bf16_t*)(ws + WS_A), (float*)(ws + WS_LOWF), (const float*)(ws + WS_SS) + (size_t)(2 * l) * MT, out_ptr(), (long long)(O_KP + (size_t)l * 2097152), (long long)(O_VP + (size_t)l * 2097152), (long long)(O_KS + (size_t)l * 131072), (long long)(O_VS + (size_t)l * 131072)};
            pg8::gemm_phase<pg8::EpiIn, pg8::StaticOrder, true, true>(lds, g, S, E, tid);
            if (PROBE_IN2) pg8::gemm_phase<pg8::EpiIn, pg8::StaticOrder, true, true>(lds, g, S, E, tid);
            {
                float* outp = out_ptr();
                SArgs a{}; a.A = (const bf16_t*)(ws + WS_B) + (size_t)MP * DM; a.Bt = (const bf16_t*)(ws + WS_WIN) + (size_t)l * PS * DM; a.K = DM; a.nunits = 4 * 57;
                a.obf = (bf16_t*)(ws + WS_A) + (size_t)MP * PS; a.ldo = PS; a.ss_in = (const float*)(ws + WS_SS) + (size_t)(2 * l) * MT + MP; a.lowf = (float*)(ws + WS_LOWF) + (size_t)MP * 16;
                a.ksout = outp + O_KS + (size_t)l * 131072; a.vsout = outp + O_VS + (size_t)l * 131072;
                int ub, us; sample_share((MP / 256) * (PS / 256), GG, bxq, ub, us);
                sample_gemm<SK_IN>(lds, a, ub, us, wave, lane);
            }
            if (l == 1) conv_cache(in_ptr(4), in_ptr(5), (bf16_t*)(ws + WS_CKB), 1, bxq * 512 + tid, GG * 512);
            }
        }
        xcd_barrier(xbar);
        {
            LANE_TID();
            { const float* rb = in_ptr(14) + (size_t)l * 8 * NREL; for (int i = tid; i < 8 * NREV; i += 512) { const int hh = i / NREV, j = i % NREV; int k = 382 - j; k = k < 0 ? 0 : (k > NREL - 1 ? NREL - 1 : k); biasT[i] = rb[hh * NREL + k] * 1.4426950408889634f; } }
            __syncthreads();
        }
#define MAKE_CTX() LANE_TID(); int wv = wave; asm volatile("" : "+s"(wv)); unsigned char* ws = ws_ptr(); Ctx C; C.l = l; C.lane = lane; C.kq = lane >> 5; C.li = lane & 31; C.proj = (const bf16_t*)(ws + WS_A); C.lowf = (const float*)(ws + WS_LOWF); \
        C.rope = (const float*)(ws + WS_ROPE); C.cat = (bf16_t*)(ws + WS_B); C.kvt = (float*)(ws + WS_C); C.gdec = (float*)(ws + WS_G); C.out = out_ptr(); \
        C.wa2 = in_ptr(10) + (size_t)l * 16 * 256; C.ba = in_ptr(11) + l * 256; C.nw = (wv < 4 ? in_ptr(12) : in_ptr(13)) + l * 256; C.st = (wv < 4 ? in_ptr(2) : in_ptr(3)); C.ckb = (const bf16_t*)(ws + WS_CKB); C.cvb = C.ckb + CACHE_ELEMS; \
        __builtin_amdgcn_sched_barrier(0)
        for (int rep = 0; rep < 1 + PROBE_M1X2; ++rep)
        for (int u = bx; u < 256; u += G) {
            const int b = u & 7, n = u >> 3;
            for (int rk = 0; rk < 1 + PROBE_KVX2; ++rk) { MAKE_CTX(); kv_local<false>(C, wv >> 2, b, n, wv & 3, wl); }
            for (int ra = 0; ra < 1 + PROBE_ATX2; ++ra) { MAKE_CTX(); attn_wave<false>(C, b, n, wave, wl, biasT + wave * NREV, biasT[wave * NREV]); }
            if (n == 0) { MAKE_CTX(); attn_wave<true>(C, b, 0, wave, wl, biasT + wave * NREV, biasT[wave * NREV]); }
            if (n == 1) { MAKE_CTX(); mix_out<true>(C, wv >> 2, b, 0, wv & 3, wl); }
            if (n == 2) { MAKE_CTX(); kv_local<true>(C, wv >> 2, b, 0, wv & 3, wl); }
        }
        xcd_barrier(xbar);
        {
            LANE_TID();
            float* KVT = (float*)WSP(WS_C); const float* GDEC = (const float*)WSP(WS_G); float* outp = out_ptr();
            for (int it = bx * 512 + tid; it < 131072; it += G * 512) {
                const int seq = it >> 11, e2 = it & 2047, type = seq >> 5, b = (seq >> 2) & 7, h = seq & 3;
                const int dv = e2 >> 5, dk = (2 * e2) & 63;
                float* base = KVT + (size_t)seq * 32 * 4096 + 2 * e2;
                const float dret = exp2f(ret_lg2(h) * 64.0f);
                const float* gd = GDEC + (size_t)((b * 4 + h) * 32) * 64 + dk;
                f32x2 kvv[32], dd[32];
#pragma unroll
                for (int c = 0; c < 32; ++c) kvv[c] = *(const f32x2*)(base + (size_t)c * 4096);
                if (type == 1) {
#pragma unroll
                    for (int c = 0; c < 32; ++c) dd[c] = *(const f32x2*)(gd + c * 64);
                } else {
#pragma unroll
                    for (int c = 0; c < 32; ++c) dd[c] = (f32x2){dret, dret};
                }
                f32x2 s = (f32x2){0.f, 0.f};
#pragma unroll
                for (int c = 0; c < 32; ++c) { *(f32x2*)(base + (size_t)c * 4096) = s; s = dd[c] * s + kvv[c]; }
                float* so = outp + (type == 0 ? O_RETP : O_GLAP) + (size_t)((l * 8 + b) * 4 + h) * 4096;
                so[dk * 64 + dv] = s[0]; so[(dk + 1) * 64 + dv] = s[1];
            }
        }
        xcd_barrier(xbar);
        for (int rep = 0; rep < 1 + PROBE_M3X2; ++rep)
        for (int u = bx; u < 256; u += G) { MAKE_CTX(); mix_out<false>(C, wv >> 2, u & 7, u >> 3, wv & 3, wl); }
        xcd_barrier(xbar);
        {
            LANE_TID();
            unsigned char* ws = ws_ptr(); float* XR = out_ptr() + O_Y;
            const float* x_prompt = in_ptr(0); const float* x_sample = in_ptr(1);
            pg8::Gemm g{(const bf16_t*)(ws + WS_B), (const bf16_t*)(ws + WS_WOUT) + (size_t)l * DM * DM, MP, DM, DM}; pg8::StaticOrder S; S.init(MP, DM, Gq, bxq);
            pg8::EpiRes E{l == 0 ? x_prompt : XR, l == 0 ? (long long)((const char*)x_sample - (const char*)x_prompt) : (long long)MP * DM * 4, XR, (bf16_t*)(ws + WS_C), (float*)(ws + WS_SS) + (size_t)(2 * l + 1) * MT};
            pg8::gemm_phase<pg8::EpiRes, pg8::StaticOrder, true, true>(lds, g, S, E, tid);
            {
                SArgs a{}; a.A = (const bf16_t*)(ws + WS_B) + (size_t)MP * DM; a.Bt = (const bf16_t*)(ws + WS_WOUT) + (size_t)l * DM * DM; a.K = DM; a.nunits = 4 * 16;
                a.obf = (bf16_t*)(ws + WS_C) + (size_t)MP * DM; a.ldo = DM; a.ss_out = (float*)(ws + WS_SS) + (size_t)(2 * l + 1) * MT + MP;
                a.xold = l == 0 ? x_sample : XR + (size_t)MP * DM; a.xr = XR + (size_t)MP * DM;
                int ub, us; sample_share((MP / 256) * (DM / 256), Gq, bxq, ub, us);
                sample_gemm<SK_RES>(lds, a, ub, us, wave, lane);
                const int nsamp = a.nunits < Gq ? a.nunits : Gq;
                if (Gq == 256 && bxq >= nsamp) {
                    LAS float* scr = (LAS float*)(lds + wave * WAVE_LDS);
                    for (int it = (bxq - nsamp) * 8 + wave; it < 128 * 8; it += (Gq - nsamp) * 8)
                        tr_item128(in_ptr(17) + (size_t)l * DFF * DM, DFF, DM, (bf16_t*)(ws + WS_WDN) + (size_t)l * DM * DFF, it / 8, it % 8, nullptr, scr, lane);
                }
            }
        }
        xcd_barrier(xbar);
        {
            LANE_TID();
            unsigned char* ws = ws_ptr();
            pg8::Gemm g{(const bf16_t*)(ws + WS_C), (const bf16_t*)(ws + WS_WUP) + (size_t)l * DFF * DM, MP, DFF, DM}; pg8::StaticOrder S; S.init(MP, DFF, Gq, bxq);
            pg8::EpiUp E{(bf16_t*)(ws + WS_A), (const float*)(ws + WS_SS) + (size_t)(2 * l + 1) * MT, DFF};
            pg8::gemm_phase<pg8::EpiUp, pg8::StaticOrder, true, true>(lds, g, S, E, tid);
            if (PROBE_UP2) pg8::gemm_phase<pg8::EpiUp, pg8::StaticOrder, true, true>(lds, g, S, E, tid);
            if (PROBE_UP2B) { xcd_barrier(xbar); pg8::gemm_phase<pg8::EpiUp, pg8::StaticOrder, true, true>(lds, g, S, E, tid); }
            {
                SArgs a{}; a.A = (const bf16_t*)(ws + WS_C) + (size_t)MP * DM; a.Bt = (const bf16_t*)(ws + WS_WUP) + (size_t)l * DFF * DM; a.K = DM; a.nunits = 4 * 64;
                a.obf = (bf16_t*)(ws + WS_A) + (size_t)MP * DFF; a.ldo = DFF; a.ss_in = (const float*)(ws + WS_SS) + (size_t)(2 * l + 1) * MT + MP;
                int ub, us; sample_share((MP / 256) * (DFF / 256), Gq, bxq, ub, us);
                sample_gemm<SK_UP>(lds, a, ub, us, wave, lane);
            }
        }
        xcd_barrier(xbar);
        {
            LANE_TID();
            unsigned char* ws = ws_ptr(); float* XR = out_ptr() + O_Y;
            pg8::Gemm g{(const bf16_t*)(ws + WS_A), (const bf16_t*)(ws + WS_WDN) + (size_t)l * DM * DFF, MP, DM, DFF}; pg8::StaticOrder S; S.init(MP, DM, Gq, bxq);
            if (PROBE_DN2) { pg8::EpiUp E2{(bf16_t*)(ws + WS_C), (const float*)(ws + WS_SS) + (size_t)(2 * l + 1) * MT, DM}; pg8::gemm_phase<pg8::EpiUp, pg8::StaticOrder, true, true>(lds, g, S, E2, tid); }
            pg8::EpiRes E{XR, (long long)MP * DM * 4, XR, l == 0 ? (bf16_t*)(ws + WS_B) : (bf16_t*)nullptr, (float*)(ws + WS_SS) + (size_t)(2 * l + 2) * MT};
            pg8::gemm_phase<pg8::EpiRes, pg8::StaticOrder, true, true>(lds, g, S, E, tid);
            {
                SArgs a{}; a.A = (const bf16_t*)(ws + WS_A) + (size_t)MP * DFF; a.Bt = (const bf16_t*)(ws + WS_WDN) + (size_t)l * DM * DFF; a.K = DFF; a.nunits = 4 * 16;
                a.obf = l == 0 ? (bf16_t*)(ws + WS_B) + (size_t)MP * DM : (bf16_t*)nullptr; a.ldo = DM; a.ss_out = (float*)(ws + WS_SS) + (size_t)(2 * l + 2) * MT + MP;
                a.xold = XR + (size_t)MP * DM; a.xr = XR + (size_t)MP * DM;
                int ub, us; sample_share((MP / 256) * (DM / 256), Gq, bxq, ub, us);
                sample_gemm<SK_RES>(lds, a, ub, us, wave, lane);
            }
        }
        xcd_barrier(xbar);
    }
    for (int i = 0; i < PROBE_SYNCS; ++i) xcd_barrier(xbar);
    {
        LANE_TID();
        const int gw = bx * 8 + wave, NGW = G * 8;
        const float* fw = in_ptr(8); const float* SS = (const float*)WSP(WS_SS); float* XR = out_ptr() + O_Y;
        f32x4 w4[4];
#pragma unroll
        for (int j = 0; j < 4; ++j) w4[j] = *((const f32x4*)fw + lane + 64 * j);
        for (int m0 = gw; m0 < MT; m0 += 2 * NGW) {
            f32x4 v[2][4]; float rs[2];
#pragma unroll
            for (int q = 0; q < 2; ++q) {
                const int m = m0 + q * NGW;
                if (m < MT) {
                    rs[q] = SS[(size_t)4 * MT + m];
                    const f32x4* xr = (const f32x4*)(XR + (size_t)m * DM) + lane;
#pragma unroll
                    for (int j = 0; j < 4; ++j) v[q][j] = xr[64 * j];
                }
            }
#pragma unroll
            for (int q = 0; q < 2; ++q) {
                const int m = m0 + q * NGW;
                if (m < MT) {
                    const float r = 1.0f / sqrtf(rs[q] * (1.0f / 1024.0f) + EPS);
                    f32x4* xr = (f32x4*)(XR + (size_t)m * DM) + lane;
#pragma unroll
                    for (int j = 0; j < 4; ++j) xr[64 * j] = v[q][j] * r * w4[j];
                }
            }
        }
    }
}

extern "C" void kernel_launch(void* const* d_in, const int* in_sizes, int n_in, void* d_out, int out_size, void* d_ws, size_t ws_size, hipStream_t stream) {
    static int grid = 0;
    if (grid == 0) {
        if (n_in != 18 || (size_t)out_size != O_END || ws_size < WS_END) { fprintf(stderr, "kernel_launch: unexpected shapes: n_in %d out %d ws %zu (need %zu)\n", n_in, out_size, ws_size, (size_t)WS_END); grid = -1; return; }
        int dev = 0, cus = 0, per_cu = 0;
        hipGetDevice(&dev); hipDeviceGetAttribute(&cus, hipDeviceAttributeMultiprocessorCount, dev);
        if (hipFuncSetAttribute((const void*)hybrid_fwd, hipFuncAttributeMaxDynamicSharedMemorySize, LDS_BYTES) != hipSuccess) { fprintf(stderr, "kernel_launch: hipFuncSetAttribute failed\n"); }
        if (hipOccupancyMaxActiveBlocksPerMultiprocessor(&per_cu, (const void*)hybrid_fwd, 512, LDS_BYTES) != hipSuccess || per_cu < 1) { fprintf(stderr, "kernel_launch: occupancy query says %d\n", per_cu); per_cu = 1; }
        (void)hipGetLastError();
        grid = cus * per_cu;
        if (grid > 256) grid = 256;
    }
    if (grid < 0) return;
    if (hipMemsetAsync((unsigned char*)d_ws + WS_CTL, 0, CTL_BYTES, stream) != hipSuccess) { fprintf(stderr, "kernel_launch: memset of the barrier words failed\n"); return; }
    Params p{};
    for (int i = 0; i < 18; ++i) p.in[i] = (const float*)d_in[i];
    p.out = (float*)d_out; p.ws = (unsigned char*)d_ws;
    void* args[] = {&p};
    hipError_t e = hipLaunchCooperativeKernel((const void*)hybrid_fwd, dim3(grid), dim3(512), args, LDS_BYTES, stream);
    if (e != hipSuccess) fprintf(stderr, "kernel_launch: cooperative launch failed: %s (grid %d)\n", hipGetErrorString(e), grid);
}
```

```cpp
#include <hip/hip_runtime.h>
#include <hip/hip_cooperative_groups.h>
#include <cstdio>
#include <cstdint>
namespace cg = cooperative_groups;
#ifndef PROBE_UP2
#define PROBE_UP2 0
#endif
#ifndef PROBE_M1X2
#define PROBE_M1X2 0
#endif
#ifndef PROBE_P0X2
#define PROBE_P0X2 0
#endif
#ifndef PROBE_SYNCS
#define PROBE_SYNCS 0
#endif
#ifndef PROBE_IN2
#define PROBE_IN2 0
#endif
#ifndef PROBE_DN2
#define PROBE_DN2 0
#endif
#ifndef PROBE_UP2B
#define PROBE_UP2B 0
#endif
#ifndef PROBE_KVX2
#define PROBE_KVX2 0
#endif
#ifndef PROBE_ATX2
#define PROBE_ATX2 0
#endif
#ifndef PROBE_M3X2
#define PROBE_M3X2 0
#endif
namespace pg8 {
#define PG8_LAS __attribute__((address_space(3)))
typedef unsigned short bf16_t;
typedef short bf16x8 __attribute__((ext_vector_type(8)));
typedef float f32x4 __attribute__((ext_vector_type(4)));
typedef unsigned u32x4 __attribute__((ext_vector_type(4)));
constexpr int BM = 256, BK = 64, HALF = 128, HTB = HALF * BK * 2  , STAGE_BYTES = 8 * HTB, NXCD = 8, WGM = 8;

__host__ __device__ __forceinline__ int lds_byte(int r, int c) { const int st = (r >> 4) * 2 + (c >> 5), rr = r & 15, cc = c & 31, ob = rr * 64 + cc * 2; return st * 1024 + (ob ^ (((ob >> 9) & 1) << 5)); }
__host__ __device__ __forceinline__ void stage_rc(int b, int& R, int& C) { const int st = b / 1024, sb = b % 1024, swz = sb ^ (((sb >> 9) & 1) << 5); R = (st >> 1) * 16 + swz / 64; C = (st & 1) * 32 + (swz % 64) / 2; }
__host__ __device__ __forceinline__ int perm32(int rho) { const int n = rho >> 4, i = rho & 15; return 8 * (i >> 2) + 4 * n + (i & 3); }

struct Unit { int pm, pn; };
struct Gemm { const bf16_t* A; const bf16_t* Bt; int M, N, K; };

struct StaticOrder {
    int nM, nN, nwg, G, c;
    __host__ __device__ __forceinline__ void init(int M, int N, int G_, int c_) { nM = M / BM; nN = N / BM; nwg = nM * nN; G = G_; c = c_; }
    __host__ __device__ __forceinline__ bool next(int i, Unit& u) const {
        const long L = (long)i * G + c; if (L >= nwg) return false;
        int wgid = (int)L; { const int q = nwg / NXCD, r = nwg % NXCD, xcd = wgid % NXCD, off = wgid / NXCD; wgid = (xcd < r ? xcd * (q + 1) : r * (q + 1) + (xcd - r) * q) + off; }
        const int nig = WGM * nN, gid = wgid / nig, fm = gid * WGM, gsz = (nM - fm) < WGM ? (nM - fm) : WGM;
        u.pm = fm + ((wgid % nig) % gsz); u.pn = (wgid % nig) / gsz; return true;
    }
    __device__ __forceinline__ void a_ready(const Unit&) const {}
    __device__ __forceinline__ void done(const Unit&) const {}
};

__device__ __forceinline__ unsigned cvt_pk_bf16(float lo, float hi) { unsigned r; asm volatile("v_cvt_pk_bf16_f32 %0, %1, %2" : "=v"(r) : "v"(lo), "v"(hi)); return r; }
typedef float f32x2 __attribute__((ext_vector_type(2)));

typedef unsigned u32x2 __attribute__((ext_vector_type(2)));
constexpr int E_MP = 16384;
struct EpiIn {
    static constexpr bool PERM = true, AFTER_DRAIN = false;
    bf16_t* proj; float* lowf; const float* ss; float* out; long long okp, ovp, oks, ovs;
    __device__ __forceinline__ void operator()(const f32x4 (&acc)[2][2][4][2], const Unit& u, int wr, int wc, int fr, int fq) const {
        const int row0 = u.pm * BM + wr * 64 + fr, col0 = u.pn * BM + wc * 32 + 8 * fq;
        float* kv = nullptr; int rsub = 0, cbase = 0;
        if (u.pn >= 10 && u.pn < 14) {
            const bool isk = u.pn < 12; cbase = isk ? 2560 : 3072;
            if (u.pm >= 64) { kv = out + (isk ? oks : ovs); rsub = E_MP; }
            else if ((u.pm & 7) >= 6) { kv = out + (isk ? okp : ovp); rsub = 1536 * ((u.pm >> 3) + 1); }
        }
        const bool lowt = (u.pn == 14) && (wc == 0) && (fq < 2);
#pragma unroll
        for (int ai = 0; ai < 2; ++ai)
#pragma unroll
            for (int m = 0; m < 4; ++m) {
                const int r = row0 + ai * HALF + m * 16;
                const float rs = 1.0f / sqrtf(ss[r] * (1.0f / 1024.0f) + 1e-6f);
                bf16_t* rowp = proj + (size_t)r * 3840 + col0;
#pragma unroll
                for (int bj = 0; bj < 2; ++bj) {
                    const f32x4 v0 = acc[ai][bj][m][0] * rs, v1 = acc[ai][bj][m][1] * rs;
                    u32x4 w; w.x = cvt_pk_bf16(v0[0], v0[1]); w.y = cvt_pk_bf16(v0[2], v0[3]); w.z = cvt_pk_bf16(v1[0], v1[1]); w.w = cvt_pk_bf16(v1[2], v1[3]);
                    *(u32x4*)(rowp + bj * HALF) = w;
                    if (kv) { float* d = kv + (size_t)(r - rsub) * 512 + (col0 + bj * HALF - cbase); *(f32x4*)d = v0; *(f32x4*)(d + 4) = v1; }
                    if (lowt && bj == 0) { float* d = lowf + (size_t)r * 16 + 8 * fq; *(f32x4*)d = v0; *(f32x4*)(d + 4) = v1; }
                }
            }
    }
};
struct EpiRes {
    static constexpr bool PERM = true, AFTER_DRAIN = false;
    const float* xold_p; long long sdelta; float* xr; bf16_t* xb; float* ss;
    __device__ __forceinline__ void operator()(const f32x4 (&acc)[2][2][4][2], const Unit& u, int wr, int wc, int fr, int fq) const {
        const int row0 = u.pm * BM + wr * 64 + fr, col0 = u.pn * BM + wc * 32 + 8 * fq;
#pragma unroll
        for (int ai = 0; ai < 2; ++ai)
#pragma unroll
            for (int m = 0; m < 4; ++m) {
                const int r = row0 + ai * HALF + m * 16;
                const long long xoff = (u.pm < 64) ? (long long)r * 4096 : sdelta + (long long)(r - E_MP) * 4096;
                const float* xo = (const float*)((const char*)xold_p + xoff) + col0;
                float* xn = xr + (size_t)r * 1024 + col0;
                float sq = 0.f;
#pragma unroll
                for (int bj = 0; bj < 2; ++bj) {
                    const f32x4 v0 = acc[ai][bj][m][0] + *(const f32x4*)(xo + bj * HALF), v1 = acc[ai][bj][m][1] + *(const f32x4*)(xo + bj * HALF + 4);
                    *(f32x4*)(xn + bj * HALF) = v0; *(f32x4*)(xn + bj * HALF + 4) = v1;
                    sq += (v0[0] * v0[0] + v0[1] * v0[1]) + (v0[2] * v0[2] + v0[3] * v0[3]) + (v1[0] * v1[0] + v1[1] * v1[1]) + (v1[2] * v1[2] + v1[3] * v1[3]);
                    if (xb) { u32x4 w; w.x = cvt_pk_bf16(v0[0], v0[1]); w.y = cvt_pk_bf16(v0[2], v0[3]); w.z = cvt_pk_bf16(v1[0], v1[1]); w.w = cvt_pk_bf16(v1[2], v1[3]);
                        *(u32x4*)(xb + (size_t)r * 1024 + col0 + bj * HALF) = w; }
                }
                sq += __shfl_xor(sq, 16); sq += __shfl_xor(sq, 32);
                if (fq == 0) atomicAdd(ss + r, sq);
            }
    }
};
struct EpiUp {
    static constexpr bool PERM = true, AFTER_DRAIN = false;
    bf16_t* U; const float* ss; int ldu;
    __device__ __forceinline__ void operator()(const f32x4 (&acc)[2][2][4][2], const Unit& u, int wr, int wc, int fr, int fq) const {
        const int row0 = u.pm * BM + wr * 64 + fr, col0 = u.pn * BM + wc * 32 + 8 * fq;
#pragma unroll
        for (int ai = 0; ai < 2; ++ai)
#pragma unroll
            for (int m = 0; m < 4; ++m) {
                const int r = row0 + ai * HALF + m * 16;
                const float rs = 1.0f / sqrtf(ss[r] * (1.0f / 1024.0f) + 1e-6f);
                bf16_t* rowp = U + (size_t)r * ldu + col0;
#pragma unroll
                for (int bj = 0; bj < 2; ++bj) {
                    f32x4 v0 = acc[ai][bj][m][0] * rs, v1 = acc[ai][bj][m][1] * rs;
#pragma unroll
                    for (int e = 0; e < 4; ++e) { const float a = fmaxf(v0[e], 0.f), b = fmaxf(v1[e], 0.f); v0[e] = a * a; v1[e] = b * b; }
                    u32x4 w; w.x = cvt_pk_bf16(v0[0], v0[1]); w.y = cvt_pk_bf16(v0[2], v0[3]); w.z = cvt_pk_bf16(v1[0], v1[1]); w.w = cvt_pk_bf16(v1[2], v1[3]);
                    *(u32x4*)(rowp + bj * HALF) = w;
                }
            }
    }
};

template <class Epi, class Sched, bool ALIGN_EPI = false, bool SP2 = false>
__device__ __forceinline__ void gemm_phase(PG8_LAS unsigned char* lds, const Gemm g, const Sched& S, const Epi& E, const int tid_in) {
    int tid_ = tid_in; asm volatile("" : "+v"(tid_));
    const int tid = tid_, wid = __builtin_amdgcn_readfirstlane(tid >> 6), lane = tid & 63, wr = wid >> 2, wc = wid & 3, fr = lane & 15, fq = lane >> 4;
    const int K = g.K, nt = K / BK;
    unsigned voffA[2], voffB[2];
#pragma unroll
    for (int i = 0; i < 2; ++i) { int R, C; stage_rc(tid * 16 + i * 8192, R, C); const int Rb = Epi::PERM ? ((R & ~31) + perm32(R & 31)) : R;
        voffA[i] = (unsigned)(R * K + C) * 2u; voffB[i] = (unsigned)(Rb * K + C) * 2u; }
    const size_t kstep = (size_t)(BK * 2);
    const size_t hstep = (size_t)HALF * K * 2;
    const size_t tstep = 2 * hstep;
    const unsigned ldsw = (unsigned)wid * 1024u;
    const int aoff = lds_byte(wr * 64 + fr, fq * 8), boff = lds_byte(wc * 32 + fr, fq * 8);
#define PG8_SA(b, h) (((b) * 2 + (h)) * HTB)
#define PG8_SB(b, h) ((4 + (b) * 2 + (h)) * HTB)
#define PG8_STAGE(bufoff, gbase, voff) do { _Pragma("unroll") for (int _i = 0; _i < 2; ++_i) \
        __builtin_amdgcn_global_load_lds((const unsigned*)((const char*)(gbase) + (voff)[_i]), (PG8_LAS unsigned*)(lds + (bufoff) + ldsw + _i * 8192), 16, 0, 0); } while (0)
#define PG8_LDA(dst, b, h) do { _Pragma("unroll") for (int m = 0; m < 4; ++m) _Pragma("unroll") for (int k = 0; k < 2; ++k) dst[m][k] = *(const PG8_LAS bf16x8*)(lds + PG8_SA(b, h) + aoff + m * 2048 + k * 1024); } while (0)
#define PG8_LDB(dst, b, h) do { _Pragma("unroll") for (int n = 0; n < 2; ++n) _Pragma("unroll") for (int k = 0; k < 2; ++k) dst[n][k] = *(const PG8_LAS bf16x8*)(lds + PG8_SB(b, h) + boff + n * 2048 + k * 1024); } while (0)
#define PG8_MMA(ai, bj, At, Bt) do { __builtin_amdgcn_s_setprio(1); _Pragma("unroll") for (int m = 0; m < 4; ++m) _Pragma("unroll") for (int n = 0; n < 2; ++n) _Pragma("unroll") for (int k = 0; k < 2; ++k) \
        acc[ai][bj][m][n] = __builtin_amdgcn_mfma_f32_16x16x32_bf16(Bt[n][k], At[m][k], acc[ai][bj][m][n], 0, 0, 0); __builtin_amdgcn_s_setprio(0); } while (0)
#define PG8_WAIT_V(n) asm volatile("s_waitcnt vmcnt(" #n ")" ::: "memory")
#define PG8_WAIT_L(n) asm volatile("s_waitcnt lgkmcnt(" #n ")" ::: "memory")
#define PG8_BAR __builtin_amdgcn_s_barrier()
#define PG8_SCHED __builtin_amdgcn_sched_barrier(0)
    Unit cur, nxt; int ui = 0;
    if (!S.next(0, cur)) return;
    f32x4 acc[2][2][4][2];
#pragma unroll
    for (int a = 0; a < 2; ++a)
#pragma unroll
        for (int b = 0; b < 2; ++b)
#pragma unroll
            for (int m = 0; m < 4; ++m)
#pragma unroll
                for (int n = 0; n < 2; ++n) acc[a][b][m][n] = (f32x4){0.f, 0.f, 0.f, 0.f};
    bf16x8 At[4][2], B0[2][2], B1[2][2];
    const char* cA = (const char*)g.A + (size_t)cur.pm * tstep; const char* cB = (const char*)g.Bt + (size_t)cur.pn * tstep;
    S.a_ready(cur);
    if constexpr (SP2) {
        PG8_STAGE(PG8_SB(0, 0), cB, voffB); PG8_STAGE(PG8_SB(0, 1), cB + hstep, voffB); PG8_STAGE(PG8_SA(0, 0), cA, voffA); PG8_STAGE(PG8_SA(0, 1), cA + hstep, voffA);
        if (wr == 1) PG8_BAR;
        PG8_WAIT_V(2); PG8_BAR;
        PG8_STAGE(PG8_SB(1, 0), cB + kstep, voffB); PG8_STAGE(PG8_SA(1, 0), cA + kstep, voffA); PG8_STAGE(PG8_SB(1, 1), cB + hstep + kstep, voffB);
        PG8_WAIT_V(6); PG8_BAR;
    } else {
        PG8_STAGE(PG8_SB(0, 0), cB, voffB); PG8_STAGE(PG8_SA(0, 0), cA, voffA); PG8_STAGE(PG8_SB(0, 1), cB + hstep, voffB); PG8_STAGE(PG8_SA(0, 1), cA + hstep, voffA);
        if (wr == 1) PG8_BAR;
        PG8_WAIT_V(4); PG8_BAR;
        PG8_STAGE(PG8_SB(1, 0), cB + kstep, voffB); PG8_STAGE(PG8_SA(1, 0), cA + kstep, voffA); PG8_STAGE(PG8_SB(1, 1), cB + hstep + kstep, voffB);
        PG8_WAIT_V(6); PG8_BAR;
    }
    for (;;) {
        const bool has_next = S.next(ui + 1, nxt);
        const char* nA = has_next ? (const char*)g.A + (size_t)nxt.pm * tstep : cA; const char* nB = has_next ? (const char*)g.Bt + (size_t)nxt.pn * tstep : cB;
        for (int t = 0; t < nt; t += 2) {
            const bool last = (t == nt - 2);
            const char* a1 = cA + (size_t)(t + 1) * kstep;
            const char* a2 = last ? nA : cA + (size_t)(t + 2) * kstep; const char* b2 = last ? nB : cB + (size_t)(t + 2) * kstep;
            const char* a3 = a2 + kstep; const char* b3 = b2 + kstep;
            if (last && has_next) S.a_ready(nxt);
            if constexpr (SP2) {
            PG8_LDB(B0, 0, 0); PG8_LDB(B1, 0, 1); PG8_SCHED; PG8_LDA(At, 0, 0); PG8_STAGE(PG8_SA(1, 1), a1 + hstep, voffA);
            PG8_WAIT_V(8); PG8_WAIT_L(0); PG8_BAR; PG8_MMA(0, 0, At, B0); PG8_MMA(0, 1, At, B1); PG8_BAR; PG8_SCHED;
            PG8_LDA(At, 0, 1); PG8_STAGE(PG8_SB(0, 0), b2, voffB); PG8_STAGE(PG8_SB(0, 1), b2 + hstep, voffB); PG8_STAGE(PG8_SA(0, 0), a2, voffA);
            PG8_WAIT_V(8); PG8_WAIT_L(0); PG8_BAR; PG8_MMA(1, 0, At, B0); PG8_MMA(1, 1, At, B1); PG8_BAR; PG8_SCHED;
            PG8_LDB(B0, 1, 0); PG8_LDB(B1, 1, 1); PG8_SCHED; PG8_LDA(At, 1, 0); PG8_STAGE(PG8_SA(0, 1), a2 + hstep, voffA);
            PG8_WAIT_V(8); PG8_WAIT_L(0); PG8_BAR; PG8_MMA(0, 0, At, B0); PG8_MMA(0, 1, At, B1); PG8_BAR; PG8_SCHED;
            PG8_LDA(At, 1, 1); PG8_STAGE(PG8_SB(1, 0), b3, voffB); PG8_STAGE(PG8_SB(1, 1), b3 + hstep, voffB); PG8_STAGE(PG8_SA(1, 0), a3, voffA);
            PG8_WAIT_V(8); PG8_WAIT_L(0); PG8_BAR; PG8_MMA(1, 0, At, B0); PG8_MMA(1, 1, At, B1); PG8_BAR; PG8_SCHED;
            } else {
            PG8_LDB(B0, 0, 0); PG8_SCHED; PG8_LDA(At, 0, 0); PG8_STAGE(PG8_SA(1, 1), a1 + hstep, voffA);
            PG8_WAIT_L(8); PG8_BAR; PG8_WAIT_L(0); PG8_MMA(0, 0, At, B0); PG8_BAR; PG8_SCHED;
            PG8_LDB(B1, 0, 1); PG8_STAGE(PG8_SB(0, 0), b2, voffB);
            PG8_BAR; PG8_WAIT_L(0); PG8_MMA(0, 1, At, B1); PG8_BAR;
            PG8_LDA(At, 0, 1); PG8_STAGE(PG8_SA(0, 0), a2, voffA);
            PG8_BAR; PG8_WAIT_L(0); PG8_MMA(1, 0, At, B0); PG8_BAR; PG8_SCHED;
            PG8_STAGE(PG8_SB(0, 1), b2 + hstep, voffB);
            PG8_WAIT_V(6); PG8_BAR; PG8_MMA(1, 1, At, B1); PG8_BAR;
            PG8_LDB(B0, 1, 0); PG8_SCHED; PG8_LDA(At, 1, 0); PG8_STAGE(PG8_SA(0, 1), a2 + hstep, voffA);
            PG8_WAIT_L(8); PG8_BAR; PG8_WAIT_L(0); PG8_MMA(0, 0, At, B0); PG8_BAR; PG8_SCHED;
            PG8_LDB(B1, 1, 1); PG8_STAGE(PG8_SB(1, 0), b3, voffB);
            PG8_BAR; PG8_WAIT_L(0); PG8_MMA(0, 1, At, B1); PG8_BAR;
            PG8_LDA(At, 1, 1); PG8_STAGE(PG8_SA(1, 0), a3, voffA);
            PG8_BAR; PG8_WAIT_L(0); PG8_MMA(1, 0, At, B0); PG8_BAR; PG8_SCHED;
            PG8_STAGE(PG8_SB(1, 1), b3 + hstep, voffB);
            PG8_WAIT_V(6); PG8_BAR; PG8_MMA(1, 1, At, B1); PG8_BAR;
            }
        }
        if constexpr (ALIGN_EPI) { if (wr == 0) PG8_BAR; }
        if constexpr (!Epi::AFTER_DRAIN) { E(acc, cur, wr, wc, fr, fq); S.done(cur); }
        if (!has_next) break;
#pragma unroll
        for (int a = 0; a < 2; ++a)
#pragma unroll
            for (int b = 0; b < 2; ++b)
#pragma unroll
                for (int m = 0; m < 4; ++m)
#pragma unroll
                    for (int n = 0; n < 2; ++n) acc[a][b][m][n] = (f32x4){0.f, 0.f, 0.f, 0.f};
        cur = nxt; cA = nA; cB = nB; ++ui;
        if constexpr (ALIGN_EPI) { if (wr == 1) PG8_BAR; }
    }
    PG8_WAIT_V(0);
    if constexpr (!ALIGN_EPI) { if (wr == 0) PG8_BAR; }
    PG8_BAR;
    if constexpr (Epi::AFTER_DRAIN) { E.fused(acc, cur, wr, wc, fr, fq, lds, wid, lane); S.done(cur); }
#undef PG8_SA
#undef PG8_SB
#undef PG8_STAGE
#undef PG8_LDA
#undef PG8_LDB
#undef PG8_MMA
#undef PG8_WAIT_V
#undef PG8_WAIT_L
#undef PG8_BAR
#undef PG8_SCHED
}
}


#define LAS __attribute__((address_space(3)))
typedef unsigned short bf16_t;
typedef short bf16x8 __attribute__((ext_vector_type(8)));
typedef short s16x4 __attribute__((ext_vector_type(4)));
typedef short v4i16_t __attribute__((ext_vector_type(4)));
typedef float f32x4 __attribute__((ext_vector_type(4)));
typedef float f32x2 __attribute__((ext_vector_type(2)));
typedef float f32x16 __attribute__((ext_vector_type(16)));
typedef unsigned u32x4 __attribute__((ext_vector_type(4)));
typedef unsigned u32x2 __attribute__((ext_vector_type(2)));

constexpr int DM = 1024, NB = 8, SEQ = 2048, MP = NB * SEQ, SL = 32, MS = NB * SL, MT = MP + MS;
constexpr int PS = 3840, DFF = 4096, INCOLS = 3600;
constexpr int C_QA = 0, C_KA = 256, C_VA = 512, C_GA = 768, C_QB = 1024, C_KB = 1280, C_VB = 1536, C_GB = 1792, C_QC = 2048, C_KC = 2560, C_VC = 3072, C_LOW = 3584;
constexpr int NREL = 320;
constexpr float EPS = 1e-6f;
constexpr size_t WS_A = 0;
constexpr size_t WS_B = WS_A + (size_t)MT * DFF * 2;
constexpr size_t WS_C = WS_B + (size_t)MT * DM * 2;
constexpr size_t WS_WIN = WS_C + (size_t)MT * DM * 2;
constexpr size_t WS_WOUT = WS_WIN + (size_t)2 * PS * DM * 2;
constexpr size_t WS_WUP = WS_WOUT + (size_t)2 * DM * DM * 2;
constexpr size_t WS_WDN = WS_WUP + (size_t)2 * DFF * DM * 2;
constexpr size_t WS_LOWF = WS_WDN + (size_t)2 * DFF * DM * 2;
constexpr size_t WS_SS = WS_LOWF + (size_t)MT * 16 * 4;
constexpr size_t WS_G = WS_SS + (size_t)5 * MT * 4;
constexpr size_t WS_ROPE = WS_G + (size_t)1024 * 64 * 4;
constexpr size_t WS_CTL = WS_ROPE + (size_t)2080 * 64 * 4;
constexpr size_t CTL_BYTES = 16384;
constexpr size_t WS_END = WS_CTL + CTL_BYTES;
static_assert((size_t)2048 * 4096 * 4 <= (size_t)MT * DM * 2, "KVT fits region C");
constexpr size_t WS_CKB = WS_A + (size_t)MT * PS * 2;
constexpr size_t CACHE_ELEMS = (size_t)8 * 512 * 512;
static_assert(WS_CKB + 2 * CACHE_ELEMS * 2 <= WS_B, "cache copies fit behind PROJ");
static_assert(WS_END <= (size_t)256 * 1024 * 1024, "d_ws map");
constexpr size_t O_Y = 0, O_RETP = (size_t)MT * DM, O_GLAP = O_RETP + 262144, O_KP = O_GLAP + 262144, O_VP = O_KP + 4194304, O_RETS = O_VP + 4194304, O_GLAS = O_RETS + 262144,
                 O_KS = O_GLAS + 262144, O_VS = O_KS + 262144, O_END = O_VS + 262144;
constexpr int TS = 144;
constexpr int TILE_B = 64 * TS;
constexpr int WAVE_LDS = 2 * TILE_B;
constexpr int LDS_BIAS = 8 * WAVE_LDS;
constexpr int NREV = 384;
constexpr int LDS_BARST = LDS_BIAS + 8 * NREV * 4;
constexpr int LDS_BYTES = LDS_BARST + 16;
static_assert(LDS_BYTES <= 160 * 1024 && pg8::STAGE_BYTES <= LDS_BIAS, "LDS map");

struct Params { const float* in[18]; float* out; unsigned char* ws; };
__device__ __forceinline__ int lane_id_asm() { int l; asm volatile("v_mbcnt_lo_u32_b32 %0, -1, 0\n\tv_mbcnt_hi_u32_b32 %0, -1, %0" : "=v"(l)); return l; }
typedef const __attribute__((address_space(4))) char* kaptr_t;
__device__ __forceinline__ kaptr_t karg_base() { kaptr_t ka = (kaptr_t)__builtin_amdgcn_kernarg_segment_ptr(); asm volatile("" : "+s"(ka)); return ka; }
__device__ __forceinline__ const float* in_ptr(int i) { return *(const float* const __attribute__((address_space(4)))*)(karg_base() + 8 * i); }
__device__ __forceinline__ float* out_ptr() { return *(float* const __attribute__((address_space(4)))*)(karg_base() + 8 * 18); }
__device__ __forceinline__ unsigned char* ws_ptr() { return *(unsigned char* const __attribute__((address_space(4)))*)(karg_base() + 8 * 19); }

typedef float f32x2_t __attribute__((ext_vector_type(2))); typedef __bf16 bf16x2_t __attribute__((ext_vector_type(2)));
__device__ __forceinline__ unsigned pk2(float lo, float hi) { const f32x2_t v = {lo, hi}; const bf16x2_t b = __builtin_convertvector(v, bf16x2_t); return __builtin_bit_cast(unsigned, b); }
__device__ __forceinline__ float bflo(unsigned u) { return __uint_as_float(u << 16); }
__device__ __forceinline__ float bfhi(unsigned u) { return __uint_as_float(u & 0xffff0000u); }
__device__ __forceinline__ float bf2f(bf16_t h) { return __uint_as_float((unsigned)h << 16); }
__device__ __forceinline__ bf16_t f2bf(float f) { return (bf16_t)(pk2(f, 0.f) & 0xffffu); }
__device__ __forceinline__ int crow(int r, int hi) { return (r & 3) + 8 * (r >> 2) + 4 * hi; }
__device__ __forceinline__ float silu(float x) { return x / (1.0f + __expf(-x)); }
__device__ __forceinline__ f32x16 mfma32(bf16x8 a, bf16x8 b, f32x16 c) { return __builtin_amdgcn_mfma_f32_32x32x16_bf16(a, b, c, 0, 0, 0); }
__device__ __forceinline__ bf16x8 as_bf16x8(u32x4 v) { return __builtin_bit_cast(bf16x8, v); }
__device__ __forceinline__ f32x16 zero16() { f32x16 z;
#pragma unroll
    for (int i = 0; i < 16; ++i) z[i] = 0.f; return z; }
__device__ __forceinline__ s16x4 ds_tr(LAS const unsigned char* p) { return __builtin_bit_cast(s16x4, __builtin_amdgcn_ds_read_tr16_b64_v4i16((LAS v4i16_t*)p)); }
__device__ __forceinline__ bf16x8 tr_nat(LAS const unsigned char* tile, int k0, int cb, int lane) {
    const int kq = lane >> 5, g = (lane >> 4) & 1, q = (lane & 15) >> 2, p = lane & 3;
    LAS const unsigned char* a = tile + (k0 + 8 * kq + q) * TS + (cb + 16 * g + 4 * p) * 2;
    const s16x4 lo = ds_tr(a), hi = ds_tr(a + 4 * TS);
    return (bf16x8){lo[0], lo[1], lo[2], lo[3], hi[0], hi[1], hi[2], hi[3]};
}
template <int STR = TS> __device__ __forceinline__ bf16x8 tr_perm(LAS const unsigned char* tile, int k0, int cb, int lane) {
    const int kq = lane >> 5, g = (lane >> 4) & 1, q = (lane & 15) >> 2, p = lane & 3;
    LAS const unsigned char* a = tile + (k0 + 4 * kq + q) * STR + (cb + 16 * g + 4 * p) * 2;
    const s16x4 lo = ds_tr(a), hi = ds_tr(a + 8 * STR);
    return (bf16x8){lo[0], lo[1], lo[2], lo[3], hi[0], hi[1], hi[2], hi[3]};
}
__device__ __forceinline__ bf16x8 row_frag(LAS const unsigned char* tile, int r0, int ks, int lane) {
    return *(LAS const bf16x8*)(tile + (r0 + (lane & 31)) * TS + (16 * ks + 8 * (lane >> 5)) * 2);
}
__device__ __forceinline__ bf16x8 pack_step(const f32x16& x, int s) {
    u32x4 w; w.x = pk2(x[8 * s + 0], x[8 * s + 1]); w.y = pk2(x[8 * s + 2], x[8 * s + 3]); w.z = pk2(x[8 * s + 4], x[8 * s + 5]); w.w = pk2(x[8 * s + 6], x[8 * s + 7]);
    return as_bf16x8(w);
}
__device__ __forceinline__ void load_tile(LAS unsigned char* tile, const bf16_t* src, int pitch, int nvalid, int lane) {
#pragma unroll
    for (int it = 0; it < 8; ++it) {
        const int id = it * 64 + lane, row = id >> 3, ch = id & 7;
        u32x4 v = (u32x4){0u, 0u, 0u, 0u};
        if (row < nvalid) v = *(const u32x4*)(src + (size_t)row * pitch + ch * 8);
        *(LAS u32x4*)(tile + row * TS + ch * 16) = v;
    }
}
__device__ __forceinline__ void store_tile(LAS const unsigned char* tile, bf16_t* dst, int pitch, int nvalid, int lane) {
#pragma unroll
    for (int it = 0; it < 8; ++it) {
        const int id = it * 64 + lane, row = id >> 3, ch = id & 7;
        const u32x4 v = *(LAS const u32x4*)(tile + row * TS + ch * 16);
        if (row < nvalid) *(u32x4*)(dst + (size_t)row * pitch + ch * 8) = v;
    }
}
__device__ __forceinline__ void load_tile_f32(LAS unsigned char* tile, const float* src, int pitch, int lane) {
#pragma unroll
    for (int it = 0; it < 16; ++it) {
        const int id = it * 64 + lane, row = id >> 4, c4 = id & 15;
        const f32x4 v = *(const f32x4*)(src + (size_t)row * pitch + c4 * 4);
        u32x2 w; w.x = pk2(v[0], v[1]); w.y = pk2(v[2], v[3]);
        *(LAS u32x2*)(tile + row * TS + c4 * 8) = w;
    }
}
__device__ __forceinline__ void load_rot(const bf16_t* rp, const float* cs, int kq, float scale, bool valid, bf16x8 (&fr)[4]) {
    u32x4 c[4];
#pragma unroll
    for (int ks = 0; ks < 4; ++ks) c[ks] = valid ? *(const u32x4*)(rp + 16 * ks + 8 * kq) : (u32x4){0u, 0u, 0u, 0u};
#pragma unroll
    for (int g = 0; g < 2; ++g) {
        const float* cp = cs + 16 * g + 8 * kq;
        const f32x4 ca = *(const f32x4*)cp, cb = *(const f32x4*)(cp + 4), sa = *(const f32x4*)(cp + 32), sb = *(const f32x4*)(cp + 36);
        float o1[8], o2[8];
#pragma unroll
        for (int e = 0; e < 8; ++e) {
            const unsigned w1 = c[g][e >> 1], w2 = c[g + 2][e >> 1];
            const float x1 = (e & 1) ? bfhi(w1) : bflo(w1), x2 = (e & 1) ? bfhi(w2) : bflo(w2);
            const float cc = (e < 4) ? ca[e & 3] : cb[e & 3], sn = (e < 4) ? sa[e & 3] : sb[e & 3];
            o1[e] = (x1 * cc - x2 * sn) * scale; o2[e] = (x1 * sn + x2 * cc) * scale;
        }
        u32x4 a, b;
        a.x = pk2(o1[0], o1[1]); a.y = pk2(o1[2], o1[3]); a.z = pk2(o1[4], o1[5]); a.w = pk2(o1[6], o1[7]);
        b.x = pk2(o2[0], o2[1]); b.y = pk2(o2[2], o2[3]); b.z = pk2(o2[4], o2[5]); b.w = pk2(o2[6], o2[7]);
        fr[g] = as_bf16x8(a); fr[g + 2] = as_bf16x8(b);
    }
}

struct Ctx {
    int l, lane, kq, li;
    const bf16_t* proj; const float* lowf; const float* rope; bf16_t* cat; float* kvt; float* gdec; float* out;
    const float* wa2; const float* ba; const float* nw; const float* st; const bf16_t* ckb; const bf16_t* cvb;
};
__device__ __forceinline__ float ret_lg2(int h) { return __log2f(1.0f - exp2f(-5.0f - (float)h)); }

struct GlaGate {
    f32x4 lw[4]; float w[16]; float bias, run;
    template <int L> __device__ __forceinline__ void init(const Ctx& C, int m0, int h) {
#pragma unroll
        for (int q = 0; q < 4; ++q) lw[q] = (C.lane < L) ? *(const f32x4*)(C.lowf + (size_t)(m0 + C.lane) * 16 + 4 * q) : (f32x4){0.f, 0.f, 0.f, 0.f};
#pragma unroll
        for (int j = 0; j < 16; ++j) w[j] = C.wa2[j * 256 + h * 64 + C.lane];
        bias = C.ba[h * 64 + C.lane]; run = 0.f;
    }
    __device__ __forceinline__ float step(int s) {
        float z0 = bias, z1 = 0.f;
#pragma unroll
        for (int j = 0; j < 16; j += 2) {
            z0 += __int_as_float(__builtin_amdgcn_readlane(__float_as_int(lw[j >> 2][j & 3]), s)) * w[j];
            z1 += __int_as_float(__builtin_amdgcn_readlane(__float_as_int(lw[(j + 1) >> 2][(j + 1) & 3]), s)) * w[j + 1];
        }
        const float z = z0 + z1;
        const float lf = fminf(z, 0.f) - __logf(1.0f + __expf(-fabsf(z)));
        run += lf * (1.0f / 16.0f);
        return run;
    }
};

template <bool SAMPLE> __device__ __forceinline__ void kv_local(const Ctx& C, int type, int b, int n, int h, LAS unsigned char* wl) {
    constexpr int L = SAMPLE ? 32 : 64, NKS = L / 16;
    const int m0 = SAMPLE ? MP + b * SL : b * SEQ + n * 64;
    const int pidx0 = SAMPLE ? 2048 : n * 64;
    LAS unsigned char* tK = wl; LAS unsigned char* tV = wl + TILE_B;
    const int lane = C.lane, kq = C.kq, li = C.li;
    float gdk = 0.f;
    if (type == 0) {
        const float lg = ret_lg2(h);
#pragma unroll
        for (int rb = 0; rb < L / 32; ++rb) {
            const int s = 32 * rb + li;
            bf16x8 fr[4];
            load_rot(C.proj + (size_t)(m0 + s) * PS + C_KA + h * 64, C.rope + (size_t)(pidx0 + s) * 64, kq, 0.125f * __builtin_amdgcn_exp2f(lg * (float)(L - 1 - s)), true, fr);
#pragma unroll
            for (int ks = 0; ks < 4; ++ks) *(LAS bf16x8*)(tK + s * TS + (16 * ks + 8 * kq) * 2) = fr[ks];
        }
        load_tile(tV, C.proj + (size_t)m0 * PS + C_VA + h * 64, PS, L, lane);
    } else {
        load_tile(tK, C.proj + (size_t)m0 * PS + C_KB + h * 64, PS, L, lane);
        GlaGate gg; gg.init<L>(C, m0, h);
        if (!SAMPLE) {
            load_tile(tV, C.proj + (size_t)m0 * PS + C_QB + h * 64, PS, L, lane);
#pragma unroll 4
            for (int s = 0; s < L; ++s) {
                const float e = __expf(gg.step(s));
                LAS bf16_t* kp = (LAS bf16_t*)(tK + s * TS + lane * 2); LAS bf16_t* qp = (LAS bf16_t*)(tV + s * TS + lane * 2);
                *kp = f2bf(bf2f(*kp) / e); *qp = f2bf(bf2f(*qp) * 0.125f * e);
            }
            asm volatile("s_waitcnt lgkmcnt(0)" ::: "memory");
            store_tile(tV, (bf16_t*)C.proj + (size_t)m0 * PS + C_QB + h * 64, PS, L, lane);
            store_tile(tK, (bf16_t*)C.proj + (size_t)m0 * PS + C_KB + h * 64, PS, L, lane);
            asm volatile("s_waitcnt lgkmcnt(0)" ::: "memory");
            load_tile(tV, C.proj + (size_t)m0 * PS + C_VB + h * 64, PS, L, lane);
        } else {
            load_tile(tV, C.proj + (size_t)m0 * PS + C_VB + h * 64, PS, L, lane);
#pragma unroll 4
            for (int s = 0; s < L; ++s) {
                const float bs = gg.step(s);
                LAS bf16_t* kp = (LAS bf16_t*)(tK + s * TS + lane * 2);
                *kp = f2bf(bf2f(*kp) * __expf(-bs));
            }
        }
        gdk = __expf(gg.run);
    }
    f32x16 kv[2][2];
#pragma unroll
    for (int db = 0; db < 2; ++db)
#pragma unroll
        for (int kb = 0; kb < 2; ++kb) kv[db][kb] = zero16();
#pragma unroll
    for (int ks = 0; ks < NKS; ++ks) {
        bf16x8 a[2], bb[2];
#pragma unroll
        for (int db = 0; db < 2; ++db) a[db] = tr_nat(tV, 16 * ks, 32 * db, lane);
#pragma unroll
        for (int kb = 0; kb < 2; ++kb) bb[kb] = tr_nat(tK, 16 * ks, 32 * kb, lane);
#pragma unroll
        for (int db = 0; db < 2; ++db)
#pragma unroll
            for (int kb = 0; kb < 2; ++kb) kv[db][kb] = mfma32(a[db], bb[kb], kv[db][kb]);
    }
    if (type == 1) {
#pragma unroll
        for (int kb = 0; kb < 2; ++kb) { const float cs = __int_as_float(__builtin_amdgcn_ds_bpermute((32 * kb + li) * 4, __float_as_int(gdk)));
#pragma unroll
            for (int db = 0; db < 2; ++db) kv[db][kb] = kv[db][kb] * cs; }
    }
    if (!SAMPLE) {
        const int uidx = ((type * 8 + b) * 4 + h) * 32 + n;
        float* dst = C.kvt + (size_t)uidx * 4096;
#pragma unroll
        for (int db = 0; db < 2; ++db)
#pragma unroll
            for (int kb = 0; kb < 2; ++kb)
#pragma unroll
                for (int r = 0; r < 16; ++r) dst[(32 * db + crow(r, kq)) * 64 + 32 * kb + li] = kv[db][kb][r];
        if (type == 1) C.gdec[(size_t)(((b * 4 + h) * 32 + n)) * 64 + lane] = gdk;
    } else {
        const float* s0 = C.st + (size_t)((C.l * 8 + b) * 4 + h) * 4096;
        float* so = C.out + (type == 0 ? O_RETS : O_GLAS) + (size_t)((C.l * 8 + b) * 4 + h) * 4096;
        const float dret = exp2f(ret_lg2(h) * (float)L);
#pragma unroll
        for (int kb = 0; kb < 2; ++kb) {
            const int dk = 32 * kb + li;
            const float dec = (type == 0) ? dret : __int_as_float(__builtin_amdgcn_ds_bpermute(dk * 4, __float_as_int(gdk)));
#pragma unroll
            for (int db = 0; db < 2; ++db)
#pragma unroll
                for (int rr = 0; rr < 4; ++rr) {
                    const int dv = 32 * db + 8 * rr + 4 * kq;
                    const f32x4 o = *(const f32x4*)(s0 + dk * 64 + dv);
                    f32x4 nv;
#pragma unroll
                    for (int e = 0; e < 4; ++e) nv[e] = dec * o[e] + kv[db][kb][4 * rr + e];
                    *(f32x4*)(so + dk * 64 + dv) = nv;
                }
        }
    }
}

template <bool SAMPLE> __device__ __forceinline__ void mix_out(const Ctx& C, int type, int b, int n, int h, LAS unsigned char* wl) {
    constexpr int L = SAMPLE ? 32 : 64, NTB = L / 32;
    const int m0 = SAMPLE ? MP + b * SL : b * SEQ + n * 64;
    const int pidx0 = SAMPLE ? 2048 : n * 64;
    LAS unsigned char* t0 = wl; LAS unsigned char* t1 = wl + TILE_B;
    const int lane = C.lane, kq = C.kq, li = C.li;
    bf16x8 qfr[NTB][4];
    const float lg = ret_lg2(h);
    if (type == 0) {
#pragma unroll
        for (int tb = 0; tb < NTB; ++tb) {
            const int s = 32 * tb + li;
            load_rot(C.proj + (size_t)(m0 + s) * PS + C_QA + h * 64, C.rope + (size_t)(pidx0 + s) * 64, kq, __builtin_amdgcn_exp2f(lg * (float)(s + 1)), true, qfr[tb]);
        }
        load_tile(t0, C.proj + (size_t)m0 * PS + C_VA + h * 64, PS, L, lane);
    } else {
        load_tile(t0, C.proj + (size_t)m0 * PS + C_QB + h * 64, PS, L, lane);
        load_tile(t1, C.proj + (size_t)m0 * PS + C_KB + h * 64, PS, L, lane);
        if (SAMPLE) {
            GlaGate gg; gg.init<L>(C, m0, h);
#pragma unroll 4
            for (int s = 0; s < L; ++s) {
                const float e = __expf(gg.step(s));
                LAS bf16_t* qp = (LAS bf16_t*)(t0 + s * TS + lane * 2); LAS bf16_t* kp = (LAS bf16_t*)(t1 + s * TS + lane * 2);
                *qp = f2bf(bf2f(*qp) * 0.125f * e); *kp = f2bf(bf2f(*kp) / e);
            }
        }
        __builtin_amdgcn_sched_barrier(0);
#pragma unroll
        for (int tb = 0; tb < NTB; ++tb)
#pragma unroll
            for (int ks = 0; ks < 4; ++ks) qfr[tb][ks] = row_frag(t0, 32 * tb, ks, lane);
        asm volatile("s_waitcnt lgkmcnt(0)" ::: "memory");
        __builtin_amdgcn_sched_barrier(0);
        load_tile(t0, C.proj + (size_t)m0 * PS + C_VB + h * 64, PS, L, lane);
    }
    __builtin_amdgcn_sched_barrier(0);
    f32x16 o[2][NTB];
#pragma unroll
    for (int db = 0; db < 2; ++db)
#pragma unroll
        for (int tb = 0; tb < NTB; ++tb) o[db][tb] = zero16();
    {
        const int uidx = ((type * 8 + b) * 4 + h) * 32 + n;
        const float* sT = C.kvt + (size_t)uidx * 4096;
        const float* s0 = C.st + (size_t)((C.l * 8 + b) * 4 + h) * 4096;
#pragma unroll
        for (int db = 0; db < 2; ++db)
#pragma unroll
            for (int ks = 0; ks < 4; ++ks) {
                const int dv = 32 * db + li, dk0 = 16 * ks + 8 * kq;
                float sv[8];
                if (!SAMPLE) { const f32x4 x = *(const f32x4*)(sT + dv * 64 + dk0), y = *(const f32x4*)(sT + dv * 64 + dk0 + 4);
#pragma unroll
                    for (int e = 0; e < 4; ++e) { sv[e] = x[e]; sv[4 + e] = y[e]; } }
                else {
#pragma unroll
                    for (int e = 0; e < 8; ++e) sv[e] = s0[(dk0 + e) * 64 + dv]; }
                u32x4 w; w.x = pk2(sv[0], sv[1]); w.y = pk2(sv[2], sv[3]); w.z = pk2(sv[4], sv[5]); w.w = pk2(sv[6], sv[7]);
                const bf16x8 sa = as_bf16x8(w);
#pragma unroll
                for (int tb = 0; tb < NTB; ++tb) o[db][tb] = mfma32(sa, qfr[tb][ks], o[db][tb]);
            }
    }
    __builtin_amdgcn_sched_barrier(0);
#pragma unroll
    for (int sb = 0; sb < NTB; ++sb) {
        bf16x8 kfr[4];
        if (type == 0) load_rot(C.proj + (size_t)(m0 + 32 * sb + li) * PS + C_KA + h * 64, C.rope + (size_t)(pidx0 + 32 * sb + li) * 64, kq, 0.125f * __builtin_amdgcn_exp2f(-lg * (float)(32 * sb + li + 1)), true, kfr);
        else {
#pragma unroll
            for (int ks = 0; ks < 4; ++ks) kfr[ks] = row_frag(t1, 32 * sb, ks, lane);
        }
        f32x16 st[NTB];
#pragma unroll
        for (int tb = sb; tb < NTB; ++tb) {
            f32x16 a = zero16();
#pragma unroll
            for (int ks = 0; ks < 4; ++ks) a = mfma32(kfr[ks], qfr[tb][ks], a);
#pragma unroll
            for (int r = 0; r < 16; ++r) {
                const int s = 32 * sb + crow(r, kq), t = 32 * tb + li;
                a[r] = (t >= s) ? a[r] : 0.0f;
            }
            st[tb] = a;
        }
#pragma unroll
        for (int half = 0; half < 2; ++half) {
            bf16x8 va[2];
#pragma unroll
            for (int db = 0; db < 2; ++db) va[db] = tr_perm(t0, 32 * sb + 16 * half, 32 * db, lane);
#pragma unroll
            for (int tb = sb; tb < NTB; ++tb) {
                const bf16x8 pf = pack_step(st[tb], half);
#pragma unroll
                for (int db = 0; db < 2; ++db) o[db][tb] = mfma32(va[db], pf, o[db][tb]);
            }
        }
        __builtin_amdgcn_sched_barrier(0);
    }
    const float* nw = C.nw + h * 64;
    const int gcol = (type == 0 ? C_GA : C_GB) + h * 64;
#pragma unroll
    for (int tb = 0; tb < NTB; ++tb) {
        const int t = 32 * tb + li;
        float s1 = 0.f, s2 = 0.f;
#pragma unroll
        for (int db = 0; db < 2; ++db)
#pragma unroll
            for (int r = 0; r < 16; ++r) { const float x = o[db][tb][r]; s1 += x; s2 += x * x; }
        s1 += __shfl_xor(s1, 32); s2 += __shfl_xor(s2, 32);
        float mu = 0.f, rstd;
        if (type == 0) { mu = s1 * (1.0f / 64.0f); const float var = fmaxf(s2 * (1.0f / 64.0f) - mu * mu, 0.f); rstd = 1.0f / sqrtf(var + EPS); }
        else rstd = 1.0f / sqrtf(s2 * (1.0f / 64.0f) + EPS);
        const bf16_t* grow = C.proj + (size_t)(m0 + t) * PS + gcol;
        bf16_t* orow = C.cat + (size_t)(m0 + t) * DM + type * 256 + h * 64;
#pragma unroll
        for (int db = 0; db < 2; ++db)
#pragma unroll
            for (int rr = 0; rr < 4; ++rr) {
                const int dv = 32 * db + 8 * rr + 4 * kq;
                const u32x2 gw = *(const u32x2*)(grow + dv);
                const f32x4 wv = *(const f32x4*)(nw + dv);
                const float g0 = bflo(gw.x), g1 = bfhi(gw.x), g2 = bflo(gw.y), g3 = bfhi(gw.y);
                const float y0 = (o[db][tb][4 * rr + 0] - mu) * rstd * wv[0] * silu(g0), y1 = (o[db][tb][4 * rr + 1] - mu) * rstd * wv[1] * silu(g1);
                const float y2 = (o[db][tb][4 * rr + 2] - mu) * rstd * wv[2] * silu(g2), y3 = (o[db][tb][4 * rr + 3] - mu) * rstd * wv[3] * silu(g3);
                u32x2 w; w.x = pk2(y0, y1); w.y = pk2(y2, y3);
                *(u32x2*)(orow + dv) = w;
            }
    }
}

template <bool SAMPLE> __device__ __forceinline__ void attn_wave(const Ctx& C, int b, int n, int h, LAS unsigned char* wl, LAS const float* revT, float cb2) {
    constexpr int NTB = SAMPLE ? 1 : 2;
    constexpr float SC = 0.125f * 1.4426950408889634f;
    const int m0 = SAMPLE ? MP + b * SL : b * SEQ + n * 64;
    const int lane = C.lane, kq = C.kq, li = C.li;
    const int jt0 = SAMPLE ? 0 : (n < 8 ? 8 - n : 0);
#define ATT_SRC(jt, kp, vp, pitch, rmask) const bf16_t* kp; const bf16_t* vp; int pitch; int rmask = 63; \
    if (SAMPLE && (jt) < 8) { kp = C.ckb + (size_t)(b * 512 + 64 * (jt)) * 512 + h * 64; vp = C.cvb + (size_t)(b * 512 + 64 * (jt)) * 512 + h * 64; pitch = 512; } \
    else { const int kr0 = SAMPLE ? m0 : b * SEQ + (n - 8 + (jt)) * 64; kp = C.proj + (size_t)kr0 * PS + C_KC + h * 64; vp = kp + (C_VC - C_KC); pitch = PS; if (SAMPLE) rmask = 31; }
#define ATT_ISSUE(jt, kdst, vbuf) do { ATT_SRC(jt, kp_, vp_, pitch_, rmask_); \
    _Pragma("unroll") for (int sb = 0; sb < 2; ++sb) _Pragma("unroll") for (int ks = 0; ks < 4; ++ks) kdst[sb][ks] = *(const u32x4*)(kp_ + (size_t)((32 * sb + li) & rmask_) * pitch_ + 16 * ks + 8 * kq); \
    _Pragma("unroll") for (int it = 0; it < 8; ++it) __builtin_amdgcn_global_load_lds((const unsigned*)(vp_ + (size_t)((it * 8 + (lane >> 3)) & rmask_) * pitch_ + (lane & 7) * 8), (LAS unsigned*)((vbuf) + it * 1024), 16, 0, 0); } while (0)
    bf16x8 qfr[NTB][4];
#pragma unroll
    for (int tb = 0; tb < NTB; ++tb)
#pragma unroll
        for (int ks = 0; ks < 4; ++ks) qfr[tb][ks] = as_bf16x8(*(const u32x4*)(C.proj + (size_t)(m0 + 32 * tb + li) * PS + C_QC + h * 64 + 16 * ks + 8 * kq));
    f32x16 o[2][NTB]; float mrun[NTB], lrun[NTB];
#pragma unroll
    for (int tb = 0; tb < NTB; ++tb) { mrun[tb] = -1e30f; lrun[tb] = 0.f;
#pragma unroll
        for (int db = 0; db < 2; ++db) o[db][tb] = zero16(); }
    u32x4 kcur[2][4], knext[2][4];
    ATT_ISSUE(jt0, kcur, wl + ((jt0 & 1) ? TILE_B : 0));
    for (int jt = jt0; jt <= 8; ++jt) {
        asm volatile("s_waitcnt vmcnt(0)" ::: "memory");
        __builtin_amdgcn_sched_barrier(0);
        LAS unsigned char* tV = wl + ((jt & 1) ? TILE_B : 0);
        if (jt < 8) { ATT_ISSUE(jt + 1, knext, wl + (((jt + 1) & 1) ? TILE_B : 0)); }
        __builtin_amdgcn_sched_barrier(0);
        const bool cst = jt <= 3;
#pragma unroll
        for (int sb = 0; sb < 2; ++sb) {
            if (SAMPLE && jt == 8 && sb == 1) continue;
#pragma unroll
            for (int tb = 0; tb < NTB; ++tb) {
                f32x16 a = zero16();
#pragma unroll
                for (int ks = 0; ks < 4; ++ks) a = mfma32(as_bf16x8(kcur[sb][ks]), qfr[tb][ks], a);
                if (!cst) {
                    const int dbase = (8 - jt) * 64 + 63 + 32 * tb + li - 32 * sb;
                    LAS const float* rp = revT + (382 - dbase + 4 * kq);
#pragma unroll
                    for (int r = 0; r < 16; ++r) a[r] = a[r] * SC + rp[(r & 3) + 8 * (r >> 2)];
                }
                float mx = -1e30f;
#pragma unroll
                for (int r = 0; r < 16; ++r) mx = fmaxf(mx, a[r]);
                if (cst) mx = mx * SC + cb2;
                mx = fmaxf(mx, __shfl_xor(mx, 32));
                const float mnew = fmaxf(mrun[tb], mx);
                const bool moved = __builtin_amdgcn_ballot_w64(mnew != mrun[tb]) != 0ull;
                const float alpha = __builtin_amdgcn_exp2f(mrun[tb] - mnew);
                mrun[tb] = mnew;
                float ps = 0.f;
                if (cst) { const float off = cb2 - mnew;
#pragma unroll
                    for (int r = 0; r < 16; ++r) { const float pp = __builtin_amdgcn_exp2f(a[r] * SC + off); a[r] = pp; ps += pp; } }
                else {
#pragma unroll
                    for (int r = 0; r < 16; ++r) { const float pp = __builtin_amdgcn_exp2f(a[r] - mnew); a[r] = pp; ps += pp; } }
                lrun[tb] = lrun[tb] * alpha + ps;
                if (moved) {
#pragma unroll
                    for (int db = 0; db < 2; ++db) o[db][tb] = o[db][tb] * alpha;
                }
#pragma unroll
                for (int half = 0; half < 2; ++half) {
                    const bf16x8 pf = pack_step(a, half);
#pragma unroll
                    for (int db = 0; db < 2; ++db) o[db][tb] = mfma32(tr_perm<128>(tV, 32 * sb + 16 * half, 32 * db, lane), pf, o[db][tb]);
                }
            }
        }
#pragma unroll
        for (int sb = 0; sb < 2; ++sb)
#pragma unroll
            for (int ks = 0; ks < 4; ++ks) kcur[sb][ks] = knext[sb][ks];
    }
#pragma unroll
    for (int tb = 0; tb < NTB; ++tb) {
        const float lt = lrun[tb] + __shfl_xor(lrun[tb], 32), inv = 1.0f / lt;
        bf16_t* orow = C.cat + (size_t)(m0 + 32 * tb + li) * DM + 512 + h * 64;
#pragma unroll
        for (int db = 0; db < 2; ++db)
#pragma unroll
            for (int rr = 0; rr < 4; ++rr) {
                u32x2 w; w.x = pk2(o[db][tb][4 * rr] * inv, o[db][tb][4 * rr + 1] * inv); w.y = pk2(o[db][tb][4 * rr + 2] * inv, o[db][tb][4 * rr + 3] * inv);
                *(u32x2*)(orow + 32 * db + 8 * rr + 4 * kq) = w;
            }
    }
#undef ATT_ISSUE
#undef ATT_SRC
}

__device__ __forceinline__ void conv_cache(const float* ck, const float* cv, bf16_t* dst, int l, int gt, int NGT) {
    for (int i = gt; i < (int)(2 * CACHE_ELEMS / 8); i += NGT) {
        const bool isv = i >= (int)(CACHE_ELEMS / 8); const int j = isv ? i - (int)(CACHE_ELEMS / 8) : i;
        const float* s = (isv ? cv : ck) + (size_t)l * CACHE_ELEMS + (size_t)j * 8;
        const f32x4 x = *(const f32x4*)s, y = *(const f32x4*)(s + 4);
        u32x4 w; w.x = pk2(x[0], x[1]); w.y = pk2(x[2], x[3]); w.z = pk2(y[0], y[1]); w.w = pk2(y[2], y[3]);
        *(u32x4*)(dst + (size_t)i * 8) = w;
    }
}

__device__ __forceinline__ int win_src(int n) { return n < 2048 ? n : (n < 3584 ? n + 16 : (n < 3600 ? n - 1536 : -1)); }
__device__ __forceinline__ void tr_item(const float* W, int K, int Nsrc, bf16_t* WT, int kb, int nb, bool inmap, const float* kscale, LAS float* scr, int lane) {
    const int k0 = 64 * kb, n0 = 32 * nb, n = n0 + (lane & 31), sc = inmap ? win_src(n) : n;
    float wv[32];
#pragma unroll
    for (int i = 0; i < 32; ++i) { const int kk = 2 * i + (lane >> 5); wv[i] = (sc >= 0) ? W[(size_t)(k0 + kk) * Nsrc + sc] : 0.f; }
    if (kscale) {
#pragma unroll
        for (int i = 0; i < 32; ++i) wv[i] *= kscale[k0 + 2 * i + (lane >> 5)];
    }
#pragma unroll
    for (int i = 0; i < 32; ++i) scr[(2 * i + (lane >> 5)) * 33 + (lane & 31)] = wv[i];
    asm volatile("s_waitcnt lgkmcnt(0)" ::: "memory");
    const int c = lane & 7;
#pragma unroll
    for (int j = 0; j < 4; ++j) { const int nn = (lane >> 3) + 8 * j; const LAS float* s = scr + (8 * c) * 33 + nn;
        u32x4 o; o.x = pk2(s[0 * 33], s[1 * 33]); o.y = pk2(s[2 * 33], s[3 * 33]); o.z = pk2(s[4 * 33], s[5 * 33]); o.w = pk2(s[6 * 33], s[7 * 33]);
        *(u32x4*)(WT + (size_t)(n0 + nn) * K + k0 + 8 * c) = o; }
    asm volatile("s_waitcnt lgkmcnt(0)" ::: "memory");
}


enum { SK_IN = 0, SK_RES = 1, SK_UP = 2 };
struct SArgs {
    const bf16_t* A; const bf16_t* Bt; int K, nunits;
    bf16_t* obf; int ldo;
    const float* ss_in; float* ss_out;
    const float* xold; float* xr;
    float* lowf; float* ksout; float* vsout;
};
template <int KIND> __device__ __forceinline__ void sample_gemm(LAS unsigned char* lds, const SArgs& a, int ubeg, int ustep, int wave, int lane) {
    const int kq = lane >> 5, li = lane & 31, K = a.K, kw = K >> 3, kbeg = wave * kw;
    for (int u = ubeg; u < a.nunits; u += ustep) {
        const int row0 = 64 * (u & 3), col0 = 64 * (u >> 2);
        f32x16 acc[2][2];
#pragma unroll
        for (int rb = 0; rb < 2; ++rb)
#pragma unroll
            for (int cb = 0; cb < 2; ++cb) acc[rb][cb] = zero16();
        const bf16_t* ap = a.A + (size_t)(row0 + li) * K + kbeg + 8 * kq;
        const bf16_t* bp = a.Bt + (size_t)(col0 + li) * K + kbeg + 8 * kq;
        u32x4 af[4][2], bv[4][2], an[4][2], bn[4][2];
#define SG_LOAD(dsta, dstb, k) _Pragma("unroll") for (int s = 0; s < 4; ++s) _Pragma("unroll") for (int h = 0; h < 2; ++h) { dsta[s][h] = *(const u32x4*)(ap + (size_t)(32 * h) * K + (k) + 16 * s); dstb[s][h] = *(const u32x4*)(bp + (size_t)(32 * h) * K + (k) + 16 * s); }
        SG_LOAD(af, bv, 0);
        for (int k = 0; k < kw; k += 64) {
            if (k + 64 < kw) { SG_LOAD(an, bn, k + 64); }
#pragma unroll
            for (int s = 0; s < 4; ++s)
#pragma unroll
                for (int rb = 0; rb < 2; ++rb)
#pragma unroll
                    for (int cb = 0; cb < 2; ++cb) acc[rb][cb] = mfma32(as_bf16x8(af[s][rb]), as_bf16x8(bv[s][cb]), acc[rb][cb]);
#pragma unroll
            for (int s = 0; s < 4; ++s)
#pragma unroll
                for (int h = 0; h < 2; ++h) { af[s][h] = an[s][h]; bv[s][h] = bn[s][h]; }
        }
#undef SG_LOAD
        LAS float* wp = (LAS float*)(lds + wave * WAVE_LDS);
#pragma unroll
        for (int rb = 0; rb < 2; ++rb)
#pragma unroll
            for (int cb = 0; cb < 2; ++cb)
#pragma unroll
                for (int r = 0; r < 16; ++r) wp[(32 * rb + crow(r, kq)) * 64 + 32 * cb + li] = acc[rb][cb][r];
        __syncthreads();
        const int t = wave * 64 + lane, row = t >> 3, c8 = (t & 7) * 8;
        float v[8];
#pragma unroll
        for (int e = 0; e < 8; ++e) v[e] = 0.f;
#pragma unroll
        for (int w = 0; w < 8; ++w) {
            const f32x4 x = *(LAS const f32x4*)(lds + w * WAVE_LDS + (row * 64 + c8) * 4), y = *(LAS const f32x4*)(lds + w * WAVE_LDS + (row * 64 + c8) * 4 + 16);
#pragma unroll
            for (int e = 0; e < 4; ++e) { v[e] += x[e]; v[4 + e] += y[e]; }
        }
        const int r = row0 + row, c = col0 + c8;
        if (KIND == SK_IN || KIND == SK_UP) {
            const float rs = 1.0f / sqrtf(a.ss_in[r] * (1.0f / 1024.0f) + EPS);
#pragma unroll
            for (int e = 0; e < 8; ++e) { v[e] *= rs; if (KIND == SK_UP) { const float q = fmaxf(v[e], 0.f); v[e] = q * q; } }
        }
        if (KIND == SK_RES) {
            const float* xo = a.xold + (size_t)r * 1024 + c;
            const f32x4 x = *(const f32x4*)xo, y = *(const f32x4*)(xo + 4);
            float sq = 0.f;
#pragma unroll
            for (int e = 0; e < 4; ++e) { v[e] += x[e]; v[4 + e] += y[e]; }
#pragma unroll
            for (int e = 0; e < 8; ++e) sq += v[e] * v[e];
            float* xn = a.xr + (size_t)r * 1024 + c;
            *(f32x4*)xn = (f32x4){v[0], v[1], v[2], v[3]}; *(f32x4*)(xn + 4) = (f32x4){v[4], v[5], v[6], v[7]};
            sq += __shfl_xor(sq, 1); sq += __shfl_xor(sq, 2); sq += __shfl_xor(sq, 4);
            if ((t & 7) == 0) atomicAdd(a.ss_out + r, sq);
        }
        if (a.obf) { u32x4 w; w.x = pk2(v[0], v[1]); w.y = pk2(v[2], v[3]); w.z = pk2(v[4], v[5]); w.w = pk2(v[6], v[7]); *(u32x4*)(a.obf + (size_t)r * a.ldo + c) = w; }
        if (KIND == SK_IN) {
            float* d = nullptr;
            if (c >= C_KC && c < C_VC) d = a.ksout + (size_t)r * 512 + (c - C_KC);
            else if (c >= C_VC && c < C_LOW) d = a.vsout + (size_t)r * 512 + (c - C_VC);
            else if (c >= C_LOW && c < C_LOW + 16) d = a.lowf + (size_t)r * 16 + (c - C_LOW);
            if (d) { *(f32x4*)d = (f32x4){v[0], v[1], v[2], v[3]}; *(f32x4*)(d + 4) = (f32x4){v[4], v[5], v[6], v[7]}; }
        }
        __syncthreads();
    }
}
__device__ __forceinline__ void sample_share(int nwg, int G, int bx, int& ubeg, int& ustep) { const int nfull = nwg % G; if (nfull == 0) { ubeg = bx; ustep = G; } else if (bx >= nfull) { ubeg = bx - nfull; ustep = G - nfull; } else { ubeg = 1 << 30; ustep = 1; } }

#define XB_TMO      128
#define XB_XCNT(j)  (256  + 64 * (j))
#define XB_XSUB(j)  (1280 + 64 * (j))
#define XB_XGEN(j)  (2304 + 64 * (j))
#define XB_TOP      3328
#define XB_TOPGEN   3392
#define XCD_BAR_WORDS 3456
#define XB_SPIN_CAP (1u << 18)

__device__ __forceinline__ unsigned xb_ld(unsigned* p)              { return __hip_atomic_load(p, __ATOMIC_RELAXED, __HIP_MEMORY_SCOPE_AGENT); }
__device__ __forceinline__ unsigned xb_add(unsigned* p, unsigned v) { return __hip_atomic_fetch_add(p, v, __ATOMIC_RELAXED, __HIP_MEMORY_SCOPE_AGENT); }
__device__ __forceinline__ unsigned xb_xcc_id() { return (unsigned)__builtin_amdgcn_s_getreg((3 << 11) | 20) & 0xFu; }
#define XB_SPIN(cond, bar) do { unsigned _sp = 0; while (cond) { __builtin_amdgcn_s_sleep(1); \
    if ((++_sp & 255u) == 0u) { if (xb_ld(&(bar)[XB_TMO])) break; if (_sp > XB_SPIN_CAP) { atomicAdd(&(bar)[XB_TMO], 1u); break; } } } } while (0)

struct XcdBarrier {
    unsigned* bar; unsigned x; bool wave0;
    volatile LAS unsigned* st;
};

__device__ __forceinline__ XcdBarrier xcd_barrier_post(unsigned* bar, volatile LAS unsigned* st) {
    XcdBarrier b; b.bar = bar; b.x = xb_xcc_id(); b.st = st;
    if (threadIdx.x == 0) (void)xb_add(&bar[XB_XCNT(b.x)], 1u);
    return b;
}
__device__ __forceinline__ void xcd_barrier_complete(unsigned* bar, unsigned x, unsigned& nloc, unsigned& nx) {
    const unsigned G = gridDim.x * gridDim.y * gridDim.z;
    unsigned sum, cnt, mine, sp = 0u;
    for (;;) {
        sum = 0u; cnt = 0u; mine = 0u;
#pragma unroll
        for (unsigned j = 0; j < 16; ++j) { const unsigned c = xb_ld(&bar[XB_XCNT(j)]); sum += c; cnt += (c > 0u) ? 1u : 0u; mine = (j == x) ? c : mine; }
        if (sum == G) break;
        __builtin_amdgcn_s_sleep(1);
        if ((++sp & 255u) == 0u) { if (xb_ld(&bar[XB_TMO])) break; if (sp > XB_SPIN_CAP) { atomicAdd(&bar[XB_TMO], 1u); break; } }
    }
    nloc = mine > 0u ? mine : 1u; nx = cnt > 0u ? cnt : 1u;
}

__device__ __forceinline__ void xcd_barrier(const XcdBarrier& b) {
    asm volatile("s_waitcnt vmcnt(0)" ::: "memory");
    __syncthreads();
    if (b.wave0 && lane_id_asm() == 0) {
        unsigned* bar = b.bar;
        __builtin_amdgcn_s_waitcnt(0);
        unsigned nloc = b.st[0], nx = b.st[1];
        if (nloc == 0u) { xcd_barrier_complete(bar, b.x, nloc, nx); b.st[0] = nloc; b.st[1] = nx; }
        const unsigned old = xb_add(&bar[XB_XSUB(b.x)], 1u);
        const unsigned gen = old / nloc;
        if (old + 1u == (gen + 1u) * nloc) {
            __builtin_amdgcn_fence(__ATOMIC_RELEASE, "agent");
            asm volatile("s_waitcnt vmcnt(0)" ::: "memory");
            const unsigned og = xb_add(&bar[XB_TOP], 1u);
            const unsigned tg = og / nx;
            if (og + 1u == (tg + 1u) * nx) xb_add(&bar[XB_TOPGEN], 1u);
            else XB_SPIN(xb_ld(&bar[XB_TOPGEN]) == tg, bar);
            __builtin_amdgcn_fence(__ATOMIC_ACQUIRE, "agent");
            xb_add(&bar[XB_XGEN(b.x)], 1u);
            asm volatile("s_waitcnt vmcnt(0)" ::: "memory");
        } else {
            XB_SPIN(xb_ld(&bar[XB_XGEN(b.x)]) == gen, bar);
            __builtin_amdgcn_fence(__ATOMIC_ACQUIRE, "agent");
            asm volatile("s_waitcnt vmcnt(0)" ::: "memory");
        }
    }
    __syncthreads();
}


__device__ __forceinline__ void tr_item128(const float* W, int K, int Nsrc, bf16_t* WT, int kb, int nb, const float* kscale, LAS float* scr, int lane) {
    const int k0 = 32 * kb, n0 = 128 * nb, n4 = (lane & 31) * 4;
    f32x4 wv[16];
#pragma unroll
    for (int i = 0; i < 16; ++i) wv[i] = *(const f32x4*)(W + (size_t)(k0 + 2 * i + (lane >> 5)) * Nsrc + n0 + n4);
    if (kscale) {
#pragma unroll
        for (int i = 0; i < 16; ++i) wv[i] = wv[i] * kscale[k0 + 2 * i + (lane >> 5)];
    }
#pragma unroll
    for (int i = 0; i < 16; ++i) { LAS float* d = scr + (2 * i + (lane >> 5)) * 129 + n4; d[0] = wv[i][0]; d[1] = wv[i][1]; d[2] = wv[i][2]; d[3] = wv[i][3]; }
    asm volatile("s_waitcnt lgkmcnt(0)" ::: "memory");
#pragma unroll
    for (int j = 0; j < 8; ++j) { const int id = j * 64 + lane, n = id >> 2, c = id & 3; const LAS float* s = scr + (8 * c) * 129 + n;
        u32x4 o; o.x = pk2(s[0 * 129], s[1 * 129]); o.y = pk2(s[2 * 129], s[3 * 129]); o.z = pk2(s[4 * 129], s[5 * 129]); o.w = pk2(s[6 * 129], s[7 * 129]);
        *(u32x4*)(WT + (size_t)(n0 + n) * K + k0 + 8 * c) = o; }
    asm volatile("s_waitcnt lgkmcnt(0)" ::: "memory");
}
constexpr int CONV_WGS = 16;

__global__ void __launch_bounds__(512, 2) hybrid_fwd(Params p) {
    extern __shared__ __attribute__((aligned(16))) unsigned char lds_raw[];
    cg::grid_group grid = cg::this_grid();
    LAS unsigned char* lds = (LAS unsigned char*)lds_raw;
    const int wave = __builtin_amdgcn_readfirstlane((int)threadIdx.x >> 6);
    const int G = gridDim.x, bx = blockIdx.x;
#define WSP(off) (ws_ptr() + (off))
#define LANE_TID() const int lane = lane_id_asm(); const int tid = wave * 64 + lane; (void)tid; int Gq = G, bxq = bx; asm volatile("" : "+s"(Gq), "+s"(bxq)); (void)Gq; (void)bxq
    LAS unsigned char* wl = lds + wave * WAVE_LDS;
    LAS float* biasT = (LAS float*)(lds + LDS_BIAS);
    if (threadIdx.x < 4) ((LAS unsigned*)(lds + LDS_BARST))[threadIdx.x] = 0u;
    __syncthreads();
    XcdBarrier xbar = xcd_barrier_post((unsigned*)WSP(WS_CTL), (volatile LAS unsigned*)(lds + LDS_BARST)); xbar.wave0 = (wave == 0);

    for (int rep = 0; rep < 1 + PROBE_P0X2; ++rep) {
        LANE_TID();
        unsigned char* ws = ws_ptr();
        bf16_t* XB = (bf16_t*)(ws + WS_B); bf16_t* WIN = (bf16_t*)(ws + WS_WIN); bf16_t* WOUT = (bf16_t*)(ws + WS_WOUT); bf16_t* WUP = (bf16_t*)(ws + WS_WUP); bf16_t* WDN = (bf16_t*)(ws + WS_WDN);
        float* SS = (float*)(ws + WS_SS); float* ROPE = (float*)(ws + WS_ROPE);
        const int gw = bx * 8 + wave, NGW = G * 8;
        LAS float* scr = (LAS float*)wl;
        constexpr int I_IN = 16 * (PS / 32), I_OUT = 16 * 32, I_UP = 16 * 128, I_DN = 64 * 32, I_L = I_IN + I_OUT + I_UP + I_DN;
        const bool split = (G == 256);
        for (int it = gw; it < 2 * I_L; it += NGW) {
            const int l = it / I_L; int r = it % I_L;
            if (split && r >= I_IN) continue;
            if (r < I_IN) { tr_item(in_ptr(9) + (size_t)l * DM * INCOLS, DM, INCOLS, WIN + (size_t)l * PS * DM, r / (PS / 32), r % (PS / 32), true, in_ptr(6) + l * DM, scr, lane); continue; } r -= I_IN;
            if (r < I_OUT) { tr_item(in_ptr(15) + (size_t)l * DM * DM, DM, DM, WOUT + (size_t)l * DM * DM, r / 32, r % 32, false, nullptr, scr, lane); continue; } r -= I_OUT;
            if (r < I_UP) { tr_item(in_ptr(16) + (size_t)l * DM * DFF, DM, DFF, WUP + (size_t)l * DFF * DM, r / 128, r % 128, false, in_ptr(7) + l * DM, scr, lane); continue; } r -= I_UP;
            tr_item(in_ptr(17) + (size_t)l * DFF * DM, DFF, DM, WDN + (size_t)l * DM * DFF, r / 32, r % 32, false, nullptr, scr, lane);
        }
        const float* x_prompt = in_ptr(0); const float* x_sample = in_ptr(1);
        for (int m0 = gw; m0 < MT; m0 += 2 * NGW) {
            f32x4 v[2][4]; float s[2];
#pragma unroll
            for (int q = 0; q < 2; ++q) {
                const int m = m0 + q * NGW; s[q] = 0.f;
                if (m < MT) {
                    const float* xrow = (m < MP) ? x_prompt + (size_t)m * DM : x_sample + (size_t)(m - MP) * DM;
                    const f32x4* xr = (const f32x4*)xrow + lane;
#pragma unroll
                    for (int j = 0; j < 4; ++j) v[q][j] = xr[64 * j];
                }
            }
#pragma unroll
            for (int q = 0; q < 2; ++q) {
                const int m = m0 + q * NGW;
                if (m < MT) {
#pragma unroll
                    for (int j = 0; j < 4; ++j) s[q] += (v[q][j][0] * v[q][j][0] + v[q][j][1] * v[q][j][1]) + (v[q][j][2] * v[q][j][2] + v[q][j][3] * v[q][j][3]);
#pragma unroll
                    for (int o = 1; o < 64; o <<= 1) s[q] += __shfl_xor(s[q], o);
                    u32x2* o8 = (u32x2*)(XB + (size_t)m * DM) + lane;
#pragma unroll
                    for (int j = 0; j < 4; ++j) { u32x2 w; w.x = pk2(v[q][j][0], v[q][j][1]); w.y = pk2(v[q][j][2], v[q][j][3]); o8[64 * j] = w; }
                    if (lane == 0) SS[m] = s[q];
                }
            }
        }
        const int gt = bx * 512 + tid, NGT = G * 512;
        for (int i = gt; i < 4 * MT; i += NGT) SS[MT + i] = 0.f;
        conv_cache(in_ptr(4), in_ptr(5), (bf16_t*)(ws + WS_CKB), 0, gt, NGT);
        for (int i = gt; i < 2080 * 32; i += NGT) {
            const int pi = i >> 5, f = i & 31; const int pos = pi < 2048 ? pi : 4096 + (pi - 2048);
            const float inv_freq = (float)exp(-(double)f * (9.210340371976184 / 32.0));
            const float ang = (float)pos * inv_freq;
            double rev = (double)ang * 0.15915494309189535; rev -= rint(rev);
            const float rf = (float)rev;
            ROPE[(size_t)pi * 64 + f] = __builtin_amdgcn_cosf(rf); ROPE[(size_t)pi * 64 + 32 + f] = __builtin_amdgcn_sinf(rf);
        }
    }
    if (G == 0x7fffffff) grid.sync();
    xcd_barrier(xbar);

    for (int l = 0; l < 2; ++l) {
        {
            LANE_TID();
            unsigned char* ws = ws_ptr();
            const bool split = (Gq == 256); const int GG = split ? Gq - CONV_WGS : Gq;
            if (split && bxq >= GG) {
                LAS float* scr = (LAS float*)(lds + wave * WAVE_LDS);
                constexpr int J_OUT = 32 * 8, J_UP = 32 * 32;
                for (int it = (bxq - GG) * 8 + wave; it < J_OUT + J_UP; it += CONV_WGS * 8) {
                    if (it < J_OUT) tr_item128(in_ptr(15) + (size_t)l * DM * DM, DM, DM, (bf16_t*)(ws + WS_WOUT) + (size_t)l * DM * DM, it / 8, it % 8, nullptr, scr, lane);
                    else { const int r = it - J_OUT; tr_item128(in_ptr(16) + (size_t)l * DM * DFF, DM, DFF, (bf16_t*)(ws + WS_WUP) + (size_t)l * DFF * DM, r / 32, r % 32, in_ptr(7) + l * DM, scr, lane); }
                }
            } else {
            pg8::Gemm g{(const bf16_t*)(ws + WS_B), (const bf16_t*)(ws + WS_WIN) + (size_t)l * PS * DM, MP, PS, DM}; pg8::StaticOrder S; S.init(MP, PS, GG, bxq);
            pg8::EpiIn E{(bf16_t*)(ws + WS_A), (float*)(ws + WS_LOWF), (const float*)(ws + WS_SS) + (size_t)(2 * l) * MT, out_ptr(), (long long)(O_KP + (size_t)l * 2097152), (long long)(O_VP + (size_t)l * 2097152), (long long)(O_KS + (size_t)l * 131072), (long long)(O_VS + (size_t)l * 131072)};
            pg8::gemm_phase<pg8::EpiIn, pg8::StaticOrder, true, true>(lds, g, S, E, tid);
            if (PROBE_IN2) pg8::gemm_phase<pg8::EpiIn, pg8::StaticOrder, true, true>(lds, g, S, E, tid);
            {
                float* outp = out_ptr();
                SArgs a{}; a.A = (const bf16_t*)(ws + WS_B) + (size_t)MP * DM; a.Bt = (const bf16_t*)(ws + WS_WIN) + (size_t)l * PS * DM; a.K = DM; a.nunits = 4 * 57;
                a.obf = (bf16_t*)(ws + WS_A) + (size_t)MP * PS; a.ldo = PS; a.ss_in = (const float*)(ws + WS_SS) + (size_t)(2 * l) * MT + MP; a.lowf = (float*)(ws + WS_LOWF) + (size_t)MP * 16;
                a.ksout = outp + O_KS + (size_t)l * 131072; a.vsout = outp + O_VS + (size_t)l * 131072;
                int ub, us; sample_share((MP / 256) * (PS / 256), GG, bxq, ub, us);
                sample_gemm<SK_IN>(lds, a, ub, us, wave, lane);
            }
            if (l == 1) conv_cache(in_ptr(4), in_ptr(5), (bf16_t*)(ws + WS_CKB), 1, bxq * 512 + tid, GG * 512);
            }
        }
        xcd_barrier(xbar);
        {
            LANE_TID();
            { const float* rb = in_ptr(14) + (size_t)l * 8 * NREL; for (int i = tid; i < 8 * NREV; i += 512) { const int hh = i / NREV, j = i % NREV; int k = 382 - j; k = k < 0 ? 0 : (k > NREL - 1 ? NREL - 1 : k); biasT[i] = rb[hh * NREL + k] * 1.4426950408889634f; } }
            __syncthreads();
        }
#define MAKE_CTX() LANE_TID(); int wv = wave; asm volatile("" : "+s"(wv)); unsigned char* ws = ws_ptr(); Ctx C; C.l = l; C.lane = lane; C.kq = lane >> 5; C.li = lane & 31; C.proj = (const bf16_t*)(ws + WS_A); C.lowf = (const float*)(ws + WS_LOWF); \
        C.rope = (const float*)(ws + WS_ROPE); C.cat = (bf16_t*)(ws + WS_B); C.kvt = (float*)(ws + WS_C); C.gdec = (float*)(ws + WS_G); C.out = out_ptr(); \
        C.wa2 = in_ptr(10) + (size_t)l * 16 * 256; C.ba = in_ptr(11) + l * 256; C.nw = (wv < 4 ? in_ptr(12) : in_ptr(13)) + l * 256; C.st = (wv < 4 ? in_ptr(2) : in_ptr(3)); C.ckb = (const bf16_t*)(ws + WS_CKB); C.cvb = C.ckb + CACHE_ELEMS; \
        __builtin_amdgcn_sched_barrier(0)
        for (int rep = 0; rep < 1 + PROBE_M1X2; ++rep)
        for (int u = bx; u < 256; u += G) {
            const int b = u & 7, n = u >> 3;
            for (int rk = 0; rk < 1 + PROBE_KVX2; ++rk) { MAKE_CTX(); kv_local<false>(C, wv >> 2, b, n, wv & 3, wl); }
            for (int ra = 0; ra < 1 + PROBE_ATX2; ++ra) { MAKE_CTX(); attn_wave<false>(C, b, n, wave, wl, biasT + wave * NREV, biasT[wave * NREV]); }
            if (n == 0) { MAKE_CTX(); attn_wave<true>(C, b, 0, wave, wl, biasT + wave * NREV, biasT[wave * NREV]); }
            if (n == 1) { MAKE_CTX(); mix_out<true>(C, wv >> 2, b, 0, wv & 3, wl); }
            if (n == 2) { MAKE_CTX(); kv_local<true>(C, wv >> 2, b, 0, wv & 3, wl); }
        }
        xcd_barrier(xbar);
        {
            LANE_TID();
            float* KVT = (float*)WSP(WS_C); const float* GDEC = (const float*)WSP(WS_G); float* outp = out_ptr();
            for (int it = bx * 512 + tid; it < 131072; it += G * 512) {
                const int seq = it >> 11, e2 = it & 2047, type = seq >> 5, b = (seq >> 2) & 7, h = seq & 3;
                const int dv = e2 >> 5, dk = (2 * e2) & 63;
                float* base = KVT + (size_t)seq * 32 * 4096 + 2 * e2;
                const float dret = exp2f(ret_lg2(h) * 64.0f);
                const float* gd = GDEC + (size_t)((b * 4 + h) * 32) * 64 + dk;
                f32x2 kvv[32], dd[32];
#pragma unroll
                for (int c = 0; c < 32; ++c) kvv[c] = *(const f32x2*)(base + (size_t)c * 4096);
                if (type == 1) {
#pragma unroll
                    for (int c = 0; c < 32; ++c) dd[c] = *(const f32x2*)(gd + c * 64);
                } else {
#pragma unroll
                    for (int c = 0; c < 32; ++c) dd[c] = (f32x2){dret, dret};
                }
                f32x2 s = (f32x2){0.f, 0.f};
#pragma unroll
                for (int c = 0; c < 32; ++c) { *(f32x2*)(base + (size_t)c * 4096) = s; s = dd[c] * s + kvv[c]; }
                float* so = outp + (type == 0 ? O_RETP : O_GLAP) + (size_t)((l * 8 + b) * 4 + h) * 4096;
                so[dk * 64 + dv] = s[0]; so[(dk + 1) * 64 + dv] = s[1];
            }
        }
        xcd_barrier(xbar);
        for (int rep = 0; rep < 1 + PROBE_M3X2; ++rep)
        for (int u = bx; u < 256; u += G) { MAKE_CTX(); mix_out<false>(C, wv >> 2, u & 7, u >> 3, wv & 3, wl); }
        xcd_barrier(xbar);
        {
            LANE_TID();
            unsigned char* ws = ws_ptr(); float* XR = out_ptr() + O_Y;
            const float* x_prompt = in_ptr(0); const float* x_sample = in_ptr(1);
            pg8::Gemm g{(const bf16_t*)(ws + WS_B), (const bf16_t*)(ws + WS_WOUT) + (size_t)l * DM * DM, MP, DM, DM}; pg8::StaticOrder S; S.init(MP, DM, Gq, bxq);
            pg8::EpiRes E{l == 0 ? x_prompt : XR, l == 0 ? (long long)((const char*)x_sample - (const char*)x_prompt) : (long long)MP * DM * 4, XR, (bf16_t*)(ws + WS_C), (float*)(ws + WS_SS) + (size_t)(2 * l + 1) * MT};
            pg8::gemm_phase<pg8::EpiRes, pg8::StaticOrder, true, true>(lds, g, S, E, tid);
            {
                SArgs a{}; a.A = (const bf16_t*)(ws + WS_B) + (size_t)MP * DM; a.Bt = (const bf16_t*)(ws + WS_WOUT) + (size_t)l * DM * DM; a.K = DM; a.nunits = 4 * 16;
                a.obf = (bf16_t*)(ws + WS_C) + (size_t)MP * DM; a.ldo = DM; a.ss_out = (float*)(ws + WS_SS) + (size_t)(2 * l + 1) * MT + MP;
                a.xold = l == 0 ? x_sample : XR + (size_t)MP * DM; a.xr = XR + (size_t)MP * DM;
                int ub, us; sample_share((MP / 256) * (DM / 256), Gq, bxq, ub, us);
                sample_gemm<SK_RES>(lds, a, ub, us, wave, lane);
                const int nsamp = a.nunits < Gq ? a.nunits : Gq;
                if (Gq == 256 && bxq >= nsamp) {
                    LAS float* scr = (LAS float*)(lds + wave * WAVE_LDS);
                    for (int it = (bxq - nsamp) * 8 + wave; it < 128 * 8; it += (Gq - nsamp) * 8)
                        tr_item128(in_ptr(17) + (size_t)l * DFF * DM, DFF, DM, (bf16_t*)(ws + WS_WDN) + (size_t)l * DM * DFF, it / 8, it % 8, nullptr, scr, lane);
                }
            }
        }
        xcd_barrier(xbar);
        {
            LANE_TID();
            unsigned char* ws = ws_ptr();
            pg8::Gemm g{(const bf16_t*)(ws + WS_C), (const bf16_t*)(ws + WS_WUP) + (size_t)l * DFF * DM, MP, DFF, DM}; pg8::StaticOrder S; S.init(MP, DFF, Gq, bxq);
            pg8::EpiUp E{(bf16_t*)(ws + WS_A), (const float*)(ws + WS_SS) + (size_t)(2 * l + 1) * MT, DFF};
            pg8::gemm_phase<pg8::EpiUp, pg8::StaticOrder, true, true>(lds, g, S, E, tid);
            if (PROBE_UP2) pg8::gemm_phase<pg8::EpiUp, pg8::StaticOrder, true, true>(lds, g, S, E, tid);
            if (PROBE_UP2B) { xcd_barrier(xbar); pg8::gemm_phase<pg8::EpiUp, pg8::StaticOrder, true, true>(lds, g, S, E, tid); }
            {
                SArgs a{}; a.A = (const bf16_t*)(ws + WS_C) + (size_t)MP * DM; a.Bt = (const bf16_t*)(ws + WS_WUP) + (size_t)l * DFF * DM; a.K = DM; a.nunits = 4 * 64;
                a.obf = (bf16_t*)(ws + WS_A) + (size_t)MP * DFF; a.ldo = DFF; a.ss_in = (const float*)(ws + WS_SS) + (size_t)(2 * l + 1) * MT + MP;
                int ub, us; sample_share((MP / 256) * (DFF / 256), Gq, bxq, ub, us);
                sample_gemm<SK_UP>(lds, a, ub, us, wave, lane);
            }
        }
        xcd_barrier(xbar);
        {
            LANE_TID();
            unsigned char* ws = ws_ptr(); float* XR = out_ptr() + O_Y;
            pg8::Gemm g{(const bf16_t*)(ws + WS_A), (const bf16_t*)(ws + WS_WDN) + (size_t)l * DM * DFF, MP, DM, DFF}; pg8::StaticOrder S; S.init(MP, DM, Gq, bxq);
            if (PROBE_DN2) { pg8::EpiUp E2{(bf16_t*)(ws + WS_C), (const float*)(ws + WS_SS) + (size_t)(2 * l + 1) * MT, DM}; pg8::gemm_phase<pg8::EpiUp, pg8::StaticOrder, true, true>(lds, g, S, E2, tid); }
            pg8::EpiRes E{XR, (long long)MP * DM * 4, XR, l == 0 ? (bf16_t*)(ws + WS_B) : (bf16_t*)nullptr, (float*)(ws + WS_SS) + (size_t)(2 * l + 2) * MT};
            pg8::gemm_phase<pg8::EpiRes, pg8::StaticOrder, true, true>(lds, g, S, E, tid);
            {
                SArgs a{}; a.A = (const bf16_t*)(ws + WS_A) + (size_t)MP * DFF; a.Bt = (const bf16_t*)(ws + WS_WDN) + (size_t)l * DM * DFF; a.K = DFF; a.nunits = 4 * 16;
                a.obf = l == 0 ? (bf16_t*)(ws + WS_B) + (size_t)MP * DM : (bf16_t*)nullptr; a.ldo = DM; a.ss_out = (float*)(ws + WS_SS) + (size_t)(2 * l + 2) * MT + MP;
                a.xold = XR + (size_t)MP * DM; a.xr = XR + (size_t)MP * DM;
                int ub, us; sample_share((MP / 256) * (DM / 256), Gq, bxq, ub, us);
                sample_gemm<SK_RES>(lds, a, ub, us, wave, lane);
            }
        }
        xcd_barrier(xbar);
    }
    for (int i = 0; i < PROBE_SYNCS; ++i) xcd_barrier(xbar);
    {
        LANE_TID();
        const int gw = bx * 8 + wave, NGW = G * 8;
        const float* fw = in_ptr(8); const float* SS = (const float*)WSP(WS_SS); float* XR = out_ptr() + O_Y;
        f32x4 w4[4];
#pragma unroll
        for (int j = 0; j < 4; ++j) w4[j] = *((const f32x4*)fw + lane + 64 * j);
        for (int m0 = gw; m0 < MT; m0 += 2 * NGW) {
            f32x4 v[2][4]; float rs[2];
#pragma unroll
            for (int q = 0; q < 2; ++q) {
                const int m = m0 + q * NGW;
                if (m < MT) {
                    rs[q] = SS[(size_t)4 * MT + m];
                    const f32x4* xr = (const f32x4*)(XR + (size_t)m * DM) + lane;
#pragma unroll
                    for (int j = 0; j < 4; ++j) v[q][j] = xr[64 * j];
                }
            }
#pragma unroll
            for (int q = 0; q < 2; ++q) {
                const int m = m0 + q * NGW;
                if (m < MT) {
                    const float r = 1.0f / sqrtf(rs[q] * (1.0f / 1024.0f) + EPS);
                    f32x4* xr = (f32x4*)(XR + (size_t)m * DM) + lane;
#pragma unroll
                    for (int j = 0; j < 4; ++j) xr[64 * j] = v[q][j] * r * w4[j];
                }
            }
        }
    }
}

extern "C" void kernel_launch(void* const* d_in, const int* in_sizes, int n_in, void* d_out, int out_size, void* d_ws, size_t ws_size, hipStream_t stream) {
    static int grid = 0;
    if (grid == 0) {
        if (n_in != 18 || (size_t)out_size != O_END || ws_size < WS_END) { fprintf(stderr, "kernel_launch: unexpected shapes: n_in %d out %d ws %zu (need %zu)\n", n_in, out_size, ws_size, (size_t)WS_END); grid = -1; return; }
        int dev = 0, cus = 0, per_cu = 0;
        hipGetDevice(&dev); hipDeviceGetAttribute(&cus, hipDeviceAttributeMultiprocessorCount, dev);
        if (hipFuncSetAttribute((const void*)hybrid_fwd, hipFuncAttributeMaxDynamicSharedMemorySize, LDS_BYTES) != hipSuccess) { fprintf(stderr, "kernel_launch: hipFuncSetAttribute failed\n"); }
        if (hipOccupancyMaxActiveBlocksPerMultiprocessor(&per_cu, (const void*)hybrid_fwd, 512, LDS_BYTES) != hipSuccess || per_cu < 1) { fprintf(stderr, "kernel_launch: occupancy query says %d\n", per_cu); per_cu = 1; }
        (void)hipGetLastError();
        grid = cus * per_cu;
        if (grid > 256) grid = 256;
    }
    if (grid < 0) return;
    if (hipMemsetAsync((unsigned char*)d_ws + WS_CTL, 0, CTL_BYTES, stream) != hipSuccess) { fprintf(stderr, "kernel_launch: memset of the barrier words failed\n"); return; }
    Params p{};
    for (int i = 0; i < 18; ++i) p.in[i] = (const float*)d_in[i];
    p.out = (float*)d_out; p.ws = (unsigned char*)d_ws;
    void* args[] = {&p};
    hipError_t e = hipLaunchCooperativeKernel((const void*)hybrid_fwd, dim3(grid), dim3(512), args, LDS_BYTES, stream);
    if (e != hipSuccess) fprintf(stderr, "kernel_launch: cooperative launch failed: %s (grid %d)\n", hipGetErrorString(e), grid);
}
```

```cpp
#include <hip/hip_runtime.h>
#include <hip/hip_cooperative_groups.h>
#include <cstdio>
#include <cstdint>
namespace cg = cooperative_groups;
#ifndef PROBE_UP2
#define PROBE_UP2 0
#endif
#ifndef PROBE_M1X2
#define PROBE_M1X2 0
#endif
#ifndef PROBE_P0X2
#define PROBE_P0X2 0
#endif
#ifndef PROBE_SYNCS
#define PROBE_SYNCS 0
#endif
#ifndef PROBE_IN2
#define PROBE_IN2 0
#endif
#ifndef PROBE_DN2
#define PROBE_DN2 0
#endif
#ifndef PROBE_UP2B
#define PROBE_UP2B 0
#endif
#ifndef PROBE_KVX2
#define PROBE_KVX2 0
#endif
#ifndef PROBE_ATX2
#define PROBE_ATX2 0
#endif
#ifndef PROBE_M3X2
#define PROBE_M3X2 0
#endif
namespace pg8 {
#define PG8_LAS __attribute__((address_space(3)))
typedef unsigned short bf16_t;
typedef short bf16x8 __attribute__((ext_vector_type(8)));
typedef float f32x4 __attribute__((ext_vector_type(4)));
typedef unsigned u32x4 __attribute__((ext_vector_type(4)));
constexpr int BM = 256, BK = 64, HALF = 128, HTB = HALF * BK * 2  , STAGE_BYTES = 8 * HTB, NXCD = 8, WGM = 8;

__host__ __device__ __forceinline__ int lds_byte(int r, int c) { const int st = (r >> 4) * 2 + (c >> 5), rr = r & 15, cc = c & 31, ob = rr * 64 + cc * 2; return st * 1024 + (ob ^ (((ob >> 9) & 1) << 5)); }
__host__ __device__ __forceinline__ void stage_rc(int b, int& R, int& C) { const int st = b / 1024, sb = b % 1024, swz = sb ^ (((sb >> 9) & 1) << 5); R = (st >> 1) * 16 + swz / 64; C = (st & 1) * 32 + (swz % 64) / 2; }
__host__ __device__ __forceinline__ int perm32(int rho) { const int n = rho >> 4, i = rho & 15; return 8 * (i >> 2) + 4 * n + (i & 3); }

struct Unit { int pm, pn; };
struct Gemm { const bf16_t* A; const bf16_t* Bt; int M, N, K; };

struct StaticOrder {
    int nM, nN, nwg, G, c;
    __host__ __device__ __forceinline__ void init(int M, int N, int G_, int c_) { nM = M / BM; nN = N / BM; nwg = nM * nN; G = G_; c = c_; }
    __host__ __device__ __forceinline__ bool next(int i, Unit& u) const {
        const long L = (long)i * G + c; if (L >= nwg) return false;
        int wgid = (int)L; { const int q = nwg / NXCD, r = nwg % NXCD, xcd = wgid % NXCD, off = wgid / NXCD; wgid = (xcd < r ? xcd * (q + 1) : r * (q + 1) + (xcd - r) * q) + off; }
        const int nig = WGM * nN, gid = wgid / nig, fm = gid * WGM, gsz = (nM - fm) < WGM ? (nM - fm) : WGM;
        u.pm = fm + ((wgid % nig) % gsz); u.pn = (wgid % nig) / gsz; return true;
    }
    __device__ __forceinline__ void a_ready(const Unit&) const {}
    __device__ __forceinline__ void done(const Unit&) const {}
};

__device__ __forceinline__ unsigned cvt_pk_bf16(float lo, float hi) { unsigned r; asm volatile("v_cvt_pk_bf16_f32 %0, %1, %2" : "=v"(r) : "v"(lo), "v"(hi)); return r; }
typedef float f32x2 __attribute__((ext_vector_type(2)));

typedef unsigned u32x2 __attribute__((ext_vector_type(2)));
constexpr int E_MP = 16384;
struct EpiIn {
    static constexpr bool PERM = true, AFTER_DRAIN = false;
    bf16_t* proj; float* lowf; const float* ss; float* out; long long okp, ovp, oks, ovs;
    __device__ __forceinline__ void operator()(const f32x4 (&acc)[2][2][4][2], const Unit& u, int wr, int wc, int fr, int fq) const {
        const int row0 = u.pm * BM + wr * 64 + fr, col0 = u.pn * BM + wc * 32 + 8 * fq;
        float* kv = nullptr; int rsub = 0, cbase = 0;
        if (u.pn >= 10 && u.pn < 14) {
            const bool isk = u.pn < 12; cbase = isk ? 2560 : 3072;
            if (u.pm >= 64) { kv = out + (isk ? oks : ovs); rsub = E_MP; }
            else if ((u.pm & 7) >= 6) { kv = out + (isk ? okp : ovp); rsub = 1536 * ((u.pm >> 3) + 1); }
        }
        const bool lowt = (u.pn == 14) && (wc == 0) && (fq < 2);
#pragma unroll
        for (int ai = 0; ai < 2; ++ai)
#pragma unroll
            for (int m = 0; m < 4; ++m) {
                const int r = row0 + ai * HALF + m * 16;
                const float rs = 1.0f / sqrtf(ss[r] * (1.0f / 1024.0f) + 1e-6f);
                bf16_t* rowp = proj + (size_t)r * 3840 + col0;
#pragma unroll
                for (int bj = 0; bj < 2; ++bj) {
                    const f32x4 v0 = acc[ai][bj][m][0] * rs, v1 = acc[ai][bj][m][1] * rs;
                    u32x4 w; w.x = cvt_pk_bf16(v0[0], v0[1]); w.y = cvt_pk_bf16(v0[2], v0[3]); w.z = cvt_pk_bf16(v1[0], v1[1]); w.w = cvt_pk_bf16(v1[2], v1[3]);
                    *(u32x4*)(rowp + bj * HALF) = w;
                    if (kv) { float* d = kv + (size_t)(r - rsub) * 512 + (col0 + bj * HALF - cbase); *(f32x4*)d = v0; *(f32x4*)(d + 4) = v1; }
                    if (lowt && bj == 0) { float* d = lowf + (size_t)r * 16 + 8 * fq; *(f32x4*)d = v0; *(f32x4*)(d + 4) = v1; }
                }
            }
    }
};
struct EpiRes {
    static constexpr bool PERM = true, AFTER_DRAIN = false;
    const float* xold_p; long long sdelta; float* xr; bf16_t* xb; float* ss;
    __device__ __forceinline__ void operator()(const f32x4 (&acc)[2][2][4][2], const Unit& u, int wr, int wc, int fr, int fq) const {
        const int row0 = u.pm * BM + wr * 64 + fr, col0 = u.pn * BM + wc * 32 + 8 * fq;
#pragma unroll
        for (int ai = 0; ai < 2; ++ai)
#pragma unroll
            for (int m = 0; m < 4; ++m) {
                const int r = row0 + ai * HALF + m * 16;
                const long long xoff = (u.pm < 64) ? (long long)r * 4096 : sdelta + (long long)(r - E_MP) * 4096;
                const float* xo = (const float*)((const char*)xold_p + xoff) + col0;
                float* xn = xr + (size_t)r * 1024 + col0;
                float sq = 0.f;
#pragma unroll
                for (int bj = 0; bj < 2; ++bj) {
                    const f32x4 v0 = acc[ai][bj][m][0] + *(const f32x4*)(xo + bj * HALF), v1 = acc[ai][bj][m][1] + *(const f32x4*)(xo + bj * HALF + 4);
                    *(f32x4*)(xn + bj * HALF) = v0; *(f32x4*)(xn + bj * HALF + 4) = v1;
                    sq += (v0[0] * v0[0] + v0[1] * v0[1]) + (v0[2] * v0[2] + v0[3] * v0[3]) + (v1[0] * v1[0] + v1[1] * v1[1]) + (v1[2] * v1[2] + v1[3] * v1[3]);
                    if (xb) { u32x4 w; w.x = cvt_pk_bf16(v0[0], v0[1]); w.y = cvt_pk_bf16(v0[2], v0[3]); w.z = cvt_pk_bf16(v1[0], v1[1]); w.w = cvt_pk_bf16(v1[2], v1[3]);
                        *(u32x4*)(xb + (size_t)r * 1024 + col0 + bj * HALF) = w; }
                }
                sq += __shfl_xor(sq, 16); sq += __shfl_xor(sq, 32);
                if (fq == 0) atomicAdd(ss + r, sq);
            }
    }
};
struct EpiUp {
    static constexpr bool PERM = true, AFTER_DRAIN = false;
    bf16_t* U; const float* ss; int ldu;
    __device__ __forceinline__ void operator()(const f32x4 (&acc)[2][2][4][2], const Unit& u, int wr, int wc, int fr, int fq) const {
        const int row0 = u.pm * BM + wr * 64 + fr, col0 = u.pn * BM + wc * 32 + 8 * fq;
#pragma unroll
        for (int ai = 0; ai < 2; ++ai)
#pragma unroll
            for (int m = 0; m < 4; ++m) {
                const int r = row0 + ai * HALF + m * 16;
                const float rs = 1.0f / sqrtf(ss[r] * (1.0f / 1024.0f) + 1e-6f);
                bf16_t* rowp = U + (size_t)r * ldu + col0;
#pragma unroll
                for (int bj = 0; bj < 2; ++bj) {
                    f32x4 v0 = acc[ai][bj][m][0] * rs, v1 = acc[ai][bj][m][1] * rs;
#pragma unroll
                    for (int e = 0; e < 4; ++e) { const float a = fmaxf(v0[e], 0.f), b = fmaxf(v1[e], 0.f); v0[e] = a * a; v1[e] = b * b; }
                    u32x4 w; w.x = cvt_pk_bf16(v0[0], v0[1]); w.y = cvt_pk_bf16(v0[2], v0[3]); w.z = cvt_pk_bf16(v1[0], v1[1]); w.w = cvt_pk_bf16(v1[2], v1[3]);
                    *(u32x4*)(rowp + bj * HALF) = w;
                }
            }
    }
};

template <class Epi, class Sched, bool ALIGN_EPI = false, bool SP2 = false>
__device__ __forceinline__ void gemm_phase(PG8_LAS unsigned char* lds, const Gemm g, const Sched& S, const Epi& E, const int tid_in) {
    int tid_ = tid_in; asm volatile("" : "+v"(tid_));
    const int tid = tid_, wid = __builtin_amdgcn_readfirstlane(tid >> 6), lane = tid & 63, wr = wid >> 2, wc = wid & 3, fr = lane & 15, fq = lane >> 4;
    const int K = g.K, nt = K / BK;
    unsigned voffA[2], voffB[2];
#pragma unroll
    for (int i = 0; i < 2; ++i) { int R, C; stage_rc(tid * 16 + i * 8192, R, C); const int Rb = Epi::PERM ? ((R & ~31) + perm32(R & 31)) : R;
        voffA[i] = (unsigned)(R * K + C) * 2u; voffB[i] = (unsigned)(Rb * K + C) * 2u; }
    const size_t kstep = (size_t)(BK * 2);
    const size_t hstep = (size_t)HALF * K * 2;
    const size_t tstep = 2 * hstep;
    const unsigned ldsw = (unsigned)wid * 1024u;
    const int aoff = lds_byte(wr * 64 + fr, fq * 8), boff = lds_byte(wc * 32 + fr, fq * 8);
#define PG8_SA(b, h) (((b) * 2 + (h)) * HTB)
#define PG8_SB(b, h) ((4 + (b) * 2 + (h)) * HTB)
#define PG8_STAGE(bufoff, gbase, voff) do { _Pragma("unroll") for (int _i = 0; _i < 2; ++_i) \
        __builtin_amdgcn_global_load_lds((const unsigned*)((const char*)(gbase) + (voff)[_i]), (PG8_LAS unsigned*)(lds + (bufoff) + ldsw + _i * 8192), 16, 0, 0); } while (0)
#define PG8_LDA(dst, b, h) do { _Pragma("unroll") for (int m = 0; m < 4; ++m) _Pragma("unroll") for (int k = 0; k < 2; ++k) dst[m][k] = *(const PG8_LAS bf16x8*)(lds + PG8_SA(b, h) + aoff + m * 2048 + k * 1024); } while (0)
#define PG8_LDB(dst, b, h) do { _Pragma("unroll") for (int n = 0; n < 2; ++n) _Pragma("unroll") for (int k = 0; k < 2; ++k) dst[n][k] = *(const PG8_LAS bf16x8*)(lds + PG8_SB(b, h) + boff + n * 2048 + k * 1024); } while (0)
#define PG8_MMA(ai, bj, At, Bt) do { __builtin_amdgcn_s_setprio(1); _Pragma("unroll") for (int m = 0; m < 4; ++m) _Pragma("unroll") for (int n = 0; n < 2; ++n) _Pragma("unroll") for (int k = 0; k < 2; ++k) \
        acc[ai][bj][m][n] = __builtin_amdgcn_mfma_f32_16x16x32_bf16(Bt[n][k], At[m][k], acc[ai][bj][m][n], 0, 0, 0); __builtin_amdgcn_s_setprio(0); } while (0)
#define PG8_WAIT_V(n) asm volatile("s_waitcnt vmcnt(" #n ")" ::: "memory")
#define PG8_WAIT_L(n) asm volatile("s_waitcnt lgkmcnt(" #n ")" ::: "memory")
#define PG8_BAR __builtin_amdgcn_s_barrier()
#define PG8_SCHED __builtin_amdgcn_sched_barrier(0)
    Unit cur, nxt; int ui = 0;
    if (!S.next(0, cur)) return;
    f32x4 acc[2][2][4][2];
#pragma unroll
    for (int a = 0; a < 2; ++a)
#pragma unroll
        for (int b = 0; b < 2; ++b)
#pragma unroll
            for (int m = 0; m < 4; ++m)
#pragma unroll
                for (int n = 0; n < 2; ++n) acc[a][b][m][n] = (f32x4){0.f, 0.f, 0.f, 0.f};
    bf16x8 At[4][2], B0[2][2], B1[2][2];
    const char* cA = (const char*)g.A + (size_t)cur.pm * tstep; const char* cB = (const char*)g.Bt + (size_t)cur.pn * tstep;
    S.a_ready(cur);
    if constexpr (SP2) {
        PG8_STAGE(PG8_SB(0, 0), cB, voffB); PG8_STAGE(PG8_SB(0, 1), cB + hstep, voffB); PG8_STAGE(PG8_SA(0, 0), cA, voffA); PG8_STAGE(PG8_SA(0, 1), cA + hstep, voffA);
        if (wr == 1) PG8_BAR;
        PG8_WAIT_V(2); PG8_BAR;
        PG8_STAGE(PG8_SB(1, 0), cB + kstep, voffB); PG8_STAGE(PG8_SA(1, 0), cA + kstep, voffA); PG8_STAGE(PG8_SB(1, 1), cB + hstep + kstep, voffB);
        PG8_WAIT_V(6); PG8_BAR;
    } else {
        PG8_STAGE(PG8_SB(0, 0), cB, voffB); PG8_STAGE(PG8_SA(0, 0), cA, voffA); PG8_STAGE(PG8_SB(0, 1), cB + hstep, voffB); PG8_STAGE(PG8_SA(0, 1), cA + hstep, voffA);
        if (wr == 1) PG8_BAR;
        PG8_WAIT_V(4); PG8_BAR;
        PG8_STAGE(PG8_SB(1, 0), cB + kstep, voffB); PG8_STAGE(PG8_SA(1, 0), cA + kstep, voffA); PG8_STAGE(PG8_SB(1, 1), cB + hstep + kstep, voffB);
        PG8_WAIT_V(6); PG8_BAR;
    }
    for (;;) {
        const bool has_next = S.next(ui + 1, nxt);
        const char* nA = has_next ? (const char*)g.A + (size_t)nxt.pm * tstep : cA; const char* nB = has_next ? (const char*)g.Bt + (size_t)nxt.pn * tstep : cB;
        for (int t = 0; t < nt; t += 2) {
            const bool last = (t == nt - 2);
            const char* a1 = cA + (size_t)(t + 1) * kstep;
            const char* a2 = last ? nA : cA + (size_t)(t + 2) * kstep; const char* b2 = last ? nB : cB + (size_t)(t + 2) * kstep;
            const char* a3 = a2 + kstep; const char* b3 = b2 + kstep;
            if (last && has_next) S.a_ready(nxt);
            if constexpr (SP2) {
            PG8_LDB(B0, 0, 0); PG8_LDB(B1, 0, 1); PG8_SCHED; PG8_LDA(At, 0, 0); PG8_STAGE(PG8_SA(1, 1), a1 + hstep, voffA);
            PG8_WAIT_V(8); PG8_WAIT_L(0); PG8_BAR; PG8_MMA(0, 0, At, B0); PG8_MMA(0, 1, At, B1); PG8_BAR; PG8_SCHED;
            PG8_LDA(At, 0, 1); PG8_STAGE(PG8_SB(0, 0), b2, voffB); PG8_STAGE(PG8_SB(0, 1), b2 + hstep, voffB); PG8_STAGE(PG8_SA(0, 0), a2, voffA);
            PG8_WAIT_V(8); PG8_WAIT_L(0); PG8_BAR; PG8_MMA(1, 0, At, B0); PG8_MMA(1, 1, At, B1); PG8_BAR; PG8_SCHED;
            PG8_LDB(B0, 1, 0); PG8_LDB(B1, 1, 1); PG8_SCHED; PG8_LDA(At, 1, 0); PG8_STAGE(PG8_SA(0, 1), a2 + hstep, voffA);
            PG8_WAIT_V(8); PG8_WAIT_L(0); PG8_BAR; PG8_MMA(0, 0, At, B0); PG8_MMA(0, 1, At, B1); PG8_BAR; PG8_SCHED;
            PG8_LDA(At, 1, 1); PG8_STAGE(PG8_SB(1, 0), b3, voffB); PG8_STAGE(PG8_SB(1, 1), b3 + hstep, voffB); PG8_STAGE(PG8_SA(1, 0), a3, voffA);
            PG8_WAIT_V(8); PG8_WAIT_L(0); PG8_BAR; PG8_MMA(1, 0, At, B0); PG8_MMA(1, 1, At, B1); PG8_BAR; PG8_SCHED;
            } else {
            PG8_LDB(B0, 0, 0); PG8_SCHED; PG8_LDA(At, 0, 0); PG8_STAGE(PG8_SA(1, 1), a1 + hstep, voffA);
            PG8_WAIT_L(8); PG8_BAR; PG8_WAIT_L(0); PG8_MMA(0, 0, At, B0); PG8_BAR; PG8_SCHED;
            PG8_LDB(B1, 0, 1); PG8_STAGE(PG8_SB(0, 0), b2, voffB);
            PG8_BAR; PG8_WAIT_L(0); PG8_MMA(0, 1, At, B1); PG8_BAR;
            PG8_LDA(At, 0, 1); PG8_STAGE(PG8_SA(0, 0), a2, voffA);
            PG8_BAR; PG8_WAIT_L(0); PG8_MMA(1, 0, At, B0); PG8_BAR; PG8_SCHED;
            PG8_STAGE(PG8_SB(0, 1), b2 + hstep, voffB);
            PG8_WAIT_V(6); PG8_BAR; PG8_MMA(1, 1, At, B1); PG8_BAR;
            PG8_LDB(B0, 1, 0); PG8_SCHED; PG8_LDA(At, 1, 0); PG8_STAGE(PG8_SA(0, 1), a2 + hstep, voffA);
            PG8_WAIT_L(8); PG8_BAR; PG8_WAIT_L(0); PG8_MMA(0, 0, At, B0); PG8_BAR; PG8_SCHED;
            PG8_LDB(B1, 1, 1); PG8_STAGE(PG8_SB(1, 0), b3, voffB);
            PG8_BAR; PG8_WAIT_L(0); PG8_MMA(0, 1, At, B1); PG8_BAR;
            PG8_LDA(At, 1, 1); PG8_STAGE(PG8_SA(1, 0), a3, voffA);
            PG8_BAR; PG8_WAIT_L(0); PG8_MMA(1, 0, At, B0); PG8_BAR; PG8_SCHED;
            PG8_STAGE(PG8_SB(1, 1), b3 + hstep, voffB);
            PG8_WAIT_V(6); PG8_BAR; PG8_MMA(1, 1, At, B1); PG8_BAR;
            }
        }
        if constexpr (ALIGN_EPI) { if (wr == 0) PG8_BAR; }
        if constexpr (!Epi::AFTER_DRAIN) { E(acc, cur, wr, wc, fr, fq); S.done(cur); }
        if (!has_next) break;
#pragma unroll
        for (int a = 0; a < 2; ++a)
#pragma unroll
            for (int b = 0; b < 2; ++b)
#pragma unroll
                for (int m = 0; m < 4; ++m)
#pragma unroll
                    for (int n = 0; n < 2; ++n) acc[a][b][m][n] = (f32x4){0.f, 0.f, 0.f, 0.f};
        cur = nxt; cA = nA; cB = nB; ++ui;
        if constexpr (ALIGN_EPI) { if (wr == 1) PG8_BAR; }
    }
    PG8_WAIT_V(0);
    if constexpr (!ALIGN_EPI) { if (wr == 0) PG8_BAR; }
    PG8_BAR;
    if constexpr (Epi::AFTER_DRAIN) { E.fused(acc, cur, wr, wc, fr, fq, lds, wid, lane); S.done(cur); }
#undef PG8_SA
#undef PG8_SB
#undef PG8_STAGE
#undef PG8_LDA
#undef PG8_LDB
#undef PG8_MMA
#undef PG8_WAIT_V
#undef PG8_WAIT_L
#undef PG8_BAR
#undef PG8_SCHED
}
}


#define LAS __attribute__((address_space(3)))
typedef unsigned short bf16_t;
typedef short bf16x8 __attribute__((ext_vector_type(8)));
typedef short s16x4 __attribute__((ext_vector_type(4)));
typedef short v4i16_t __attribute__((ext_vector_type(4)));
typedef float f32x4 __attribute__((ext_vector_type(4)));
typedef float f32x2 __attribute__((ext_vector_type(2)));
typedef float f32x16 __attribute__((ext_vector_type(16)));
typedef unsigned u32x4 __attribute__((ext_vector_type(4)));
typedef unsigned u32x2 __attribute__((ext_vector_type(2)));

constexpr int DM = 1024, NB = 8, SEQ = 2048, MP = NB * SEQ, SL = 32, MS = NB * SL, MT = MP + MS;
constexpr int PS = 3840, DFF = 4096, INCOLS = 3600;
constexpr int C_QA = 0, C_KA = 256, C_VA = 512, C_GA = 768, C_QB = 1024, C_KB = 1280, C_VB = 1536, C_GB = 1792, C_QC = 2048, C_KC = 2560, C_VC = 3072, C_LOW = 3584;
constexpr int NREL = 320;
constexpr float EPS = 1e-6f;
constexpr size_t WS_A = 0;
constexpr size_t WS_B = WS_A + (size_t)MT * DFF * 2;
constexpr size_t WS_C = WS_B + (size_t)MT * DM * 2;
constexpr size_t WS_WIN = WS_C + (size_t)MT * DM * 2;
constexpr size_t WS_WOUT = WS_WIN + (size_t)2 * PS * DM * 2;
constexpr size_t WS_WUP = WS_WOUT + (size_t)2 * DM * DM * 2;
constexpr size_t WS_WDN = WS_WUP + (size_t)2 * DFF * DM * 2;
constexpr size_t WS_LOWF = WS_WDN + (size_t)2 * DFF * DM * 2;
constexpr size_t WS_SS = WS_LOWF + (size_t)MT * 16 * 4;
constexpr size_t WS_G = WS_SS + (size_t)5 * MT * 4;
constexpr size_t WS_ROPE = WS_G + (size_t)1024 * 64 * 4;
constexpr size_t WS_CTL = WS_ROPE + (size_t)2080 * 64 * 4;
constexpr size_t CTL_BYTES = 16384;
constexpr size_t WS_END = WS_CTL + CTL_BYTES;
static_assert((size_t)2048 * 4096 * 4 <= (size_t)MT * DM * 2, "KVT fits region C");
constexpr size_t WS_CKB = WS_A + (size_t)MT * PS * 2;
constexpr size_t CACHE_ELEMS = (size_t)8 * 512 * 512;
static_assert(WS_CKB + 2 * CACHE_ELEMS * 2 <= WS_B, "cache copies fit behind PROJ");
static_assert(WS_END <= (size_t)256 * 1024 * 1024, "d_ws map");
constexpr size_t O_Y = 0, O_RETP = (size_t)MT * DM, O_GLAP = O_RETP + 262144, O_KP = O_GLAP + 262144, O_VP = O_KP + 4194304, O_RETS = O_VP + 4194304, O_GLAS = O_RETS + 262144,
                 O_KS = O_GLAS + 262144, O_VS = O_KS + 262144, O_END = O_VS + 262144;
constexpr int TS = 144;
constexpr int TILE_B = 64 * TS;
constexpr int WAVE_LDS = 2 * TILE_B;
constexpr int LDS_BIAS = 8 * WAVE_LDS;
constexpr int NREV = 384;
constexpr int LDS_BARST = LDS_BIAS + 8 * NREV * 4;
constexpr int LDS_BYTES = LDS_BARST + 16;
static_assert(LDS_BYTES <= 160 * 1024 && pg8::STAGE_BYTES <= LDS_BIAS, "LDS map");

struct Params { const float* in[18]; float* out; unsigned char* ws; };
__device__ __forceinline__ int lane_id_asm() { int l; asm volatile("v_mbcnt_lo_u32_b32 %0, -1, 0\n\tv_mbcnt_hi_u32_b32 %0, -1, %0" : "=v"(l)); return l; }
typedef const __attribute__((address_space(4))) char* kaptr_t;
__device__ __forceinline__ kaptr_t karg_base() { kaptr_t ka = (kaptr_t)__builtin_amdgcn_kernarg_segment_ptr(); asm volatile("" : "+s"(ka)); return ka; }
__device__ __forceinline__ const float* in_ptr(int i) { return *(const float* const __attribute__((address_space(4)))*)(karg_base() + 8 * i); }
__device__ __forceinline__ float* out_ptr() { return *(float* const __attribute__((address_space(4)))*)(karg_base() + 8 * 18); }
__device__ __forceinline__ unsigned char* ws_ptr() { return *(unsigned char* const __attribute__((address_space(4)))*)(karg_base() + 8 * 19); }

typedef float f32x2_t __attribute__((ext_vector_type(2))); typedef __bf16 bf16x2_t __attribute__((ext_vector_type(2)));
__device__ __forceinline__ unsigned pk2(float lo, float hi) { const f32x2_t v = {lo, hi}; const bf16x2_t b = __builtin_convertvector(v, bf16x2_t); return __builtin_bit_cast(unsigned, b); }
__device__ __forceinline__ float bflo(unsigned u) { return __uint_as_float(u << 16); }
__device__ __forceinline__ float bfhi(unsigned u) { return __uint_as_float(u & 0xffff0000u); }
__device__ __forceinline__ float bf2f(bf16_t h) { return __uint_as_float((unsigned)h << 16); }
__device__ __forceinline__ bf16_t f2bf(float f) { return (bf16_t)(pk2(f, 0.f) & 0xffffu); }
__device__ __forceinline__ int crow(int r, int hi) { return (r & 3) + 8 * (r >> 2) + 4 * hi; }
__device__ __forceinline__ float silu(float x) { return x / (1.0f + __expf(-x)); }
__device__ __forceinline__ f32x16 mfma32(bf16x8 a, bf16x8 b, f32x16 c) { return __builtin_amdgcn_mfma_f32_32x32x16_bf16(a, b, c, 0, 0, 0); }
__device__ __forceinline__ bf16x8 as_bf16x8(u32x4 v) { return __builtin_bit_cast(bf16x8, v); }
__device__ __forceinline__ f32x16 zero16() { f32x16 z;
#pragma unroll
    for (int i = 0; i < 16; ++i) z[i] = 0.f; return z; }
__device__ __forceinline__ s16x4 ds_tr(LAS const unsigned char* p) { return __builtin_bit_cast(s16x4, __builtin_amdgcn_ds_read_tr16_b64_v4i16((LAS v4i16_t*)p)); }
__device__ __forceinline__ bf16x8 tr_nat(LAS const unsigned char* tile, int k0, int cb, int lane) {
    const int kq = lane >> 5, g = (lane >> 4) & 1, q = (lane & 15) >> 2, p = lane & 3;
    LAS const unsigned char* a = tile + (k0 + 8 * kq + q) * TS + (cb + 16 * g + 4 * p) * 2;
    const s16x4 lo = ds_tr(a), hi = ds_tr(a + 4 * TS);
    return (bf16x8){lo[0], lo[1], lo[2], lo[3], hi[0], hi[1], hi[2], hi[3]};
}
template <int STR = TS> __device__ __forceinline__ bf16x8 tr_perm(LAS const unsigned char* tile, int k0, int cb, int lane) {
    const int kq = lane >> 5, g = (lane >> 4) & 1, q = (lane & 15) >> 2, p = lane & 3;
    LAS const unsigned char* a = tile + (k0 + 4 * kq + q) * STR + (cb + 16 * g + 4 * p) * 2;
    const s16x4 lo = ds_tr(a), hi = ds_tr(a + 8 * STR);
    return (bf16x8){lo[0], lo[1], lo[2], lo[3], hi[0], hi[1], hi[2], hi[3]};
}
__device__ __forceinline__ bf16x8 tr_perm_swz(LAS const unsigned char* tile, int k0, int cb, int lane) {
    const int kq = lane >> 5, g = (lane >> 4) & 1, q = (lane & 15) >> 2, p = lane & 3;
    const int row = k0 + 4 * kq + q, ob = ((cb + 16 * g + 4 * p) * 2) ^ ((row & 2) << 5);
    LAS const unsigned char* a = tile + row * 128 + ob;
    const s16x4 lo = ds_tr(a), hi = ds_tr(a + 8 * 128);
    return (bf16x8){lo[0], lo[1], lo[2], lo[3], hi[0], hi[1], hi[2], hi[3]};
}
__device__ __forceinline__ bf16x8 row_frag(LAS const unsigned char* tile, int r0, int ks, int lane) {
    return *(LAS const bf16x8*)(tile + (r0 + (lane & 31)) * TS + (16 * ks + 8 * (lane >> 5)) * 2);
}
__device__ __forceinline__ bf16x8 pack_step(const f32x16& x, int s) {
    u32x4 w; w.x = pk2(x[8 * s + 0], x[8 * s + 1]); w.y = pk2(x[8 * s + 2], x[8 * s + 3]); w.z = pk2(x[8 * s + 4], x[8 * s + 5]); w.w = pk2(x[8 * s + 6], x[8 * s + 7]);
    return as_bf16x8(w);
}
__device__ __forceinline__ void load_tile(LAS unsigned char* tile, const bf16_t* src, int pitch, int nvalid, int lane) {
#pragma unroll
    for (int it = 0; it < 8; ++it) {
        const int id = it * 64 + lane, row = id >> 3, ch = id & 7;
        u32x4 v = (u32x4){0u, 0u, 0u, 0u};
        if (row < nvalid) v = *(const u32x4*)(src + (size_t)row * pitch + ch * 8);
        *(LAS u32x4*)(tile + row * TS + ch * 16) = v;
    }
}
__device__ __forceinline__ void store_tile(LAS const unsigned char* tile, bf16_t* dst, int pitch, int nvalid, int lane) {
#pragma unroll
    for (int it = 0; it < 8; ++it) {
        const int id = it * 64 + lane, row = id >> 3, ch = id & 7;
        const u32x4 v = *(LAS const u32x4*)(tile + row * TS + ch * 16);
        if (row < nvalid) *(u32x4*)(dst + (size_t)row * pitch + ch * 8) = v;
    }
}
__device__ __forceinline__ void load_tile_f32(LAS unsigned char* tile, const float* src, int pitch, int lane) {
#pragma unroll
    for (int it = 0; it < 16; ++it) {
        const int id = it * 64 + lane, row = id >> 4, c4 = id & 15;
        const f32x4 v = *(const f32x4*)(src + (size_t)row * pitch + c4 * 4);
        u32x2 w; w.x = pk2(v[0], v[1]); w.y = pk2(v[2], v[3]);
        *(LAS u32x2*)(tile + row * TS + c4 * 8) = w;
    }
}
__device__ __forceinline__ void load_rot(const bf16_t* rp, const float* cs, int kq, float scale, bool valid, bf16x8 (&fr)[4]) {
    u32x4 c[4];
#pragma unroll
    for (int ks = 0; ks < 4; ++ks) c[ks] = valid ? *(const u32x4*)(rp + 16 * ks + 8 * kq) : (u32x4){0u, 0u, 0u, 0u};
#pragma unroll
    for (int g = 0; g < 2; ++g) {
        const float* cp = cs + 16 * g + 8 * kq;
        const f32x4 ca = *(const f32x4*)cp, cb = *(const f32x4*)(cp + 4), sa = *(const f32x4*)(cp + 32), sb = *(const f32x4*)(cp + 36);
        float o1[8], o2[8];
#pragma unroll
        for (int e = 0; e < 8; ++e) {
            const unsigned w1 = c[g][e >> 1], w2 = c[g + 2][e >> 1];
            const float x1 = (e & 1) ? bfhi(w1) : bflo(w1), x2 = (e & 1) ? bfhi(w2) : bflo(w2);
            const float cc = (e < 4) ? ca[e & 3] : cb[e & 3], sn = (e < 4) ? sa[e & 3] : sb[e & 3];
            o1[e] = (x1 * cc - x2 * sn) * scale; o2[e] = (x1 * sn + x2 * cc) * scale;
        }
        u32x4 a, b;
        a.x = pk2(o1[0], o1[1]); a.y = pk2(o1[2], o1[3]); a.z = pk2(o1[4], o1[5]); a.w = pk2(o1[6], o1[7]);
        b.x = pk2(o2[0], o2[1]); b.y = pk2(o2[2], o2[3]); b.z = pk2(o2[4], o2[5]); b.w = pk2(o2[6], o2[7]);
        fr[g] = as_bf16x8(a); fr[g + 2] = as_bf16x8(b);
    }
}

struct Ctx {
    int l, lane, kq, li;
    const bf16_t* proj; const float* lowf; const float* rope; bf16_t* cat; float* kvt; float* gdec; float* out;
    const float* wa2; const float* ba; const float* nw; const float* st; const bf16_t* ckb; const bf16_t* cvb;
};
__device__ __forceinline__ float ret_lg2(int h) { return __log2f(1.0f - exp2f(-5.0f - (float)h)); }

struct GlaGate {
    f32x4 lw[4]; float w[16]; float bias, run;
    template <int L> __device__ __forceinline__ void init(const Ctx& C, int m0, int h) {
#pragma unroll
        for (int q = 0; q < 4; ++q) lw[q] = (C.lane < L) ? *(const f32x4*)(C.lowf + (size_t)(m0 + C.lane) * 16 + 4 * q) : (f32x4){0.f, 0.f, 0.f, 0.f};
#pragma unroll
        for (int j = 0; j < 16; ++j) w[j] = C.wa2[j * 256 + h * 64 + C.lane];
        bias = C.ba[h * 64 + C.lane]; run = 0.f;
    }
    __device__ __forceinline__ float step(int s) {
        float z0 = bias, z1 = 0.f;
#pragma unroll
        for (int j = 0; j < 16; j += 2) {
            z0 += __int_as_float(__builtin_amdgcn_readlane(__float_as_int(lw[j >> 2][j & 3]), s)) * w[j];
            z1 += __int_as_float(__builtin_amdgcn_readlane(__float_as_int(lw[(j + 1) >> 2][(j + 1) & 3]), s)) * w[j + 1];
        }
        const float z = z0 + z1;
        const float lf = fminf(z, 0.f) - __logf(1.0f + __expf(-fabsf(z)));
        run += lf * (1.0f / 16.0f);
        return run;
    }
};

template <bool SAMPLE> __device__ __forceinline__ void kv_local(const Ctx& C, int type, int b, int n, int h, LAS unsigned char* wl) {
    constexpr int L = SAMPLE ? 32 : 64, NKS = L / 16;
    const int m0 = SAMPLE ? MP + b * SL : b * SEQ + n * 64;
    const int pidx0 = SAMPLE ? 2048 : n * 64;
    LAS unsigned char* tK = wl; LAS unsigned char* tV = wl + TILE_B;
    const int lane = C.lane, kq = C.kq, li = C.li;
    float gdk = 0.f;
    if (type == 0) {
        const float lg = ret_lg2(h);
#pragma unroll
        for (int rb = 0; rb < L / 32; ++rb) {
            const int s = 32 * rb + li;
            bf16x8 fr[4];
            load_rot(C.proj + (size_t)(m0 + s) * PS + C_KA + h * 64, C.rope + (size_t)(pidx0 + s) * 64, kq, 0.125f * __builtin_amdgcn_exp2f(lg * (float)(L - 1 - s)), true, fr);
#pragma unroll
            for (int ks = 0; ks < 4; ++ks) *(LAS bf16x8*)(tK + s * TS + (16 * ks + 8 * kq) * 2) = fr[ks];
        }
        load_tile(tV, C.proj + (size_t)m0 * PS + C_VA + h * 64, PS, L, lane);
    } else {
        load_tile(tK, C.proj + (size_t)m0 * PS + C_KB + h * 64, PS, L, lane);
        GlaGate gg; gg.init<L>(C, m0, h);
        if (!SAMPLE) {
            load_tile(tV, C.proj + (size_t)m0 * PS + C_QB + h * 64, PS, L, lane);
#pragma unroll 4
            for (int s = 0; s < L; ++s) {
                const float e = __expf(gg.step(s));
                LAS bf16_t* kp = (LAS bf16_t*)(tK + s * TS + lane * 2); LAS bf16_t* qp = (LAS bf16_t*)(tV + s * TS + lane * 2);
                *kp = f2bf(bf2f(*kp) / e); *qp = f2bf(bf2f(*qp) * 0.125f * e);
            }
            asm volatile("s_waitcnt lgkmcnt(0)" ::: "memory");
            store_tile(tV, (bf16_t*)C.proj + (size_t)m0 * PS + C_QB + h * 64, PS, L, lane);
            store_tile(tK, (bf16_t*)C.proj + (size_t)m0 * PS + C_KB + h * 64, PS, L, lane);
            asm volatile("s_waitcnt lgkmcnt(0)" ::: "memory");
            load_tile(tV, C.proj + (size_t)m0 * PS + C_VB + h * 64, PS, L, lane);
        } else {
            load_tile(tV, C.proj + (size_t)m0 * PS + C_VB + h * 64, PS, L, lane);
#pragma unroll 4
            for (int s = 0; s < L; ++s) {
                const float bs = gg.step(s);
                LAS bf16_t* kp = (LAS bf16_t*)(tK + s * TS + lane * 2);
                *kp = f2bf(bf2f(*kp) * __expf(-bs));
            }
        }
        gdk = __expf(gg.run);
    }
    f32x16 kv[2][2];
#pragma unroll
    for (int db = 0; db < 2; ++db)
#pragma unroll
        for (int kb = 0; kb < 2; ++kb) kv[db][kb] = zero16();
#pragma unroll
    for (int ks = 0; ks < NKS; ++ks) {
        bf16x8 a[2], bb[2];
#pragma unroll
        for (int db = 0; db < 2; ++db) a[db] = tr_nat(tV, 16 * ks, 32 * db, lane);
#pragma unroll
        for (int kb = 0; kb < 2; ++kb) bb[kb] = tr_nat(tK, 16 * ks, 32 * kb, lane);
#pragma unroll
        for (int db = 0; db < 2; ++db)
#pragma unroll
            for (int kb = 0; kb < 2; ++kb) kv[db][kb] = mfma32(a[db], bb[kb], kv[db][kb]);
    }
    if (type == 1) {
#pragma unroll
        for (int kb = 0; kb < 2; ++kb) { const float cs = __int_as_float(__builtin_amdgcn_ds_bpermute((32 * kb + li) * 4, __float_as_int(gdk)));
#pragma unroll
            for (int db = 0; db < 2; ++db) kv[db][kb] = kv[db][kb] * cs; }
    }
    if (!SAMPLE) {
        const int uidx = ((type * 8 + b) * 4 + h) * 32 + n;
        float* dst = C.kvt + (size_t)uidx * 4096;
#pragma unroll
        for (int db = 0; db < 2; ++db)
#pragma unroll
            for (int kb = 0; kb < 2; ++kb)
#pragma unroll
                for (int r = 0; r < 16; ++r) dst[(32 * db + crow(r, kq)) * 64 + 32 * kb + li] = kv[db][kb][r];
        if (type == 1) C.gdec[(size_t)(((b * 4 + h) * 32 + n)) * 64 + lane] = gdk;
    } else {
        const float* s0 = C.st + (size_t)((C.l * 8 + b) * 4 + h) * 4096;
        float* so = C.out + (type == 0 ? O_RETS : O_GLAS) + (size_t)((C.l * 8 + b) * 4 + h) * 4096;
        const float dret = exp2f(ret_lg2(h) * (float)L);
#pragma unroll
        for (int kb = 0; kb < 2; ++kb) {
            const int dk = 32 * kb + li;
            const float dec = (type == 0) ? dret : __int_as_float(__builtin_amdgcn_ds_bpermute(dk * 4, __float_as_int(gdk)));
#pragma unroll
            for (int db = 0; db < 2; ++db)
#pragma unroll
                for (int rr = 0; rr < 4; ++rr) {
                    const int dv = 32 * db + 8 * rr + 4 * kq;
                    const f32x4 o = *(const f32x4*)(s0 + dk * 64 + dv);
                    f32x4 nv;
#pragma unroll
                    for (int e = 0; e < 4; ++e) nv[e] = dec * o[e] + kv[db][kb][4 * rr + e];
                    *(f32x4*)(so + dk * 64 + dv) = nv;
                }
        }
    }
}

template <bool SAMPLE> __device__ __forceinline__ void mix_out(const Ctx& C, int type, int b, int n, int h, LAS unsigned char* wl) {
    constexpr int L = SAMPLE ? 32 : 64, NTB = L / 32;
    const int m0 = SAMPLE ? MP + b * SL : b * SEQ + n * 64;
    const int pidx0 = SAMPLE ? 2048 : n * 64;
    LAS unsigned char* t0 = wl; LAS unsigned char* t1 = wl + TILE_B;
    const int lane = C.lane, kq = C.kq, li = C.li;
    bf16x8 qfr[NTB][4];
    const float lg = ret_lg2(h);
    if (type == 0) {
#pragma unroll
        for (int tb = 0; tb < NTB; ++tb) {
            const int s = 32 * tb + li;
            load_rot(C.proj + (size_t)(m0 + s) * PS + C_QA + h * 64, C.rope + (size_t)(pidx0 + s) * 64, kq, __builtin_amdgcn_exp2f(lg * (float)(s + 1)), true, qfr[tb]);
        }
        load_tile(t0, C.proj + (size_t)m0 * PS + C_VA + h * 64, PS, L, lane);
    } else {
        load_tile(t0, C.proj + (size_t)m0 * PS + C_QB + h * 64, PS, L, lane);
        load_tile(t1, C.proj + (size_t)m0 * PS + C_KB + h * 64, PS, L, lane);
        if (SAMPLE) {
            GlaGate gg; gg.init<L>(C, m0, h);
#pragma unroll 4
            for (int s = 0; s < L; ++s) {
                const float e = __expf(gg.step(s));
                LAS bf16_t* qp = (LAS bf16_t*)(t0 + s * TS + lane * 2); LAS bf16_t* kp = (LAS bf16_t*)(t1 + s * TS + lane * 2);
                *qp = f2bf(bf2f(*qp) * 0.125f * e); *kp = f2bf(bf2f(*kp) / e);
            }
        }
        __builtin_amdgcn_sched_barrier(0);
#pragma unroll
        for (int tb = 0; tb < NTB; ++tb)
#pragma unroll
            for (int ks = 0; ks < 4; ++ks) qfr[tb][ks] = row_frag(t0, 32 * tb, ks, lane);
        asm volatile("s_waitcnt lgkmcnt(0)" ::: "memory");
        __builtin_amdgcn_sched_barrier(0);
        load_tile(t0, C.proj + (size_t)m0 * PS + C_VB + h * 64, PS, L, lane);
    }
    __builtin_amdgcn_sched_barrier(0);
    f32x16 o[2][NTB];
#pragma unroll
    for (int db = 0; db < 2; ++db)
#pragma unroll
        for (int tb = 0; tb < NTB; ++tb) o[db][tb] = zero16();
    {
        const int uidx = ((type * 8 + b) * 4 + h) * 32 + n;
        const float* sT = C.kvt + (size_t)uidx * 4096;
        const float* s0 = C.st + (size_t)((C.l * 8 + b) * 4 + h) * 4096;
#pragma unroll
        for (int db = 0; db < 2; ++db)
#pragma unroll
            for (int ks = 0; ks < 4; ++ks) {
                const int dv = 32 * db + li, dk0 = 16 * ks + 8 * kq;
                float sv[8];
                if (!SAMPLE) { const f32x4 x = *(const f32x4*)(sT + dv * 64 + dk0), y = *(const f32x4*)(sT + dv * 64 + dk0 + 4);
#pragma unroll
                    for (int e = 0; e < 4; ++e) { sv[e] = x[e]; sv[4 + e] = y[e]; } }
                else {
#pragma unroll
                    for (int e = 0; e < 8; ++e) sv[e] = s0[(dk0 + e) * 64 + dv]; }
                u32x4 w; w.x = pk2(sv[0], sv[1]); w.y = pk2(sv[2], sv[3]); w.z = pk2(sv[4], sv[5]); w.w = pk2(sv[6], sv[7]);
                const bf16x8 sa = as_bf16x8(w);
#pragma unroll
                for (int tb = 0; tb < NTB; ++tb) o[db][tb] = mfma32(sa, qfr[tb][ks], o[db][tb]);
            }
    }
    __builtin_amdgcn_sched_barrier(0);
#pragma unroll
    for (int sb = 0; sb < NTB; ++sb) {
        bf16x8 kfr[4];
        if (type == 0) load_rot(C.proj + (size_t)(m0 + 32 * sb + li) * PS + C_KA + h * 64, C.rope + (size_t)(pidx0 + 32 * sb + li) * 64, kq, 0.125f * __builtin_amdgcn_exp2f(-lg * (float)(32 * sb + li + 1)), true, kfr);
        else {
#pragma unroll
            for (int ks = 0; ks < 4; ++ks) kfr[ks] = row_frag(t1, 32 * sb, ks, lane);
        }
        f32x16 st[NTB];
#pragma unroll
        for (int tb = sb; tb < NTB; ++tb) {
            f32x16 a = zero16();
#pragma unroll
            for (int ks = 0; ks < 4; ++ks) a = mfma32(kfr[ks], qfr[tb][ks], a);
#pragma unroll
            for (int r = 0; r < 16; ++r) {
                const int s = 32 * sb + crow(r, kq), t = 32 * tb + li;
                a[r] = (t >= s) ? a[r] : 0.0f;
            }
            st[tb] = a;
        }
#pragma unroll
        for (int half = 0; half < 2; ++half) {
            bf16x8 va[2];
#pragma unroll
            for (int db = 0; db < 2; ++db) va[db] = tr_perm(t0, 32 * sb + 16 * half, 32 * db, lane);
#pragma unroll
            for (int tb = sb; tb < NTB; ++tb) {
                const bf16x8 pf = pack_step(st[tb], half);
#pragma unroll
                for (int db = 0; db < 2; ++db) o[db][tb] = mfma32(va[db], pf, o[db][tb]);
            }
        }
        __builtin_amdgcn_sched_barrier(0);
    }
    const float* nw = C.nw + h * 64;
    const int gcol = (type == 0 ? C_GA : C_GB) + h * 64;
#pragma unroll
    for (int tb = 0; tb < NTB; ++tb) {
        const int t = 32 * tb + li;
        float s1 = 0.f, s2 = 0.f;
#pragma unroll
        for (int db = 0; db < 2; ++db)
#pragma unroll
            for (int r = 0; r < 16; ++r) { const float x = o[db][tb][r]; s1 += x; s2 += x * x; }
        s1 += __shfl_xor(s1, 32); s2 += __shfl_xor(s2, 32);
        float mu = 0.f, rstd;
        if (type == 0) { mu = s1 * (1.0f / 64.0f); const float var = fmaxf(s2 * (1.0f / 64.0f) - mu * mu, 0.f); rstd = 1.0f / sqrtf(var + EPS); }
        else rstd = 1.0f / sqrtf(s2 * (1.0f / 64.0f) + EPS);
        const bf16_t* grow = C.proj + (size_t)(m0 + t) * PS + gcol;
        bf16_t* orow = C.cat + (size_t)(m0 + t) * DM + type * 256 + h * 64;
#pragma unroll
        for (int db = 0; db < 2; ++db)
#pragma unroll
            for (int rr = 0; rr < 4; ++rr) {
                const int dv = 32 * db + 8 * rr + 4 * kq;
                const u32x2 gw = *(const u32x2*)(grow + dv);
                const f32x4 wv = *(const f32x4*)(nw + dv);
                const float g0 = bflo(gw.x), g1 = bfhi(gw.x), g2 = bflo(gw.y), g3 = bfhi(gw.y);
                const float y0 = (o[db][tb][4 * rr + 0] - mu) * rstd * wv[0] * silu(g0), y1 = (o[db][tb][4 * rr + 1] - mu) * rstd * wv[1] * silu(g1);
                const float y2 = (o[db][tb][4 * rr + 2] - mu) * rstd * wv[2] * silu(g2), y3 = (o[db][tb][4 * rr + 3] - mu) * rstd * wv[3] * silu(g3);
                u32x2 w; w.x = pk2(y0, y1); w.y = pk2(y2, y3);
                *(u32x2*)(orow + dv) = w;
            }
    }
}

template <bool SAMPLE> __device__ __forceinline__ void attn_wave(const Ctx& C, int b, int n, int h, LAS unsigned char* wl, LAS const float* revT, float cb2) {
    constexpr int NTB = SAMPLE ? 1 : 2;
    constexpr float SC = 0.125f * 1.4426950408889634f;
    const int m0 = SAMPLE ? MP + b * SL : b * SEQ + n * 64;
    const int lane = C.lane, kq = C.kq, li = C.li;
    const int jt0 = SAMPLE ? 0 : (n < 8 ? 8 - n : 0);
#define ATT_SRC(jt, kp, vp, pitch, rmask) const bf16_t* kp; const bf16_t* vp; int pitch; int rmask = 63; \
    if (SAMPLE && (jt) < 8) { kp = C.ckb + (size_t)(b * 512 + 64 * (jt)) * 512 + h * 64; vp = C.cvb + (size_t)(b * 512 + 64 * (jt)) * 512 + h * 64; pitch = 512; } \
    else { const int kr0 = SAMPLE ? m0 : b * SEQ + (n - 8 + (jt)) * 64; kp = C.proj + (size_t)kr0 * PS + C_KC + h * 64; vp = kp + (C_VC - C_KC); pitch = PS; if (SAMPLE) rmask = 31; }
#define ATT_ISSUE(jt, kdst, vbuf) do { ATT_SRC(jt, kp_, vp_, pitch_, rmask_); \
    _Pragma("unroll") for (int sb = 0; sb < 2; ++sb) _Pragma("unroll") for (int ks = 0; ks < 4; ++ks) kdst[sb][ks] = *(const u32x4*)(kp_ + (size_t)((32 * sb + li) & rmask_) * pitch_ + 16 * ks + 8 * kq); \
    _Pragma("unroll") for (int it = 0; it < 8; ++it) __builtin_amdgcn_global_load_lds((const unsigned*)(vp_ + (size_t)((it * 8 + (lane >> 3)) & rmask_) * pitch_ + (((lane & 7) ^ (((lane >> 3) & 2) << 1)) * 8)), (LAS unsigned*)((vbuf) + it * 1024), 16, 0, 0); } while (0)
    bf16x8 qfr[NTB][4];
#pragma unroll
    for (int tb = 0; tb < NTB; ++tb)
#pragma unroll
        for (int ks = 0; ks < 4; ++ks) qfr[tb][ks] = as_bf16x8(*(const u32x4*)(C.proj + (size_t)(m0 + 32 * tb + li) * PS + C_QC + h * 64 + 16 * ks + 8 * kq));
    f32x16 o[2][NTB]; float mrun[NTB], lrun[NTB];
#pragma unroll
    for (int tb = 0; tb < NTB; ++tb) { mrun[tb] = -1e30f; lrun[tb] = 0.f;
#pragma unroll
        for (int db = 0; db < 2; ++db) o[db][tb] = zero16(); }
    u32x4 kcur[2][4], knext[2][4];
    ATT_ISSUE(jt0, kcur, wl + ((jt0 & 1) ? TILE_B : 0));
    for (int jt = jt0; jt <= 8; ++jt) {
        asm volatile("s_waitcnt vmcnt(0)" ::: "memory");
        __builtin_amdgcn_sched_barrier(0);
        LAS unsigned char* tV = wl + ((jt & 1) ? TILE_B : 0);
        if (jt < 8) { ATT_ISSUE(jt + 1, knext, wl + (((jt + 1) & 1) ? TILE_B : 0)); }
        __builtin_amdgcn_sched_barrier(0);
        const bool cst = jt <= 3;
#pragma unroll
        for (int sb = 0; sb < 2; ++sb) {
            if (SAMPLE && jt == 8 && sb == 1) continue;
#pragma unroll
            for (int tb = 0; tb < NTB; ++tb) {
                f32x16 a = zero16();
#pragma unroll
                for (int ks = 0; ks < 4; ++ks) a = mfma32(as_bf16x8(kcur[sb][ks]), qfr[tb][ks], a);
                if (!cst) {
                    const int dbase = (8 - jt) * 64 + 63 + 32 * tb + li - 32 * sb;
                    LAS const float* rp = revT + (382 - dbase + 4 * kq);
#pragma unroll
                    for (int r = 0; r < 16; ++r) a[r] = a[r] * SC + rp[(r & 3) + 8 * (r >> 2)];
                }
                float mx = -1e30f;
#pragma unroll
                for (int r = 0; r < 16; ++r) mx = fmaxf(mx, a[r]);
                if (cst) mx = mx * SC + cb2;
                mx = fmaxf(mx, __shfl_xor(mx, 32));
                const float mnew = fmaxf(mrun[tb], mx);
                const bool moved = __builtin_amdgcn_ballot_w64(mnew != mrun[tb]) != 0ull;
                const float alpha = __builtin_amdgcn_exp2f(mrun[tb] - mnew);
                mrun[tb] = mnew;
                float ps = 0.f;
                if (cst) { const float off = cb2 - mnew;
#pragma unroll
                    for (int r = 0; r < 16; ++r) { const float pp = __builtin_amdgcn_exp2f(a[r] * SC + off); a[r] = pp; ps += pp; } }
                else {
#pragma unroll
                    for (int r = 0; r < 16; ++r) { const float pp = __builtin_amdgcn_exp2f(a[r] - mnew); a[r] = pp; ps += pp; } }
                lrun[tb] = lrun[tb] * alpha + ps;
                if (moved) {
#pragma unroll
                    for (int db = 0; db < 2; ++db) o[db][tb] = o[db][tb] * alpha;
                }
#pragma unroll
                for (int half = 0; half < 2; ++half) {
                    const bf16x8 pf = pack_step(a, half);
#pragma unroll
                    for (int db = 0; db < 2; ++db) o[db][tb] = mfma32(tr_perm_swz(tV, 32 * sb + 16 * half, 32 * db, lane), pf, o[db][tb]);
                }
            }
        }
#pragma unroll
        for (int sb = 0; sb < 2; ++sb)
#pragma unroll
            for (int ks = 0; ks < 4; ++ks) kcur[sb][ks] = knext[sb][ks];
    }
#pragma unroll
    for (int tb = 0; tb < NTB; ++tb) {
        const float lt = lrun[tb] + __shfl_xor(lrun[tb], 32), inv = 1.0f / lt;
        bf16_t* orow = C.cat + (size_t)(m0 + 32 * tb + li) * DM + 512 + h * 64;
#pragma unroll
        for (int db = 0; db < 2; ++db)
#pragma unroll
            for (int rr = 0; rr < 4; ++rr) {
                u32x2 w; w.x = pk2(o[db][tb][4 * rr] * inv, o[db][tb][4 * rr + 1] * inv); w.y = pk2(o[db][tb][4 * rr + 2] * inv, o[db][tb][4 * rr + 3] * inv);
                *(u32x2*)(orow + 32 * db + 8 * rr + 4 * kq) = w;
            }
    }
#undef ATT_ISSUE
#undef ATT_SRC
}

__device__ __forceinline__ void conv_cache(const float* ck, const float* cv, bf16_t* dst, int l, int gt, int NGT) {
    for (int i = gt; i < (int)(2 * CACHE_ELEMS / 8); i += NGT) {
        const bool isv = i >= (int)(CACHE_ELEMS / 8); const int j = isv ? i - (int)(CACHE_ELEMS / 8) : i;
        const float* s = (isv ? cv : ck) + (size_t)l * CACHE_ELEMS + (size_t)j * 8;
        const f32x4 x = *(const f32x4*)s, y = *(const f32x4*)(s + 4);
        u32x4 w; w.x = pk2(x[0], x[1]); w.y = pk2(x[2], x[3]); w.z = pk2(y[0], y[1]); w.w = pk2(y[2], y[3]);
        *(u32x4*)(dst + (size_t)i * 8) = w;
    }
}

__device__ __forceinline__ int win_src(int n) { return n < 2048 ? n : (n < 3584 ? n + 16 : (n < 3600 ? n - 1536 : -1)); }
__device__ __forceinline__ void tr_item(const float* W, int K, int Nsrc, bf16_t* WT, int kb, int nb, bool inmap, const float* kscale, LAS float* scr, int lane) {
    const int k0 = 64 * kb, n0 = 32 * nb, n = n0 + (lane & 31), sc = inmap ? win_src(n) : n;
    float wv[32];
#pragma unroll
    for (int i = 0; i < 32; ++i) { const int kk = 2 * i + (lane >> 5); wv[i] = (sc >= 0) ? W[(size_t)(k0 + kk) * Nsrc + sc] : 0.f; }
    if (kscale) {
#pragma unroll
        for (int i = 0; i < 32; ++i) wv[i] *= kscale[k0 + 2 * i + (lane >> 5)];
    }
#pragma unroll
    for (int i = 0; i < 32; ++i) scr[(2 * i + (lane >> 5)) * 33 + (lane & 31)] = wv[i];
    asm volatile("s_waitcnt lgkmcnt(0)" ::: "memory");
    const int c = lane & 7;
#pragma unroll
    for (int j = 0; j < 4; ++j) { const int nn = (lane >> 3) + 8 * j; const LAS float* s = scr + (8 * c) * 33 + nn;
        u32x4 o; o.x = pk2(s[0 * 33], s[1 * 33]); o.y = pk2(s[2 * 33], s[3 * 33]); o.z = pk2(s[4 * 33], s[5 * 33]); o.w = pk2(s[6 * 33], s[7 * 33]);
        *(u32x4*)(WT + (size_t)(n0 + nn) * K + k0 + 8 * c) = o; }
    asm volatile("s_waitcnt lgkmcnt(0)" ::: "memory");
}


enum { SK_IN = 0, SK_RES = 1, SK_UP = 2 };
struct SArgs {
    const bf16_t* A; const bf16_t* Bt; int K, nunits;
    bf16_t* obf; int ldo;
    const float* ss_in; float* ss_out;
    const float* xold; float* xr;
    float* lowf; float* ksout; float* vsout;
};
template <int KIND> __device__ __forceinline__ void sample_gemm(LAS unsigned char* lds, const SArgs& a, int ubeg, int ustep, int wave, int lane) {
    const int kq = lane >> 5, li = lane & 31, K = a.K, kw = K >> 3, kbeg = wave * kw;
    for (int u = ubeg; u < a.nunits; u += ustep) {
        const int row0 = 64 * (u & 3), col0 = 64 * (u >> 2);
        f32x16 acc[2][2];
#pragma unroll
        for (int rb = 0; rb < 2; ++rb)
#pragma unroll
            for (int cb = 0; cb < 2; ++cb) acc[rb][cb] = zero16();
        const bf16_t* ap = a.A + (size_t)(row0 + li) * K + kbeg + 8 * kq;
        const bf16_t* bp = a.Bt + (size_t)(col0 + li) * K + kbeg + 8 * kq;
        u32x4 af[4][2], bv[4][2], an[4][2], bn[4][2];
#define SG_LOAD(dsta, dstb, k) _Pragma("unroll") for (int s = 0; s < 4; ++s) _Pragma("unroll") for (int h = 0; h < 2; ++h) { dsta[s][h] = *(const u32x4*)(ap + (size_t)(32 * h) * K + (k) + 16 * s); dstb[s][h] = *(const u32x4*)(bp + (size_t)(32 * h) * K + (k) + 16 * s); }
        SG_LOAD(af, bv, 0);
        for (int k = 0; k < kw; k += 64) {
            if (k + 64 < kw) { SG_LOAD(an, bn, k + 64); }
#pragma unroll
            for (int s = 0; s < 4; ++s)
#pragma unroll
                for (int rb = 0; rb < 2; ++rb)
#pragma unroll
                    for (int cb = 0; cb < 2; ++cb) acc[rb][cb] = mfma32(as_bf16x8(af[s][rb]), as_bf16x8(bv[s][cb]), acc[rb][cb]);
#pragma unroll
            for (int s = 0; s < 4; ++s)
#pragma unroll
                for (int h = 0; h < 2; ++h) { af[s][h] = an[s][h]; bv[s][h] = bn[s][h]; }
        }
#undef SG_LOAD
        LAS float* wp = (LAS float*)(lds + wave * WAVE_LDS);
#pragma unroll
        for (int rb = 0; rb < 2; ++rb)
#pragma unroll
            for (int cb = 0; cb < 2; ++cb)
#pragma unroll
                for (int r = 0; r < 16; ++r) wp[(32 * rb + crow(r, kq)) * 64 + 32 * cb + li] = acc[rb][cb][r];
        __syncthreads();
        const int t = wave * 64 + lane, row = t >> 3, c8 = (t & 7) * 8;
        float v[8];
#pragma unroll
        for (int e = 0; e < 8; ++e) v[e] = 0.f;
#pragma unroll
        for (int w = 0; w < 8; ++w) {
            const f32x4 x = *(LAS const f32x4*)(lds + w * WAVE_LDS + (row * 64 + c8) * 4), y = *(LAS const f32x4*)(lds + w * WAVE_LDS + (row * 64 + c8) * 4 + 16);
#pragma unroll
            for (int e = 0; e < 4; ++e) { v[e] += x[e]; v[4 + e] += y[e]; }
        }
        const int r = row0 + row, c = col0 + c8;
        if (KIND == SK_IN || KIND == SK_UP) {
            const float rs = 1.0f / sqrtf(a.ss_in[r] * (1.0f / 1024.0f) + EPS);
#pragma unroll
            for (int e = 0; e < 8; ++e) { v[e] *= rs; if (KIND == SK_UP) { const float q = fmaxf(v[e], 0.f); v[e] = q * q; } }
        }
        if (KIND == SK_RES) {
            const float* xo = a.xold + (size_t)r * 1024 + c;
            const f32x4 x = *(const f32x4*)xo, y = *(const f32x4*)(xo + 4);
            float sq = 0.f;
#pragma unroll
            for (int e = 0; e < 4; ++e) { v[e] += x[e]; v[4 + e] += y[e]; }
#pragma unroll
            for (int e = 0; e < 8; ++e) sq += v[e] * v[e];
            float* xn = a.xr + (size_t)r * 1024 + c;
            *(f32x4*)xn = (f32x4){v[0], v[1], v[2], v[3]}; *(f32x4*)(xn + 4) = (f32x4){v[4], v[5], v[6], v[7]};
            sq += __shfl_xor(sq, 1); sq += __shfl_xor(sq, 2); sq += __shfl_xor(sq, 4);
            if ((t & 7) == 0) atomicAdd(a.ss_out + r, sq);
        }
        if (a.obf) { u32x4 w; w.x = pk2(v[0], v[1]); w.y = pk2(v[2], v[3]); w.z = pk2(v[4], v[5]); w.w = pk2(v[6], v[7]); *(u32x4*)(a.obf + (size_t)r * a.ldo + c) = w; }
        if (KIND == SK_IN) {
            float* d = nullptr;
            if (c >= C_KC && c < C_VC) d = a.ksout + (size_t)r * 512 + (c - C_KC);
            else if (c >= C_VC && c < C_LOW) d = a.vsout + (size_t)r * 512 + (c - C_VC);
            else if (c >= C_LOW && c < C_LOW + 16) d = a.lowf + (size_t)r * 16 + (c - C_LOW);
            if (d) { *(f32x4*)d = (f32x4){v[0], v[1], v[2], v[3]}; *(f32x4*)(d + 4) = (f32x4){v[4], v[5], v[6], v[7]}; }
        }
        __syncthreads();
    }
}
__device__ __forceinline__ void sample_share(int nwg, int G, int bx, int& ubeg, int& ustep) { const int nfull = nwg % G; if (nfull == 0) { ubeg = bx; ustep = G; } else if (bx >= nfull) { ubeg = bx - nfull; ustep = G - nfull; } else { ubeg = 1 << 30; ustep = 1; } }

#define XB_TMO      128
#define XB_XCNT(j)  (256  + 64 * (j))
#define XB_XSUB(j)  (1280 + 64 * (j))
#define XB_XGEN(j)  (2304 + 64 * (j))
#define XB_TOP      3328
#define XB_TOPGEN   3392
#define XCD_BAR_WORDS 3456
#define XB_SPIN_CAP (1u << 18)

__device__ __forceinline__ unsigned xb_ld(unsigned* p)              { return __hip_atomic_load(p, __ATOMIC_RELAXED, __HIP_MEMORY_SCOPE_AGENT); }
__device__ __forceinline__ unsigned xb_add(unsigned* p, unsigned v) { return __hip_atomic_fetch_add(p, v, __ATOMIC_RELAXED, __HIP_MEMORY_SCOPE_AGENT); }
__device__ __forceinline__ unsigned xb_xcc_id() { return (unsigned)__builtin_amdgcn_s_getreg((3 << 11) | 20) & 0xFu; }
#define XB_SPIN(cond, bar) do { unsigned _sp = 0; while (cond) { __builtin_amdgcn_s_sleep(1); \
    if ((++_sp & 255u) == 0u) { if (xb_ld(&(bar)[XB_TMO])) break; if (_sp > XB_SPIN_CAP) { atomicAdd(&(bar)[XB_TMO], 1u); break; } } } } while (0)

struct XcdBarrier {
    unsigned* bar; unsigned x; bool wave0;
    volatile LAS unsigned* st;
};

__device__ __forceinline__ XcdBarrier xcd_barrier_post(unsigned* bar, volatile LAS unsigned* st) {
    XcdBarrier b; b.bar = bar; b.x = xb_xcc_id(); b.st = st;
    if (threadIdx.x == 0) (void)xb_add(&bar[XB_XCNT(b.x)], 1u);
    return b;
}
__device__ __forceinline__ void xcd_barrier_complete(unsigned* bar, unsigned x, unsigned& nloc, unsigned& nx) {
    const unsigned G = gridDim.x * gridDim.y * gridDim.z;
    unsigned sum, cnt, mine, sp = 0u;
    for (;;) {
        sum = 0u; cnt = 0u; mine = 0u;
#pragma unroll
        for (unsigned j = 0; j < 16; ++j) { const unsigned c = xb_ld(&bar[XB_XCNT(j)]); sum += c; cnt += (c > 0u) ? 1u : 0u; mine = (j == x) ? c : mine; }
        if (sum == G) break;
        __builtin_amdgcn_s_sleep(1);
        if ((++sp & 255u) == 0u) { if (xb_ld(&bar[XB_TMO])) break; if (sp > XB_SPIN_CAP) { atomicAdd(&bar[XB_TMO], 1u); break; } }
    }
    nloc = mine > 0u ? mine : 1u; nx = cnt > 0u ? cnt : 1u;
}

__device__ __forceinline__ void xcd_barrier(const XcdBarrier& b) {
    asm volatile("s_waitcnt vmcnt(0)" ::: "memory");
    __syncthreads();
    if (b.wave0 && lane_id_asm() == 0) {
        unsigned* bar = b.bar;
        __builtin_amdgcn_s_waitcnt(0);
        unsigned nloc = b.st[0], nx = b.st[1];
        if (nloc == 0u) { xcd_barrier_complete(bar, b.x, nloc, nx); b.st[0] = nloc; b.st[1] = nx; }
        const unsigned old = xb_add(&bar[XB_XSUB(b.x)], 1u);
        const unsigned gen = old / nloc;
        if (old + 1u == (gen + 1u) * nloc) {
            __builtin_amdgcn_fence(__ATOMIC_RELEASE, "agent");
            asm volatile("s_waitcnt vmcnt(0)" ::: "memory");
            const unsigned og = xb_add(&bar[XB_TOP], 1u);
            const unsigned tg = og / nx;
            if (og + 1u == (tg + 1u) * nx) xb_add(&bar[XB_TOPGEN], 1u);
            else XB_SPIN(xb_ld(&bar[XB_TOPGEN]) == tg, bar);
            __builtin_amdgcn_fence(__ATOMIC_ACQUIRE, "agent");
            xb_add(&bar[XB_XGEN(b.x)], 1u);
            asm volatile("s_waitcnt vmcnt(0)" ::: "memory");
        } else {
            XB_SPIN(xb_ld(&bar[XB_XGEN(b.x)]) == gen, bar);
            __builtin_amdgcn_fence(__ATOMIC_ACQUIRE, "agent");
            asm volatile("s_waitcnt vmcnt(0)" ::: "memory");
        }
    }
    __syncthreads();
}


__device__ __forceinline__ void tr_item128(const float* W, int K, int Nsrc, bf16_t* WT, int kb, int nb, const float* kscale, LAS float* scr, int lane) {
    const int k0 = 32 * kb, n0 = 128 * nb, n4 = (lane & 31) * 4;
    f32x4 wv[16];
#pragma unroll
    for (int i = 0; i < 16; ++i) wv[i] = *(const f32x4*)(W + (size_t)(k0 + 2 * i + (lane >> 5)) * Nsrc + n0 + n4);
    if (kscale) {
#pragma unroll
        for (int i = 0; i < 16; ++i) wv[i] = wv[i] * kscale[k0 + 2 * i + (lane >> 5)];
    }
#pragma unroll
    for (int i = 0; i < 16; ++i) { LAS float* d = scr + (2 * i + (lane >> 5)) * 129 + n4; d[0] = wv[i][0]; d[1] = wv[i][1]; d[2] = wv[i][2]; d[3] = wv[i][3]; }
    asm volatile("s_waitcnt lgkmcnt(0)" ::: "memory");
#pragma unroll
    for (int j = 0; j < 8; ++j) { const int id = j * 64 + lane, n = id >> 2, c = id & 3; const LAS float* s = scr + (8 * c) * 129 + n;
        u32x4 o; o.x = pk2(s[0 * 129], s[1 * 129]); o.y = pk2(s[2 * 129], s[3 * 129]); o.z = pk2(s[4 * 129], s[5 * 129]); o.w = pk2(s[6 * 129], s[7 * 129]);
        *(u32x4*)(WT + (size_t)(n0 + n) * K + k0 + 8 * c) = o; }
    asm volatile("s_waitcnt lgkmcnt(0)" ::: "memory");
}
constexpr int CONV_WGS = 16;

__global__ void __launch_bounds__(512, 2) hybrid_fwd(Params p) {
    extern __shared__ __attribute__((aligned(16))) unsigned char lds_raw[];
    cg::grid_group grid = cg::this_grid();
    LAS unsigned char* lds = (LAS unsigned char*)lds_raw;
    const int wave = __builtin_amdgcn_readfirstlane((int)threadIdx.x >> 6);
    const int G = gridDim.x, bx = blockIdx.x;
#define WSP(off) (ws_ptr() + (off))
#define LANE_TID() const int lane = lane_id_asm(); const int tid = wave * 64 + lane; (void)tid; int Gq = G, bxq = bx; asm volatile("" : "+s"(Gq), "+s"(bxq)); (void)Gq; (void)bxq
    LAS unsigned char* wl = lds + wave * WAVE_LDS;
    LAS float* biasT = (LAS float*)(lds + LDS_BIAS);
    if (threadIdx.x < 4) ((LAS unsigned*)(lds + LDS_BARST))[threadIdx.x] = 0u;
    __syncthreads();
    XcdBarrier xbar = xcd_barrier_post((unsigned*)WSP(WS_CTL), (volatile LAS unsigned*)(lds + LDS_BARST)); xbar.wave0 = (wave == 0);

    for (int rep = 0; rep < 1 + PROBE_P0X2; ++rep) {
        LANE_TID();
        unsigned char* ws = ws_ptr();
        bf16_t* XB = (bf16_t*)(ws + WS_B); bf16_t* WIN = (bf16_t*)(ws + WS_WIN); bf16_t* WOUT = (bf16_t*)(ws + WS_WOUT); bf16_t* WUP = (bf16_t*)(ws + WS_WUP); bf16_t* WDN = (bf16_t*)(ws + WS_WDN);
        float* SS = (float*)(ws + WS_SS); float* ROPE = (float*)(ws + WS_ROPE);
        const int gw = bx * 8 + wave, NGW = G * 8;
        LAS float* scr = (LAS float*)wl;
        constexpr int I_IN = 16 * (PS / 32), I_OUT = 16 * 32, I_UP = 16 * 128, I_DN = 64 * 32, I_L = I_IN + I_OUT + I_UP + I_DN;
        const bool split = (G == 256);
        for (int it = gw; it < 2 * I_L; it += NGW) {
            const int l = it / I_L; int r = it % I_L;
            if (split && r >= I_IN) continue;
            if (r < I_IN) { tr_item(in_ptr(9) + (size_t)l * DM * INCOLS, DM, INCOLS, WIN + (size_t)l * PS * DM, r / (PS / 32), r % (PS / 32), true, in_ptr(6) + l * DM, scr, lane); continue; } r -= I_IN;
            if (r < I_OUT) { tr_item(in_ptr(15) + (size_t)l * DM * DM, DM, DM, WOUT + (size_t)l * DM * DM, r / 32, r % 32, false, nullptr, scr, lane); continue; } r -= I_OUT;
            if (r < I_UP) { tr_item(in_ptr(16) + (size_t)l * DM * DFF, DM, DFF, WUP + (size_t)l * DFF * DM, r / 128, r % 128, false, in_ptr(7) + l * DM, scr, lane); continue; } r -= I_UP;
            tr_item(in_ptr(17) + (size_t)l * DFF * DM, DFF, DM, WDN + (size_t)l * DM * DFF, r / 32, r % 32, false, nullptr, scr, lane);
        }
        const float* x_prompt = in_ptr(0); const float* x_sample = in_ptr(1);
        for (int m0 = gw; m0 < MT; m0 += 2 * NGW) {
            f32x4 v[2][4]; float s[2];
#pragma unroll
            for (int q = 0; q < 2; ++q) {
                const int m = m0 + q * NGW; s[q] = 0.f;
                if (m < MT) {
                    const float* xrow = (m < MP) ? x_prompt + (size_t)m * DM : x_sample + (size_t)(m - MP) * DM;
                    const f32x4* xr = (const f32x4*)xrow + lane;
#pragma unroll
                    for (int j = 0; j < 4; ++j) v[q][j] = xr[64 * j];
                }
            }
#pragma unroll
            for (int q = 0; q < 2; ++q) {
                const int m = m0 + q * NGW;
                if (m < MT) {
#pragma unroll
                    for (int j = 0; j < 4; ++j) s[q] += (v[q][j][0] * v[q][j][0] + v[q][j][1] * v[q][j][1]) + (v[q][j][2] * v[q][j][2] + v[q][j][3] * v[q][j][3]);
#pragma unroll
                    for (int o = 1; o < 64; o <<= 1) s[q] += __shfl_xor(s[q], o);
                    u32x2* o8 = (u32x2*)(XB + (size_t)m * DM) + lane;
#pragma unroll
                    for (int j = 0; j < 4; ++j) { u32x2 w; w.x = pk2(v[q][j][0], v[q][j][1]); w.y = pk2(v[q][j][2], v[q][j][3]); o8[64 * j] = w; }
                    if (lane == 0) SS[m] = s[q];
                }
            }
        }
        const int gt = bx * 512 + tid, NGT = G * 512;
        for (int i = gt; i < 4 * MT; i += NGT) SS[MT + i] = 0.f;
        conv_cache(in_ptr(4), in_ptr(5), (bf16_t*)(ws + WS_CKB), 0, gt, NGT);
        for (int i = gt; i < 2080 * 32; i += NGT) {
            const int pi = i >> 5, f = i & 31; const int pos = pi < 2048 ? pi : 4096 + (pi - 2048);
            const float inv_freq = (float)exp(-(double)f * (9.210340371976184 / 32.0));
            const float ang = (float)pos * inv_freq;
            double rev = (double)ang * 0.15915494309189535; rev -= rint(rev);
            const float rf = (float)rev;
            ROPE[(size_t)pi * 64 + f] = __builtin_amdgcn_cosf(rf); ROPE[(size_t)pi * 64 + 32 + f] = __builtin_amdgcn_sinf(rf);
        }
    }
    if (G == 0x7fffffff) grid.sync();
    xcd_barrier(xbar);

    for (int l = 0; l < 2; ++l) {
        {
            LANE_TID();
            unsigned char* ws = ws_ptr();
            const bool split = (Gq == 256); const int GG = split ? Gq - CONV_WGS : Gq;
            if (split && bxq >= GG) {
                LAS float* scr = (LAS float*)(lds + wave * WAVE_LDS);
                constexpr int J_OUT = 32 * 8, J_UP = 32 * 32;
                for (int it = (bxq - GG) * 8 + wave; it < J_OUT + J_UP; it += CONV_WGS * 8) {
                    if (it < J_OUT) tr_item128(in_ptr(15) + (size_t)l * DM * DM, DM, DM, (bf16_t*)(ws + WS_WOUT) + (size_t)l * DM * DM, it / 8, it % 8, nullptr, scr, lane);
                    else { const int r = it - J_OUT; tr_item128(in_ptr(16) + (size_t)l * DM * DFF, DM, DFF, (bf16_t*)(ws + WS_WUP) + (size_t)l * DFF * DM, r / 32, r % 32, in_ptr(7) + l * DM, scr, lane); }
                }
            } else {
            pg8::Gemm g{(const bf16_t*)(ws + WS_B), (const bf16_t*)(ws + WS_WIN) + (size_t)l * PS * DM, MP, PS, DM}; pg8::StaticOrder S; S.init(MP, PS, GG, bxq);
            pg8::EpiIn E{(bf16_t*)(ws + WS_A), (float*)(ws + WS_LOWF), (const float*)(ws + WS_SS) + (size_t)(2 * l) * MT, out_ptr(), (long long)(O_KP + (size_t)l * 2097152), (long long)(O_VP + (size_t)l * 2097152), (long long)(O_KS + (size_t)l * 131072), (long long)(O_VS + (size_t)l * 131072)};
            pg8::gemm_phase<pg8::EpiIn, pg8::StaticOrder, true, true>(lds, g, S, E, tid);
            if (PROBE_IN2) pg8::gemm_phase<pg8::EpiIn, pg8::StaticOrder, true, true>(lds, g, S, E, tid);
            {
                float* outp = out_ptr();
                SArgs a{}; a.A = (const bf16_t*)(ws + WS_B) + (size_t)MP * DM; a.Bt = (const bf16_t*)(ws + WS_WIN) + (size_t)l * PS * DM; a.K = DM; a.nunits = 4 * 57;
                a.obf = (bf16_t*)(ws + WS_A) + (size_t)MP * PS; a.ldo = PS; a.ss_in = (const float*)(ws + WS_SS) + (size_t)(2 * l) * MT + MP; a.lowf = (float*)(ws + WS_LOWF) + (size_t)MP * 16;
                a.ksout = outp + O_KS + (size_t)l * 131072; a.vsout = outp + O_VS + (size_t)l * 131072;
                int ub, us; sample_share((MP / 256) * (PS / 256), GG, bxq, ub, us);
                sample_gemm<SK_IN>(lds, a, ub, us, wave, lane);
            }
            if (l == 1) conv_cache(in_ptr(4), in_ptr(5), (bf16_t*)(ws + WS_CKB), 1, bxq * 512 + tid, GG * 512);
            }
        }
        xcd_barrier(xbar);
        {
            LANE_TID();
            { const float* rb = in_ptr(14) + (size_t)l * 8 * NREL; for (int i = tid; i < 8 * NREV; i += 512) { const int hh = i / NREV, j = i % NREV; int k = 382 - j; k = k < 0 ? 0 : (k > NREL - 1 ? NREL - 1 : k); biasT[i] = rb[hh * NREL + k] * 1.4426950408889634f; } }
            __syncthreads();
        }
#define MAKE_CTX() LANE_TID(); int wv = wave; asm volatile("" : "+s"(wv)); unsigned char* ws = ws_ptr(); Ctx C; C.l = l; C.lane = lane; C.kq = lane >> 5; C.li = lane & 31; C.proj = (const bf16_t*)(ws + WS_A); C.lowf = (const float*)(ws + WS_LOWF); \
        C.rope = (const float*)(ws + WS_ROPE); C.cat = (bf16_t*)(ws + WS_B); C.kvt = (float*)(ws + WS_C); C.gdec = (float*)(ws + WS_G); C.out = out_ptr(); \
        C.wa2 = in_ptr(10) + (size_t)l * 16 * 256; C.ba = in_ptr(11) + l * 256; C.nw = (wv < 4 ? in_ptr(12) : in_ptr(13)) + l * 256; C.st = (wv < 4 ? in_ptr(2) : in_ptr(3)); C.ckb = (const bf16_t*)(ws + WS_CKB); C.cvb = C.ckb + CACHE_ELEMS; \
        __builtin_amdgcn_sched_barrier(0)
        for (int rep = 0; rep < 1 + PROBE_M1X2; ++rep)
        for (int u = bx; u < 256; u += G) {
            const int b = u & 7, n = u >> 3;
            for (int rk = 0; rk < 1 + PROBE_KVX2; ++rk) { MAKE_CTX(); kv_local<false>(C, wv >> 2, b, n, wv & 3, wl); }
            for (int ra = 0; ra < 1 + PROBE_ATX2; ++ra) { MAKE_CTX(); attn_wave<false>(C, b, n, wave, wl, biasT + wave * NREV, biasT[wave * NREV]); }
            if (n == 0) { MAKE_CTX(); attn_wave<true>(C, b, 0, wave, wl, biasT + wave * NREV, biasT[wave * NREV]); }
            if (n == 1) { MAKE_CTX(); mix_out<true>(C, wv >> 2, b, 0, wv & 3, wl); }
            if (n == 2) { MAKE_CTX(); kv_local<true>(C, wv >> 2, b, 0, wv & 3, wl); }
        }
        xcd_barrier(xbar);
        {
            LANE_TID();
            float* KVT = (float*)WSP(WS_C); const float* GDEC = (const float*)WSP(WS_G); float* outp = out_ptr();
            for (int it = bx * 512 + tid; it < 131072; it += G * 512) {
                const int seq = it >> 11, e2 = it & 2047, type = seq >> 5, b = (seq >> 2) & 7, h = seq & 3;
                const int dv = e2 >> 5, dk = (2 * e2) & 63;
                float* base = KVT + (size_t)seq * 32 * 4096 + 2 * e2;
                const float dret = exp2f(ret_lg2(h) * 64.0f);
                const float* gd = GDEC + (size_t)((b * 4 + h) * 32) * 64 + dk;
                f32x2 kvv[32], dd[32];
#pragma unroll
                for (int c = 0; c < 32; ++c) kvv[c] = *(const f32x2*)(base + (size_t)c * 4096);
                if (type == 1) {
#pragma unroll
                    for (int c = 0; c < 32; ++c) dd[c] = *(const f32x2*)(gd + c * 64);
                } else {
#pragma unroll
                    for (int c = 0; c < 32; ++c) dd[c] = (f32x2){dret, dret};
                }
                f32x2 s = (f32x2){0.f, 0.f};
#pragma unroll
                for (int c = 0; c < 32; ++c) { *(f32x2*)(base + (size_t)c * 4096) = s; s = dd[c] * s + kvv[c]; }
                float* so = outp + (type == 0 ? O_RETP : O_GLAP) + (size_t)((l * 8 + b) * 4 + h) * 4096;
                so[dk * 64 + dv] = s[0]; so[(dk + 1) * 64 + dv] = s[1];
            }
        }
        xcd_barrier(xbar);
        for (int rep = 0; rep < 1 + PROBE_M3X2; ++rep)
        for (int u = bx; u < 256; u += G) { MAKE_CTX(); mix_out<false>(C, wv >> 2, u & 7, u >> 3, wv & 3, wl); }
        xcd_barrier(xbar);
        {
            LANE_TID();
            unsigned char* ws = ws_ptr(); float* XR = out_ptr() + O_Y;
            const float* x_prompt = in_ptr(0); const float* x_sample = in_ptr(1);
            pg8::Gemm g{(const bf16_t*)(ws + WS_B), (const bf16_t*)(ws + WS_WOUT) + (size_t)l * DM * DM, MP, DM, DM}; pg8::StaticOrder S; S.init(MP, DM, Gq, bxq);
            pg8::EpiRes E{l == 0 ? x_prompt : XR, l == 0 ? (long long)((const char*)x_sample - (const char*)x_prompt) : (long long)MP * DM * 4, XR, (bf16_t*)(ws + WS_C), (float*)(ws + WS_SS) + (size_t)(2 * l + 1) * MT};
            pg8::gemm_phase<pg8::EpiRes, pg8::StaticOrder, true, true>(lds, g, S, E, tid);
            {
                SArgs a{}; a.A = (const bf16_t*)(ws + WS_B) + (size_t)MP * DM; a.Bt = (const bf16_t*)(ws + WS_WOUT) + (size_t)l * DM * DM; a.K = DM; a.nunits = 4 * 16;
                a.obf = (bf16_t*)(ws + WS_C) + (size_t)MP * DM; a.ldo = DM; a.ss_out = (float*)(ws + WS_SS) + (size_t)(2 * l + 1) * MT + MP;
                a.xold = l == 0 ? x_sample : XR + (size_t)MP * DM; a.xr = XR + (size_t)MP * DM;
                int ub, us; sample_share((MP / 256) * (DM / 256), Gq, bxq, ub, us);
                sample_gemm<SK_RES>(lds, a, ub, us, wave, lane);
                const int nsamp = a.nunits < Gq ? a.nunits : Gq;
                if (Gq == 256 && bxq >= nsamp) {
                    LAS float* scr = (LAS float*)(lds + wave * WAVE_LDS);
                    for (int it = (bxq - nsamp) * 8 + wave; it < 128 * 8; it += (Gq - nsamp) * 8)
                        tr_item128(in_ptr(17) + (size_t)l * DFF * DM, DFF, DM, (bf16_t*)(ws + WS_WDN) + (size_t)l * DM * DFF, it / 8, it % 8, nullptr, scr, lane);
                }
            }
        }
        xcd_barrier(xbar);
        {
            LANE_TID();
            unsigned char* ws = ws_ptr();
            pg8::Gemm g{(const bf16_t*)(ws + WS_C), (const bf16_t*)(ws + WS_WUP) + (size_t)l * DFF * DM, MP, DFF, DM}; pg8::StaticOrder S; S.init(MP, DFF, Gq, bxq);
            pg8::EpiUp E{(bf16_t*)(ws + WS_A), (const float*)(ws + WS_SS) + (size_t)(2 * l + 1) * MT, DFF};
            pg8::gemm_phase<pg8::EpiUp, pg8::StaticOrder, true, true>(lds, g, S, E, tid);
            if (PROBE_UP2) pg8::gemm_phase<pg8::EpiUp, pg8::StaticOrder, true, true>(lds, g, S, E, tid);
            if (PROBE_UP2B) { xcd_barrier(xbar); pg8::gemm_phase<pg8::EpiUp, pg8::StaticOrder, true, true>(lds, g, S, E, tid); }
            {
                SArgs a{}; a.A = (const bf16_t*)(ws + WS_C) + (size_t)MP * DM; a.Bt = (const bf16_t*)(ws + WS_WUP) + (size_t)l * DFF * DM; a.K = DM; a.nunits = 4 * 64;
                a.obf = (bf16_t*)(ws + WS_A) + (size_t)MP * DFF; a.ldo = DFF; a.ss_in = (const float*)(ws + WS_SS) + (size_t)(2 * l + 1) * MT + MP;
                int ub, us; sample_share((MP / 256) * (DFF / 256), Gq, bxq, ub, us);
                sample_gemm<SK_UP>(lds, a, ub, us, wave, lane);
            }
        }
        xcd_barrier(xbar);
        {
            LANE_TID();
            unsigned char* ws = ws_ptr(); float* XR = out_ptr() + O_Y;
            pg8::Gemm g{(const bf16_t*)(ws + WS_A), (const bf16_t*)(ws + WS_WDN) + (size_t)l * DM * DFF, MP, DM, DFF}; pg8::StaticOrder S; S.init(MP, DM, Gq, bxq);
            if (PROBE_DN2) { pg8::EpiUp E2{(bf16_t*)(ws + WS_C), (const float*)(ws + WS_SS) + (size_t)(2 * l + 1) * MT, DM}; pg8::gemm_phase<pg8::EpiUp, pg8::StaticOrder, true, true>(lds, g, S, E2, tid); }
            pg8::EpiRes E{XR, (long long)MP * DM * 4, XR, l == 0 ? (bf16_t*)(ws + WS_B) : (bf16_t*)nullptr, (float*)(ws + WS_SS) + (size_t)(2 * l + 2) * MT};
            pg8::gemm_phase<pg8::EpiRes, pg8::StaticOrder, true, true>(lds, g, S, E, tid);
            {
                SArgs a{}; a.A = (const bf16_t*)(ws + WS_A) + (size_t)MP * DFF; a.Bt = (const bf16_t*)(ws + WS_WDN) + (size_t)l * DM * DFF; a.K = DFF; a.nunits = 4 * 16;
                a.obf = l == 0 ? (bf16_t*)(ws + WS_B) + (size_t)MP * DM : (bf16_t*)nullptr; a.ldo = DM; a.ss_out = (float*)(ws + WS_SS) + (size_t)(2 * l + 2) * MT + MP;
                a.xold = XR + (size_t)MP * DM; a.xr = XR + (size_t)MP * DM;
                int ub, us; sample_share((MP / 256) * (DM / 256), Gq, bxq, ub, us);
                sample_gemm<SK_RES>(lds, a, ub, us, wave, lane);
            }
        }
        xcd_barrier(xbar);
    }
    for (int i = 0; i < PROBE_SYNCS; ++i) xcd_barrier(xbar);
    {
        LANE_TID();
        const int gw = bx * 8 + wave, NGW = G * 8;
        const float* fw = in_ptr(8); const float* SS = (const float*)WSP(WS_SS); float* XR = out_ptr() + O_Y;
        f32x4 w4[4];
#pragma unroll
        for (int j = 0; j < 4; ++j) w4[j] = *((const f32x4*)fw + lane + 64 * j);
        for (int m0 = gw; m0 < MT; m0 += 2 * NGW) {
            f32x4 v[2][4]; float rs[2];
#pragma unroll
            for (int q = 0; q < 2; ++q) {
                const int m = m0 + q * NGW;
                if (m < MT) {
                    rs[q] = SS[(size_t)4 * MT + m];
                    const f32x4* xr = (const f32x4*)(XR + (size_t)m * DM) + lane;
#pragma unroll
                    for (int j = 0; j < 4; ++j) v[q][j] = xr[64 * j];
                }
            }
#pragma unroll
            for (int q = 0; q < 2; ++q) {
                const int m = m0 + q * NGW;
                if (m < MT) {
                    const float r = 1.0f / sqrtf(rs[q] * (1.0f / 1024.0f) + EPS);
                    f32x4* xr = (f32x4*)(XR + (size_t)m * DM) + lane;
#pragma unroll
                    for (int j = 0; j < 4; ++j) xr[64 * j] = v[q][j] * r * w4[j];
                }
            }
        }
    }
}

extern "C" void kernel_launch(void* const* d_in, const int* in_sizes, int n_in, void* d_out, int out_size, void* d_ws, size_t ws_size, hipStream_t stream) {
    static int grid = 0;
    if (grid == 0) {
        if (n_in != 18 || (size_t)out_size != O_END || ws_size < WS_END) { fprintf(stderr, "kernel_launch: unexpected shapes: n_in %d out %d ws %zu (need %zu)\n", n_in, out_size, ws_size, (size_t)WS_END); grid = -1; return; }
        int dev = 0, cus = 0, per_cu = 0;
        hipGetDevice(&dev); hipDeviceGetAttribute(&cus, hipDeviceAttributeMultiprocessorCount, dev);
        if (hipFuncSetAttribute((const void*)hybrid_fwd, hipFuncAttributeMaxDynamicSharedMemorySize, LDS_BYTES) != hipSuccess) { fprintf(stderr, "kernel_launch: hipFuncSetAttribute failed\n"); }
        if (hipOccupancyMaxActiveBlocksPerMultiprocessor(&per_cu, (const void*)hybrid_fwd, 512, LDS_BYTES) != hipSuccess || per_cu < 1) { fprintf(stderr, "kernel_launch: occupancy query says %d\n", per_cu); per_cu = 1; }
        (void)hipGetLastError();
        grid = cus * per_cu;
        if (grid > 256) grid = 256;
    }
    if (grid < 0) return;
    if (hipMemsetAsync((unsigned char*)d_ws + WS_CTL, 0, CTL_BYTES, stream) != hipSuccess) { fprintf(stderr, "kernel_launch: memset of the barrier words failed\n"); return; }
    Params p{};
    for (int i = 0; i < 18; ++i) p.in[i] = (const float*)d_in[i];
    p.out = (float*)d_out; p.ws = (unsigned char*)d_ws;
    void* args[] = {&p};
    hipError_t e = hipLaunchCooperativeKernel((const void*)hybrid_fwd, dim3(grid), dim3(512), args, LDS_BYTES, stream);
    if (e != hipSuccess) fprintf(stderr, "kernel_launch: cooperative launch failed: %s (grid %d)\n", hipGetErrorString(e), grid);
}
```

```cpp
#include <hip/hip_runtime.h>
#include <hip/hip_cooperative_groups.h>
#include <cstdio>
#include <cstdint>
namespace cg = cooperative_groups;
#ifndef PROBE_UP2
#define PROBE_UP2 0
#endif
#ifndef PROBE_M1X2
#define PROBE_M1X2 0
#endif
#ifndef PROBE_P0X2
#define PROBE_P0X2 0
#endif
#ifndef PROBE_SYNCS
#define PROBE_SYNCS 0
#endif
#ifndef PROBE_IN2
#define PROBE_IN2 0
#endif
#ifndef PROBE_DN2
#define PROBE_DN2 0
#endif
#ifndef PROBE_UP2B
#define PROBE_UP2B 0
#endif
#ifndef PROBE_KVX2
#define PROBE_KVX2 0
#endif
#ifndef PROBE_ATX2
#define PROBE_ATX2 0
#endif
#ifndef PROBE_M3X2
#define PROBE_M3X2 0
#endif
namespace pg8 {
#define PG8_LAS __attribute__((address_space(3)))
typedef unsigned short bf16_t;
typedef short bf16x8 __attribute__((ext_vector_type(8)));
typedef float f32x4 __attribute__((ext_vector_type(4)));
typedef unsigned u32x4 __attribute__((ext_vector_type(4)));
constexpr int BM = 256, BK = 64, HALF = 128, HTB = HALF * BK * 2  , STAGE_BYTES = 8 * HTB, NXCD = 8, WGM = 8;

__host__ __device__ __forceinline__ int lds_byte(int r, int c) { const int st = (r >> 4) * 2 + (c >> 5), rr = r & 15, cc = c & 31, ob = rr * 64 + cc * 2; return st * 1024 + (ob ^ (((ob >> 9) & 1) << 5)); }
__host__ __device__ __forceinline__ void stage_rc(int b, int& R, int& C) { const int st = b / 1024, sb = b % 1024, swz = sb ^ (((sb >> 9) & 1) << 5); R = (st >> 1) * 16 + swz / 64; C = (st & 1) * 32 + (swz % 64) / 2; }
__host__ __device__ __forceinline__ int perm32(int rho) { const int n = rho >> 4, i = rho & 15; return 8 * (i >> 2) + 4 * n + (i & 3); }

struct Unit { int pm, pn; };
struct Gemm { const bf16_t* A; const bf16_t* Bt; int M, N, K; };

struct StaticOrder {
    int nM, nN, nwg, G, c;
    __host__ __device__ __forceinline__ void init(int M, int N, int G_, int c_) { nM = M / BM; nN = N / BM; nwg = nM * nN; G = G_; c = c_; }
    __host__ __device__ __forceinline__ bool next(int i, Unit& u) const {
        const long L = (long)i * G + c; if (L >= nwg) return false;
        int wgid = (int)L; { const int q = nwg / NXCD, r = nwg % NXCD, xcd = wgid % NXCD, off = wgid / NXCD; wgid = (xcd < r ? xcd * (q + 1) : r * (q + 1) + (xcd - r) * q) + off; }
        const int nig = WGM * nN, gid = wgid / nig, fm = gid * WGM, gsz = (nM - fm) < WGM ? (nM - fm) : WGM;
        u.pm = fm + ((wgid % nig) % gsz); u.pn = (wgid % nig) / gsz; return true;
    }
    __device__ __forceinline__ void a_ready(const Unit&) const {}
    __device__ __forceinline__ void done(const Unit&) const {}
};

__device__ __forceinline__ unsigned cvt_pk_bf16(float lo, float hi) { unsigned r; asm volatile("v_cvt_pk_bf16_f32 %0, %1, %2" : "=v"(r) : "v"(lo), "v"(hi)); return r; }
typedef float f32x2 __attribute__((ext_vector_type(2)));

typedef unsigned u32x2 __attribute__((ext_vector_type(2)));
constexpr int E_MP = 16384;
struct EpiIn {
    static constexpr bool PERM = true, AFTER_DRAIN = false;
    bf16_t* proj; float* lowf; const float* ss; float* out; long long okp, ovp, oks, ovs;
    __device__ __forceinline__ void operator()(const f32x4 (&acc)[2][2][4][2], const Unit& u, int wr, int wc, int fr, int fq) const {
        const int row0 = u.pm * BM + wr * 64 + fr, col0 = u.pn * BM + wc * 32 + 8 * fq;
        float* kv = nullptr; int rsub = 0, cbase = 0;
        if (u.pn >= 10 && u.pn < 14) {
            const bool isk = u.pn < 12; cbase = isk ? 2560 : 3072;
            if (u.pm >= 64) { kv = out + (isk ? oks : ovs); rsub = E_MP; }
            else if ((u.pm & 7) >= 6) { kv = out + (isk ? okp : ovp); rsub = 1536 * ((u.pm >> 3) + 1); }
        }
        const bool lowt = (u.pn == 14) && (wc == 0) && (fq < 2);
#pragma unroll
        for (int ai = 0; ai < 2; ++ai)
#pragma unroll
            for (int m = 0; m < 4; ++m) {
                const int r = row0 + ai * HALF + m * 16;
                const float rs = 1.0f / sqrtf(ss[r] * (1.0f / 1024.0f) + 1e-6f);
                bf16_t* rowp = proj + (size_t)r * 3840 + col0;
#pragma unroll
                for (int bj = 0; bj < 2; ++bj) {
                    const f32x4 v0 = acc[ai][bj][m][0] * rs, v1 = acc[ai][bj][m][1] * rs;
                    u32x4 w; w.x = cvt_pk_bf16(v0[0], v0[1]); w.y = cvt_pk_bf16(v0[2], v0[3]); w.z = cvt_pk_bf16(v1[0], v1[1]); w.w = cvt_pk_bf16(v1[2], v1[3]);
                    *(u32x4*)(rowp + bj * HALF) = w;
                    if (kv) { float* d = kv + (size_t)(r - rsub) * 512 + (col0 + bj * HALF - cbase); *(f32x4*)d = v0; *(f32x4*)(d + 4) = v1; }
                    if (lowt && bj == 0) { float* d = lowf + (size_t)r * 16 + 8 * fq; *(f32x4*)d = v0; *(f32x4*)(d + 4) = v1; }
                }
            }
    }
};
struct EpiRes {
    static constexpr bool PERM = true, AFTER_DRAIN = false;
    const float* xold_p; long long sdelta; float* xr; bf16_t* xb; float* ss;
    __device__ __forceinline__ void operator()(const f32x4 (&acc)[2][2][4][2], const Unit& u, int wr, int wc, int fr, int fq) const {
        const int row0 = u.pm * BM + wr * 64 + fr, col0 = u.pn * BM + wc * 32 + 8 * fq;
#pragma unroll
        for (int ai = 0; ai < 2; ++ai)
#pragma unroll
            for (int m = 0; m < 4; ++m) {
                const int r = row0 + ai * HALF + m * 16;
                const long long xoff = (u.pm < 64) ? (long long)r * 4096 : sdelta + (long long)(r - E_MP) * 4096;
                const float* xo = (const float*)((const char*)xold_p + xoff) + col0;
                float* xn = xr + (size_t)r * 1024 + col0;
                float sq = 0.f;
#pragma unroll
                for (int bj = 0; bj < 2; ++bj) {
                    const f32x4 v0 = acc[ai][bj][m][0] + *(const f32x4*)(xo + bj * HALF), v1 = acc[ai][bj][m][1] + *(const f32x4*)(xo + bj * HALF + 4);
                    *(f32x4*)(xn + bj * HALF) = v0; *(f32x4*)(xn + bj * HALF + 4) = v1;
                    sq += (v0[0] * v0[0] + v0[1] * v0[1]) + (v0[2] * v0[2] + v0[3] * v0[3]) + (v1[0] * v1[0] + v1[1] * v1[1]) + (v1[2] * v1[2] + v1[3] * v1[3]);
                    if (xb) { u32x4 w; w.x = cvt_pk_bf16(v0[0], v0[1]); w.y = cvt_pk_bf16(v0[2], v0[3]); w.z = cvt_pk_bf16(v1[0], v1[1]); w.w = cvt_pk_bf16(v1[2], v1[3]);
                        *(u32x4*)(xb + (size_t)r * 1024 + col0 + bj * HALF) = w; }
                }
                sq += __shfl_xor(sq, 16); sq += __shfl_xor(sq, 32);
                if (fq == 0) atomicAdd(ss + r, sq);
            }
    }
};
struct EpiUp {
    static constexpr bool PERM = true, AFTER_DRAIN = false;
    bf16_t* U; const float* ss; int ldu;
    __device__ __forceinline__ void operator()(const f32x4 (&acc)[2][2][4][2], const Unit& u, int wr, int wc, int fr, int fq) const {
        const int row0 = u.pm * BM + wr * 64 + fr, col0 = u.pn * BM + wc * 32 + 8 * fq;
#pragma unroll
        for (int ai = 0; ai < 2; ++ai)
#pragma unroll
            for (int m = 0; m < 4; ++m) {
                const int r = row0 + ai * HALF + m * 16;
                const float rs = 1.0f / sqrtf(ss[r] * (1.0f / 1024.0f) + 1e-6f);
                bf16_t* rowp = U + (size_t)r * ldu + col0;
#pragma unroll
                for (int bj = 0; bj < 2; ++bj) {
                    f32x4 v0 = acc[ai][bj][m][0] * rs, v1 = acc[ai][bj][m][1] * rs;
#pragma unroll
                    for (int e = 0; e < 4; ++e) { const float a = fmaxf(v0[e], 0.f), b = fmaxf(v1[e], 0.f); v0[e] = a * a; v1[e] = b * b; }
                    u32x4 w; w.x = cvt_pk_bf16(v0[0], v0[1]); w.y = cvt_pk_bf16(v0[2], v0[3]); w.z = cvt_pk_bf16(v1[0], v1[1]); w.w = cvt_pk_bf16(v1[2], v1[3]);
                    *(u32x4*)(rowp + bj * HALF) = w;
                }
            }
    }
};

template <class Epi, class Sched, bool ALIGN_EPI = false, bool SP2 = false>
__device__ __forceinline__ void gemm_phase(PG8_LAS unsigned char* lds, const Gemm g, const Sched& S, const Epi& E, const int tid_in) {
    int tid_ = tid_in; asm volatile("" : "+v"(tid_));
    const int tid = tid_, wid = __builtin_amdgcn_readfirstlane(tid >> 6), lane = tid & 63, wr = wid >> 2, wc = wid & 3, fr = lane & 15, fq = lane >> 4;
    const int K = g.K, nt = K / BK;
    unsigned voffA[2], voffB[2];
#pragma unroll
    for (int i = 0; i < 2; ++i) { int R, C; stage_rc(tid * 16 + i * 8192, R, C); const int Rb = Epi::PERM ? ((R & ~31) + perm32(R & 31)) : R;
        voffA[i] = (unsigned)(R * K + C) * 2u; voffB[i] = (unsigned)(Rb * K + C) * 2u; }
    const size_t kstep = (size_t)(BK * 2);
    const size_t hstep = (size_t)HALF * K * 2;
    const size_t tstep = 2 * hstep;
    const unsigned ldsw = (unsigned)wid * 1024u;
    const int aoff = lds_byte(wr * 64 + fr, fq * 8), boff = lds_byte(wc * 32 + fr, fq * 8);
#define PG8_SA(b, h) (((b) * 2 + (h)) * HTB)
#define PG8_SB(b, h) ((4 + (b) * 2 + (h)) * HTB)
#define PG8_STAGE(bufoff, gbase, voff) do { _Pragma("unroll") for (int _i = 0; _i < 2; ++_i) \
        __builtin_amdgcn_global_load_lds((const unsigned*)((const char*)(gbase) + (voff)[_i]), (PG8_LAS unsigned*)(lds + (bufoff) + ldsw + _i * 8192), 16, 0, 0); } while (0)
#define PG8_LDA(dst, b, h) do { _Pragma("unroll") for (int m = 0; m < 4; ++m) _Pragma("unroll") for (int k = 0; k < 2; ++k) dst[m][k] = *(const PG8_LAS bf16x8*)(lds + PG8_SA(b, h) + aoff + m * 2048 + k * 1024); } while (0)
#define PG8_LDB(dst, b, h) do { _Pragma("unroll") for (int n = 0; n < 2; ++n) _Pragma("unroll") for (int k = 0; k < 2; ++k) dst[n][k] = *(const PG8_LAS bf16x8*)(lds + PG8_SB(b, h) + boff + n * 2048 + k * 1024); } while (0)
#define PG8_MMA(ai, bj, At, Bt) do { __builtin_amdgcn_s_setprio(1); _Pragma("unroll") for (int m = 0; m < 4; ++m) _Pragma("unroll") for (int n = 0; n < 2; ++n) _Pragma("unroll") for (int k = 0; k < 2; ++k) \
        acc[ai][bj][m][n] = __builtin_amdgcn_mfma_f32_16x16x32_bf16(Bt[n][k], At[m][k], acc[ai][bj][m][n], 0, 0, 0); __builtin_amdgcn_s_setprio(0); } while (0)
#define PG8_WAIT_V(n) asm volatile("s_waitcnt vmcnt(" #n ")" ::: "memory")
#define PG8_WAIT_L(n) asm volatile("s_waitcnt lgkmcnt(" #n ")" ::: "memory")
#define PG8_BAR __builtin_amdgcn_s_barrier()
#define PG8_SCHED __builtin_amdgcn_sched_barrier(0)
    Unit cur, nxt; int ui = 0;
    if (!S.next(0, cur)) return;
    f32x4 acc[2][2][4][2];
#pragma unroll
    for (int a = 0; a < 2; ++a)
#pragma unroll
        for (int b = 0; b < 2; ++b)
#pragma unroll
            for (int m = 0; m < 4; ++m)
#pragma unroll
                for (int n = 0; n < 2; ++n) acc[a][b][m][n] = (f32x4){0.f, 0.f, 0.f, 0.f};
    bf16x8 At[4][2], B0[2][2], B1[2][2];
    const char* cA = (const char*)g.A + (size_t)cur.pm * tstep; const char* cB = (const char*)g.Bt + (size_t)cur.pn * tstep;
    S.a_ready(cur);
    if constexpr (SP2) {
        PG8_STAGE(PG8_SB(0, 0), cB, voffB); PG8_STAGE(PG8_SB(0, 1), cB + hstep, voffB); PG8_STAGE(PG8_SA(0, 0), cA, voffA); PG8_STAGE(PG8_SA(0, 1), cA + hstep, voffA);
        if (wr == 1) PG8_BAR;
        PG8_WAIT_V(2); PG8_BAR;
        PG8_STAGE(PG8_SB(1, 0), cB + kstep, voffB); PG8_STAGE(PG8_SA(1, 0), cA + kstep, voffA); PG8_STAGE(PG8_SB(1, 1), cB + hstep + kstep, voffB);
        PG8_WAIT_V(6); PG8_BAR;
    } else {
        PG8_STAGE(PG8_SB(0, 0), cB, voffB); PG8_STAGE(PG8_SA(0, 0), cA, voffA); PG8_STAGE(PG8_SB(0, 1), cB + hstep, voffB); PG8_STAGE(PG8_SA(0, 1), cA + hstep, voffA);
        if (wr == 1) PG8_BAR;
        PG8_WAIT_V(4); PG8_BAR;
        PG8_STAGE(PG8_SB(1, 0), cB + kstep, voffB); PG8_STAGE(PG8_SA(1, 0), cA + kstep, voffA); PG8_STAGE(PG8_SB(1, 1), cB + hstep + kstep, voffB);
        PG8_WAIT_V(6); PG8_BAR;
    }
    for (;;) {
        const bool has_next = S.next(ui + 1, nxt);
        const char* nA = has_next ? (const char*)g.A + (size_t)nxt.pm * tstep : cA; const char* nB = has_next ? (const char*)g.Bt + (size_t)nxt.pn * tstep : cB;
        for (int t = 0; t < nt; t += 2) {
            const bool last = (t == nt - 2);
            const char* a1 = cA + (size_t)(t + 1) * kstep;
            const char* a2 = last ? nA : cA + (size_t)(t + 2) * kstep; const char* b2 = last ? nB : cB + (size_t)(t + 2) * kstep;
            const char* a3 = a2 + kstep; const char* b3 = b2 + kstep;
            if (last && has_next) S.a_ready(nxt);
            if constexpr (SP2) {
            PG8_LDB(B0, 0, 0); PG8_LDB(B1, 0, 1); PG8_SCHED; PG8_LDA(At, 0, 0); PG8_STAGE(PG8_SA(1, 1), a1 + hstep, voffA);
            PG8_WAIT_V(8); PG8_WAIT_L(0); PG8_BAR; PG8_MMA(0, 0, At, B0); PG8_MMA(0, 1, At, B1); PG8_BAR; PG8_SCHED;
            PG8_LDA(At, 0, 1); PG8_STAGE(PG8_SB(0, 0), b2, voffB); PG8_STAGE(PG8_SB(0, 1), b2 + hstep, voffB); PG8_STAGE(PG8_SA(0, 0), a2, voffA);
            PG8_WAIT_V(8); PG8_WAIT_L(0); PG8_BAR; PG8_MMA(1, 0, At, B0); PG8_MMA(1, 1, At, B1); PG8_BAR; PG8_SCHED;
            PG8_LDB(B0, 1, 0); PG8_LDB(B1, 1, 1); PG8_SCHED; PG8_LDA(At, 1, 0); PG8_STAGE(PG8_SA(0, 1), a2 + hstep, voffA);
            PG8_WAIT_V(8); PG8_WAIT_L(0); PG8_BAR; PG8_MMA(0, 0, At, B0); PG8_MMA(0, 1, At, B1); PG8_BAR; PG8_SCHED;
            PG8_LDA(At, 1, 1); PG8_STAGE(PG8_SB(1, 0), b3, voffB); PG8_STAGE(PG8_SB(1, 1), b3 + hstep, voffB); PG8_STAGE(PG8_SA(1, 0), a3, voffA);
            PG8_WAIT_V(8); PG8_WAIT_L(0); PG8_BAR; PG8_MMA(1, 0, At, B0); PG8_MMA(1, 1, At, B1); PG8_BAR; PG8_SCHED;
            } else {
            PG8_LDB(B0, 0, 0); PG8_SCHED; PG8_LDA(At, 0, 0); PG8_STAGE(PG8_SA(1, 1), a1 + hstep, voffA);
            PG8_WAIT_L(8); PG8_BAR; PG8_WAIT_L(0); PG8_MMA(0, 0, At, B0); PG8_BAR; PG8_SCHED;
            PG8_LDB(B1, 0, 1); PG8_STAGE(PG8_SB(0, 0), b2, voffB);
            PG8_BAR; PG8_WAIT_L(0); PG8_MMA(0, 1, At, B1); PG8_BAR;
            PG8_LDA(At, 0, 1); PG8_STAGE(PG8_SA(0, 0), a2, voffA);
            PG8_BAR; PG8_WAIT_L(0); PG8_MMA(1, 0, At, B0); PG8_BAR; PG8_SCHED;
            PG8_STAGE(PG8_SB(0, 1), b2 + hstep, voffB);
            PG8_WAIT_V(6); PG8_BAR; PG8_MMA(1, 1, At, B1); PG8_BAR;
            PG8_LDB(B0, 1, 0); PG8_SCHED; PG8_LDA(At, 1, 0); PG8_STAGE(PG8_SA(0, 1), a2 + hstep, voffA);
            PG8_WAIT_L(8); PG8_BAR; PG8_WAIT_L(0); PG8_MMA(0, 0, At, B0); PG8_BAR; PG8_SCHED;
            PG8_LDB(B1, 1, 1); PG8_STAGE(PG8_SB(1, 0), b3, voffB);
            PG8_BAR; PG8_WAIT_L(0); PG8_MMA(0, 1, At, B1); PG8_BAR;
            PG8_LDA(At, 1, 1); PG8_STAGE(PG8_SA(1, 0), a3, voffA);
            PG8_BAR; PG8_WAIT_L(0); PG8_MMA(1, 0, At, B0); PG8_BAR; PG8_SCHED;
            PG8_STAGE(PG8_SB(1, 1), b3 + hstep, voffB);
            PG8_WAIT_V(6); PG8_BAR; PG8_MMA(1, 1, At, B1); PG8_BAR;
            }
        }
        if constexpr (ALIGN_EPI) { if (wr == 0) PG8_BAR; }
        if constexpr (!Epi::AFTER_DRAIN) { E(acc, cur, wr, wc, fr, fq); S.done(cur); }
        if (!has_next) break;
#pragma unroll
        for (int a = 0; a < 2; ++a)
#pragma unroll
            for (int b = 0; b < 2; ++b)
#pragma unroll
                for (int m = 0; m < 4; ++m)
#pragma unroll
                    for (int n = 0; n < 2; ++n) acc[a][b][m][n] = (f32x4){0.f, 0.f, 0.f, 0.f};
        cur = nxt; cA = nA; cB = nB; ++ui;
        if constexpr (ALIGN_EPI) { if (wr == 1) PG8_BAR; }
    }
    PG8_WAIT_V(0);
    if constexpr (!ALIGN_EPI) { if (wr == 0) PG8_BAR; }
    PG8_BAR;
    if constexpr (Epi::AFTER_DRAIN) { E.fused(acc, cur, wr, wc, fr, fq, lds, wid, lane); S.done(cur); }
#undef PG8_SA
#undef PG8_SB
#undef PG8_STAGE
#undef PG8_LDA
#undef PG8_LDB
#undef PG8_MMA
#undef PG8_WAIT_V
#undef PG8_WAIT_L
#undef PG8_BAR
#undef PG8_SCHED
}
}


#define LAS __attribute__((address_space(3)))
typedef unsigned short bf16_t;
typedef short bf16x8 __attribute__((ext_vector_type(8)));
typedef short s16x4 __attribute__((ext_vector_type(4)));
typedef short v4i16_t __attribute__((ext_vector_type(4)));
typedef float f32x4 __attribute__((ext_vector_type(4)));
typedef float f32x2 __attribute__((ext_vector_type(2)));
typedef float f32x16 __attribute__((ext_vector_type(16)));
typedef unsigned u32x4 __attribute__((ext_vector_type(4)));
typedef unsigned u32x2 __attribute__((ext_vector_type(2)));

constexpr int DM = 1024, NB = 8, SEQ = 2048, MP = NB * SEQ, SL = 32, MS = NB * SL, MT = MP + MS;
constexpr int PS = 3840, DFF = 4096, INCOLS = 3600;
constexpr int C_QA = 0, C_KA = 256, C_VA = 512, C_GA = 768, C_QB = 1024, C_KB = 1280, C_VB = 1536, C_GB = 1792, C_QC = 2048, C_KC = 2560, C_VC = 3072, C_LOW = 3584;
constexpr int NREL = 320;
constexpr float EPS = 1e-6f;
constexpr size_t WS_A = 0;
constexpr size_t WS_B = WS_A + (size_t)MT * DFF * 2;
constexpr size_t WS_C = WS_B + (size_t)MT * DM * 2;
constexpr size_t WS_WIN = WS_C + (size_t)MT * DM * 2;
constexpr size_t WS_WOUT = WS_WIN + (size_t)2 * PS * DM * 2;
constexpr size_t WS_WUP = WS_WOUT + (size_t)2 * DM * DM * 2;
constexpr size_t WS_WDN = WS_WUP + (size_t)2 * DFF * DM * 2;
constexpr size_t WS_LOWF = WS_WDN + (size_t)2 * DFF * DM * 2;
constexpr size_t WS_SS = WS_LOWF + (size_t)MT * 16 * 4;
constexpr size_t WS_G = WS_SS + (size_t)5 * MT * 4;
constexpr size_t WS_ROPE = WS_G + (size_t)1024 * 64 * 4;
constexpr size_t WS_CTL = WS_ROPE + (size_t)2080 * 64 * 4;
constexpr size_t CTL_BYTES = 16384;
constexpr size_t WS_END = WS_CTL + CTL_BYTES;
static_assert((size_t)2048 * 4096 * 4 <= (size_t)MT * DM * 2, "KVT fits region C");
constexpr size_t WS_CKB = WS_A + (size_t)MT * PS * 2;
constexpr size_t CACHE_ELEMS = (size_t)8 * 512 * 512;
static_assert(WS_CKB + 2 * CACHE_ELEMS * 2 <= WS_B, "cache copies fit behind PROJ");
static_assert(WS_END <= (size_t)256 * 1024 * 1024, "d_ws map");
constexpr size_t O_Y = 0, O_RETP = (size_t)MT * DM, O_GLAP = O_RETP + 262144, O_KP = O_GLAP + 262144, O_VP = O_KP + 4194304, O_RETS = O_VP + 4194304, O_GLAS = O_RETS + 262144,
                 O_KS = O_GLAS + 262144, O_VS = O_KS + 262144, O_END = O_VS + 262144;
constexpr int TS = 144;
constexpr int TILE_B = 64 * TS;
constexpr int WAVE_LDS = 2 * TILE_B;
constexpr int LDS_BIAS = 8 * WAVE_LDS;
constexpr int NREV = 384;
constexpr int LDS_BARST = LDS_BIAS + 8 * NREV * 4;
constexpr int LDS_BYTES = LDS_BARST + 16;
static_assert(LDS_BYTES <= 160 * 1024 && pg8::STAGE_BYTES <= LDS_BIAS, "LDS map");

struct Params { const float* in[18]; float* out; unsigned char* ws; };
__device__ __forceinline__ int lane_id_asm() { int l; asm volatile("v_mbcnt_lo_u32_b32 %0, -1, 0\n\tv_mbcnt_hi_u32_b32 %0, -1, %0" : "=v"(l)); return l; }
typedef const __attribute__((address_space(4))) char* kaptr_t;
__device__ __forceinline__ kaptr_t karg_base() { kaptr_t ka = (kaptr_t)__builtin_amdgcn_kernarg_segment_ptr(); asm volatile("" : "+s"(ka)); return ka; }
__device__ __forceinline__ const float* in_ptr(int i) { return *(const float* const __attribute__((address_space(4)))*)(karg_base() + 8 * i); }
__device__ __forceinline__ float* out_ptr() { return *(float* const __attribute__((address_space(4)))*)(karg_base() + 8 * 18); }
__device__ __forceinline__ unsigned char* ws_ptr() { return *(unsigned char* const __attribute__((address_space(4)))*)(karg_base() + 8 * 19); }

typedef float f32x2_t __attribute__((ext_vector_type(2))); typedef __bf16 bf16x2_t __attribute__((ext_vector_type(2)));
__device__ __forceinline__ unsigned pk2(float lo, float hi) { const f32x2_t v = {lo, hi}; const bf16x2_t b = __builtin_convertvector(v, bf16x2_t); return __builtin_bit_cast(unsigned, b); }
__device__ __forceinline__ float bflo(unsigned u) { return __uint_as_float(u << 16); }
__device__ __forceinline__ float bfhi(unsigned u) { return __uint_as_float(u & 0xffff0000u); }
__device__ __forceinline__ float bf2f(bf16_t h) { return __uint_as_float((unsigned)h << 16); }
__device__ __forceinline__ bf16_t f2bf(float f) { return (bf16_t)(pk2(f, 0.f) & 0xffffu); }
__device__ __forceinline__ int crow(int r, int hi) { return (r & 3) + 8 * (r >> 2) + 4 * hi; }
__device__ __forceinline__ float silu(float x) { return x / (1.0f + __expf(-x)); }
__device__ __forceinline__ f32x16 mfma32(bf16x8 a, bf16x8 b, f32x16 c) { return __builtin_amdgcn_mfma_f32_32x32x16_bf16(a, b, c, 0, 0, 0); }
__device__ __forceinline__ bf16x8 as_bf16x8(u32x4 v) { return __builtin_bit_cast(bf16x8, v); }
__device__ __forceinline__ f32x16 zero16() { f32x16 z;
#pragma unroll
    for (int i = 0; i < 16; ++i) z[i] = 0.f; return z; }
__device__ __forceinline__ s16x4 ds_tr(LAS const unsigned char* p) { return __builtin_bit_cast(s16x4, __builtin_amdgcn_ds_read_tr16_b64_v4i16((LAS v4i16_t*)p)); }
__device__ __forceinline__ bf16x8 tr_nat(LAS const unsigned char* tile, int k0, int cb, int lane) {
    const int kq = lane >> 5, g = (lane >> 4) & 1, q = (lane & 15) >> 2, p = lane & 3;
    LAS const unsigned char* a = tile + (k0 + 8 * kq + q) * TS + (cb + 16 * g + 4 * p) * 2;
    const s16x4 lo = ds_tr(a), hi = ds_tr(a + 4 * TS);
    return (bf16x8){lo[0], lo[1], lo[2], lo[3], hi[0], hi[1], hi[2], hi[3]};
}
template <int STR = TS> __device__ __forceinline__ bf16x8 tr_perm(LAS const unsigned char* tile, int k0, int cb, int lane) {
    const int kq = lane >> 5, g = (lane >> 4) & 1, q = (lane & 15) >> 2, p = lane & 3;
    LAS const unsigned char* a = tile + (k0 + 4 * kq + q) * STR + (cb + 16 * g + 4 * p) * 2;
    const s16x4 lo = ds_tr(a), hi = ds_tr(a + 8 * STR);
    return (bf16x8){lo[0], lo[1], lo[2], lo[3], hi[0], hi[1], hi[2], hi[3]};
}
__device__ __forceinline__ bf16x8 tr_perm_swz(LAS const unsigned char* tile, int k0, int cb, int lane) {
    const int kq = lane >> 5, g = (lane >> 4) & 1, q = (lane & 15) >> 2, p = lane & 3;
    const int row = k0 + 4 * kq + q, ob = ((cb + 16 * g + 4 * p) * 2) ^ ((row & 2) << 5);
    LAS const unsigned char* a = tile + row * 128 + ob;
    const s16x4 lo = ds_tr(a), hi = ds_tr(a + 8 * 128);
    return (bf16x8){lo[0], lo[1], lo[2], lo[3], hi[0], hi[1], hi[2], hi[3]};
}
__device__ __forceinline__ bf16x8 row_frag(LAS const unsigned char* tile, int r0, int ks, int lane) {
    return *(LAS const bf16x8*)(tile + (r0 + (lane & 31)) * TS + (16 * ks + 8 * (lane >> 5)) * 2);
}
__device__ __forceinline__ bf16x8 pack_step(const f32x16& x, int s) {
    u32x4 w; w.x = pk2(x[8 * s + 0], x[8 * s + 1]); w.y = pk2(x[8 * s + 2], x[8 * s + 3]); w.z = pk2(x[8 * s + 4], x[8 * s + 5]); w.w = pk2(x[8 * s + 6], x[8 * s + 7]);
    return as_bf16x8(w);
}
__device__ __forceinline__ void load_tile(LAS unsigned char* tile, const bf16_t* src, int pitch, int nvalid, int lane) {
#pragma unroll
    for (int it = 0; it < 8; ++it) {
        const int id = it * 64 + lane, row = id >> 3, ch = id & 7;
        u32x4 v = (u32x4){0u, 0u, 0u, 0u};
        if (row < nvalid) v = *(const u32x4*)(src + (size_t)row * pitch + ch * 8);
        *(LAS u32x4*)(tile + row * TS + ch * 16) = v;
    }
}
__device__ __forceinline__ void store_tile(LAS const unsigned char* tile, bf16_t* dst, int pitch, int nvalid, int lane) {
#pragma unroll
    for (int it = 0; it < 8; ++it) {
        const int id = it * 64 + lane, row = id >> 3, ch = id & 7;
        const u32x4 v = *(LAS const u32x4*)(tile + row * TS + ch * 16);
        if (row < nvalid) *(u32x4*)(dst + (size_t)row * pitch + ch * 8) = v;
    }
}
__device__ __forceinline__ void load_tile_f32(LAS unsigned char* tile, const float* src, int pitch, int lane) {
#pragma unroll
    for (int it = 0; it < 16; ++it) {
        const int id = it * 64 + lane, row = id >> 4, c4 = id & 15;
        const f32x4 v = *(const f32x4*)(src + (size_t)row * pitch + c4 * 4);
        u32x2 w; w.x = pk2(v[0], v[1]); w.y = pk2(v[2], v[3]);
        *(LAS u32x2*)(tile + row * TS + c4 * 8) = w;
    }
}
__device__ __forceinline__ void load_rot(const bf16_t* rp, const float* cs, int kq, float scale, bool valid, bf16x8 (&fr)[4]) {
    u32x4 c[4];
#pragma unroll
    for (int ks = 0; ks < 4; ++ks) c[ks] = valid ? *(const u32x4*)(rp + 16 * ks + 8 * kq) : (u32x4){0u, 0u, 0u, 0u};
#pragma unroll
    for (int g = 0; g < 2; ++g) {
        const float* cp = cs + 16 * g + 8 * kq;
        const f32x4 ca = *(const f32x4*)cp, cb = *(const f32x4*)(cp + 4), sa = *(const f32x4*)(cp + 32), sb = *(const f32x4*)(cp + 36);
        float o1[8], o2[8];
#pragma unroll
        for (int e = 0; e < 8; ++e) {
            const unsigned w1 = c[g][e >> 1], w2 = c[g + 2][e >> 1];
            const float x1 = (e & 1) ? bfhi(w1) : bflo(w1), x2 = (e & 1) ? bfhi(w2) : bflo(w2);
            const float cc = (e < 4) ? ca[e & 3] : cb[e & 3], sn = (e < 4) ? sa[e & 3] : sb[e & 3];
            o1[e] = (x1 * cc - x2 * sn) * scale; o2[e] = (x1 * sn + x2 * cc) * scale;
        }
        u32x4 a, b;
        a.x = pk2(o1[0], o1[1]); a.y = pk2(o1[2], o1[3]); a.z = pk2(o1[4], o1[5]); a.w = pk2(o1[6], o1[7]);
        b.x = pk2(o2[0], o2[1]); b.y = pk2(o2[2], o2[3]); b.z = pk2(o2[4], o2[5]); b.w = pk2(o2[6], o2[7]);
        fr[g] = as_bf16x8(a); fr[g + 2] = as_bf16x8(b);
    }
}

struct Ctx {
    int l, lane, kq, li;
    const bf16_t* proj; const float* lowf; const float* rope; bf16_t* cat; float* kvt; float* gdec; float* out;
    const float* wa2; const float* ba; const float* nw; const float* st; const bf16_t* ckb; const bf16_t* cvb;
};
__device__ __forceinline__ float ret_lg2(int h) { return __log2f(1.0f - exp2f(-5.0f - (float)h)); }

struct GlaGate {
    f32x4 lw[4]; float w[16]; float bias, run;
    template <int L> __device__ __forceinline__ void init(const Ctx& C, int m0, int h) {
#pragma unroll
        for (int q = 0; q < 4; ++q) lw[q] = (C.lane < L) ? *(const f32x4*)(C.lowf + (size_t)(m0 + C.lane) * 16 + 4 * q) : (f32x4){0.f, 0.f, 0.f, 0.f};
#pragma unroll
        for (int j = 0; j < 16; ++j) w[j] = C.wa2[j * 256 + h * 64 + C.lane];
        bias = C.ba[h * 64 + C.lane]; run = 0.f;
    }
    __device__ __forceinline__ float step(int s) {
        float z0 = bias, z1 = 0.f;
#pragma unroll
        for (int j = 0; j < 16; j += 2) {
            z0 += __int_as_float(__builtin_amdgcn_readlane(__float_as_int(lw[j >> 2][j & 3]), s)) * w[j];
            z1 += __int_as_float(__builtin_amdgcn_readlane(__float_as_int(lw[(j + 1) >> 2][(j + 1) & 3]), s)) * w[j + 1];
        }
        const float z = z0 + z1;
        const float lf = fminf(z, 0.f) - __logf(1.0f + __expf(-fabsf(z)));
        run += lf * (1.0f / 16.0f);
        return run;
    }
};

template <bool SAMPLE> __device__ __forceinline__ void kv_local(const Ctx& C, int type, int b, int n, int h, LAS unsigned char* wl) {
    constexpr int L = SAMPLE ? 32 : 64, NKS = L / 16;
    const int m0 = SAMPLE ? MP + b * SL : b * SEQ + n * 64;
    const int pidx0 = SAMPLE ? 2048 : n * 64;
    LAS unsigned char* tK = wl; LAS unsigned char* tV = wl + TILE_B;
    const int lane = C.lane, kq = C.kq, li = C.li;
    float gdk = 0.f;
    if (type == 0) {
        const float lg = ret_lg2(h);
#pragma unroll
        for (int rb = 0; rb < L / 32; ++rb) {
            const int s = 32 * rb + li;
            bf16x8 fr[4];
            load_rot(C.proj + (size_t)(m0 + s) * PS + C_KA + h * 64, C.rope + (size_t)(pidx0 + s) * 64, kq, 0.125f * __builtin_amdgcn_exp2f(lg * (float)(L - 1 - s)), true, fr);
#pragma unroll
            for (int ks = 0; ks < 4; ++ks) *(LAS bf16x8*)(tK + s * TS + (16 * ks + 8 * kq) * 2) = fr[ks];
        }
        load_tile(tV, C.proj + (size_t)m0 * PS + C_VA + h * 64, PS, L, lane);
    } else {
        load_tile(tK, C.proj + (size_t)m0 * PS + C_KB + h * 64, PS, L, lane);
        GlaGate gg; gg.init<L>(C, m0, h);
        if (!SAMPLE) {
            load_tile(tV, C.proj + (size_t)m0 * PS + C_QB + h * 64, PS, L, lane);
#pragma unroll 4
            for (int s = 0; s < L; ++s) {
                const float e = __expf(gg.step(s));
                LAS bf16_t* kp = (LAS bf16_t*)(tK + s * TS + lane * 2); LAS bf16_t* qp = (LAS bf16_t*)(tV + s * TS + lane * 2);
                *kp = f2bf(bf2f(*kp) / e); *qp = f2bf(bf2f(*qp) * 0.125f * e);
            }
            asm volatile("s_waitcnt lgkmcnt(0)" ::: "memory");
            store_tile(tV, (bf16_t*)C.proj + (size_t)m0 * PS + C_QB + h * 64, PS, L, lane);
            store_tile(tK, (bf16_t*)C.proj + (size_t)m0 * PS + C_KB + h * 64, PS, L, lane);
            asm volatile("s_waitcnt lgkmcnt(0)" ::: "memory");
            load_tile(tV, C.proj + (size_t)m0 * PS + C_VB + h * 64, PS, L, lane);
        } else {
            load_tile(tV, C.proj + (size_t)m0 * PS + C_VB + h * 64, PS, L, lane);
#pragma unroll 4
            for (int s = 0; s < L; ++s) {
                const float bs = gg.step(s);
                LAS bf16_t* kp = (LAS bf16_t*)(tK + s * TS + lane * 2);
                *kp = f2bf(bf2f(*kp) * __expf(-bs));
            }
        }
        gdk = __expf(gg.run);
    }
    f32x16 kv[2][2];
#pragma unroll
    for (int db = 0; db < 2; ++db)
#pragma unroll
        for (int kb = 0; kb < 2; ++kb) kv[db][kb] = zero16();
#pragma unroll
    for (int ks = 0; ks < NKS; ++ks) {
        bf16x8 a[2], bb[2];
#pragma unroll
        for (int db = 0; db < 2; ++db) a[db] = tr_nat(tV, 16 * ks, 32 * db, lane);
#pragma unroll
        for (int kb = 0; kb < 2; ++kb) bb[kb] = tr_nat(tK, 16 * ks, 32 * kb, lane);
#pragma unroll
        for (int db = 0; db < 2; ++db)
#pragma unroll
            for (int kb = 0; kb < 2; ++kb) kv[db][kb] = mfma32(a[db], bb[kb], kv[db][kb]);
    }
    if (type == 1) {
#pragma unroll
        for (int kb = 0; kb < 2; ++kb) { const float cs = __int_as_float(__builtin_amdgcn_ds_bpermute((32 * kb + li) * 4, __float_as_int(gdk)));
#pragma unroll
            for (int db = 0; db < 2; ++db) kv[db][kb] = kv[db][kb] * cs; }
    }
    if (!SAMPLE) {
        const int uidx = ((type * 8 + b) * 4 + h) * 32 + n;
        bf16_t* dst = (bf16_t*)C.kvt + (size_t)uidx * 4096;
#pragma unroll
        for (int db = 0; db < 2; ++db)
#pragma unroll
            for (int kb = 0; kb < 2; ++kb)
#pragma unroll
                for (int r = 0; r < 16; ++r) dst[(32 * db + crow(r, kq)) * 64 + 32 * kb + li] = f2bf(kv[db][kb][r]);
        if (type == 1) C.gdec[(size_t)(((b * 4 + h) * 32 + n)) * 64 + lane] = gdk;
    } else {
        const float* s0 = C.st + (size_t)((C.l * 8 + b) * 4 + h) * 4096;
        float* so = C.out + (type == 0 ? O_RETS : O_GLAS) + (size_t)((C.l * 8 + b) * 4 + h) * 4096;
        const float dret = exp2f(ret_lg2(h) * (float)L);
#pragma unroll
        for (int kb = 0; kb < 2; ++kb) {
            const int dk = 32 * kb + li;
            const float dec = (type == 0) ? dret : __int_as_float(__builtin_amdgcn_ds_bpermute(dk * 4, __float_as_int(gdk)));
#pragma unroll
            for (int db = 0; db < 2; ++db)
#pragma unroll
                for (int rr = 0; rr < 4; ++rr) {
                    const int dv = 32 * db + 8 * rr + 4 * kq;
                    const f32x4 o = *(const f32x4*)(s0 + dk * 64 + dv);
                    f32x4 nv;
#pragma unroll
                    for (int e = 0; e < 4; ++e) nv[e] = dec * o[e] + kv[db][kb][4 * rr + e];
                    *(f32x4*)(so + dk * 64 + dv) = nv;
                }
        }
    }
}

template <bool SAMPLE> __device__ __forceinline__ void mix_out(const Ctx& C, int type, int b, int n, int h, LAS unsigned char* wl) {
    constexpr int L = SAMPLE ? 32 : 64, NTB = L / 32;
    const int m0 = SAMPLE ? MP + b * SL : b * SEQ + n * 64;
    const int pidx0 = SAMPLE ? 2048 : n * 64;
    LAS unsigned char* t0 = wl; LAS unsigned char* t1 = wl + TILE_B;
    const int lane = C.lane, kq = C.kq, li = C.li;
    bf16x8 qfr[NTB][4];
    const float lg = ret_lg2(h);
    if (type == 0) {
#pragma unroll
        for (int tb = 0; tb < NTB; ++tb) {
            const int s = 32 * tb + li;
            load_rot(C.proj + (size_t)(m0 + s) * PS + C_QA + h * 64, C.rope + (size_t)(pidx0 + s) * 64, kq, __builtin_amdgcn_exp2f(lg * (float)(s + 1)), true, qfr[tb]);
        }
        load_tile(t0, C.proj + (size_t)m0 * PS + C_VA + h * 64, PS, L, lane);
    } else {
        load_tile(t0, C.proj + (size_t)m0 * PS + C_QB + h * 64, PS, L, lane);
        load_tile(t1, C.proj + (size_t)m0 * PS + C_KB + h * 64, PS, L, lane);
        if (SAMPLE) {
            GlaGate gg; gg.init<L>(C, m0, h);
#pragma unroll 4
            for (int s = 0; s < L; ++s) {
                const float e = __expf(gg.step(s));
                LAS bf16_t* qp = (LAS bf16_t*)(t0 + s * TS + lane * 2); LAS bf16_t* kp = (LAS bf16_t*)(t1 + s * TS + lane * 2);
                *qp = f2bf(bf2f(*qp) * 0.125f * e); *kp = f2bf(bf2f(*kp) / e);
            }
        }
        __builtin_amdgcn_sched_barrier(0);
#pragma unroll
        for (int tb = 0; tb < NTB; ++tb)
#pragma unroll
            for (int ks = 0; ks < 4; ++ks) qfr[tb][ks] = row_frag(t0, 32 * tb, ks, lane);
        asm volatile("s_waitcnt lgkmcnt(0)" ::: "memory");
        __builtin_amdgcn_sched_barrier(0);
        load_tile(t0, C.proj + (size_t)m0 * PS + C_VB + h * 64, PS, L, lane);
    }
    __builtin_amdgcn_sched_barrier(0);
    f32x16 o[2][NTB];
#pragma unroll
    for (int db = 0; db < 2; ++db)
#pragma unroll
        for (int tb = 0; tb < NTB; ++tb) o[db][tb] = zero16();
    {
        const int uidx = ((type * 8 + b) * 4 + h) * 32 + n;
        const bf16_t* sT = (const bf16_t*)C.kvt + (size_t)uidx * 4096;
        const float* s0 = C.st + (size_t)((C.l * 8 + b) * 4 + h) * 4096;
#pragma unroll
        for (int db = 0; db < 2; ++db)
#pragma unroll
            for (int ks = 0; ks < 4; ++ks) {
                const int dv = 32 * db + li, dk0 = 16 * ks + 8 * kq;
                bf16x8 sa;
                if (!SAMPLE) sa = as_bf16x8(*(const u32x4*)(sT + dv * 64 + dk0));
                else { float sv[8];
#pragma unroll
                    for (int e = 0; e < 8; ++e) sv[e] = s0[(dk0 + e) * 64 + dv];
                    u32x4 w; w.x = pk2(sv[0], sv[1]); w.y = pk2(sv[2], sv[3]); w.z = pk2(sv[4], sv[5]); w.w = pk2(sv[6], sv[7]);
                    sa = as_bf16x8(w); }
#pragma unroll
                for (int tb = 0; tb < NTB; ++tb) o[db][tb] = mfma32(sa, qfr[tb][ks], o[db][tb]);
            }
    }
    __builtin_amdgcn_sched_barrier(0);
#pragma unroll
    for (int sb = 0; sb < NTB; ++sb) {
        bf16x8 kfr[4];
        if (type == 0) load_rot(C.proj + (size_t)(m0 + 32 * sb + li) * PS + C_KA + h * 64, C.rope + (size_t)(pidx0 + 32 * sb + li) * 64, kq, 0.125f * __builtin_amdgcn_exp2f(-lg * (float)(32 * sb + li + 1)), true, kfr);
        else {
#pragma unroll
            for (int ks = 0; ks < 4; ++ks) kfr[ks] = row_frag(t1, 32 * sb, ks, lane);
        }
        f32x16 st[NTB];
#pragma unroll
        for (int tb = sb; tb < NTB; ++tb) {
            f32x16 a = zero16();
#pragma unroll
            for (int ks = 0; ks < 4; ++ks) a = mfma32(kfr[ks], qfr[tb][ks], a);
#pragma unroll
            for (int r = 0; r < 16; ++r) {
                const int s = 32 * sb + crow(r, kq), t = 32 * tb + li;
                a[r] = (t >= s) ? a[r] : 0.0f;
            }
            st[tb] = a;
        }
#pragma unroll
        for (int half = 0; half < 2; ++half) {
            bf16x8 va[2];
#pragma unroll
            for (int db = 0; db < 2; ++db) va[db] = tr_perm(t0, 32 * sb + 16 * half, 32 * db, lane);
#pragma unroll
            for (int tb = sb; tb < NTB; ++tb) {
                const bf16x8 pf = pack_step(st[tb], half);
#pragma unroll
                for (int db = 0; db < 2; ++db) o[db][tb] = mfma32(va[db], pf, o[db][tb]);
            }
        }
        __builtin_amdgcn_sched_barrier(0);
    }
    const float* nw = C.nw + h * 64;
    const int gcol = (type == 0 ? C_GA : C_GB) + h * 64;
#pragma unroll
    for (int tb = 0; tb < NTB; ++tb) {
        const int t = 32 * tb + li;
        float s1 = 0.f, s2 = 0.f;
#pragma unroll
        for (int db = 0; db < 2; ++db)
#pragma unroll
            for (int r = 0; r < 16; ++r) { const float x = o[db][tb][r]; s1 += x; s2 += x * x; }
        s1 += __shfl_xor(s1, 32); s2 += __shfl_xor(s2, 32);
        float mu = 0.f, rstd;
        if (type == 0) { mu = s1 * (1.0f / 64.0f); const float var = fmaxf(s2 * (1.0f / 64.0f) - mu * mu, 0.f); rstd = 1.0f / sqrtf(var + EPS); }
        else rstd = 1.0f / sqrtf(s2 * (1.0f / 64.0f) + EPS);
        const bf16_t* grow = C.proj + (size_t)(m0 + t) * PS + gcol;
        bf16_t* orow = C.cat + (size_t)(m0 + t) * DM + type * 256 + h * 64;
#pragma unroll
        for (int db = 0; db < 2; ++db)
#pragma unroll
            for (int rr = 0; rr < 4; ++rr) {
                const int dv = 32 * db + 8 * rr + 4 * kq;
                const u32x2 gw = *(const u32x2*)(grow + dv);
                const f32x4 wv = *(const f32x4*)(nw + dv);
                const float g0 = bflo(gw.x), g1 = bfhi(gw.x), g2 = bflo(gw.y), g3 = bfhi(gw.y);
                const float y0 = (o[db][tb][4 * rr + 0] - mu) * rstd * wv[0] * silu(g0), y1 = (o[db][tb][4 * rr + 1] - mu) * rstd * wv[1] * silu(g1);
                const float y2 = (o[db][tb][4 * rr + 2] - mu) * rstd * wv[2] * silu(g2), y3 = (o[db][tb][4 * rr + 3] - mu) * rstd * wv[3] * silu(g3);
                u32x2 w; w.x = pk2(y0, y1); w.y = pk2(y2, y3);
                *(u32x2*)(orow + dv) = w;
            }
    }
}

template <bool SAMPLE> __device__ __forceinline__ void attn_wave(const Ctx& C, int b, int n, int h, LAS unsigned char* wl, LAS const float* revT, float cb2) {
    constexpr int NTB = SAMPLE ? 1 : 2;
    constexpr float SC = 0.125f * 1.4426950408889634f;
    const int m0 = SAMPLE ? MP + b * SL : b * SEQ + n * 64;
    const int lane = C.lane, kq = C.kq, li = C.li;
    const int jt0 = SAMPLE ? 0 : (n < 8 ? 8 - n : 0);
#define ATT_SRC(jt, kp, vp, pitch, rmask) const bf16_t* kp; const bf16_t* vp; int pitch; int rmask = 63; \
    if (SAMPLE && (jt) < 8) { kp = C.ckb + (size_t)(b * 512 + 64 * (jt)) * 512 + h * 64; vp = C.cvb + (size_t)(b * 512 + 64 * (jt)) * 512 + h * 64; pitch = 512; } \
    else { const int kr0 = SAMPLE ? m0 : b * SEQ + (n - 8 + (jt)) * 64; kp = C.proj + (size_t)kr0 * PS + C_KC + h * 64; vp = kp + (C_VC - C_KC); pitch = PS; if (SAMPLE) rmask = 31; }
#define ATT_ISSUE(jt, kdst, vbuf) do { ATT_SRC(jt, kp_, vp_, pitch_, rmask_); \
    _Pragma("unroll") for (int sb = 0; sb < 2; ++sb) _Pragma("unroll") for (int ks = 0; ks < 4; ++ks) kdst[sb][ks] = *(const u32x4*)(kp_ + (size_t)((32 * sb + li) & rmask_) * pitch_ + 16 * ks + 8 * kq); \
    _Pragma("unroll") for (int it = 0; it < 8; ++it) __builtin_amdgcn_global_load_lds((const unsigned*)(vp_ + (size_t)((it * 8 + (lane >> 3)) & rmask_) * pitch_ + (((lane & 7) ^ (((lane >> 3) & 2) << 1)) * 8)), (LAS unsigned*)((vbuf) + it * 1024), 16, 0, 0); } while (0)
    bf16x8 qfr[NTB][4];
#pragma unroll
    for (int tb = 0; tb < NTB; ++tb)
#pragma unroll
        for (int ks = 0; ks < 4; ++ks) qfr[tb][ks] = as_bf16x8(*(const u32x4*)(C.proj + (size_t)(m0 + 32 * tb + li) * PS + C_QC + h * 64 + 16 * ks + 8 * kq));
    f32x16 o[2][NTB]; float mrun[NTB], lrun[NTB];
#pragma unroll
    for (int tb = 0; tb < NTB; ++tb) { mrun[tb] = -1e30f; lrun[tb] = 0.f;
#pragma unroll
        for (int db = 0; db < 2; ++db) o[db][tb] = zero16(); }
    u32x4 kcur[2][4], knext[2][4];
    ATT_ISSUE(jt0, kcur, wl + ((jt0 & 1) ? TILE_B : 0));
    for (int jt = jt0; jt <= 8; ++jt) {
        asm volatile("s_waitcnt vmcnt(0)" ::: "memory");
        __builtin_amdgcn_sched_barrier(0);
        LAS unsigned char* tV = wl + ((jt & 1) ? TILE_B : 0);
        if (jt < 8) { ATT_ISSUE(jt + 1, knext, wl + (((jt + 1) & 1) ? TILE_B : 0)); }
        __builtin_amdgcn_sched_barrier(0);
        const bool cst = jt <= 3;
#pragma unroll
        for (int sb = 0; sb < 2; ++sb) {
            if (SAMPLE && jt == 8 && sb == 1) continue;
#pragma unroll
            for (int tb = 0; tb < NTB; ++tb) {
                f32x16 a = zero16();
#pragma unroll
                for (int ks = 0; ks < 4; ++ks) a = mfma32(as_bf16x8(kcur[sb][ks]), qfr[tb][ks], a);
                if (!cst) {
                    const int dbase = (8 - jt) * 64 + 63 + 32 * tb + li - 32 * sb;
                    LAS const float* rp = revT + (382 - dbase + 4 * kq);
#pragma unroll
                    for (int r = 0; r < 16; ++r) a[r] = a[r] * SC + rp[(r & 3) + 8 * (r >> 2)];
                }
                float mx = -1e30f;
#pragma unroll
                for (int r = 0; r < 16; ++r) mx = fmaxf(mx, a[r]);
                if (cst) mx = mx * SC + cb2;
                mx = fmaxf(mx, __shfl_xor(mx, 32));
                const float mnew = fmaxf(mrun[tb], mx);
                const bool moved = __builtin_amdgcn_ballot_w64(mnew != mrun[tb]) != 0ull;
                const float alpha = __builtin_amdgcn_exp2f(mrun[tb] - mnew);
                mrun[tb] = mnew;
                float ps = 0.f;
                if (cst) { const float off = cb2 - mnew;
#pragma unroll
                    for (int r = 0; r < 16; ++r) { const float pp = __builtin_amdgcn_exp2f(a[r] * SC + off); a[r] = pp; ps += pp; } }
                else {
#pragma unroll
                    for (int r = 0; r < 16; ++r) { const float pp = __builtin_amdgcn_exp2f(a[r] - mnew); a[r] = pp; ps += pp; } }
                lrun[tb] = lrun[tb] * alpha + ps;
                if (moved) {
#pragma unroll
                    for (int db = 0; db < 2; ++db) o[db][tb] = o[db][tb] * alpha;
                }
#pragma unroll
                for (int half = 0; half < 2; ++half) {
                    const bf16x8 pf = pack_step(a, half);
#pragma unroll
                    for (int db = 0; db < 2; ++db) o[db][tb] = mfma32(tr_perm_swz(tV, 32 * sb + 16 * half, 32 * db, lane), pf, o[db][tb]);
                }
            }
        }
#pragma unroll
        for (int sb = 0; sb < 2; ++sb)
#pragma unroll
            for (int ks = 0; ks < 4; ++ks) kcur[sb][ks] = knext[sb][ks];
    }
#pragma unroll
    for (int tb = 0; tb < NTB; ++tb) {
        const float lt = lrun[tb] + __shfl_xor(lrun[tb], 32), inv = 1.0f / lt;
        bf16_t* orow = C.cat + (size_t)(m0 + 32 * tb + li) * DM + 512 + h * 64;
#pragma unroll
        for (int db = 0; db < 2; ++db)
#pragma unroll
            for (int rr = 0; rr < 4; ++rr) {
                u32x2 w; w.x = pk2(o[db][tb][4 * rr] * inv, o[db][tb][4 * rr + 1] * inv); w.y = pk2(o[db][tb][4 * rr + 2] * inv, o[db][tb][4 * rr + 3] * inv);
                *(u32x2*)(orow + 32 * db + 8 * rr + 4 * kq) = w;
            }
    }
#undef ATT_ISSUE
#undef ATT_SRC
}

__device__ __forceinline__ void conv_cache(const float* ck, const float* cv, bf16_t* dst, int l, int gt, int NGT) {
    for (int i = gt; i < (int)(2 * CACHE_ELEMS / 8); i += NGT) {
        const bool isv = i >= (int)(CACHE_ELEMS / 8); const int j = isv ? i - (int)(CACHE_ELEMS / 8) : i;
        const float* s = (isv ? cv : ck) + (size_t)l * CACHE_ELEMS + (size_t)j * 8;
        const f32x4 x = *(const f32x4*)s, y = *(const f32x4*)(s + 4);
        u32x4 w; w.x = pk2(x[0], x[1]); w.y = pk2(x[2], x[3]); w.z = pk2(y[0], y[1]); w.w = pk2(y[2], y[3]);
        *(u32x4*)(dst + (size_t)i * 8) = w;
    }
}

__device__ __forceinline__ int win_src(int n) { return n < 2048 ? n : (n < 3584 ? n + 16 : (n < 3600 ? n - 1536 : -1)); }
__device__ __forceinline__ void tr_item(const float* W, int K, int Nsrc, bf16_t* WT, int kb, int nb, bool inmap, const float* kscale, LAS float* scr, int lane) {
    const int k0 = 64 * kb, n0 = 32 * nb, n = n0 + (lane & 31), sc = inmap ? win_src(n) : n;
    float wv[32];
#pragma unroll
    for (int i = 0; i < 32; ++i) { const int kk = 2 * i + (lane >> 5); wv[i] = (sc >= 0) ? W[(size_t)(k0 + kk) * Nsrc + sc] : 0.f; }
    if (kscale) {
#pragma unroll
        for (int i = 0; i < 32; ++i) wv[i] *= kscale[k0 + 2 * i + (lane >> 5)];
    }
#pragma unroll
    for (int i = 0; i < 32; ++i) scr[(2 * i + (lane >> 5)) * 33 + (lane & 31)] = wv[i];
    asm volatile("s_waitcnt lgkmcnt(0)" ::: "memory");
    const int c = lane & 7;
#pragma unroll
    for (int j = 0; j < 4; ++j) { const int nn = (lane >> 3) + 8 * j; const LAS float* s = scr + (8 * c) * 33 + nn;
        u32x4 o; o.x = pk2(s[0 * 33], s[1 * 33]); o.y = pk2(s[2 * 33], s[3 * 33]); o.z = pk2(s[4 * 33], s[5 * 33]); o.w = pk2(s[6 * 33], s[7 * 33]);
        *(u32x4*)(WT + (size_t)(n0 + nn) * K + k0 + 8 * c) = o; }
    asm volatile("s_waitcnt lgkmcnt(0)" ::: "memory");
}


enum { SK_IN = 0, SK_RES = 1, SK_UP = 2 };
struct SArgs {
    const bf16_t* A; const bf16_t* Bt; int K, nunits;
    bf16_t* obf; int ldo;
    const float* ss_in; float* ss_out;
    const float* xold; float* xr;
    float* lowf; float* ksout; float* vsout;
};
template <int KIND> __device__ __forceinline__ void sample_gemm(LAS unsigned char* lds, const SArgs& a, int ubeg, int ustep, int wave, int lane) {
    const int kq = lane >> 5, li = lane & 31, K = a.K, kw = K >> 3, kbeg = wave * kw;
    for (int u = ubeg; u < a.nunits; u += ustep) {
        const int row0 = 64 * (u & 3), col0 = 64 * (u >> 2);
        f32x16 acc[2][2];
#pragma unroll
        for (int rb = 0; rb < 2; ++rb)
#pragma unroll
            for (int cb = 0; cb < 2; ++cb) acc[rb][cb] = zero16();
        const bf16_t* ap = a.A + (size_t)(row0 + li) * K + kbeg + 8 * kq;
        const bf16_t* bp = a.Bt + (size_t)(col0 + li) * K + kbeg + 8 * kq;
        u32x4 af[4][2], bv[4][2], an[4][2], bn[4][2];
#define SG_LOAD(dsta, dstb, k) _Pragma("unroll") for (int s = 0; s < 4; ++s) _Pragma("unroll") for (int h = 0; h < 2; ++h) { dsta[s][h] = *(const u32x4*)(ap + (size_t)(32 * h) * K + (k) + 16 * s); dstb[s][h] = *(const u32x4*)(bp + (size_t)(32 * h) * K + (k) + 16 * s); }
        SG_LOAD(af, bv, 0);
        for (int k = 0; k < kw; k += 64) {
            if (k + 64 < kw) { SG_LOAD(an, bn, k + 64); }
#pragma unroll
            for (int s = 0; s < 4; ++s)
#pragma unroll
                for (int rb = 0; rb < 2; ++rb)
#pragma unroll
                    for (int cb = 0; cb < 2; ++cb) acc[rb][cb] = mfma32(as_bf16x8(af[s][rb]), as_bf16x8(bv[s][cb]), acc[rb][cb]);
#pragma unroll
            for (int s = 0; s < 4; ++s)
#pragma unroll
                for (int h = 0; h < 2; ++h) { af[s][h] = an[s][h]; bv[s][h] = bn[s][h]; }
        }
#undef SG_LOAD
        LAS float* wp = (LAS float*)(lds + wave * WAVE_LDS);
#pragma unroll
        for (int rb = 0; rb < 2; ++rb)
#pragma unroll
            for (int cb = 0; cb < 2; ++cb)
#pragma unroll
                for (int r = 0; r < 16; ++r) wp[(32 * rb + crow(r, kq)) * 64 + 32 * cb + li] = acc[rb][cb][r];
        __syncthreads();
        const int t = wave * 64 + lane, row = t >> 3, c8 = (t & 7) * 8;
        float v[8];
#pragma unroll
        for (int e = 0; e < 8; ++e) v[e] = 0.f;
#pragma unroll
        for (int w = 0; w < 8; ++w) {
            const f32x4 x = *(LAS const f32x4*)(lds + w * WAVE_LDS + (row * 64 + c8) * 4), y = *(LAS const f32x4*)(lds + w * WAVE_LDS + (row * 64 + c8) * 4 + 16);
#pragma unroll
            for (int e = 0; e < 4; ++e) { v[e] += x[e]; v[4 + e] += y[e]; }
        }
        const int r = row0 + row, c = col0 + c8;
        if (KIND == SK_IN || KIND == SK_UP) {
            const float rs = 1.0f / sqrtf(a.ss_in[r] * (1.0f / 1024.0f) + EPS);
#pragma unroll
            for (int e = 0; e < 8; ++e) { v[e] *= rs; if (KIND == SK_UP) { const float q = fmaxf(v[e], 0.f); v[e] = q * q; } }
        }
        if (KIND == SK_RES) {
            const float* xo = a.xold + (size_t)r * 1024 + c;
            const f32x4 x = *(const f32x4*)xo, y = *(const f32x4*)(xo + 4);
            float sq = 0.f;
#pragma unroll
            for (int e = 0; e < 4; ++e) { v[e] += x[e]; v[4 + e] += y[e]; }
#pragma unroll
            for (int e = 0; e < 8; ++e) sq += v[e] * v[e];
            float* xn = a.xr + (size_t)r * 1024 + c;
            *(f32x4*)xn = (f32x4){v[0], v[1], v[2], v[3]}; *(f32x4*)(xn + 4) = (f32x4){v[4], v[5], v[6], v[7]};
            sq += __shfl_xor(sq, 1); sq += __shfl_xor(sq, 2); sq += __shfl_xor(sq, 4);
            if ((t & 7) == 0) atomicAdd(a.ss_out + r, sq);
        }
        if (a.obf) { u32x4 w; w.x = pk2(v[0], v[1]); w.y = pk2(v[2], v[3]); w.z = pk2(v[4], v[5]); w.w = pk2(v[6], v[7]); *(u32x4*)(a.obf + (size_t)r * a.ldo + c) = w; }
        if (KIND == SK_IN) {
            float* d = nullptr;
            if (c >= C_KC && c < C_VC) d = a.ksout + (size_t)r * 512 + (c - C_KC);
            else if (c >= C_VC && c < C_LOW) d = a.vsout + (size_t)r * 512 + (c - C_VC);
            else if (c >= C_LOW && c < C_LOW + 16) d = a.lowf + (size_t)r * 16 + (c - C_LOW);
            if (d) { *(f32x4*)d = (f32x4){v[0], v[1], v[2], v[3]}; *(f32x4*)(d + 4) = (f32x4){v[4], v[5], v[6], v[7]}; }
        }
        __syncthreads();
    }
}
__device__ __forceinline__ void sample_share(int nwg, int G, int bx, int& ubeg, int& ustep) { const int nfull = nwg % G; if (nfull == 0) { ubeg = bx; ustep = G; } else if (bx >= nfull) { ubeg = bx - nfull; ustep = G - nfull; } else { ubeg = 1 << 30; ustep = 1; } }

#define XB_TMO      128
#define XB_XCNT(j)  (256  + 64 * (j))
#define XB_XSUB(j)  (1280 + 64 * (j))
#define XB_XGEN(j)  (2304 + 64 * (j))
#define XB_TOP      3328
#define XB_TOPGEN   3392
#define XCD_BAR_WORDS 3456
#define XB_SPIN_CAP (1u << 18)

__device__ __forceinline__ unsigned xb_ld(unsigned* p)              { return __hip_atomic_load(p, __ATOMIC_RELAXED, __HIP_MEMORY_SCOPE_AGENT); }
__device__ __forceinline__ unsigned xb_add(unsigned* p, unsigned v) { return __hip_atomic_fetch_add(p, v, __ATOMIC_RELAXED, __HIP_MEMORY_SCOPE_AGENT); }
__device__ __forceinline__ unsigned xb_xcc_id() { return (unsigned)__builtin_amdgcn_s_getreg((3 << 11) | 20) & 0xFu; }
#define XB_SPIN(cond, bar) do { unsigned _sp = 0; while (cond) { __builtin_amdgcn_s_sleep(1); \
    if ((++_sp & 255u) == 0u) { if (xb_ld(&(bar)[XB_TMO])) break; if (_sp > XB_SPIN_CAP) { atomicAdd(&(bar)[XB_TMO], 1u); break; } } } } while (0)

struct XcdBarrier {
    unsigned* bar; unsigned x; bool wave0;
    volatile LAS unsigned* st;
};

__device__ __forceinline__ XcdBarrier xcd_barrier_post(unsigned* bar, volatile LAS unsigned* st) {
    XcdBarrier b; b.bar = bar; b.x = xb_xcc_id(); b.st = st;
    if (threadIdx.x == 0) (void)xb_add(&bar[XB_XCNT(b.x)], 1u);
    return b;
}
__device__ __forceinline__ void xcd_barrier_complete(unsigned* bar, unsigned x, unsigned& nloc, unsigned& nx) {
    const unsigned G = gridDim.x * gridDim.y * gridDim.z;
    unsigned sum, cnt, mine, sp = 0u;
    for (;;) {
        sum = 0u; cnt = 0u; mine = 0u;
#pragma unroll
        for (unsigned j = 0; j < 16; ++j) { const unsigned c = xb_ld(&bar[XB_XCNT(j)]); sum += c; cnt += (c > 0u) ? 1u : 0u; mine = (j == x) ? c : mine; }
        if (sum == G) break;
        __builtin_amdgcn_s_sleep(1);
        if ((++sp & 255u) == 0u) { if (xb_ld(&bar[XB_TMO])) break; if (sp > XB_SPIN_CAP) { atomicAdd(&bar[XB_TMO], 1u); break; } }
    }
    nloc = mine > 0u ? mine : 1u; nx = cnt > 0u ? cnt : 1u;
}

__device__ __forceinline__ void xcd_barrier(const XcdBarrier& b) {
    asm volatile("s_waitcnt vmcnt(0)" ::: "memory");
    __syncthreads();
    if (b.wave0 && lane_id_asm() == 0) {
        unsigned* bar = b.bar;
        __builtin_amdgcn_s_waitcnt(0);
        unsigned nloc = b.st[0], nx = b.st[1];
        if (nloc == 0u) { xcd_barrier_complete(bar, b.x, nloc, nx); b.st[0] = nloc; b.st[1] = nx; }
        const unsigned old = xb_add(&bar[XB_XSUB(b.x)], 1u);
        const unsigned gen = old / nloc;
        if (old + 1u == (gen + 1u) * nloc) {
            __builtin_amdgcn_fence(__ATOMIC_RELEASE, "agent");
            asm volatile("s_waitcnt vmcnt(0)" ::: "memory");
            const unsigned og = xb_add(&bar[XB_TOP], 1u);
            const unsigned tg = og / nx;
            if (og + 1u == (tg + 1u) * nx) xb_add(&bar[XB_TOPGEN], 1u);
            else XB_SPIN(xb_ld(&bar[XB_TOPGEN]) == tg, bar);
            __builtin_amdgcn_fence(__ATOMIC_ACQUIRE, "agent");
            xb_add(&bar[XB_XGEN(b.x)], 1u);
            asm volatile("s_waitcnt vmcnt(0)" ::: "memory");
        } else {
            XB_SPIN(xb_ld(&bar[XB_XGEN(b.x)]) == gen, bar);
            __builtin_amdgcn_fence(__ATOMIC_ACQUIRE, "agent");
            asm volatile("s_waitcnt vmcnt(0)" ::: "memory");
        }
    }
    __syncthreads();
}


__device__ __forceinline__ void tr_item128(const float* W, int K, int Nsrc, bf16_t* WT, int kb, int nb, const float* kscale, LAS float* scr, int lane) {
    const int k0 = 32 * kb, n0 = 128 * nb, n4 = (lane & 31) * 4;
    f32x4 wv[16];
#pragma unroll
    for (int i = 0; i < 16; ++i) wv[i] = *(const f32x4*)(W + (size_t)(k0 + 2 * i + (lane >> 5)) * Nsrc + n0 + n4);
    if (kscale) {
#pragma unroll
        for (int i = 0; i < 16; ++i) wv[i] = wv[i] * kscale[k0 + 2 * i + (lane >> 5)];
    }
#pragma unroll
    for (int i = 0; i < 16; ++i) { LAS float* d = scr + (2 * i + (lane >> 5)) * 129 + n4; d[0] = wv[i][0]; d[1] = wv[i][1]; d[2] = wv[i][2]; d[3] = wv[i][3]; }
    asm volatile("s_waitcnt lgkmcnt(0)" ::: "memory");
#pragma unroll
    for (int j = 0; j < 8; ++j) { const int id = j * 64 + lane, n = id >> 2, c = id & 3; const LAS float* s = scr + (8 * c) * 129 + n;
        u32x4 o; o.x = pk2(s[0 * 129], s[1 * 129]); o.y = pk2(s[2 * 129], s[3 * 129]); o.z = pk2(s[4 * 129], s[5 * 129]); o.w = pk2(s[6 * 129], s[7 * 129]);
        *(u32x4*)(WT + (size_t)(n0 + n) * K + k0 + 8 * c) = o; }
    asm volatile("s_waitcnt lgkmcnt(0)" ::: "memory");
}
constexpr int CONV_WGS = 16;

__global__ void __launch_bounds__(512, 2) hybrid_fwd(Params p) {
    extern __shared__ __attribute__((aligned(16))) unsigned char lds_raw[];
    cg::grid_group grid = cg::this_grid();
    LAS unsigned char* lds = (LAS unsigned char*)lds_raw;
    const int wave = __builtin_amdgcn_readfirstlane((int)threadIdx.x >> 6);
    const int G = gridDim.x, bx = blockIdx.x;
#define WSP(off) (ws_ptr() + (off))
#define LANE_TID() const int lane = lane_id_asm(); const int tid = wave * 64 + lane; (void)tid; int Gq = G, bxq = bx; asm volatile("" : "+s"(Gq), "+s"(bxq)); (void)Gq; (void)bxq
    LAS unsigned char* wl = lds + wave * WAVE_LDS;
    LAS float* biasT = (LAS float*)(lds + LDS_BIAS);
    if (threadIdx.x < 4) ((LAS unsigned*)(lds + LDS_BARST))[threadIdx.x] = 0u;
    __syncthreads();
    XcdBarrier xbar = xcd_barrier_post((unsigned*)WSP(WS_CTL), (volatile LAS unsigned*)(lds + LDS_BARST)); xbar.wave0 = (wave == 0);

    for (int rep = 0; rep < 1 + PROBE_P0X2; ++rep) {
        LANE_TID();
        unsigned char* ws = ws_ptr();
        bf16_t* XB = (bf16_t*)(ws + WS_B); bf16_t* WIN = (bf16_t*)(ws + WS_WIN); bf16_t* WOUT = (bf16_t*)(ws + WS_WOUT); bf16_t* WUP = (bf16_t*)(ws + WS_WUP); bf16_t* WDN = (bf16_t*)(ws + WS_WDN);
        float* SS = (float*)(ws + WS_SS); float* ROPE = (float*)(ws + WS_ROPE);
        const int gw = bx * 8 + wave, NGW = G * 8;
        LAS float* scr = (LAS float*)wl;
        constexpr int I_IN = 16 * (PS / 32), I_OUT = 16 * 32, I_UP = 16 * 128, I_DN = 64 * 32, I_L = I_IN + I_OUT + I_UP + I_DN;
        const bool split = (G == 256);
        for (int it = gw; it < 2 * I_L; it += NGW) {
            const int l = it / I_L; int r = it % I_L;
            if (split && r >= I_IN) continue;
            if (r < I_IN) { tr_item(in_ptr(9) + (size_t)l * DM * INCOLS, DM, INCOLS, WIN + (size_t)l * PS * DM, r / (PS / 32), r % (PS / 32), true, in_ptr(6) + l * DM, scr, lane); continue; } r -= I_IN;
            if (r < I_OUT) { tr_item(in_ptr(15) + (size_t)l * DM * DM, DM, DM, WOUT + (size_t)l * DM * DM, r / 32, r % 32, false, nullptr, scr, lane); continue; } r -= I_OUT;
            if (r < I_UP) { tr_item(in_ptr(16) + (size_t)l * DM * DFF, DM, DFF, WUP + (size_t)l * DFF * DM, r / 128, r % 128, false, in_ptr(7) + l * DM, scr, lane); continue; } r -= I_UP;
            tr_item(in_ptr(17) + (size_t)l * DFF * DM, DFF, DM, WDN + (size_t)l * DM * DFF, r / 32, r % 32, false, nullptr, scr, lane);
        }
        const float* x_prompt = in_ptr(0); const float* x_sample = in_ptr(1);
        for (int m0 = gw; m0 < MT; m0 += 2 * NGW) {
            f32x4 v[2][4]; float s[2];
#pragma unroll
            for (int q = 0; q < 2; ++q) {
                const int m = m0 + q * NGW; s[q] = 0.f;
                if (m < MT) {
                    const float* xrow = (m < MP) ? x_prompt + (size_t)m * DM : x_sample + (size_t)(m - MP) * DM;
                    const f32x4* xr = (const f32x4*)xrow + lane;
#pragma unroll
                    for (int j = 0; j < 4; ++j) v[q][j] = xr[64 * j];
                }
            }
#pragma unroll
            for (int q = 0; q < 2; ++q) {
                const int m = m0 + q * NGW;
                if (m < MT) {
#pragma unroll
                    for (int j = 0; j < 4; ++j) s[q] += (v[q][j][0] * v[q][j][0] + v[q][j][1] * v[q][j][1]) + (v[q][j][2] * v[q][j][2] + v[q][j][3] * v[q][j][3]);
#pragma unroll
                    for (int o = 1; o < 64; o <<= 1) s[q] += __shfl_xor(s[q], o);
                    u32x2* o8 = (u32x2*)(XB + (size_t)m * DM) + lane;
#pragma unroll
                    for (int j = 0; j < 4; ++j) { u32x2 w; w.x = pk2(v[q][j][0], v[q][j][1]); w.y = pk2(v[q][j][2], v[q][j][3]); o8[64 * j] = w; }
                    if (lane == 0) SS[m] = s[q];
                }
            }
        }
        const int gt = bx * 512 + tid, NGT = G * 512;
        for (int i = gt; i < 4 * MT; i += NGT) SS[MT + i] = 0.f;
        conv_cache(in_ptr(4), in_ptr(5), (bf16_t*)(ws + WS_CKB), 0, gt, NGT);
        for (int i = gt; i < 2080 * 32; i += NGT) {
            const int pi = i >> 5, f = i & 31; const int pos = pi < 2048 ? pi : 4096 + (pi - 2048);
            const float inv_freq = (float)exp(-(double)f * (9.210340371976184 / 32.0));
            const float ang = (float)pos * inv_freq;
            double rev = (double)ang * 0.15915494309189535; rev -= rint(rev);
            const float rf = (float)rev;
            ROPE[(size_t)pi * 64 + f] = __builtin_amdgcn_cosf(rf); ROPE[(size_t)pi * 64 + 32 + f] = __builtin_amdgcn_sinf(rf);
        }
    }
    if (G == 0x7fffffff) grid.sync();
    xcd_barrier(xbar);

    for (int l = 0; l < 2; ++l) {
        {
            LANE_TID();
            unsigned char* ws = ws_ptr();
            const bool split = (Gq == 256); const int GG = split ? Gq - CONV_WGS : Gq;
            if (split && bxq >= GG) {
                LAS float* scr = (LAS float*)(lds + wave * WAVE_LDS);
                constexpr int J_OUT = 32 * 8, J_UP = 32 * 32;
                for (int it = (bxq - GG) * 8 + wave; it < J_OUT + J_UP; it += CONV_WGS * 8) {
                    if (it < J_OUT) tr_item128(in_ptr(15) + (size_t)l * DM * DM, DM, DM, (bf16_t*)(ws + WS_WOUT) + (size_t)l * DM * DM, it / 8, it % 8, nullptr, scr, lane);
                    else { const int r = it - J_OUT; tr_item128(in_ptr(16) + (size_t)l * DM * DFF, DM, DFF, (bf16_t*)(ws + WS_WUP) + (size_t)l * DFF * DM, r / 32, r % 32, in_ptr(7) + l * DM, scr, lane); }
                }
            } else {
            pg8::Gemm g{(const bf16_t*)(ws + WS_B), (const bf16_t*)(ws + WS_WIN) + (size_t)l * PS * DM, MP, PS, DM}; pg8::StaticOrder S; S.init(MP, PS, GG, bxq);
            pg8::EpiIn E{(bf16_t*)(ws + WS_A), (float*)(ws + WS_LOWF), (const float*)(ws + WS_SS) + (size_t)(2 * l) * MT, out_ptr(), (long long)(O_KP + (size_t)l * 2097152), (long long)(O_VP + (size_t)l * 2097152), (long long)(O_KS + (size_t)l * 131072), (long long)(O_VS + (size_t)l * 131072)};
            pg8::gemm_phase<pg8::EpiIn, pg8::StaticOrder, true, true>(lds, g, S, E, tid);
            if (PROBE_IN2) pg8::gemm_phase<pg8::EpiIn, pg8::StaticOrder, true, true>(lds, g, S, E, tid);
            {
                float* outp = out_ptr();
                SArgs a{}; a.A = (const bf16_t*)(ws + WS_B) + (size_t)MP * DM; a.Bt = (const bf16_t*)(ws + WS_WIN) + (size_t)l * PS * DM; a.K = DM; a.nunits = 4 * 57;
                a.obf = (bf16_t*)(ws + WS_A) + (size_t)MP * PS; a.ldo = PS; a.ss_in = (const float*)(ws + WS_SS) + (size_t)(2 * l) * MT + MP; a.lowf = (float*)(ws + WS_LOWF) + (size_t)MP * 16;
                a.ksout = outp + O_KS + (size_t)l * 131072; a.vsout = outp + O_VS + (size_t)l * 131072;
                int ub, us; sample_share((MP / 256) * (PS / 256), GG, bxq, ub, us);
                sample_gemm<SK_IN>(lds, a, ub, us, wave, lane);
            }
            if (l == 1) conv_cache(in_ptr(4), in_ptr(5), (bf16_t*)(ws + WS_CKB), 1, bxq * 512 + tid, GG * 512);
            }
        }
        xcd_barrier(xbar);
        {
            LANE_TID();
            { const float* rb = in_ptr(14) + (size_t)l * 8 * NREL; for (int i = tid; i < 8 * NREV; i += 512) { const int hh = i / NREV, j = i % NREV; int k = 382 - j; k = k < 0 ? 0 : (k > NREL - 1 ? NREL - 1 : k); biasT[i] = rb[hh * NREL + k] * 1.4426950408889634f; } }
            __syncthreads();
        }
#define MAKE_CTX() LANE_TID(); int wv = wave; asm volatile("" : "+s"(wv)); unsigned char* ws = ws_ptr(); Ctx C; C.l = l; C.lane = lane; C.kq = lane >> 5; C.li = lane & 31; C.proj = (const bf16_t*)(ws + WS_A); C.lowf = (const float*)(ws + WS_LOWF); \
        C.rope = (const float*)(ws + WS_ROPE); C.cat = (bf16_t*)(ws + WS_B); C.kvt = (float*)(ws + WS_C); C.gdec = (float*)(ws + WS_G); C.out = out_ptr(); \
        C.wa2 = in_ptr(10) + (size_t)l * 16 * 256; C.ba = in_ptr(11) + l * 256; C.nw = (wv < 4 ? in_ptr(12) : in_ptr(13)) + l * 256; C.st = (wv < 4 ? in_ptr(2) : in_ptr(3)); C.ckb = (const bf16_t*)(ws + WS_CKB); C.cvb = C.ckb + CACHE_ELEMS; \
        __builtin_amdgcn_sched_barrier(0)
        for (int rep = 0; rep < 1 + PROBE_M1X2; ++rep)
        for (int u = bx; u < 256; u += G) {
            const int b = u & 7, n = u >> 3;
            for (int rk = 0; rk < 1 + PROBE_KVX2; ++rk) { MAKE_CTX(); kv_local<false>(C, wv >> 2, b, n, wv & 3, wl); }
            for (int ra = 0; ra < 1 + PROBE_ATX2; ++ra) { MAKE_CTX(); attn_wave<false>(C, b, n, wave, wl, biasT + wave * NREV, biasT[wave * NREV]); }
            if (n == 0) { MAKE_CTX(); attn_wave<true>(C, b, 0, wave, wl, biasT + wave * NREV, biasT[wave * NREV]); }
            if (n == 1) { MAKE_CTX(); mix_out<true>(C, wv >> 2, b, 0, wv & 3, wl); }
            if (n == 2) { MAKE_CTX(); kv_local<true>(C, wv >> 2, b, 0, wv & 3, wl); }
        }
        xcd_barrier(xbar);
        {
            LANE_TID();
            float* KVT = (float*)WSP(WS_C); const float* GDEC = (const float*)WSP(WS_G); float* outp = out_ptr();
            for (int it = bx * 512 + tid; it < 131072; it += G * 512) {
                const int seq = it >> 11, e2 = it & 2047, type = seq >> 5, b = (seq >> 2) & 7, h = seq & 3;
                const int dv = e2 >> 5, dk = (2 * e2) & 63;
                bf16_t* base = (bf16_t*)KVT + (size_t)seq * 32 * 4096 + 2 * e2;
                const float dret = exp2f(ret_lg2(h) * 64.0f);
                const float* gd = GDEC + (size_t)((b * 4 + h) * 32) * 64 + dk;
                unsigned kvr[32]; f32x2 dd[32];
#pragma unroll
                for (int c = 0; c < 32; ++c) kvr[c] = *(const unsigned*)(base + (size_t)c * 4096);
                if (type == 1) {
#pragma unroll
                    for (int c = 0; c < 32; ++c) dd[c] = *(const f32x2*)(gd + c * 64);
                } else {
#pragma unroll
                    for (int c = 0; c < 32; ++c) dd[c] = (f32x2){dret, dret};
                }
                f32x2 s = (f32x2){0.f, 0.f};
#pragma unroll
                for (int c = 0; c < 32; ++c) { *(unsigned*)(base + (size_t)c * 4096) = pk2(s[0], s[1]); s = dd[c] * s + (f32x2){bflo(kvr[c]), bfhi(kvr[c])}; }
                float* so = outp + (type == 0 ? O_RETP : O_GLAP) + (size_t)((l * 8 + b) * 4 + h) * 4096;
                so[dk * 64 + dv] = s[0]; so[(dk + 1) * 64 + dv] = s[1];
            }
        }
        xcd_barrier(xbar);
        for (int rep = 0; rep < 1 + PROBE_M3X2; ++rep)
        for (int u = bx; u < 256; u += G) { MAKE_CTX(); mix_out<false>(C, wv >> 2, u & 7, u >> 3, wv & 3, wl); }
        xcd_barrier(xbar);
        {
            LANE_TID();
            unsigned char* ws = ws_ptr(); float* XR = out_ptr() + O_Y;
            const float* x_prompt = in_ptr(0); const float* x_sample = in_ptr(1);
            pg8::Gemm g{(const bf16_t*)(ws + WS_B), (const bf16_t*)(ws + WS_WOUT) + (size_t)l * DM * DM, MP, DM, DM}; pg8::StaticOrder S; S.init(MP, DM, Gq, bxq);
            pg8::EpiRes E{l == 0 ? x_prompt : XR, l == 0 ? (long long)((const char*)x_sample - (const char*)x_prompt) : (long long)MP * DM * 4, XR, (bf16_t*)(ws + WS_C), (float*)(ws + WS_SS) + (size_t)(2 * l + 1) * MT};
            pg8::gemm_phase<pg8::EpiRes, pg8::StaticOrder, true, true>(lds, g, S, E, tid);
            {
                SArgs a{}; a.A = (const bf16_t*)(ws + WS_B) + (size_t)MP * DM; a.Bt = (const bf16_t*)(ws + WS_WOUT) + (size_t)l * DM * DM; a.K = DM; a.nunits = 4 * 16;
                a.obf = (bf16_t*)(ws + WS_C) + (size_t)MP * DM; a.ldo = DM; a.ss_out = (float*)(ws + WS_SS) + (size_t)(2 * l + 1) * MT + MP;
                a.xold = l == 0 ? x_sample : XR + (size_t)MP * DM; a.xr = XR + (size_t)MP * DM;
                int ub, us; sample_share((MP / 256) * (DM / 256), Gq, bxq, ub, us);
                sample_gemm<SK_RES>(lds, a, ub, us, wave, lane);
                const int nsamp = a.nunits < Gq ? a.nunits : Gq;
                if (Gq == 256 && bxq >= nsamp) {
                    LAS float* scr = (LAS float*)(lds + wave * WAVE_LDS);
                    for (int it = (bxq - nsamp) * 8 + wave; it < 128 * 8; it += (Gq - nsamp) * 8)
                        tr_item128(in_ptr(17) + (size_t)l * DFF * DM, DFF, DM, (bf16_t*)(ws + WS_WDN) + (size_t)l * DM * DFF, it / 8, it % 8, nullptr, scr, lane);
                }
            }
        }
        xcd_barrier(xbar);
        {
            LANE_TID();
            unsigned char* ws = ws_ptr();
            pg8::Gemm g{(const bf16_t*)(ws + WS_C), (const bf16_t*)(ws + WS_WUP) + (size_t)l * DFF * DM, MP, DFF, DM}; pg8::StaticOrder S; S.init(MP, DFF, Gq, bxq);
            pg8::EpiUp E{(bf16_t*)(ws + WS_A), (const float*)(ws + WS_SS) + (size_t)(2 * l + 1) * MT, DFF};
            pg8::gemm_phase<pg8::EpiUp, pg8::StaticOrder, true, true>(lds, g, S, E, tid);
            if (PROBE_UP2) pg8::gemm_phase<pg8::EpiUp, pg8::StaticOrder, true, true>(lds, g, S, E, tid);
            if (PROBE_UP2B) { xcd_barrier(xbar); pg8::gemm_phase<pg8::EpiUp, pg8::StaticOrder, true, true>(lds, g, S, E, tid); }
            {
                SArgs a{}; a.A = (const bf16_t*)(ws + WS_C) + (size_t)MP * DM; a.Bt = (const bf16_t*)(ws + WS_WUP) + (size_t)l * DFF * DM; a.K = DM; a.nunits = 4 * 64;
                a.obf = (bf16_t*)(ws + WS_A) + (size_t)MP * DFF; a.ldo = DFF; a.ss_in = (const float*)(ws + WS_SS) + (size_t)(2 * l + 1) * MT + MP;
                int ub, us; sample_share((MP / 256) * (DFF / 256), Gq, bxq, ub, us);
                sample_gemm<SK_UP>(lds, a, ub, us, wave, lane);
            }
        }
        xcd_barrier(xbar);
        {
            LANE_TID();
            unsigned char* ws = ws_ptr(); float* XR = out_ptr() + O_Y;
            pg8::Gemm g{(const bf16_t*)(ws + WS_A), (const bf16_t*)(ws + WS_WDN) + (size_t)l * DM * DFF, MP, DM, DFF}; pg8::StaticOrder S; S.init(MP, DM, Gq, bxq);
            if (PROBE_DN2) { pg8::EpiUp E2{(bf16_t*)(ws + WS_C), (const float*)(ws + WS_SS) + (size_t)(2 * l + 1) * MT, DM}; pg8::gemm_phase<pg8::EpiUp, pg8::StaticOrder, true, true>(lds, g, S, E2, tid); }
            pg8::EpiRes E{XR, (long long)MP * DM * 4, XR, l == 0 ? (bf16_t*)(ws + WS_B) : (bf16_t*)nullptr, (float*)(ws + WS_SS) + (size_t)(2 * l + 2) * MT};
            pg8::gemm_phase<pg8::EpiRes, pg8::StaticOrder, true, true>(lds, g, S, E, tid);
            {
                SArgs a{}; a.A = (const bf16_t*)(ws + WS_A) + (size_t)MP * DFF; a.Bt = (const bf16_t*)(ws + WS_WDN) + (size_t)l * DM * DFF; a.K = DFF; a.nunits = 4 * 16;
                a.obf = l == 0 ? (bf16_t*)(ws + WS_B) + (size_t)MP * DM : (bf16_t*)nullptr; a.ldo = DM; a.ss_out = (float*)(ws + WS_SS) + (size_t)(2 * l + 2) * MT + MP;
                a.xold = XR + (size_t)MP * DM; a.xr = XR + (size_t)MP * DM;
                int ub, us; sample_share((MP / 256) * (DM / 256), Gq, bxq, ub, us);
                sample_gemm<SK_RES>(lds, a, ub, us, wave, lane);
            }
        }
        xcd_barrier(xbar);
    }
    for (int i = 0; i < PROBE_SYNCS; ++i) xcd_barrier(xbar);
    {
        LANE_TID();
        const int gw = bx * 8 + wave, NGW = G * 8;
        const float* fw = in_ptr(8); const float* SS = (const float*)WSP(WS_SS); float* XR = out_ptr() + O_Y;
        f32x4 w4[4];
#pragma unroll
        for (int j = 0; j < 4; ++j) w4[j] = *((const f32x4*)fw + lane + 64 * j);
        for (int m0 = gw; m0 < MT; m0 += 2 * NGW) {
            f32x4 v[2][4]; float rs[2];
#pragma unroll
            for (int q = 0; q < 2; ++q) {
                const int m = m0 + q * NGW;
                if (m < MT) {
                    rs[q] = SS[(size_t)4 * MT + m];
                    const f32x4* xr = (const f32x4*)(XR + (size_t)m * DM) + lane;
#pragma unroll
                    for (int j = 0; j < 4; ++j) v[q][j] = xr[64 * j];
                }
            }
#pragma unroll
            for (int q = 0; q < 2; ++q) {
                const int m = m0 + q * NGW;
                if (m < MT) {
                    const float r = 1.0f / sqrtf(rs[q] * (1.0f / 1024.0f) + EPS);
                    f32x4* xr = (f32x4*)(XR + (size_t)m * DM) + lane;
#pragma unroll
                    for (int j = 0; j < 4; ++j) xr[64 * j] = v[q][j] * r * w4[j];
                }
            }
        }
    }
}

extern "C" void kernel_launch(void* const* d_in, const int* in_sizes, int n_in, void* d_out, int out_size, void* d_ws, size_t ws_size, hipStream_t stream) {
    static int grid = 0;
    if (grid == 0) {
        if (n_in != 18 || (size_t)out_size != O_END || ws_size < WS_END) { fprintf(stderr, "kernel_launch: unexpected shapes: n_in %d out %d ws %zu (need %zu)\n", n_in, out_size, ws_size, (size_t)WS_END); grid = -1; return; }
        int dev = 0, cus = 0, per_cu = 0;
        hipGetDevice(&dev); hipDeviceGetAttribute(&cus, hipDeviceAttributeMultiprocessorCount, dev);
        if (hipFuncSetAttribute((const void*)hybrid_fwd, hipFuncAttributeMaxDynamicSharedMemorySize, LDS_BYTES) != hipSuccess) { fprintf(stderr, "kernel_launch: hipFuncSetAttribute failed\n"); }
        if (hipOccupancyMaxActiveBlocksPerMultiprocessor(&per_cu, (const void*)hybrid_fwd, 512, LDS_BYTES) != hipSuccess || per_cu < 1) { fprintf(stderr, "kernel_launch: occupancy query says %d\n", per_cu); per_cu = 1; }
        (void)hipGetLastError();
        grid = cus * per_cu;
        if (grid > 256) grid = 256;
    }
    if (grid < 0) return;
    if (hipMemsetAsync((unsigned char*)d_ws + WS_CTL, 0, CTL_BYTES, stream) != hipSuccess) { fprintf(stderr, "kernel_launch: memset of the barrier words failed\n"); return; }
    Params p{};
    for (int i = 0; i < 18; ++i) p.in[i] = (const float*)d_in[i];
    p.out = (float*)d_out; p.ws = (unsigned char*)d_ws;
    void* args[] = {&p};
    hipError_t e = hipLaunchCooperativeKernel((const void*)hybrid_fwd, dim3(grid), dim3(512), args, LDS_BYTES, stream);
    if (e != hipSuccess) fprintf(stderr, "kernel_launch: cooperative launch failed: %s (grid %d)\n", hipGetErrorString(e), grid);
}
```

```cpp
#include <hip/hip_runtime.h>
#include <hip/hip_cooperative_groups.h>
#include <cstdio>
#include <cstdint>
namespace cg = cooperative_groups;
#ifndef PROBE_UP2
#define PROBE_UP2 0
#endif
#ifndef PROBE_M1X2
#define PROBE_M1X2 0
#endif
#ifndef PROBE_P0X2
#define PROBE_P0X2 0
#endif
#ifndef PROBE_SYNCS
#define PROBE_SYNCS 0
#endif
#ifndef PROBE_IN2
#define PROBE_IN2 0
#endif
#ifndef PROBE_DN2
#define PROBE_DN2 0
#endif
#ifndef PROBE_UP2B
#define PROBE_UP2B 0
#endif
#ifndef PROBE_KVX2
#define PROBE_KVX2 0
#endif
#ifndef PROBE_ATX2
#define PROBE_ATX2 0
#endif
#ifndef PROBE_M3X2
#define PROBE_M3X2 0
#endif
namespace pg8 {
#define PG8_LAS __attribute__((address_space(3)))
typedef unsigned short bf16_t;
typedef short bf16x8 __attribute__((ext_vector_type(8)));
typedef float f32x4 __attribute__((ext_vector_type(4)));
typedef unsigned u32x4 __attribute__((ext_vector_type(4)));
constexpr int BM = 256, BK = 64, HALF = 128, HTB = HALF * BK * 2  , STAGE_BYTES = 8 * HTB, NXCD = 8, WGM = 8;

__host__ __device__ __forceinline__ int lds_byte(int r, int c) { const int st = (r >> 4) * 2 + (c >> 5), rr = r & 15, cc = c & 31, ob = rr * 64 + cc * 2; return st * 1024 + (ob ^ (((ob >> 9) & 1) << 5)); }
__host__ __device__ __forceinline__ void stage_rc(int b, int& R, int& C) { const int st = b / 1024, sb = b % 1024, swz = sb ^ (((sb >> 9) & 1) << 5); R = (st >> 1) * 16 + swz / 64; C = (st & 1) * 32 + (swz % 64) / 2; }
__host__ __device__ __forceinline__ int perm32(int rho) { const int n = rho >> 4, i = rho & 15; return 8 * (i >> 2) + 4 * n + (i & 3); }

struct Unit { int pm, pn; };
struct Gemm { const bf16_t* A; const bf16_t* Bt; int M, N, K; };

struct StaticOrder {
    int nM, nN, nwg, G, c;
    __host__ __device__ __forceinline__ void init(int M, int N, int G_, int c_) { nM = M / BM; nN = N / BM; nwg = nM * nN; G = G_; c = c_; }
    __host__ __device__ __forceinline__ bool next(int i, Unit& u) const {
        const long L = (long)i * G + c; if (L >= nwg) return false;
        int wgid = (int)L; { const int q = nwg / NXCD, r = nwg % NXCD, xcd = wgid % NXCD, off = wgid / NXCD; wgid = (xcd < r ? xcd * (q + 1) : r * (q + 1) + (xcd - r) * q) + off; }
        const int nig = WGM * nN, gid = wgid / nig, fm = gid * WGM, gsz = (nM - fm) < WGM ? (nM - fm) : WGM;
        u.pm = fm + ((wgid % nig) % gsz); u.pn = (wgid % nig) / gsz; return true;
    }
    __device__ __forceinline__ void a_ready(const Unit&) const {}
    __device__ __forceinline__ void done(const Unit&) const {}
};

__device__ __forceinline__ unsigned cvt_pk_bf16(float lo, float hi) { unsigned r; asm volatile("v_cvt_pk_bf16_f32 %0, %1, %2" : "=v"(r) : "v"(lo), "v"(hi)); return r; }
typedef float f32x2 __attribute__((ext_vector_type(2)));

typedef unsigned u32x2 __attribute__((ext_vector_type(2)));
constexpr int E_MP = 16384;
struct EpiIn {
    static constexpr bool PERM = true, AFTER_DRAIN = false;
    bf16_t* proj; float* lowf; const float* ss; float* out; long long okp, ovp, oks, ovs;
    __device__ __forceinline__ void operator()(const f32x4 (&acc)[2][2][4][2], const Unit& u, int wr, int wc, int fr, int fq) const {
        const int row0 = u.pm * BM + wr * 64 + fr, col0 = u.pn * BM + wc * 32 + 8 * fq;
        float* kv = nullptr; int rsub = 0, cbase = 0;
        if (u.pn >= 10 && u.pn < 14) {
            const bool isk = u.pn < 12; cbase = isk ? 2560 : 3072;
            if (u.pm >= 64) { kv = out + (isk ? oks : ovs); rsub = E_MP; }
            else if ((u.pm & 7) >= 6) { kv = out + (isk ? okp : ovp); rsub = 1536 * ((u.pm >> 3) + 1); }
        }
        const bool lowt = (u.pn == 14) && (wc == 0) && (fq < 2);
#pragma unroll
        for (int ai = 0; ai < 2; ++ai)
#pragma unroll
            for (int m = 0; m < 4; ++m) {
                const int r = row0 + ai * HALF + m * 16;
                const float rs = 1.0f / sqrtf(ss[r] * (1.0f / 1024.0f) + 1e-6f);
                bf16_t* rowp = proj + (size_t)r * 3840 + col0;
#pragma unroll
                for (int bj = 0; bj < 2; ++bj) {
                    const f32x4 v0 = acc[ai][bj][m][0] * rs, v1 = acc[ai][bj][m][1] * rs;
                    u32x4 w; w.x = cvt_pk_bf16(v0[0], v0[1]); w.y = cvt_pk_bf16(v0[2], v0[3]); w.z = cvt_pk_bf16(v1[0], v1[1]); w.w = cvt_pk_bf16(v1[2], v1[3]);
                    *(u32x4*)(rowp + bj * HALF) = w;
                    if (kv) { float* d = kv + (size_t)(r - rsub) * 512 + (col0 + bj * HALF - cbase); *(f32x4*)d = v0; *(f32x4*)(d + 4) = v1; }
                    if (lowt && bj == 0) { float* d = lowf + (size_t)r * 16 + 8 * fq; *(f32x4*)d = v0; *(f32x4*)(d + 4) = v1; }
                }
            }
    }
};
struct EpiRes {
    static constexpr bool PERM = true, AFTER_DRAIN = false;
    const bf16_t* xold; float* xr; bf16_t* xb; float* ss;
    __device__ __forceinline__ void operator()(const f32x4 (&acc)[2][2][4][2], const Unit& u, int wr, int wc, int fr, int fq) const {
        const int row0 = u.pm * BM + wr * 64 + fr, col0 = u.pn * BM + wc * 32 + 8 * fq;
#pragma unroll
        for (int ai = 0; ai < 2; ++ai)
#pragma unroll
            for (int m = 0; m < 4; ++m) {
                const int r = row0 + ai * HALF + m * 16;
                const bf16_t* xo = xold + (size_t)r * 1024 + col0;
                float sq = 0.f;
#pragma unroll
                for (int bj = 0; bj < 2; ++bj) {
                    const u32x4 xw = *(const u32x4*)(xo + bj * HALF);
                    f32x4 v0, v1;
                    v0[0] = __uint_as_float(xw.x << 16); v0[1] = __uint_as_float(xw.x & 0xffff0000u); v0[2] = __uint_as_float(xw.y << 16); v0[3] = __uint_as_float(xw.y & 0xffff0000u);
                    v1[0] = __uint_as_float(xw.z << 16); v1[1] = __uint_as_float(xw.z & 0xffff0000u); v1[2] = __uint_as_float(xw.w << 16); v1[3] = __uint_as_float(xw.w & 0xffff0000u);
                    v0 = v0 + acc[ai][bj][m][0]; v1 = v1 + acc[ai][bj][m][1];
                    if (xr) { float* xn = xr + (size_t)r * 1024 + col0 + bj * HALF; *(f32x4*)xn = v0; *(f32x4*)(xn + 4) = v1; }
                    sq += (v0[0] * v0[0] + v0[1] * v0[1]) + (v0[2] * v0[2] + v0[3] * v0[3]) + (v1[0] * v1[0] + v1[1] * v1[1]) + (v1[2] * v1[2] + v1[3] * v1[3]);
                    if (xb) { u32x4 w; w.x = cvt_pk_bf16(v0[0], v0[1]); w.y = cvt_pk_bf16(v0[2], v0[3]); w.z = cvt_pk_bf16(v1[0], v1[1]); w.w = cvt_pk_bf16(v1[2], v1[3]);
                        *(u32x4*)(xb + (size_t)r * 1024 + col0 + bj * HALF) = w; }
                }
                sq += __shfl_xor(sq, 16); sq += __shfl_xor(sq, 32);
                if (fq == 0) atomicAdd(ss + r, sq);
            }
    }
};
struct EpiUp {
    static constexpr bool PERM = true, AFTER_DRAIN = false;
    bf16_t* U; const float* ss; int ldu;
    __device__ __forceinline__ void operator()(const f32x4 (&acc)[2][2][4][2], const Unit& u, int wr, int wc, int fr, int fq) const {
        const int row0 = u.pm * BM + wr * 64 + fr, col0 = u.pn * BM + wc * 32 + 8 * fq;
#pragma unroll
        for (int ai = 0; ai < 2; ++ai)
#pragma unroll
            for (int m = 0; m < 4; ++m) {
                const int r = row0 + ai * HALF + m * 16;
                const float rs = 1.0f / sqrtf(ss[r] * (1.0f / 1024.0f) + 1e-6f);
                bf16_t* rowp = U + (size_t)r * ldu + col0;
#pragma unroll
                for (int bj = 0; bj < 2; ++bj) {
                    f32x4 v0 = acc[ai][bj][m][0] * rs, v1 = acc[ai][bj][m][1] * rs;
#pragma unroll
                    for (int e = 0; e < 4; ++e) { const float a = fmaxf(v0[e], 0.f), b = fmaxf(v1[e], 0.f); v0[e] = a * a; v1[e] = b * b; }
                    u32x4 w; w.x = cvt_pk_bf16(v0[0], v0[1]); w.y = cvt_pk_bf16(v0[2], v0[3]); w.z = cvt_pk_bf16(v1[0], v1[1]); w.w = cvt_pk_bf16(v1[2], v1[3]);
                    *(u32x4*)(rowp + bj * HALF) = w;
                }
            }
    }
};

template <class Epi, class Sched, bool ALIGN_EPI = false, bool SP2 = false>
__device__ __forceinline__ void gemm_phase(PG8_LAS unsigned char* lds, const Gemm g, const Sched& S, const Epi& E, const int tid_in) {
    int tid_ = tid_in; asm volatile("" : "+v"(tid_));
    const int tid = tid_, wid = __builtin_amdgcn_readfirstlane(tid >> 6), lane = tid & 63, wr = wid >> 2, wc = wid & 3, fr = lane & 15, fq = lane >> 4;
    const int K = g.K, nt = K / BK;
    unsigned voffA[2], voffB[2];
#pragma unroll
    for (int i = 0; i < 2; ++i) { int R, C; stage_rc(tid * 16 + i * 8192, R, C); const int Rb = Epi::PERM ? ((R & ~31) + perm32(R & 31)) : R;
        voffA[i] = (unsigned)(R * K + C) * 2u; voffB[i] = (unsigned)(Rb * K + C) * 2u; }
    const size_t kstep = (size_t)(BK * 2);
    const size_t hstep = (size_t)HALF * K * 2;
    const size_t tstep = 2 * hstep;
    const unsigned ldsw = (unsigned)wid * 1024u;
    const int aoff = lds_byte(wr * 64 + fr, fq * 8), boff = lds_byte(wc * 32 + fr, fq * 8);
#define PG8_SA(b, h) (((b) * 2 + (h)) * HTB)
#define PG8_SB(b, h) ((4 + (b) * 2 + (h)) * HTB)
#define PG8_STAGE(bufoff, gbase, voff) do { _Pragma("unroll") for (int _i = 0; _i < 2; ++_i) \
        __builtin_amdgcn_global_load_lds((const unsigned*)((const char*)(gbase) + (voff)[_i]), (PG8_LAS unsigned*)(lds + (bufoff) + ldsw + _i * 8192), 16, 0, 0); } while (0)
#define PG8_LDA(dst, b, h) do { _Pragma("unroll") for (int m = 0; m < 4; ++m) _Pragma("unroll") for (int k = 0; k < 2; ++k) dst[m][k] = *(const PG8_LAS bf16x8*)(lds + PG8_SA(b, h) + aoff + m * 2048 + k * 1024); } while (0)
#define PG8_LDB(dst, b, h) do { _Pragma("unroll") for (int n = 0; n < 2; ++n) _Pragma("unroll") for (int k = 0; k < 2; ++k) dst[n][k] = *(const PG8_LAS bf16x8*)(lds + PG8_SB(b, h) + boff + n * 2048 + k * 1024); } while (0)
#define PG8_MMA(ai, bj, At, Bt) do { __builtin_amdgcn_s_setprio(1); _Pragma("unroll") for (int m = 0; m < 4; ++m) _Pragma("unroll") for (int n = 0; n < 2; ++n) _Pragma("unroll") for (int k = 0; k < 2; ++k) \
        acc[ai][bj][m][n] = __builtin_amdgcn_mfma_f32_16x16x32_bf16(Bt[n][k], At[m][k], acc[ai][bj][m][n], 0, 0, 0); __builtin_amdgcn_s_setprio(0); } while (0)
#define PG8_WAIT_V(n) asm volatile("s_waitcnt vmcnt(" #n ")" ::: "memory")
#define PG8_WAIT_L(n) asm volatile("s_waitcnt lgkmcnt(" #n ")" ::: "memory")
#define PG8_BAR __builtin_amdgcn_s_barrier()
#define PG8_SCHED __builtin_amdgcn_sched_barrier(0)
    Unit cur, nxt; int ui = 0;
    if (!S.next(0, cur)) return;
    f32x4 acc[2][2][4][2];
#pragma unroll
    for (int a = 0; a < 2; ++a)
#pragma unroll
        for (int b = 0; b < 2; ++b)
#pragma unroll
            for (int m = 0; m < 4; ++m)
#pragma unroll
                for (int n = 0; n < 2; ++n) acc[a][b][m][n] = (f32x4){0.f, 0.f, 0.f, 0.f};
    bf16x8 At[4][2], B0[2][2], B1[2][2];
    const char* cA = (const char*)g.A + (size_t)cur.pm * tstep; const char* cB = (const char*)g.Bt + (size_t)cur.pn * tstep;
    S.a_ready(cur);
    if constexpr (SP2) {
        PG8_STAGE(PG8_SB(0, 0), cB, voffB); PG8_STAGE(PG8_SB(0, 1), cB + hstep, voffB); PG8_STAGE(PG8_SA(0, 0), cA, voffA); PG8_STAGE(PG8_SA(0, 1), cA + hstep, voffA);
        if (wr == 1) PG8_BAR;
        PG8_WAIT_V(2); PG8_BAR;
        PG8_STAGE(PG8_SB(1, 0), cB + kstep, voffB); PG8_STAGE(PG8_SA(1, 0), cA + kstep, voffA); PG8_STAGE(PG8_SB(1, 1), cB + hstep + kstep, voffB);
        PG8_WAIT_V(6); PG8_BAR;
    } else {
        PG8_STAGE(PG8_SB(0, 0), cB, voffB); PG8_STAGE(PG8_SA(0, 0), cA, voffA); PG8_STAGE(PG8_SB(0, 1), cB + hstep, voffB); PG8_STAGE(PG8_SA(0, 1), cA + hstep, voffA);
        if (wr == 1) PG8_BAR;
        PG8_WAIT_V(4); PG8_BAR;
        PG8_STAGE(PG8_SB(1, 0), cB + kstep, voffB); PG8_STAGE(PG8_SA(1, 0), cA + kstep, voffA); PG8_STAGE(PG8_SB(1, 1), cB + hstep + kstep, voffB);
        PG8_WAIT_V(6); PG8_BAR;
    }
    for (;;) {
        const bool has_next = S.next(ui + 1, nxt);
        const char* nA = has_next ? (const char*)g.A + (size_t)nxt.pm * tstep : cA; const char* nB = has_next ? (const char*)g.Bt + (size_t)nxt.pn * tstep : cB;
        for (int t = 0; t < nt; t += 2) {
            const bool last = (t == nt - 2);
            const char* a1 = cA + (size_t)(t + 1) * kstep;
            const char* a2 = last ? nA : cA + (size_t)(t + 2) * kstep; const char* b2 = last ? nB : cB + (size_t)(t + 2) * kstep;
            const char* a3 = a2 + kstep; const char* b3 = b2 + kstep;
            if (last && has_next) S.a_ready(nxt);
            if constexpr (SP2) {
            PG8_LDB(B0, 0, 0); PG8_LDB(B1, 0, 1); PG8_SCHED; PG8_LDA(At, 0, 0); PG8_STAGE(PG8_SA(1, 1), a1 + hstep, voffA);
            PG8_WAIT_V(8); PG8_WAIT_L(0); PG8_BAR; PG8_MMA(0, 0, At, B0); PG8_MMA(0, 1, At, B1); PG8_BAR; PG8_SCHED;
            PG8_LDA(At, 0, 1); PG8_STAGE(PG8_SB(0, 0), b2, voffB); PG8_STAGE(PG8_SB(0, 1), b2 + hstep, voffB); PG8_STAGE(PG8_SA(0, 0), a2, voffA);
            PG8_WAIT_V(8); PG8_WAIT_L(0); PG8_BAR; PG8_MMA(1, 0, At, B0); PG8_MMA(1, 1, At, B1); PG8_BAR; PG8_SCHED;
            PG8_LDB(B0, 1, 0); PG8_LDB(B1, 1, 1); PG8_SCHED; PG8_LDA(At, 1, 0); PG8_STAGE(PG8_SA(0, 1), a2 + hstep, voffA);
            PG8_WAIT_V(8); PG8_WAIT_L(0); PG8_BAR; PG8_MMA(0, 0, At, B0); PG8_MMA(0, 1, At, B1); PG8_BAR; PG8_SCHED;
            PG8_LDA(At, 1, 1); PG8_STAGE(PG8_SB(1, 0), b3, voffB); PG8_STAGE(PG8_SB(1, 1), b3 + hstep, voffB); PG8_STAGE(PG8_SA(1, 0), a3, voffA);
            PG8_WAIT_V(8); PG8_WAIT_L(0); PG8_BAR; PG8_MMA(1, 0, At, B0); PG8_MMA(1, 1, At, B1); PG8_BAR; PG8_SCHED;
            } else {
            PG8_LDB(B0, 0, 0); PG8_SCHED; PG8_LDA(At, 0, 0); PG8_STAGE(PG8_SA(1, 1), a1 + hstep, voffA);
            PG8_WAIT_L(8); PG8_BAR; PG8_WAIT_L(0); PG8_MMA(0, 0, At, B0); PG8_BAR; PG8_SCHED;
            PG8_LDB(B1, 0, 1); PG8_STAGE(PG8_SB(0, 0), b2, voffB);
            PG8_BAR; PG8_WAIT_L(0); PG8_MMA(0, 1, At, B1); PG8_BAR;
            PG8_LDA(At, 0, 1); PG8_STAGE(PG8_SA(0, 0), a2, voffA);
            PG8_BAR; PG8_WAIT_L(0); PG8_MMA(1, 0, At, B0); PG8_BAR; PG8_SCHED;
            PG8_STAGE(PG8_SB(0, 1), b2 + hstep, voffB);
            PG8_WAIT_V(6); PG8_BAR; PG8_MMA(1, 1, At, B1); PG8_BAR;
            PG8_LDB(B0, 1, 0); PG8_SCHED; PG8_LDA(At, 1, 0); PG8_STAGE(PG8_SA(0, 1), a2 + hstep, voffA);
            PG8_WAIT_L(8); PG8_BAR; PG8_WAIT_L(0); PG8_MMA(0, 0, At, B0); PG8_BAR; PG8_SCHED;
            PG8_LDB(B1, 1, 1); PG8_STAGE(PG8_SB(1, 0), b3, voffB);
            PG8_BAR; PG8_WAIT_L(0); PG8_MMA(0, 1, At, B1); PG8_BAR;
            PG8_LDA(At, 1, 1); PG8_STAGE(PG8_SA(1, 0), a3, voffA);
            PG8_BAR; PG8_WAIT_L(0); PG8_MMA(1, 0, At, B0); PG8_BAR; PG8_SCHED;
            PG8_STAGE(PG8_SB(1, 1), b3 + hstep, voffB);
            PG8_WAIT_V(6); PG8_BAR; PG8_MMA(1, 1, At, B1); PG8_BAR;
            }
        }
        if constexpr (ALIGN_EPI) { if (wr == 0) PG8_BAR; }
        if constexpr (!Epi::AFTER_DRAIN) { E(acc, cur, wr, wc, fr, fq); S.done(cur); }
        if (!has_next) break;
#pragma unroll
        for (int a = 0; a < 2; ++a)
#pragma unroll
            for (int b = 0; b < 2; ++b)
#pragma unroll
                for (int m = 0; m < 4; ++m)
#pragma unroll
                    for (int n = 0; n < 2; ++n) acc[a][b][m][n] = (f32x4){0.f, 0.f, 0.f, 0.f};
        cur = nxt; cA = nA; cB = nB; ++ui;
        if constexpr (ALIGN_EPI) { if (wr == 1) PG8_BAR; }
    }
    PG8_WAIT_V(0);
    if constexpr (!ALIGN_EPI) { if (wr == 0) PG8_BAR; }
    PG8_BAR;
    if constexpr (Epi::AFTER_DRAIN) { E.fused(acc, cur, wr, wc, fr, fq, lds, wid, lane); S.done(cur); }
#undef PG8_SA
#undef PG8_SB
#undef PG8_STAGE
#undef PG8_LDA
#undef PG8_LDB
#undef PG8_MMA
#undef PG8_WAIT_V
#undef PG8_WAIT_L
#undef PG8_BAR
#undef PG8_SCHED
}
}


#define LAS __attribute__((address_space(3)))
typedef unsigned short bf16_t;
typedef short bf16x8 __attribute__((ext_vector_type(8)));
typedef short s16x4 __attribute__((ext_vector_type(4)));
typedef short v4i16_t __attribute__((ext_vector_type(4)));
typedef float f32x4 __attribute__((ext_vector_type(4)));
typedef float f32x2 __attribute__((ext_vector_type(2)));
typedef float f32x16 __attribute__((ext_vector_type(16)));
typedef unsigned u32x4 __attribute__((ext_vector_type(4)));
typedef unsigned u32x2 __attribute__((ext_vector_type(2)));

constexpr int DM = 1024, NB = 8, SEQ = 2048, MP = NB * SEQ, SL = 32, MS = NB * SL, MT = MP + MS;
constexpr int PS = 3840, DFF = 4096, INCOLS = 3600;
constexpr int C_QA = 0, C_KA = 256, C_VA = 512, C_GA = 768, C_QB = 1024, C_KB = 1280, C_VB = 1536, C_GB = 1792, C_QC = 2048, C_KC = 2560, C_VC = 3072, C_LOW = 3584;
constexpr int NREL = 320;
constexpr float EPS = 1e-6f;
constexpr size_t WS_A = 0;
constexpr size_t WS_B = WS_A + (size_t)MT * DFF * 2;
constexpr size_t WS_C = WS_B + (size_t)MT * DM * 2;
constexpr size_t WS_WIN = WS_C + (size_t)MT * DM * 2;
constexpr size_t WS_WOUT = WS_WIN + (size_t)2 * PS * DM * 2;
constexpr size_t WS_WUP = WS_WOUT + (size_t)2 * DM * DM * 2;
constexpr size_t WS_WDN = WS_WUP + (size_t)2 * DFF * DM * 2;
constexpr size_t WS_LOWF = WS_WDN + (size_t)2 * DFF * DM * 2;
constexpr size_t WS_SS = WS_LOWF + (size_t)MT * 16 * 4;
constexpr size_t WS_G = WS_SS + (size_t)5 * MT * 4;
constexpr size_t WS_ROPE = WS_G + (size_t)1024 * 64 * 4;
constexpr size_t WS_CTL = WS_ROPE + (size_t)2080 * 64 * 4;
constexpr size_t CTL_BYTES = 16384;
constexpr size_t WS_END = WS_CTL + CTL_BYTES;
static_assert((size_t)2048 * 4096 * 4 <= (size_t)MT * DM * 2, "KVT fits region C");
constexpr size_t WS_CKB = WS_A + (size_t)MT * PS * 2;
constexpr size_t CACHE_ELEMS = (size_t)8 * 512 * 512;
static_assert(WS_CKB + 2 * CACHE_ELEMS * 2 <= WS_B, "cache copies fit behind PROJ");
static_assert(WS_END <= (size_t)256 * 1024 * 1024, "d_ws map");
constexpr size_t O_Y = 0, O_RETP = (size_t)MT * DM, O_GLAP = O_RETP + 262144, O_KP = O_GLAP + 262144, O_VP = O_KP + 4194304, O_RETS = O_VP + 4194304, O_GLAS = O_RETS + 262144,
                 O_KS = O_GLAS + 262144, O_VS = O_KS + 262144, O_END = O_VS + 262144;
constexpr int TS = 144;
constexpr int TILE_B = 64 * TS;
constexpr int WAVE_LDS = 2 * TILE_B;
constexpr int LDS_BIAS = 8 * WAVE_LDS;
constexpr int NREV = 384;
constexpr int LDS_BARST = LDS_BIAS + 8 * NREV * 4;
constexpr int LDS_BYTES = LDS_BARST + 16;
static_assert(LDS_BYTES <= 160 * 1024 && pg8::STAGE_BYTES <= LDS_BIAS, "LDS map");

struct Params { const float* in[18]; float* out; unsigned char* ws; };
__device__ __forceinline__ int lane_id_asm() { int l; asm volatile("v_mbcnt_lo_u32_b32 %0, -1, 0\n\tv_mbcnt_hi_u32_b32 %0, -1, %0" : "=v"(l)); return l; }
typedef const __attribute__((address_space(4))) char* kaptr_t;
__device__ __forceinline__ kaptr_t karg_base() { kaptr_t ka = (kaptr_t)__builtin_amdgcn_kernarg_segment_ptr(); asm volatile("" : "+s"(ka)); return ka; }
__device__ __forceinline__ const float* in_ptr(int i) { return *(const float* const __attribute__((address_space(4)))*)(karg_base() + 8 * i); }
__device__ __forceinline__ float* out_ptr() { return *(float* const __attribute__((address_space(4)))*)(karg_base() + 8 * 18); }
__device__ __forceinline__ unsigned char* ws_ptr() { return *(unsigned char* const __attribute__((address_space(4)))*)(karg_base() + 8 * 19); }

typedef float f32x2_t __attribute__((ext_vector_type(2))); typedef __bf16 bf16x2_t __attribute__((ext_vector_type(2)));
__device__ __forceinline__ unsigned pk2(float lo, float hi) { const f32x2_t v = {lo, hi}; const bf16x2_t b = __builtin_convertvector(v, bf16x2_t); return __builtin_bit_cast(unsigned, b); }
__device__ __forceinline__ float bflo(unsigned u) { return __uint_as_float(u << 16); }
__device__ __forceinline__ float bfhi(unsigned u) { return __uint_as_float(u & 0xffff0000u); }
__device__ __forceinline__ float bf2f(bf16_t h) { return __uint_as_float((unsigned)h << 16); }
__device__ __forceinline__ bf16_t f2bf(float f) { return (bf16_t)(pk2(f, 0.f) & 0xffffu); }
__device__ __forceinline__ int crow(int r, int hi) { return (r & 3) + 8 * (r >> 2) + 4 * hi; }
__device__ __forceinline__ float silu(float x) { return x / (1.0f + __expf(-x)); }
__device__ __forceinline__ f32x16 mfma32(bf16x8 a, bf16x8 b, f32x16 c) { return __builtin_amdgcn_mfma_f32_32x32x16_bf16(a, b, c, 0, 0, 0); }
__device__ __forceinline__ bf16x8 as_bf16x8(u32x4 v) { return __builtin_bit_cast(bf16x8, v); }
__device__ __forceinline__ f32x16 zero16() { f32x16 z;
#pragma unroll
    for (int i = 0; i < 16; ++i) z[i] = 0.f; return z; }
__device__ __forceinline__ s16x4 ds_tr(LAS const unsigned char* p) { return __builtin_bit_cast(s16x4, __builtin_amdgcn_ds_read_tr16_b64_v4i16((LAS v4i16_t*)p)); }
__device__ __forceinline__ bf16x8 tr_nat(LAS const unsigned char* tile, int k0, int cb, int lane) {
    const int kq = lane >> 5, g = (lane >> 4) & 1, q = (lane & 15) >> 2, p = lane & 3;
    LAS const unsigned char* a = tile + (k0 + 8 * kq + q) * TS + (cb + 16 * g + 4 * p) * 2;
    const s16x4 lo = ds_tr(a), hi = ds_tr(a + 4 * TS);
    return (bf16x8){lo[0], lo[1], lo[2], lo[3], hi[0], hi[1], hi[2], hi[3]};
}
template <int STR = TS> __device__ __forceinline__ bf16x8 tr_perm(LAS const unsigned char* tile, int k0, int cb, int lane) {
    const int kq = lane >> 5, g = (lane >> 4) & 1, q = (lane & 15) >> 2, p = lane & 3;
    LAS const unsigned char* a = tile + (k0 + 4 * kq + q) * STR + (cb + 16 * g + 4 * p) * 2;
    const s16x4 lo = ds_tr(a), hi = ds_tr(a + 8 * STR);
    return (bf16x8){lo[0], lo[1], lo[2], lo[3], hi[0], hi[1], hi[2], hi[3]};
}
__device__ __forceinline__ bf16x8 tr_perm_swz(LAS const unsigned char* tile, int k0, int cb, int lane) {
    const int kq = lane >> 5, g = (lane >> 4) & 1, q = (lane & 15) >> 2, p = lane & 3;
    const int row = k0 + 4 * kq + q, ob = ((cb + 16 * g + 4 * p) * 2) ^ ((row & 2) << 5);
    LAS const unsigned char* a = tile + row * 128 + ob;
    const s16x4 lo = ds_tr(a), hi = ds_tr(a + 8 * 128);
    return (bf16x8){lo[0], lo[1], lo[2], lo[3], hi[0], hi[1], hi[2], hi[3]};
}
__device__ __forceinline__ bf16x8 row_frag(LAS const unsigned char* tile, int r0, int ks, int lane) {
    return *(LAS const bf16x8*)(tile + (r0 + (lane & 31)) * TS + (16 * ks + 8 * (lane >> 5)) * 2);
}
__device__ __forceinline__ bf16x8 pack_step(const f32x16& x, int s) {
    u32x4 w; w.x = pk2(x[8 * s + 0], x[8 * s + 1]); w.y = pk2(x[8 * s + 2], x[8 * s + 3]); w.z = pk2(x[8 * s + 4], x[8 * s + 5]); w.w = pk2(x[8 * s + 6], x[8 * s + 7]);
    return as_bf16x8(w);
}
__device__ __forceinline__ void load_tile(LAS unsigned char* tile, const bf16_t* src, int pitch, int nvalid, int lane) {
#pragma unroll
    for (int it = 0; it < 8; ++it) {
        const int id = it * 64 + lane, row = id >> 3, ch = id & 7;
        u32x4 v = (u32x4){0u, 0u, 0u, 0u};
        if (row < nvalid) v = *(const u32x4*)(src + (size_t)row * pitch + ch * 8);
        *(LAS u32x4*)(tile + row * TS + ch * 16) = v;
    }
}
__device__ __forceinline__ void store_tile(LAS const unsigned char* tile, bf16_t* dst, int pitch, int nvalid, int lane) {
#pragma unroll
    for (int it = 0; it < 8; ++it) {
        const int id = it * 64 + lane, row = id >> 3, ch = id & 7;
        const u32x4 v = *(LAS const u32x4*)(tile + row * TS + ch * 16);
        if (row < nvalid) *(u32x4*)(dst + (size_t)row * pitch + ch * 8) = v;
    }
}
__device__ __forceinline__ void load_tile_f32(LAS unsigned char* tile, const float* src, int pitch, int lane) {
#pragma unroll
    for (int it = 0; it < 16; ++it) {
        const int id = it * 64 + lane, row = id >> 4, c4 = id & 15;
        const f32x4 v = *(const f32x4*)(src + (size_t)row * pitch + c4 * 4);
        u32x2 w; w.x = pk2(v[0], v[1]); w.y = pk2(v[2], v[3]);
        *(LAS u32x2*)(tile + row * TS + c4 * 8) = w;
    }
}
__device__ __forceinline__ void load_rot(const bf16_t* rp, const float* cs, int kq, float scale, bool valid, bf16x8 (&fr)[4]) {
    u32x4 c[4];
#pragma unroll
    for (int ks = 0; ks < 4; ++ks) c[ks] = valid ? *(const u32x4*)(rp + 16 * ks + 8 * kq) : (u32x4){0u, 0u, 0u, 0u};
#pragma unroll
    for (int g = 0; g < 2; ++g) {
        const float* cp = cs + 16 * g + 8 * kq;
        const f32x4 ca = *(const f32x4*)cp, cb = *(const f32x4*)(cp + 4), sa = *(const f32x4*)(cp + 32), sb = *(const f32x4*)(cp + 36);
        float o1[8], o2[8];
#pragma unroll
        for (int e = 0; e < 8; ++e) {
            const unsigned w1 = c[g][e >> 1], w2 = c[g + 2][e >> 1];
            const float x1 = (e & 1) ? bfhi(w1) : bflo(w1), x2 = (e & 1) ? bfhi(w2) : bflo(w2);
            const float cc = (e < 4) ? ca[e & 3] : cb[e & 3], sn = (e < 4) ? sa[e & 3] : sb[e & 3];
            o1[e] = (x1 * cc - x2 * sn) * scale; o2[e] = (x1 * sn + x2 * cc) * scale;
        }
        u32x4 a, b;
        a.x = pk2(o1[0], o1[1]); a.y = pk2(o1[2], o1[3]); a.z = pk2(o1[4], o1[5]); a.w = pk2(o1[6], o1[7]);
        b.x = pk2(o2[0], o2[1]); b.y = pk2(o2[2], o2[3]); b.z = pk2(o2[4], o2[5]); b.w = pk2(o2[6], o2[7]);
        fr[g] = as_bf16x8(a); fr[g + 2] = as_bf16x8(b);
    }
}

struct Ctx {
    int l, lane, kq, li;
    const bf16_t* proj; const float* lowf; const float* rope; bf16_t* cat; float* kvt; float* gdec; float* out;
    const float* wa2; const float* ba; const float* nw; const float* st; const bf16_t* ckb; const bf16_t* cvb;
};
__device__ __forceinline__ float ret_lg2(int h) { return __log2f(1.0f - exp2f(-5.0f - (float)h)); }

struct GlaGate {
    f32x4 lw[4]; float w[16]; float bias, run;
    template <int L> __device__ __forceinline__ void init(const Ctx& C, int m0, int h) {
#pragma unroll
        for (int q = 0; q < 4; ++q) lw[q] = (C.lane < L) ? *(const f32x4*)(C.lowf + (size_t)(m0 + C.lane) * 16 + 4 * q) : (f32x4){0.f, 0.f, 0.f, 0.f};
#pragma unroll
        for (int j = 0; j < 16; ++j) w[j] = C.wa2[j * 256 + h * 64 + C.lane];
        bias = C.ba[h * 64 + C.lane]; run = 0.f;
    }
    __device__ __forceinline__ float step(int s) {
        float z0 = bias, z1 = 0.f;
#pragma unroll
        for (int j = 0; j < 16; j += 2) {
            z0 += __int_as_float(__builtin_amdgcn_readlane(__float_as_int(lw[j >> 2][j & 3]), s)) * w[j];
            z1 += __int_as_float(__builtin_amdgcn_readlane(__float_as_int(lw[(j + 1) >> 2][(j + 1) & 3]), s)) * w[j + 1];
        }
        const float z = z0 + z1;
        const float lf = fminf(z, 0.f) - __logf(1.0f + __expf(-fabsf(z)));
        run += lf * (1.0f / 16.0f);
        return run;
    }
};

template <bool SAMPLE> __device__ __forceinline__ void kv_local(const Ctx& C, int type, int b, int n, int h, LAS unsigned char* wl) {
    constexpr int L = SAMPLE ? 32 : 64, NKS = L / 16;
    const int m0 = SAMPLE ? MP + b * SL : b * SEQ + n * 64;
    const int pidx0 = SAMPLE ? 2048 : n * 64;
    LAS unsigned char* tK = wl; LAS unsigned char* tV = wl + TILE_B;
    const int lane = C.lane, kq = C.kq, li = C.li;
    float gdk = 0.f;
    if (type == 0) {
        const float lg = ret_lg2(h);
#pragma unroll
        for (int rb = 0; rb < L / 32; ++rb) {
            const int s = 32 * rb + li;
            bf16x8 fr[4];
            load_rot(C.proj + (size_t)(m0 + s) * PS + C_KA + h * 64, C.rope + (size_t)(pidx0 + s) * 64, kq, 0.125f * __builtin_amdgcn_exp2f(lg * (float)(L - 1 - s)), true, fr);
#pragma unroll
            for (int ks = 0; ks < 4; ++ks) *(LAS bf16x8*)(tK + s * TS + (16 * ks + 8 * kq) * 2) = fr[ks];
        }
        load_tile(tV, C.proj + (size_t)m0 * PS + C_VA + h * 64, PS, L, lane);
    } else {
        load_tile(tK, C.proj + (size_t)m0 * PS + C_KB + h * 64, PS, L, lane);
        GlaGate gg; gg.init<L>(C, m0, h);
        if (!SAMPLE) {
            load_tile(tV, C.proj + (size_t)m0 * PS + C_QB + h * 64, PS, L, lane);
#pragma unroll 4
            for (int s = 0; s < L; ++s) {
                const float e = __expf(gg.step(s));
                LAS bf16_t* kp = (LAS bf16_t*)(tK + s * TS + lane * 2); LAS bf16_t* qp = (LAS bf16_t*)(tV + s * TS + lane * 2);
                *kp = f2bf(bf2f(*kp) / e); *qp = f2bf(bf2f(*qp) * 0.125f * e);
            }
            asm volatile("s_waitcnt lgkmcnt(0)" ::: "memory");
            store_tile(tV, (bf16_t*)C.proj + (size_t)m0 * PS + C_QB + h * 64, PS, L, lane);
            store_tile(tK, (bf16_t*)C.proj + (size_t)m0 * PS + C_KB + h * 64, PS, L, lane);
            asm volatile("s_waitcnt lgkmcnt(0)" ::: "memory");
            load_tile(tV, C.proj + (size_t)m0 * PS + C_VB + h * 64, PS, L, lane);
        } else {
            load_tile(tV, C.proj + (size_t)m0 * PS + C_VB + h * 64, PS, L, lane);
#pragma unroll 4
            for (int s = 0; s < L; ++s) {
                const float bs = gg.step(s);
                LAS bf16_t* kp = (LAS bf16_t*)(tK + s * TS + lane * 2);
                *kp = f2bf(bf2f(*kp) * __expf(-bs));
            }
        }
        gdk = __expf(gg.run);
    }
    f32x16 kv[2][2];
#pragma unroll
    for (int db = 0; db < 2; ++db)
#pragma unroll
        for (int kb = 0; kb < 2; ++kb) kv[db][kb] = zero16();
#pragma unroll
    for (int ks = 0; ks < NKS; ++ks) {
        bf16x8 a[2], bb[2];
#pragma unroll
        for (int db = 0; db < 2; ++db) a[db] = tr_nat(tV, 16 * ks, 32 * db, lane);
#pragma unroll
        for (int kb = 0; kb < 2; ++kb) bb[kb] = tr_nat(tK, 16 * ks, 32 * kb, lane);
#pragma unroll
        for (int db = 0; db < 2; ++db)
#pragma unroll
            for (int kb = 0; kb < 2; ++kb) kv[db][kb] = mfma32(a[db], bb[kb], kv[db][kb]);
    }
    if (type == 1) {
#pragma unroll
        for (int kb = 0; kb < 2; ++kb) { const float cs = __int_as_float(__builtin_amdgcn_ds_bpermute((32 * kb + li) * 4, __float_as_int(gdk)));
#pragma unroll
            for (int db = 0; db < 2; ++db) kv[db][kb] = kv[db][kb] * cs; }
    }
    if (!SAMPLE) {
        const int uidx = ((type * 8 + b) * 4 + h) * 32 + n;
        bf16_t* dst = (bf16_t*)C.kvt + (size_t)uidx * 4096;
#pragma unroll
        for (int db = 0; db < 2; ++db)
#pragma unroll
            for (int kb = 0; kb < 2; ++kb)
#pragma unroll
                for (int r = 0; r < 16; ++r) dst[(32 * db + crow(r, kq)) * 64 + 32 * kb + li] = f2bf(kv[db][kb][r]);
        if (type == 1) C.gdec[(size_t)(((b * 4 + h) * 32 + n)) * 64 + lane] = gdk;
    } else {
        const float* s0 = C.st + (size_t)((C.l * 8 + b) * 4 + h) * 4096;
        float* so = C.out + (type == 0 ? O_RETS : O_GLAS) + (size_t)((C.l * 8 + b) * 4 + h) * 4096;
        const float dret = exp2f(ret_lg2(h) * (float)L);
#pragma unroll
        for (int kb = 0; kb < 2; ++kb) {
            const int dk = 32 * kb + li;
            const float dec = (type == 0) ? dret : __int_as_float(__builtin_amdgcn_ds_bpermute(dk * 4, __float_as_int(gdk)));
#pragma unroll
            for (int db = 0; db < 2; ++db)
#pragma unroll
                for (int rr = 0; rr < 4; ++rr) {
                    const int dv = 32 * db + 8 * rr + 4 * kq;
                    const f32x4 o = *(const f32x4*)(s0 + dk * 64 + dv);
                    f32x4 nv;
#pragma unroll
                    for (int e = 0; e < 4; ++e) nv[e] = dec * o[e] + kv[db][kb][4 * rr + e];
                    *(f32x4*)(so + dk * 64 + dv) = nv;
                }
        }
    }
}

template <bool SAMPLE> __device__ __forceinline__ void mix_out(const Ctx& C, int type, int b, int n, int h, LAS unsigned char* wl) {
    constexpr int L = SAMPLE ? 32 : 64, NTB = L / 32;
    const int m0 = SAMPLE ? MP + b * SL : b * SEQ + n * 64;
    const int pidx0 = SAMPLE ? 2048 : n * 64;
    LAS unsigned char* t0 = wl; LAS unsigned char* t1 = wl + TILE_B;
    const int lane = C.lane, kq = C.kq, li = C.li;
    bf16x8 qfr[NTB][4];
    const float lg = ret_lg2(h);
    if (type == 0) {
#pragma unroll
        for (int tb = 0; tb < NTB; ++tb) {
            const int s = 32 * tb + li;
            load_rot(C.proj + (size_t)(m0 + s) * PS + C_QA + h * 64, C.rope + (size_t)(pidx0 + s) * 64, kq, __builtin_amdgcn_exp2f(lg * (float)(s + 1)), true, qfr[tb]);
        }
        load_tile(t0, C.proj + (size_t)m0 * PS + C_VA + h * 64, PS, L, lane);
    } else {
        load_tile(t0, C.proj + (size_t)m0 * PS + C_QB + h * 64, PS, L, lane);
        load_tile(t1, C.proj + (size_t)m0 * PS + C_KB + h * 64, PS, L, lane);
        if (SAMPLE) {
            GlaGate gg; gg.init<L>(C, m0, h);
#pragma unroll 4
            for (int s = 0; s < L; ++s) {
                const float e = __expf(gg.step(s));
                LAS bf16_t* qp = (LAS bf16_t*)(t0 + s * TS + lane * 2); LAS bf16_t* kp = (LAS bf16_t*)(t1 + s * TS + lane * 2);
                *qp = f2bf(bf2f(*qp) * 0.125f * e); *kp = f2bf(bf2f(*kp) / e);
            }
        }
        __builtin_amdgcn_sched_barrier(0);
#pragma unroll
        for (int tb = 0; tb < NTB; ++tb)
#pragma unroll
            for (int ks = 0; ks < 4; ++ks) qfr[tb][ks] = row_frag(t0, 32 * tb, ks, lane);
        asm volatile("s_waitcnt lgkmcnt(0)" ::: "memory");
        __builtin_amdgcn_sched_barrier(0);
        load_tile(t0, C.proj + (size_t)m0 * PS + C_VB + h * 64, PS, L, lane);
    }
    __builtin_amdgcn_sched_barrier(0);
    f32x16 o[2][NTB];
#pragma unroll
    for (int db = 0; db < 2; ++db)
#pragma unroll
        for (int tb = 0; tb < NTB; ++tb) o[db][tb] = zero16();
    {
        const int uidx = ((type * 8 + b) * 4 + h) * 32 + n;
        const bf16_t* sT = (const bf16_t*)C.kvt + (size_t)uidx * 4096;
        const float* s0 = C.st + (size_t)((C.l * 8 + b) * 4 + h) * 4096;
#pragma unroll
        for (int db = 0; db < 2; ++db)
#pragma unroll
            for (int ks = 0; ks < 4; ++ks) {
                const int dv = 32 * db + li, dk0 = 16 * ks + 8 * kq;
                bf16x8 sa;
                if (!SAMPLE) sa = as_bf16x8(*(const u32x4*)(sT + dv * 64 + dk0));
                else { float sv[8];
#pragma unroll
                    for (int e = 0; e < 8; ++e) sv[e] = s0[(dk0 + e) * 64 + dv];
                    u32x4 w; w.x = pk2(sv[0], sv[1]); w.y = pk2(sv[2], sv[3]); w.z = pk2(sv[4], sv[5]); w.w = pk2(sv[6], sv[7]);
                    sa = as_bf16x8(w); }
#pragma unroll
                for (int tb = 0; tb < NTB; ++tb) o[db][tb] = mfma32(sa, qfr[tb][ks], o[db][tb]);
            }
    }
    __builtin_amdgcn_sched_barrier(0);
#pragma unroll
    for (int sb = 0; sb < NTB; ++sb) {
        bf16x8 kfr[4];
        if (type == 0) load_rot(C.proj + (size_t)(m0 + 32 * sb + li) * PS + C_KA + h * 64, C.rope + (size_t)(pidx0 + 32 * sb + li) * 64, kq, 0.125f * __builtin_amdgcn_exp2f(-lg * (float)(32 * sb + li + 1)), true, kfr);
        else {
#pragma unroll
            for (int ks = 0; ks < 4; ++ks) kfr[ks] = row_frag(t1, 32 * sb, ks, lane);
        }
        f32x16 st[NTB];
#pragma unroll
        for (int tb = sb; tb < NTB; ++tb) {
            f32x16 a = zero16();
#pragma unroll
            for (int ks = 0; ks < 4; ++ks) a = mfma32(kfr[ks], qfr[tb][ks], a);
#pragma unroll
            for (int r = 0; r < 16; ++r) {
                const int s = 32 * sb + crow(r, kq), t = 32 * tb + li;
                a[r] = (t >= s) ? a[r] : 0.0f;
            }
            st[tb] = a;
        }
#pragma unroll
        for (int half = 0; half < 2; ++half) {
            bf16x8 va[2];
#pragma unroll
            for (int db = 0; db < 2; ++db) va[db] = tr_perm(t0, 32 * sb + 16 * half, 32 * db, lane);
#pragma unroll
            for (int tb = sb; tb < NTB; ++tb) {
                const bf16x8 pf = pack_step(st[tb], half);
#pragma unroll
                for (int db = 0; db < 2; ++db) o[db][tb] = mfma32(va[db], pf, o[db][tb]);
            }
        }
        __builtin_amdgcn_sched_barrier(0);
    }
    const float* nw = C.nw + h * 64;
    const int gcol = (type == 0 ? C_GA : C_GB) + h * 64;
#pragma unroll
    for (int tb = 0; tb < NTB; ++tb) {
        const int t = 32 * tb + li;
        float s1 = 0.f, s2 = 0.f;
#pragma unroll
        for (int db = 0; db < 2; ++db)
#pragma unroll
            for (int r = 0; r < 16; ++r) { const float x = o[db][tb][r]; s1 += x; s2 += x * x; }
        s1 += __shfl_xor(s1, 32); s2 += __shfl_xor(s2, 32);
        float mu = 0.f, rstd;
        if (type == 0) { mu = s1 * (1.0f / 64.0f); const float var = fmaxf(s2 * (1.0f / 64.0f) - mu * mu, 0.f); rstd = 1.0f / sqrtf(var + EPS); }
        else rstd = 1.0f / sqrtf(s2 * (1.0f / 64.0f) + EPS);
        const bf16_t* grow = C.proj + (size_t)(m0 + t) * PS + gcol;
        bf16_t* orow = C.cat + (size_t)(m0 + t) * DM + type * 256 + h * 64;
#pragma unroll
        for (int db = 0; db < 2; ++db)
#pragma unroll
            for (int rr = 0; rr < 4; ++rr) {
                const int dv = 32 * db + 8 * rr + 4 * kq;
                const u32x2 gw = *(const u32x2*)(grow + dv);
                const f32x4 wv = *(const f32x4*)(nw + dv);
                const float g0 = bflo(gw.x), g1 = bfhi(gw.x), g2 = bflo(gw.y), g3 = bfhi(gw.y);
                const float y0 = (o[db][tb][4 * rr + 0] - mu) * rstd * wv[0] * silu(g0), y1 = (o[db][tb][4 * rr + 1] - mu) * rstd * wv[1] * silu(g1);
                const float y2 = (o[db][tb][4 * rr + 2] - mu) * rstd * wv[2] * silu(g2), y3 = (o[db][tb][4 * rr + 3] - mu) * rstd * wv[3] * silu(g3);
                u32x2 w; w.x = pk2(y0, y1); w.y = pk2(y2, y3);
                *(u32x2*)(orow + dv) = w;
            }
    }
}

template <bool SAMPLE> __device__ __forceinline__ void attn_wave(const Ctx& C, int b, int n, int h, LAS unsigned char* wl, LAS const float* revT, float cb2) {
    constexpr int NTB = SAMPLE ? 1 : 2;
    constexpr float SC = 0.125f * 1.4426950408889634f;
    const int m0 = SAMPLE ? MP + b * SL : b * SEQ + n * 64;
    const int lane = C.lane, kq = C.kq, li = C.li;
    const int jt0 = SAMPLE ? 0 : (n < 8 ? 8 - n : 0);
#define ATT_SRC(jt, kp, vp, pitch, rmask) const bf16_t* kp; const bf16_t* vp; int pitch; int rmask = 63; \
    if (SAMPLE && (jt) < 8) { kp = C.ckb + (size_t)(b * 512 + 64 * (jt)) * 512 + h * 64; vp = C.cvb + (size_t)(b * 512 + 64 * (jt)) * 512 + h * 64; pitch = 512; } \
    else { const int kr0 = SAMPLE ? m0 : b * SEQ + (n - 8 + (jt)) * 64; kp = C.proj + (size_t)kr0 * PS + C_KC + h * 64; vp = kp + (C_VC - C_KC); pitch = PS; if (SAMPLE) rmask = 31; }
#define ATT_ISSUE(jt, kdst, vbuf) do { ATT_SRC(jt, kp_, vp_, pitch_, rmask_); \
    _Pragma("unroll") for (int sb = 0; sb < 2; ++sb) _Pragma("unroll") for (int ks = 0; ks < 4; ++ks) kdst[sb][ks] = *(const u32x4*)(kp_ + (size_t)((32 * sb + li) & rmask_) * pitch_ + 16 * ks + 8 * kq); \
    _Pragma("unroll") for (int it = 0; it < 8; ++it) __builtin_amdgcn_global_load_lds((const unsigned*)(vp_ + (size_t)((it * 8 + (lane >> 3)) & rmask_) * pitch_ + (((lane & 7) ^ (((lane >> 3) & 2) << 1)) * 8)), (LAS unsigned*)((vbuf) + it * 1024), 16, 0, 0); } while (0)
    bf16x8 qfr[NTB][4];
#pragma unroll
    for (int tb = 0; tb < NTB; ++tb)
#pragma unroll
        for (int ks = 0; ks < 4; ++ks) qfr[tb][ks] = as_bf16x8(*(const u32x4*)(C.proj + (size_t)(m0 + 32 * tb + li) * PS + C_QC + h * 64 + 16 * ks + 8 * kq));
    f32x16 o[2][NTB]; float mrun[NTB], lrun[NTB];
#pragma unroll
    for (int tb = 0; tb < NTB; ++tb) { mrun[tb] = -1e30f; lrun[tb] = 0.f;
#pragma unroll
        for (int db = 0; db < 2; ++db) o[db][tb] = zero16(); }
    u32x4 kcur[2][4], knext[2][4];
    ATT_ISSUE(jt0, kcur, wl + ((jt0 & 1) ? TILE_B : 0));
    for (int jt = jt0; jt <= 8; ++jt) {
        asm volatile("s_waitcnt vmcnt(0)" ::: "memory");
        __builtin_amdgcn_sched_barrier(0);
        LAS unsigned char* tV = wl + ((jt & 1) ? TILE_B : 0);
        if (jt < 8) { ATT_ISSUE(jt + 1, knext, wl + (((jt + 1) & 1) ? TILE_B : 0)); }
        __builtin_amdgcn_sched_barrier(0);
        const bool cst = jt <= 3;
#pragma unroll
        for (int sb = 0; sb < 2; ++sb) {
            if (SAMPLE && jt == 8 && sb == 1) continue;
#pragma unroll
            for (int tb = 0; tb < NTB; ++tb) {
                f32x16 a = zero16();
#pragma unroll
                for (int ks = 0; ks < 4; ++ks) a = mfma32(as_bf16x8(kcur[sb][ks]), qfr[tb][ks], a);
                if (!cst) {
                    const int dbase = (8 - jt) * 64 + 63 + 32 * tb + li - 32 * sb;
                    LAS const float* rp = revT + (382 - dbase + 4 * kq);
#pragma unroll
                    for (int r = 0; r < 16; ++r) a[r] = a[r] * SC + rp[(r & 3) + 8 * (r >> 2)];
                }
                float mx = -1e30f;
#pragma unroll
                for (int r = 0; r < 16; ++r) mx = fmaxf(mx, a[r]);
                if (cst) mx = mx * SC + cb2;
                mx = fmaxf(mx, __shfl_xor(mx, 32));
                const float mnew = fmaxf(mrun[tb], mx);
                const bool moved = __builtin_amdgcn_ballot_w64(mnew != mrun[tb]) != 0ull;
                const float alpha = __builtin_amdgcn_exp2f(mrun[tb] - mnew);
                mrun[tb] = mnew;
                float ps = 0.f;
                if (cst) { const float off = cb2 - mnew;
#pragma unroll
                    for (int r = 0; r < 16; ++r) { const float pp = __builtin_amdgcn_exp2f(a[r] * SC + off); a[r] = pp; ps += pp; } }
                else {
#pragma unroll
                    for (int r = 0; r < 16; ++r) { const float pp = __builtin_amdgcn_exp2f(a[r] - mnew); a[r] = pp; ps += pp; } }
                lrun[tb] = lrun[tb] * alpha + ps;
                if (moved) {
#pragma unroll
                    for (int db = 0; db < 2; ++db) o[db][tb] = o[db][tb] * alpha;
                }
#pragma unroll
                for (int half = 0; half < 2; ++half) {
                    const bf16x8 pf = pack_step(a, half);
#pragma unroll
                    for (int db = 0; db < 2; ++db) o[db][tb] = mfma32(tr_perm_swz(tV, 32 * sb + 16 * half, 32 * db, lane), pf, o[db][tb]);
                }
            }
        }
#pragma unroll
        for (int sb = 0; sb < 2; ++sb)
#pragma unroll
            for (int ks = 0; ks < 4; ++ks) kcur[sb][ks] = knext[sb][ks];
    }
#pragma unroll
    for (int tb = 0; tb < NTB; ++tb) {
        const float lt = lrun[tb] + __shfl_xor(lrun[tb], 32), inv = 1.0f / lt;
        bf16_t* orow = C.cat + (size_t)(m0 + 32 * tb + li) * DM + 512 + h * 64;
#pragma unroll
        for (int db = 0; db < 2; ++db)
#pragma unroll
            for (int rr = 0; rr < 4; ++rr) {
                u32x2 w; w.x = pk2(o[db][tb][4 * rr] * inv, o[db][tb][4 * rr + 1] * inv); w.y = pk2(o[db][tb][4 * rr + 2] * inv, o[db][tb][4 * rr + 3] * inv);
                *(u32x2*)(orow + 32 * db + 8 * rr + 4 * kq) = w;
            }
    }
#undef ATT_ISSUE
#undef ATT_SRC
}

__device__ __forceinline__ void conv_cache(const float* ck, const float* cv, bf16_t* dst, int l, int gt, int NGT) {
    for (int i = gt; i < (int)(2 * CACHE_ELEMS / 8); i += NGT) {
        const bool isv = i >= (int)(CACHE_ELEMS / 8); const int j = isv ? i - (int)(CACHE_ELEMS / 8) : i;
        const float* s = (isv ? cv : ck) + (size_t)l * CACHE_ELEMS + (size_t)j * 8;
        const f32x4 x = *(const f32x4*)s, y = *(const f32x4*)(s + 4);
        u32x4 w; w.x = pk2(x[0], x[1]); w.y = pk2(x[2], x[3]); w.z = pk2(y[0], y[1]); w.w = pk2(y[2], y[3]);
        *(u32x4*)(dst + (size_t)i * 8) = w;
    }
}

__device__ __forceinline__ int win_src(int n) { return n < 2048 ? n : (n < 3584 ? n + 16 : (n < 3600 ? n - 1536 : -1)); }
__device__ __forceinline__ void tr_item(const float* W, int K, int Nsrc, bf16_t* WT, int kb, int nb, bool inmap, const float* kscale, LAS float* scr, int lane) {
    const int k0 = 64 * kb, n0 = 32 * nb, n = n0 + (lane & 31), sc = inmap ? win_src(n) : n;
    float wv[32];
#pragma unroll
    for (int i = 0; i < 32; ++i) { const int kk = 2 * i + (lane >> 5); wv[i] = (sc >= 0) ? W[(size_t)(k0 + kk) * Nsrc + sc] : 0.f; }
    if (kscale) {
#pragma unroll
        for (int i = 0; i < 32; ++i) wv[i] *= kscale[k0 + 2 * i + (lane >> 5)];
    }
#pragma unroll
    for (int i = 0; i < 32; ++i) scr[(2 * i + (lane >> 5)) * 33 + (lane & 31)] = wv[i];
    asm volatile("s_waitcnt lgkmcnt(0)" ::: "memory");
    const int c = lane & 7;
#pragma unroll
    for (int j = 0; j < 4; ++j) { const int nn = (lane >> 3) + 8 * j; const LAS float* s = scr + (8 * c) * 33 + nn;
        u32x4 o; o.x = pk2(s[0 * 33], s[1 * 33]); o.y = pk2(s[2 * 33], s[3 * 33]); o.z = pk2(s[4 * 33], s[5 * 33]); o.w = pk2(s[6 * 33], s[7 * 33]);
        *(u32x4*)(WT + (size_t)(n0 + nn) * K + k0 + 8 * c) = o; }
    asm volatile("s_waitcnt lgkmcnt(0)" ::: "memory");
}


enum { SK_IN = 0, SK_RES = 1, SK_UP = 2 };
struct SArgs {
    const bf16_t* A; const bf16_t* Bt; int K, nunits;
    bf16_t* obf; int ldo;
    const float* ss_in; float* ss_out;
    const bf16_t* xold; float* xr;
    float* lowf; float* ksout; float* vsout;
};
template <int KIND> __device__ __forceinline__ void sample_gemm(LAS unsigned char* lds, const SArgs& a, int ubeg, int ustep, int wave, int lane) {
    const int kq = lane >> 5, li = lane & 31, K = a.K, kw = K >> 3, kbeg = wave * kw;
    for (int u = ubeg; u < a.nunits; u += ustep) {
        const int row0 = 64 * (u & 3), col0 = 64 * (u >> 2);
        f32x16 acc[2][2];
#pragma unroll
        for (int rb = 0; rb < 2; ++rb)
#pragma unroll
            for (int cb = 0; cb < 2; ++cb) acc[rb][cb] = zero16();
        const bf16_t* ap = a.A + (size_t)(row0 + li) * K + kbeg + 8 * kq;
        const bf16_t* bp = a.Bt + (size_t)(col0 + li) * K + kbeg + 8 * kq;
        u32x4 af[4][2], bv[4][2], an[4][2], bn[4][2];
#define SG_LOAD(dsta, dstb, k) _Pragma("unroll") for (int s = 0; s < 4; ++s) _Pragma("unroll") for (int h = 0; h < 2; ++h) { dsta[s][h] = *(const u32x4*)(ap + (size_t)(32 * h) * K + (k) + 16 * s); dstb[s][h] = *(const u32x4*)(bp + (size_t)(32 * h) * K + (k) + 16 * s); }
        SG_LOAD(af, bv, 0);
        for (int k = 0; k < kw; k += 64) {
            if (k + 64 < kw) { SG_LOAD(an, bn, k + 64); }
#pragma unroll
            for (int s = 0; s < 4; ++s)
#pragma unroll
                for (int rb = 0; rb < 2; ++rb)
#pragma unroll
                    for (int cb = 0; cb < 2; ++cb) acc[rb][cb] = mfma32(as_bf16x8(af[s][rb]), as_bf16x8(bv[s][cb]), acc[rb][cb]);
#pragma unroll
            for (int s = 0; s < 4; ++s)
#pragma unroll
                for (int h = 0; h < 2; ++h) { af[s][h] = an[s][h]; bv[s][h] = bn[s][h]; }
        }
#undef SG_LOAD
        LAS float* wp = (LAS float*)(lds + wave * WAVE_LDS);
#pragma unroll
        for (int rb = 0; rb < 2; ++rb)
#pragma unroll
            for (int cb = 0; cb < 2; ++cb)
#pragma unroll
                for (int r = 0; r < 16; ++r) wp[(32 * rb + crow(r, kq)) * 64 + 32 * cb + li] = acc[rb][cb][r];
        __syncthreads();
        const int t = wave * 64 + lane, row = t >> 3, c8 = (t & 7) * 8;
        float v[8];
#pragma unroll
        for (int e = 0; e < 8; ++e) v[e] = 0.f;
#pragma unroll
        for (int w = 0; w < 8; ++w) {
            const f32x4 x = *(LAS const f32x4*)(lds + w * WAVE_LDS + (row * 64 + c8) * 4), y = *(LAS const f32x4*)(lds + w * WAVE_LDS + (row * 64 + c8) * 4 + 16);
#pragma unroll
            for (int e = 0; e < 4; ++e) { v[e] += x[e]; v[4 + e] += y[e]; }
        }
        const int r = row0 + row, c = col0 + c8;
        if (KIND == SK_IN || KIND == SK_UP) {
            const float rs = 1.0f / sqrtf(a.ss_in[r] * (1.0f / 1024.0f) + EPS);
#pragma unroll
            for (int e = 0; e < 8; ++e) { v[e] *= rs; if (KIND == SK_UP) { const float q = fmaxf(v[e], 0.f); v[e] = q * q; } }
        }
        if (KIND == SK_RES) {
            const u32x4 xw = *(const u32x4*)(a.xold + (size_t)r * 1024 + c);
            float sq = 0.f;
            v[0] += bflo(xw.x); v[1] += bfhi(xw.x); v[2] += bflo(xw.y); v[3] += bfhi(xw.y); v[4] += bflo(xw.z); v[5] += bfhi(xw.z); v[6] += bflo(xw.w); v[7] += bfhi(xw.w);
#pragma unroll
            for (int e = 0; e < 8; ++e) sq += v[e] * v[e];
            if (a.xr) { float* xn = a.xr + (size_t)r * 1024 + c;
                *(f32x4*)xn = (f32x4){v[0], v[1], v[2], v[3]}; *(f32x4*)(xn + 4) = (f32x4){v[4], v[5], v[6], v[7]}; }
            sq += __shfl_xor(sq, 1); sq += __shfl_xor(sq, 2); sq += __shfl_xor(sq, 4);
            if ((t & 7) == 0) atomicAdd(a.ss_out + r, sq);
        }
        if (a.obf) { u32x4 w; w.x = pk2(v[0], v[1]); w.y = pk2(v[2], v[3]); w.z = pk2(v[4], v[5]); w.w = pk2(v[6], v[7]); *(u32x4*)(a.obf + (size_t)r * a.ldo + c) = w; }
        if (KIND == SK_IN) {
            float* d = nullptr;
            if (c >= C_KC && c < C_VC) d = a.ksout + (size_t)r * 512 + (c - C_KC);
            else if (c >= C_VC && c < C_LOW) d = a.vsout + (size_t)r * 512 + (c - C_VC);
            else if (c >= C_LOW && c < C_LOW + 16) d = a.lowf + (size_t)r * 16 + (c - C_LOW);
            if (d) { *(f32x4*)d = (f32x4){v[0], v[1], v[2], v[3]}; *(f32x4*)(d + 4) = (f32x4){v[4], v[5], v[6], v[7]}; }
        }
        __syncthreads();
    }
}
__device__ __forceinline__ void sample_share(int nwg, int G, int bx, int& ubeg, int& ustep) { const int nfull = nwg % G; if (nfull == 0) { ubeg = bx; ustep = G; } else if (bx >= nfull) { ubeg = bx - nfull; ustep = G - nfull; } else { ubeg = 1 << 30; ustep = 1; } }

#define XB_TMO      128
#define XB_XCNT(j)  (256  + 64 * (j))
#define XB_XSUB(j)  (1280 + 64 * (j))
#define XB_XGEN(j)  (2304 + 64 * (j))
#define XB_TOP      3328
#define XB_TOPGEN   3392
#define XCD_BAR_WORDS 3456
#define XB_SPIN_CAP (1u << 18)

__device__ __forceinline__ unsigned xb_ld(unsigned* p)              { return __hip_atomic_load(p, __ATOMIC_RELAXED, __HIP_MEMORY_SCOPE_AGENT); }
__device__ __forceinline__ unsigned xb_add(unsigned* p, unsigned v) { return __hip_atomic_fetch_add(p, v, __ATOMIC_RELAXED, __HIP_MEMORY_SCOPE_AGENT); }
__device__ __forceinline__ unsigned xb_xcc_id() { return (unsigned)__builtin_amdgcn_s_getreg((3 << 11) | 20) & 0xFu; }
#define XB_SPIN(cond, bar) do { unsigned _sp = 0; while (cond) { __builtin_amdgcn_s_sleep(1); \
    if ((++_sp & 255u) == 0u) { if (xb_ld(&(bar)[XB_TMO])) break; if (_sp > XB_SPIN_CAP) { atomicAdd(&(bar)[XB_TMO], 1u); break; } } } } while (0)

struct XcdBarrier {
    unsigned* bar; unsigned x; bool wave0;
    volatile LAS unsigned* st;
};

__device__ __forceinline__ XcdBarrier xcd_barrier_post(unsigned* bar, volatile LAS unsigned* st) {
    XcdBarrier b; b.bar = bar; b.x = xb_xcc_id(); b.st = st;
    if (threadIdx.x == 0) (void)xb_add(&bar[XB_XCNT(b.x)], 1u);
    return b;
}
__device__ __forceinline__ void xcd_barrier_complete(unsigned* bar, unsigned x, unsigned& nloc, unsigned& nx) {
    const unsigned G = gridDim.x * gridDim.y * gridDim.z;
    unsigned sum, cnt, mine, sp = 0u;
    for (;;) {
        sum = 0u; cnt = 0u; mine = 0u;
#pragma unroll
        for (unsigned j = 0; j < 16; ++j) { const unsigned c = xb_ld(&bar[XB_XCNT(j)]); sum += c; cnt += (c > 0u) ? 1u : 0u; mine = (j == x) ? c : mine; }
        if (sum == G) break;
        __builtin_amdgcn_s_sleep(1);
        if ((++sp & 255u) == 0u) { if (xb_ld(&bar[XB_TMO])) break; if (sp > XB_SPIN_CAP) { atomicAdd(&bar[XB_TMO], 1u); break; } }
    }
    nloc = mine > 0u ? mine : 1u; nx = cnt > 0u ? cnt : 1u;
}

__device__ __forceinline__ void xcd_barrier(const XcdBarrier& b) {
    asm volatile("s_waitcnt vmcnt(0)" ::: "memory");
    __syncthreads();
    if (b.wave0 && lane_id_asm() == 0) {
        unsigned* bar = b.bar;
        __builtin_amdgcn_s_waitcnt(0);
        unsigned nloc = b.st[0], nx = b.st[1];
        if (nloc == 0u) { xcd_barrier_complete(bar, b.x, nloc, nx); b.st[0] = nloc; b.st[1] = nx; }
        const unsigned old = xb_add(&bar[XB_XSUB(b.x)], 1u);
        const unsigned gen = old / nloc;
        if (old + 1u == (gen + 1u) * nloc) {
            __builtin_amdgcn_fence(__ATOMIC_RELEASE, "agent");
            asm volatile("s_waitcnt vmcnt(0)" ::: "memory");
            const unsigned og = xb_add(&bar[XB_TOP], 1u);
            const unsigned tg = og / nx;
            if (og + 1u == (tg + 1u) * nx) xb_add(&bar[XB_TOPGEN], 1u);
            else XB_SPIN(xb_ld(&bar[XB_TOPGEN]) == tg, bar);
            __builtin_amdgcn_fence(__ATOMIC_ACQUIRE, "agent");
            xb_add(&bar[XB_XGEN(b.x)], 1u);
            asm volatile("s_waitcnt vmcnt(0)" ::: "memory");
        } else {
            XB_SPIN(xb_ld(&bar[XB_XGEN(b.x)]) == gen, bar);
            __builtin_amdgcn_fence(__ATOMIC_ACQUIRE, "agent");
            asm volatile("s_waitcnt vmcnt(0)" ::: "memory");
        }
    }
    __syncthreads();
}


__device__ __forceinline__ void tr_item128(const float* W, int K, int Nsrc, bf16_t* WT, int kb, int nb, const float* kscale, LAS float* scr, int lane) {
    const int k0 = 32 * kb, n0 = 128 * nb, n4 = (lane & 31) * 4;
    f32x4 wv[16];
#pragma unroll
    for (int i = 0; i < 16; ++i) wv[i] = *(const f32x4*)(W + (size_t)(k0 + 2 * i + (lane >> 5)) * Nsrc + n0 + n4);
    if (kscale) {
#pragma unroll
        for (int i = 0; i < 16; ++i) wv[i] = wv[i] * kscale[k0 + 2 * i + (lane >> 5)];
    }
#pragma unroll
    for (int i = 0; i < 16; ++i) { LAS float* d = scr + (2 * i + (lane >> 5)) * 129 + n4; d[0] = wv[i][0]; d[1] = wv[i][1]; d[2] = wv[i][2]; d[3] = wv[i][3]; }
    asm volatile("s_waitcnt lgkmcnt(0)" ::: "memory");
#pragma unroll
    for (int j = 0; j < 8; ++j) { const int id = j * 64 + lane, n = id >> 2, c = id & 3; const LAS float* s = scr + (8 * c) * 129 + n;
        u32x4 o; o.x = pk2(s[0 * 129], s[1 * 129]); o.y = pk2(s[2 * 129], s[3 * 129]); o.z = pk2(s[4 * 129], s[5 * 129]); o.w = pk2(s[6 * 129], s[7 * 129]);
        *(u32x4*)(WT + (size_t)(n0 + n) * K + k0 + 8 * c) = o; }
    asm volatile("s_waitcnt lgkmcnt(0)" ::: "memory");
}
constexpr int CONV_WGS = 16;

__global__ void __launch_bounds__(512, 2) hybrid_fwd(Params p) {
    extern __shared__ __attribute__((aligned(16))) unsigned char lds_raw[];
    cg::grid_group grid = cg::this_grid();
    LAS unsigned char* lds = (LAS unsigned char*)lds_raw;
    const int wave = __builtin_amdgcn_readfirstlane((int)threadIdx.x >> 6);
    const int G = gridDim.x, bx = blockIdx.x;
#define WSP(off) (ws_ptr() + (off))
#define LANE_TID() const int lane = lane_id_asm(); const int tid = wave * 64 + lane; (void)tid; int Gq = G, bxq = bx; asm volatile("" : "+s"(Gq), "+s"(bxq)); (void)Gq; (void)bxq
    LAS unsigned char* wl = lds + wave * WAVE_LDS;
    LAS float* biasT = (LAS float*)(lds + LDS_BIAS);
    if (threadIdx.x < 4) ((LAS unsigned*)(lds + LDS_BARST))[threadIdx.x] = 0u;
    __syncthreads();
    XcdBarrier xbar = xcd_barrier_post((unsigned*)WSP(WS_CTL), (volatile LAS unsigned*)(lds + LDS_BARST)); xbar.wave0 = (wave == 0);

    for (int rep = 0; rep < 1 + PROBE_P0X2; ++rep) {
        LANE_TID();
        unsigned char* ws = ws_ptr();
        bf16_t* XB = (bf16_t*)(ws + WS_B); bf16_t* WIN = (bf16_t*)(ws + WS_WIN); bf16_t* WOUT = (bf16_t*)(ws + WS_WOUT); bf16_t* WUP = (bf16_t*)(ws + WS_WUP); bf16_t* WDN = (bf16_t*)(ws + WS_WDN);
        float* SS = (float*)(ws + WS_SS); float* ROPE = (float*)(ws + WS_ROPE);
        const int gw = bx * 8 + wave, NGW = G * 8;
        LAS float* scr = (LAS float*)wl;
        constexpr int I_IN = 16 * (PS / 32), I_OUT = 16 * 32, I_UP = 16 * 128, I_DN = 64 * 32, I_L = I_IN + I_OUT + I_UP + I_DN;
        const bool split = (G == 256);
        for (int it = gw; it < 2 * I_L; it += NGW) {
            const int l = it / I_L; int r = it % I_L;
            if (split && r >= I_IN) continue;
            if (r < I_IN) { tr_item(in_ptr(9) + (size_t)l * DM * INCOLS, DM, INCOLS, WIN + (size_t)l * PS * DM, r / (PS / 32), r % (PS / 32), true, in_ptr(6) + l * DM, scr, lane); continue; } r -= I_IN;
            if (r < I_OUT) { tr_item(in_ptr(15) + (size_t)l * DM * DM, DM, DM, WOUT + (size_t)l * DM * DM, r / 32, r % 32, false, nullptr, scr, lane); continue; } r -= I_OUT;
            if (r < I_UP) { tr_item(in_ptr(16) + (size_t)l * DM * DFF, DM, DFF, WUP + (size_t)l * DFF * DM, r / 128, r % 128, false, in_ptr(7) + l * DM, scr, lane); continue; } r -= I_UP;
            tr_item(in_ptr(17) + (size_t)l * DFF * DM, DFF, DM, WDN + (size_t)l * DM * DFF, r / 32, r % 32, false, nullptr, scr, lane);
        }
        const float* x_prompt = in_ptr(0); const float* x_sample = in_ptr(1);
        for (int m0 = gw; m0 < MT; m0 += 2 * NGW) {
            f32x4 v[2][4]; float s[2];
#pragma unroll
            for (int q = 0; q < 2; ++q) {
                const int m = m0 + q * NGW; s[q] = 0.f;
                if (m < MT) {
                    const float* xrow = (m < MP) ? x_prompt + (size_t)m * DM : x_sample + (size_t)(m - MP) * DM;
                    const f32x4* xr = (const f32x4*)xrow + lane;
#pragma unroll
                    for (int j = 0; j < 4; ++j) v[q][j] = xr[64 * j];
                }
            }
#pragma unroll
            for (int q = 0; q < 2; ++q) {
                const int m = m0 + q * NGW;
                if (m < MT) {
#pragma unroll
                    for (int j = 0; j < 4; ++j) s[q] += (v[q][j][0] * v[q][j][0] + v[q][j][1] * v[q][j][1]) + (v[q][j][2] * v[q][j][2] + v[q][j][3] * v[q][j][3]);
#pragma unroll
                    for (int o = 1; o < 64; o <<= 1) s[q] += __shfl_xor(s[q], o);
                    u32x2* o8 = (u32x2*)(XB + (size_t)m * DM) + lane;
#pragma unroll
                    for (int j = 0; j < 4; ++j) { u32x2 w; w.x = pk2(v[q][j][0], v[q][j][1]); w.y = pk2(v[q][j][2], v[q][j][3]); o8[64 * j] = w; }
                    if (lane == 0) SS[m] = s[q];
                }
            }
        }
        const int gt = bx * 512 + tid, NGT = G * 512;
        for (int i = gt; i < 4 * MT; i += NGT) SS[MT + i] = 0.f;
        conv_cache(in_ptr(4), in_ptr(5), (bf16_t*)(ws + WS_CKB), 0, gt, NGT);
        for (int i = gt; i < 2080 * 32; i += NGT) {
            const int pi = i >> 5, f = i & 31; const int pos = pi < 2048 ? pi : 4096 + (pi - 2048);
            const float inv_freq = (float)exp(-(double)f * (9.210340371976184 / 32.0));
            const float ang = (float)pos * inv_freq;
            double rev = (double)ang * 0.15915494309189535; rev -= rint(rev);
            const float rf = (float)rev;
            ROPE[(size_t)pi * 64 + f] = __builtin_amdgcn_cosf(rf); ROPE[(size_t)pi * 64 + 32 + f] = __builtin_amdgcn_sinf(rf);
        }
    }
    if (G == 0x7fffffff) grid.sync();
    xcd_barrier(xbar);

    for (int l = 0; l < 2; ++l) {
        {
            LANE_TID();
            unsigned char* ws = ws_ptr();
            const bool split = (Gq == 256); const int GG = split ? Gq - CONV_WGS : Gq;
            if (split && bxq >= GG) {
                LAS float* scr = (LAS float*)(lds + wave * WAVE_LDS);
                constexpr int J_OUT = 32 * 8, J_UP = 32 * 32;
                for (int it = (bxq - GG) * 8 + wave; it < J_OUT + J_UP; it += CONV_WGS * 8) {
                    if (it < J_OUT) tr_item128(in_ptr(15) + (size_t)l * DM * DM, DM, DM, (bf16_t*)(ws + WS_WOUT) + (size_t)l * DM * DM, it / 8, it % 8, nullptr, scr, lane);
                    else { const int r = it - J_OUT; tr_item128(in_ptr(16) + (size_t)l * DM * DFF, DM, DFF, (bf16_t*)(ws + WS_WUP) + (size_t)l * DFF * DM, r / 32, r % 32, in_ptr(7) + l * DM, scr, lane); }
                }
            } else {
            pg8::Gemm g{(const bf16_t*)(ws + WS_B), (const bf16_t*)(ws + WS_WIN) + (size_t)l * PS * DM, MP, PS, DM}; pg8::StaticOrder S; S.init(MP, PS, GG, bxq);
            pg8::EpiIn E{(bf16_t*)(ws + WS_A), (float*)(ws + WS_LOWF), (const float*)(ws + WS_SS) + (size_t)(2 * l) * MT, out_ptr(), (long long)(O_KP + (size_t)l * 2097152), (long long)(O_VP + (size_t)l * 2097152), (long long)(O_KS + (size_t)l * 131072), (long long)(O_VS + (size_t)l * 131072)};
            pg8::gemm_phase<pg8::EpiIn, pg8::StaticOrder, true, true>(lds, g, S, E, tid);
            if (PROBE_IN2) pg8::gemm_phase<pg8::EpiIn, pg8::StaticOrder, true, true>(lds, g, S, E, tid);
            {
                float* outp = out_ptr();
                SArgs a{}; a.A = (const bf16_t*)(ws + WS_B) + (size_t)MP * DM; a.Bt = (const bf16_t*)(ws + WS_WIN) + (size_t)l * PS * DM; a.K = DM; a.nunits = 4 * 57;
                a.obf = (bf16_t*)(ws + WS_A) + (size_t)MP * PS; a.ldo = PS; a.ss_in = (const float*)(ws + WS_SS) + (size_t)(2 * l) * MT + MP; a.lowf = (float*)(ws + WS_LOWF) + (size_t)MP * 16;
                a.ksout = outp + O_KS + (size_t)l * 131072; a.vsout = outp + O_VS + (size_t)l * 131072;
                int ub, us; sample_share((MP / 256) * (PS / 256), GG, bxq, ub, us);
                sample_gemm<SK_IN>(lds, a, ub, us, wave, lane);
            }
            if (l == 1) conv_cache(in_ptr(4), in_ptr(5), (bf16_t*)(ws + WS_CKB), 1, bxq * 512 + tid, GG * 512);
            }
        }
        xcd_barrier(xbar);
        {
            LANE_TID();
            { const float* rb = in_ptr(14) + (size_t)l * 8 * NREL; for (int i = tid; i < 8 * NREV; i += 512) { const int hh = i / NREV, j = i % NREV; int k = 382 - j; k = k < 0 ? 0 : (k > NREL - 1 ? NREL - 1 : k); biasT[i] = rb[hh * NREL + k] * 1.4426950408889634f; } }
            __syncthreads();
        }
#define MAKE_CTX() LANE_TID(); int wv = wave; asm volatile("" : "+s"(wv)); unsigned char* ws = ws_ptr(); Ctx C; C.l = l; C.lane = lane; C.kq = lane >> 5; C.li = lane & 31; C.proj = (const bf16_t*)(ws + WS_A); C.lowf = (const float*)(ws + WS_LOWF); \
        C.rope = (const float*)(ws + WS_ROPE); C.cat = (bf16_t*)(out_ptr() + O_Y); C.kvt = (float*)(ws + WS_C); C.gdec = (float*)(ws + WS_G); C.out = out_ptr(); \
        C.wa2 = in_ptr(10) + (size_t)l * 16 * 256; C.ba = in_ptr(11) + l * 256; C.nw = (wv < 4 ? in_ptr(12) : in_ptr(13)) + l * 256; C.st = (wv < 4 ? in_ptr(2) : in_ptr(3)); C.ckb = (const bf16_t*)(ws + WS_CKB); C.cvb = C.ckb + CACHE_ELEMS; \
        __builtin_amdgcn_sched_barrier(0)
        for (int rep = 0; rep < 1 + PROBE_M1X2; ++rep)
        for (int u = bx; u < 256; u += G) {
            const int b = u & 7, n = u >> 3;
            for (int rk = 0; rk < 1 + PROBE_KVX2; ++rk) { MAKE_CTX(); kv_local<false>(C, wv >> 2, b, n, wv & 3, wl); }
            for (int ra = 0; ra < 1 + PROBE_ATX2; ++ra) { MAKE_CTX(); attn_wave<false>(C, b, n, wave, wl, biasT + wave * NREV, biasT[wave * NREV]); }
            if (n == 0) { MAKE_CTX(); attn_wave<true>(C, b, 0, wave, wl, biasT + wave * NREV, biasT[wave * NREV]); }
            if (n == 1) { MAKE_CTX(); mix_out<true>(C, wv >> 2, b, 0, wv & 3, wl); }
            if (n == 2) { MAKE_CTX(); kv_local<true>(C, wv >> 2, b, 0, wv & 3, wl); }
        }
        xcd_barrier(xbar);
        {
            LANE_TID();
            float* KVT = (float*)WSP(WS_C); const float* GDEC = (const float*)WSP(WS_G); float* outp = out_ptr();
            for (int it = bx * 512 + tid; it < 131072; it += G * 512) {
                const int seq = it >> 11, e2 = it & 2047, type = seq >> 5, b = (seq >> 2) & 7, h = seq & 3;
                const int dv = e2 >> 5, dk = (2 * e2) & 63;
                bf16_t* base = (bf16_t*)KVT + (size_t)seq * 32 * 4096 + 2 * e2;
                const float dret = exp2f(ret_lg2(h) * 64.0f);
                const float* gd = GDEC + (size_t)((b * 4 + h) * 32) * 64 + dk;
                unsigned kvr[32]; f32x2 dd[32];
#pragma unroll
                for (int c = 0; c < 32; ++c) kvr[c] = *(const unsigned*)(base + (size_t)c * 4096);
                if (type == 1) {
#pragma unroll
                    for (int c = 0; c < 32; ++c) dd[c] = *(const f32x2*)(gd + c * 64);
                } else {
#pragma unroll
                    for (int c = 0; c < 32; ++c) dd[c] = (f32x2){dret, dret};
                }
                f32x2 s = (f32x2){0.f, 0.f};
#pragma unroll
                for (int c = 0; c < 32; ++c) { *(unsigned*)(base + (size_t)c * 4096) = pk2(s[0], s[1]); s = dd[c] * s + (f32x2){bflo(kvr[c]), bfhi(kvr[c])}; }
                float* so = outp + (type == 0 ? O_RETP : O_GLAP) + (size_t)((l * 8 + b) * 4 + h) * 4096;
                so[dk * 64 + dv] = s[0]; so[(dk + 1) * 64 + dv] = s[1];
            }
        }
        xcd_barrier(xbar);
        for (int rep = 0; rep < 1 + PROBE_M3X2; ++rep)
        for (int u = bx; u < 256; u += G) { MAKE_CTX(); mix_out<false>(C, wv >> 2, u & 7, u >> 3, wv & 3, wl); }
        xcd_barrier(xbar);
        {
            LANE_TID();
            unsigned char* ws = ws_ptr(); const bf16_t* CATB = (const bf16_t*)(out_ptr() + O_Y);
            pg8::Gemm g{CATB, (const bf16_t*)(ws + WS_WOUT) + (size_t)l * DM * DM, MP, DM, DM}; pg8::StaticOrder S; S.init(MP, DM, Gq, bxq);
            pg8::EpiRes E{(const bf16_t*)(ws + WS_B), (float*)nullptr, (bf16_t*)(ws + WS_C), (float*)(ws + WS_SS) + (size_t)(2 * l + 1) * MT};
            pg8::gemm_phase<pg8::EpiRes, pg8::StaticOrder, true, true>(lds, g, S, E, tid);
            {
                SArgs a{}; a.A = CATB + (size_t)MP * DM; a.Bt = (const bf16_t*)(ws + WS_WOUT) + (size_t)l * DM * DM; a.K = DM; a.nunits = 4 * 16;
                a.obf = (bf16_t*)(ws + WS_C) + (size_t)MP * DM; a.ldo = DM; a.ss_out = (float*)(ws + WS_SS) + (size_t)(2 * l + 1) * MT + MP;
                a.xold = (const bf16_t*)(ws + WS_B) + (size_t)MP * DM; a.xr = nullptr;
                int ub, us; sample_share((MP / 256) * (DM / 256), Gq, bxq, ub, us);
                sample_gemm<SK_RES>(lds, a, ub, us, wave, lane);
                const int nsamp = a.nunits < Gq ? a.nunits : Gq;
                if (Gq == 256 && bxq >= nsamp) {
                    LAS float* scr = (LAS float*)(lds + wave * WAVE_LDS);
                    for (int it = (bxq - nsamp) * 8 + wave; it < 128 * 8; it += (Gq - nsamp) * 8)
                        tr_item128(in_ptr(17) + (size_t)l * DFF * DM, DFF, DM, (bf16_t*)(ws + WS_WDN) + (size_t)l * DM * DFF, it / 8, it % 8, nullptr, scr, lane);
                }
            }
        }
        xcd_barrier(xbar);
        {
            LANE_TID();
            unsigned char* ws = ws_ptr();
            pg8::Gemm g{(const bf16_t*)(ws + WS_C), (const bf16_t*)(ws + WS_WUP) + (size_t)l * DFF * DM, MP, DFF, DM}; pg8::StaticOrder S; S.init(MP, DFF, Gq, bxq);
            pg8::EpiUp E{(bf16_t*)(ws + WS_A), (const float*)(ws + WS_SS) + (size_t)(2 * l + 1) * MT, DFF};
            pg8::gemm_phase<pg8::EpiUp, pg8::StaticOrder, true, true>(lds, g, S, E, tid);
            if (PROBE_UP2) pg8::gemm_phase<pg8::EpiUp, pg8::StaticOrder, true, true>(lds, g, S, E, tid);
            if (PROBE_UP2B) { xcd_barrier(xbar); pg8::gemm_phase<pg8::EpiUp, pg8::StaticOrder, true, true>(lds, g, S, E, tid); }
            {
                SArgs a{}; a.A = (const bf16_t*)(ws + WS_C) + (size_t)MP * DM; a.Bt = (const bf16_t*)(ws + WS_WUP) + (size_t)l * DFF * DM; a.K = DM; a.nunits = 4 * 64;
                a.obf = (bf16_t*)(ws + WS_A) + (size_t)MP * DFF; a.ldo = DFF; a.ss_in = (const float*)(ws + WS_SS) + (size_t)(2 * l + 1) * MT + MP;
                int ub, us; sample_share((MP / 256) * (DFF / 256), Gq, bxq, ub, us);
                sample_gemm<SK_UP>(lds, a, ub, us, wave, lane);
            }
        }
        xcd_barrier(xbar);
        {
            LANE_TID();
            unsigned char* ws = ws_ptr(); float* XR = out_ptr() + O_Y;
            pg8::Gemm g{(const bf16_t*)(ws + WS_A), (const bf16_t*)(ws + WS_WDN) + (size_t)l * DM * DFF, MP, DM, DFF}; pg8::StaticOrder S; S.init(MP, DM, Gq, bxq);
            if (PROBE_DN2) { pg8::EpiUp E2{(bf16_t*)(ws + WS_C), (const float*)(ws + WS_SS) + (size_t)(2 * l + 1) * MT, DM}; pg8::gemm_phase<pg8::EpiUp, pg8::StaticOrder, true, true>(lds, g, S, E2, tid); }
            pg8::EpiRes E{(const bf16_t*)(ws + WS_C), l == 1 ? XR : (float*)nullptr, l == 0 ? (bf16_t*)(ws + WS_B) : (bf16_t*)nullptr, (float*)(ws + WS_SS) + (size_t)(2 * l + 2) * MT};
            pg8::gemm_phase<pg8::EpiRes, pg8::StaticOrder, true, true>(lds, g, S, E, tid);
            {
                SArgs a{}; a.A = (const bf16_t*)(ws + WS_A) + (size_t)MP * DFF; a.Bt = (const bf16_t*)(ws + WS_WDN) + (size_t)l * DM * DFF; a.K = DFF; a.nunits = 4 * 16;
                a.obf = l == 0 ? (bf16_t*)(ws + WS_B) + (size_t)MP * DM : (bf16_t*)nullptr; a.ldo = DM; a.ss_out = (float*)(ws + WS_SS) + (size_t)(2 * l + 2) * MT + MP;
                a.xold = (const bf16_t*)(ws + WS_C) + (size_t)MP * DM; a.xr = l == 1 ? XR + (size_t)MP * DM : (float*)nullptr;
                int ub, us; sample_share((MP / 256) * (DM / 256), Gq, bxq, ub, us);
                sample_gemm<SK_RES>(lds, a, ub, us, wave, lane);
            }
        }
        xcd_barrier(xbar);
    }
    for (int i = 0; i < PROBE_SYNCS; ++i) xcd_barrier(xbar);
    {
        LANE_TID();
        const int gw = bx * 8 + wave, NGW = G * 8;
        const float* fw = in_ptr(8); const float* SS = (const float*)WSP(WS_SS); float* XR = out_ptr() + O_Y;
        f32x4 w4[4];
#pragma unroll
        for (int j = 0; j < 4; ++j) w4[j] = *((const f32x4*)fw + lane + 64 * j);
        for (int m0 = gw; m0 < MT; m0 += 2 * NGW) {
            f32x4 v[2][4]; float rs[2];
#pragma unroll
            for (int q = 0; q < 2; ++q) {
                const int m = m0 + q * NGW;
                if (m < MT) {
                    rs[q] = SS[(size_t)4 * MT + m];
                    const f32x4* xr = (const f32x4*)(XR + (size_t)m * DM) + lane;
#pragma unroll
                    for (int j = 0; j < 4; ++j) v[q][j] = xr[64 * j];
                }
            }
#pragma unroll
            for (int q = 0; q < 2; ++q) {
                const int m = m0 + q * NGW;
                if (m < MT) {
                    const float r = 1.0f / sqrtf(rs[q] * (1.0f / 1024.0f) + EPS);
                    f32x4* xr = (f32x4*)(XR + (size_t)m * DM) + lane;
#pragma unroll
                    for (int j = 0; j < 4; ++j) xr[64 * j] = v[q][j] * r * w4[j];
                }
            }
        }
    }
}

extern "C" void kernel_launch(void* const* d_in, const int* in_sizes, int n_in, void* d_out, int out_size, void* d_ws, size_t ws_size, hipStream_t stream) {
    static int grid = 0;
    if (grid == 0) {
        if (n_in != 18 || (size_t)out_size != O_END || ws_size < WS_END) { fprintf(stderr, "kernel_launch: unexpected shapes: n_in %d out %d ws %zu (need %zu)\n", n_in, out_size, ws_size, (size_t)WS_END); grid = -1; return; }
        int dev = 0, cus = 0, per_cu = 0;
        hipGetDevice(&dev); hipDeviceGetAttribute(&cus, hipDeviceAttributeMultiprocessorCount, dev);
        if (hipFuncSetAttribute((const void*)hybrid_fwd, hipFuncAttributeMaxDynamicSharedMemorySize, LDS_BYTES) != hipSuccess) { fprintf(stderr, "kernel_launch: hipFuncSetAttribute failed\n"); }
        if (hipOccupancyMaxActiveBlocksPerMultiprocessor(&per_cu, (const void*)hybrid_fwd, 512, LDS_BYTES) != hipSuccess || per_cu < 1) { fprintf(stderr, "kernel_launch: occupancy query says %d\n", per_cu); per_cu = 1; }
        (void)hipGetLastError();
        grid = cus * per_cu;
        if (grid > 256) grid = 256;
    }
    if (grid < 0) return;
    if (hipMemsetAsync((unsigned char*)d_ws + WS_CTL, 0, CTL_BYTES, stream) != hipSuccess) { fprintf(stderr, "kernel_launch: memset of the barrier words failed\n"); return; }
    Params p{};
    for (int i = 0; i < 18; ++i) p.in[i] = (const float*)d_in[i];
    p.out = (float*)d_out; p.ws = (unsigned char*)d_ws;
    void* args[] = {&p};
    hipError_t e = hipLaunchCooperativeKernel((const void*)hybrid_fwd, dim3(grid), dim3(512), args, LDS_BYTES, stream);
    if (e != hipSuccess) fprintf(stderr, "kernel_launch: cooperative launch failed: %s (grid %d)\n", hipGetErrorString(e), grid);
}
```

```cpp
#include <hip/hip_runtime.h>
#include <hip/hip_cooperative_groups.h>
#include <cstdio>
#include <cstdint>
namespace cg = cooperative_groups;
#ifndef PROBE_UP2
#define PROBE_UP2 0
#endif
#ifndef PROBE_M1X2
#define PROBE_M1X2 0
#endif
#ifndef PROBE_P0X2
#define PROBE_P0X2 0
#endif
#ifndef PROBE_SYNCS
#define PROBE_SYNCS 0
#endif
#ifndef PROBE_IN2
#define PROBE_IN2 0
#endif
#ifndef PROBE_DN2
#define PROBE_DN2 0
#endif
#ifndef PROBE_UP2B
#define PROBE_UP2B 0
#endif
#ifndef PROBE_KVX2
#define PROBE_KVX2 0
#endif
#ifndef PROBE_ATX2
#define PROBE_ATX2 0
#endif
#ifndef PROBE_M3X2
#define PROBE_M3X2 0
#endif
namespace pg8 {
#define PG8_LAS __attribute__((address_space(3)))
typedef unsigned short bf16_t;
typedef short bf16x8 __attribute__((ext_vector_type(8)));
typedef float f32x4 __attribute__((ext_vector_type(4)));
typedef unsigned u32x4 __attribute__((ext_vector_type(4)));
constexpr int BM = 256, BK = 64, HALF = 128, HTB = HALF * BK * 2  , STAGE_BYTES = 8 * HTB, NXCD = 8, WGM = 8;

__host__ __device__ __forceinline__ int lds_byte(int r, int c) { const int st = (r >> 4) * 2 + (c >> 5), rr = r & 15, cc = c & 31, ob = rr * 64 + cc * 2; return st * 1024 + (ob ^ (((ob >> 9) & 1) << 5)); }
__host__ __device__ __forceinline__ void stage_rc(int b, int& R, int& C) { const int st = b / 1024, sb = b % 1024, swz = sb ^ (((sb >> 9) & 1) << 5); R = (st >> 1) * 16 + swz / 64; C = (st & 1) * 32 + (swz % 64) / 2; }
__host__ __device__ __forceinline__ int perm32(int rho) { const int n = rho >> 4, i = rho & 15; return 8 * (i >> 2) + 4 * n + (i & 3); }

struct Unit { int pm, pn; };
struct Gemm { const bf16_t* A; const bf16_t* Bt; int M, N, K; };

struct StaticOrder {
    int nM, nN, nwg, G, c;
    __host__ __device__ __forceinline__ void init(int M, int N, int G_, int c_) { nM = M / BM; nN = N / BM; nwg = nM * nN; G = G_; c = c_; }
    __host__ __device__ __forceinline__ bool next(int i, Unit& u) const {
        const long L = (long)i * G + c; if (L >= nwg) return false;
        int wgid = (int)L; { const int q = nwg / NXCD, r = nwg % NXCD, xcd = wgid % NXCD, off = wgid / NXCD; wgid = (xcd < r ? xcd * (q + 1) : r * (q + 1) + (xcd - r) * q) + off; }
        const int nig = WGM * nN, gid = wgid / nig, fm = gid * WGM, gsz = (nM - fm) < WGM ? (nM - fm) : WGM;
        u.pm = fm + ((wgid % nig) % gsz); u.pn = (wgid % nig) / gsz; return true;
    }
    __device__ __forceinline__ void a_ready(const Unit&) const {}
    __device__ __forceinline__ void done(const Unit&) const {}
};

__device__ __forceinline__ unsigned cvt_pk_bf16(float lo, float hi) { unsigned r; asm volatile("v_cvt_pk_bf16_f32 %0, %1, %2" : "=v"(r) : "v"(lo), "v"(hi)); return r; }
typedef float f32x2 __attribute__((ext_vector_type(2)));

typedef unsigned u32x2 __attribute__((ext_vector_type(2)));
constexpr int E_MP = 16384;
struct EpiIn {
    static constexpr bool PERM = true, AFTER_DRAIN = false;
    bf16_t* proj; float* lowf; const float* ss; float* out; long long okp, ovp, oks, ovs;
    __device__ __forceinline__ void operator()(const f32x4 (&acc)[2][2][4][2], const Unit& u, int wr, int wc, int fr, int fq) const {
        const int row0 = u.pm * BM + wr * 64 + fr, col0 = u.pn * BM + wc * 32 + 8 * fq;
        float* kv = nullptr; int rsub = 0, cbase = 0;
        if (u.pn >= 10 && u.pn < 14) {
            const bool isk = u.pn < 12; cbase = isk ? 2560 : 3072;
            if (u.pm >= 64) { kv = out + (isk ? oks : ovs); rsub = E_MP; }
            else if ((u.pm & 7) >= 6) { kv = out + (isk ? okp : ovp); rsub = 1536 * ((u.pm >> 3) + 1); }
        }
        const bool lowt = (u.pn == 14) && (wc == 0) && (fq < 2);
#pragma unroll
        for (int ai = 0; ai < 2; ++ai)
#pragma unroll
            for (int m = 0; m < 4; ++m) {
                const int r = row0 + ai * HALF + m * 16;
                const float rs = 1.0f / sqrtf(ss[r] * (1.0f / 1024.0f) + 1e-6f);
                bf16_t* rowp = proj + (size_t)r * 3840 + col0;
#pragma unroll
                for (int bj = 0; bj < 2; ++bj) {
                    const f32x4 v0 = acc[ai][bj][m][0] * rs, v1 = acc[ai][bj][m][1] * rs;
                    u32x4 w; w.x = cvt_pk_bf16(v0[0], v0[1]); w.y = cvt_pk_bf16(v0[2], v0[3]); w.z = cvt_pk_bf16(v1[0], v1[1]); w.w = cvt_pk_bf16(v1[2], v1[3]);
                    *(u32x4*)(rowp + bj * HALF) = w;
                    if (kv) { float* d = kv + (size_t)(r - rsub) * 512 + (col0 + bj * HALF - cbase); *(f32x4*)d = v0; *(f32x4*)(d + 4) = v1; }
                    if (lowt && bj == 0) { float* d = lowf + (size_t)r * 16 + 8 * fq; *(f32x4*)d = v0; *(f32x4*)(d + 4) = v1; }
                }
            }
    }
};
struct EpiRes {
    static constexpr bool PERM = true, AFTER_DRAIN = false;
    const bf16_t* xold; float* xr; bf16_t* xb; float* ss;
    __device__ __forceinline__ void operator()(const f32x4 (&acc)[2][2][4][2], const Unit& u, int wr, int wc, int fr, int fq) const {
        const int row0 = u.pm * BM + wr * 64 + fr, col0 = u.pn * BM + wc * 32 + 8 * fq;
#pragma unroll
        for (int ai = 0; ai < 2; ++ai)
#pragma unroll
            for (int m = 0; m < 4; ++m) {
                const int r = row0 + ai * HALF + m * 16;
                const bf16_t* xo = xold + (size_t)r * 1024 + col0;
                float sq = 0.f;
#pragma unroll
                for (int bj = 0; bj < 2; ++bj) {
                    const u32x4 xw = *(const u32x4*)(xo + bj * HALF);
                    f32x4 v0, v1;
                    v0[0] = __uint_as_float(xw.x << 16); v0[1] = __uint_as_float(xw.x & 0xffff0000u); v0[2] = __uint_as_float(xw.y << 16); v0[3] = __uint_as_float(xw.y & 0xffff0000u);
                    v1[0] = __uint_as_float(xw.z << 16); v1[1] = __uint_as_float(xw.z & 0xffff0000u); v1[2] = __uint_as_float(xw.w << 16); v1[3] = __uint_as_float(xw.w & 0xffff0000u);
                    v0 = v0 + acc[ai][bj][m][0]; v1 = v1 + acc[ai][bj][m][1];
                    if (xr) { float* xn = xr + (size_t)r * 1024 + col0 + bj * HALF; *(f32x4*)xn = v0; *(f32x4*)(xn + 4) = v1; }
                    sq += (v0[0] * v0[0] + v0[1] * v0[1]) + (v0[2] * v0[2] + v0[3] * v0[3]) + (v1[0] * v1[0] + v1[1] * v1[1]) + (v1[2] * v1[2] + v1[3] * v1[3]);
                    if (xb) { u32x4 w; w.x = cvt_pk_bf16(v0[0], v0[1]); w.y = cvt_pk_bf16(v0[2], v0[3]); w.z = cvt_pk_bf16(v1[0], v1[1]); w.w = cvt_pk_bf16(v1[2], v1[3]);
                        *(u32x4*)(xb + (size_t)r * 1024 + col0 + bj * HALF) = w; }
                }
                sq += __shfl_xor(sq, 16); sq += __shfl_xor(sq, 32);
                if (fq == 0) atomicAdd(ss + r, sq);
            }
    }
};
struct EpiUp {
    static constexpr bool PERM = true, AFTER_DRAIN = false;
    bf16_t* U; const float* ss; int ldu;
    __device__ __forceinline__ void operator()(const f32x4 (&acc)[2][2][4][2], const Unit& u, int wr, int wc, int fr, int fq) const {
        const int row0 = u.pm * BM + wr * 64 + fr, col0 = u.pn * BM + wc * 32 + 8 * fq;
#pragma unroll
        for (int ai = 0; ai < 2; ++ai)
#pragma unroll
            for (int m = 0; m < 4; ++m) {
                const int r = row0 + ai * HALF + m * 16;
                const float rs = 1.0f / sqrtf(ss[r] * (1.0f / 1024.0f) + 1e-6f);
                bf16_t* rowp = U + (size_t)r * ldu + col0;
#pragma unroll
                for (int bj = 0; bj < 2; ++bj) {
                    f32x4 v0 = acc[ai][bj][m][0] * rs, v1 = acc[ai][bj][m][1] * rs;
#pragma unroll
                    for (int e = 0; e < 4; ++e) { const float a = fmaxf(v0[e], 0.f), b = fmaxf(v1[e], 0.f); v0[e] = a * a; v1[e] = b * b; }
                    u32x4 w; w.x = cvt_pk_bf16(v0[0], v0[1]); w.y = cvt_pk_bf16(v0[2], v0[3]); w.z = cvt_pk_bf16(v1[0], v1[1]); w.w = cvt_pk_bf16(v1[2], v1[3]);
                    *(u32x4*)(rowp + bj * HALF) = w;
                }
            }
    }
};

template <class Epi, class Sched, bool ALIGN_EPI = false, bool SP2 = false>
__device__ __forceinline__ void gemm_phase(PG8_LAS unsigned char* lds, const Gemm g, const Sched& S, const Epi& E, const int tid_in) {
    int tid_ = tid_in; asm volatile("" : "+v"(tid_));
    const int tid = tid_, wid = __builtin_amdgcn_readfirstlane(tid >> 6), lane = tid & 63, wr = wid >> 2, wc = wid & 3, fr = lane & 15, fq = lane >> 4;
    const int K = g.K, nt = K / BK;
    unsigned voffA[2], voffB[2];
#pragma unroll
    for (int i = 0; i < 2; ++i) { int R, C; stage_rc(tid * 16 + i * 8192, R, C); const int Rb = Epi::PERM ? ((R & ~31) + perm32(R & 31)) : R;
        voffA[i] = (unsigned)(R * K + C) * 2u; voffB[i] = (unsigned)(Rb * K + C) * 2u; }
    const size_t kstep = (size_t)(BK * 2);
    const size_t hstep = (size_t)HALF * K * 2;
    const size_t tstep = 2 * hstep;
    const unsigned ldsw = (unsigned)wid * 1024u;
    const int aoff = lds_byte(wr * 64 + fr, fq * 8), boff = lds_byte(wc * 32 + fr, fq * 8);
#define PG8_SA(b, h) (((b) * 2 + (h)) * HTB)
#define PG8_SB(b, h) ((4 + (b) * 2 + (h)) * HTB)
#define PG8_STAGE(bufoff, gbase, voff) do { _Pragma("unroll") for (int _i = 0; _i < 2; ++_i) \
        __builtin_amdgcn_global_load_lds((const unsigned*)((const char*)(gbase) + (voff)[_i]), (PG8_LAS unsigned*)(lds + (bufoff) + ldsw + _i * 8192), 16, 0, 0); } while (0)
#define PG8_LDA(dst, b, h) do { _Pragma("unroll") for (int m = 0; m < 4; ++m) _Pragma("unroll") for (int k = 0; k < 2; ++k) dst[m][k] = *(const PG8_LAS bf16x8*)(lds + PG8_SA(b, h) + aoff + m * 2048 + k * 1024); } while (0)
#define PG8_LDB(dst, b, h) do { _Pragma("unroll") for (int n = 0; n < 2; ++n) _Pragma("unroll") for (int k = 0; k < 2; ++k) dst[n][k] = *(const PG8_LAS bf16x8*)(lds + PG8_SB(b, h) + boff + n * 2048 + k * 1024); } while (0)
#define PG8_MMA(ai, bj, At, Bt) do { __builtin_amdgcn_s_setprio(1); _Pragma("unroll") for (int m = 0; m < 4; ++m) _Pragma("unroll") for (int n = 0; n < 2; ++n) _Pragma("unroll") for (int k = 0; k < 2; ++k) \
        acc[ai][bj][m][n] = __builtin_amdgcn_mfma_f32_16x16x32_bf16(Bt[n][k], At[m][k], acc[ai][bj][m][n], 0, 0, 0); __builtin_amdgcn_s_setprio(0); } while (0)
#define PG8_WAIT_V(n) asm volatile("s_waitcnt vmcnt(" #n ")" ::: "memory")
#define PG8_WAIT_L(n) asm volatile("s_waitcnt lgkmcnt(" #n ")" ::: "memory")
#define PG8_BAR __builtin_amdgcn_s_barrier()
#define PG8_SCHED __builtin_amdgcn_sched_barrier(0)
    Unit cur, nxt; int ui = 0;
    if (!S.next(0, cur)) return;
    f32x4 acc[2][2][4][2];
#pragma unroll
    for (int a = 0; a < 2; ++a)
#pragma unroll
        for (int b = 0; b < 2; ++b)
#pragma unroll
            for (int m = 0; m < 4; ++m)
#pragma unroll
                for (int n = 0; n < 2; ++n) acc[a][b][m][n] = (f32x4){0.f, 0.f, 0.f, 0.f};
    bf16x8 At[4][2], B0[2][2], B1[2][2];
    const char* cA = (const char*)g.A + (size_t)cur.pm * tstep; const char* cB = (const char*)g.Bt + (size_t)cur.pn * tstep;
    S.a_ready(cur);
    if constexpr (SP2) {
        PG8_STAGE(PG8_SB(0, 0), cB, voffB); PG8_STAGE(PG8_SB(0, 1), cB + hstep, voffB); PG8_STAGE(PG8_SA(0, 0), cA, voffA); PG8_STAGE(PG8_SA(0, 1), cA + hstep, voffA);
        if (wr == 1) PG8_BAR;
        PG8_WAIT_V(2); PG8_BAR;
        PG8_STAGE(PG8_SB(1, 0), cB + kstep, voffB); PG8_STAGE(PG8_SA(1, 0), cA + kstep, voffA); PG8_STAGE(PG8_SB(1, 1), cB + hstep + kstep, voffB);
        PG8_WAIT_V(6); PG8_BAR;
    } else {
        PG8_STAGE(PG8_SB(0, 0), cB, voffB); PG8_STAGE(PG8_SA(0, 0), cA, voffA); PG8_STAGE(PG8_SB(0, 1), cB + hstep, voffB); PG8_STAGE(PG8_SA(0, 1), cA + hstep, voffA);
        if (wr == 1) PG8_BAR;
        PG8_WAIT_V(4); PG8_BAR;
        PG8_STAGE(PG8_SB(1, 0), cB + kstep, voffB); PG8_STAGE(PG8_SA(1, 0), cA + kstep, voffA); PG8_STAGE(PG8_SB(1, 1), cB + hstep + kstep, voffB);
        PG8_WAIT_V(6); PG8_BAR;
    }
    for (;;) {
        const bool has_next = S.next(ui + 1, nxt);
        const char* nA = has_next ? (const char*)g.A + (size_t)nxt.pm * tstep : cA; const char* nB = has_next ? (const char*)g.Bt + (size_t)nxt.pn * tstep : cB;
        for (int t = 0; t < nt; t += 2) {
            const bool last = (t == nt - 2);
            const char* a1 = cA + (size_t)(t + 1) * kstep;
            const char* a2 = last ? nA : cA + (size_t)(t + 2) * kstep; const char* b2 = last ? nB : cB + (size_t)(t + 2) * kstep;
            const char* a3 = a2 + kstep; const char* b3 = b2 + kstep;
            if (last && has_next) S.a_ready(nxt);
            if constexpr (SP2) {
            PG8_LDB(B0, 0, 0); PG8_LDB(B1, 0, 1); PG8_SCHED; PG8_LDA(At, 0, 0); PG8_STAGE(PG8_SA(1, 1), a1 + hstep, voffA);
            PG8_WAIT_V(8); PG8_WAIT_L(0); PG8_BAR; PG8_MMA(0, 0, At, B0); PG8_MMA(0, 1, At, B1); PG8_BAR; PG8_SCHED;
            PG8_LDA(At, 0, 1); PG8_STAGE(PG8_SB(0, 0), b2, voffB); PG8_STAGE(PG8_SB(0, 1), b2 + hstep, voffB); PG8_STAGE(PG8_SA(0, 0), a2, voffA);
            PG8_WAIT_V(8); PG8_WAIT_L(0); PG8_BAR; PG8_MMA(1, 0, At, B0); PG8_MMA(1, 1, At, B1); PG8_BAR; PG8_SCHED;
            PG8_LDB(B0, 1, 0); PG8_LDB(B1, 1, 1); PG8_SCHED; PG8_LDA(At, 1, 0); PG8_STAGE(PG8_SA(0, 1), a2 + hstep, voffA);
            PG8_WAIT_V(8); PG8_WAIT_L(0); PG8_BAR; PG8_MMA(0, 0, At, B0); PG8_MMA(0, 1, At, B1); PG8_BAR; PG8_SCHED;
            PG8_LDA(At, 1, 1); PG8_STAGE(PG8_SB(1, 0), b3, voffB); PG8_STAGE(PG8_SB(1, 1), b3 + hstep, voffB); PG8_STAGE(PG8_SA(1, 0), a3, voffA);
            PG8_WAIT_V(8); PG8_WAIT_L(0); PG8_BAR; PG8_MMA(1, 0, At, B0); PG8_MMA(1, 1, At, B1); PG8_BAR; PG8_SCHED;
            } else {
            PG8_LDB(B0, 0, 0); PG8_SCHED; PG8_LDA(At, 0, 0); PG8_STAGE(PG8_SA(1, 1), a1 + hstep, voffA);
            PG8_WAIT_L(8); PG8_BAR; PG8_WAIT_L(0); PG8_MMA(0, 0, At, B0); PG8_BAR; PG8_SCHED;
            PG8_LDB(B1, 0, 1); PG8_STAGE(PG8_SB(0, 0), b2, voffB);
            PG8_BAR; PG8_WAIT_L(0); PG8_MMA(0, 1, At, B1); PG8_BAR;
            PG8_LDA(At, 0, 1); PG8_STAGE(PG8_SA(0, 0), a2, voffA);
            PG8_BAR; PG8_WAIT_L(0); PG8_MMA(1, 0, At, B0); PG8_BAR; PG8_SCHED;
            PG8_STAGE(PG8_SB(0, 1), b2 + hstep, voffB);
            PG8_WAIT_V(6); PG8_BAR; PG8_MMA(1, 1, At, B1); PG8_BAR;
            PG8_LDB(B0, 1, 0); PG8_SCHED; PG8_LDA(At, 1, 0); PG8_STAGE(PG8_SA(0, 1), a2 + hstep, voffA);
            PG8_WAIT_L(8); PG8_BAR; PG8_WAIT_L(0); PG8_MMA(0, 0, At, B0); PG8_BAR; PG8_SCHED;
            PG8_LDB(B1, 1, 1); PG8_STAGE(PG8_SB(1, 0), b3, voffB);
            PG8_BAR; PG8_WAIT_L(0); PG8_MMA(0, 1, At, B1); PG8_BAR;
            PG8_LDA(At, 1, 1); PG8_STAGE(PG8_SA(1, 0), a3, voffA);
            PG8_BAR; PG8_WAIT_L(0); PG8_MMA(1, 0, At, B0); PG8_BAR; PG8_SCHED;
            PG8_STAGE(PG8_SB(1, 1), b3 + hstep, voffB);
            PG8_WAIT_V(6); PG8_BAR; PG8_MMA(1, 1, At, B1); PG8_BAR;
            }
        }
        if constexpr (ALIGN_EPI) { if (wr == 0) PG8_BAR; }
        if constexpr (!Epi::AFTER_DRAIN) { E(acc, cur, wr, wc, fr, fq); S.done(cur); }
        if (!has_next) break;
#pragma unroll
        for (int a = 0; a < 2; ++a)
#pragma unroll
            for (int b = 0; b < 2; ++b)
#pragma unroll
                for (int m = 0; m < 4; ++m)
#pragma unroll
                    for (int n = 0; n < 2; ++n) acc[a][b][m][n] = (f32x4){0.f, 0.f, 0.f, 0.f};
        cur = nxt; cA = nA; cB = nB; ++ui;
        if constexpr (ALIGN_EPI) { if (wr == 1) PG8_BAR; }
    }
    PG8_WAIT_V(0);
    if constexpr (!ALIGN_EPI) { if (wr == 0) PG8_BAR; }
    PG8_BAR;
    if constexpr (Epi::AFTER_DRAIN) { E.fused(acc, cur, wr, wc, fr, fq, lds, wid, lane); S.done(cur); }
#undef PG8_SA
#undef PG8_SB
#undef PG8_STAGE
#undef PG8_LDA
#undef PG8_LDB
#undef PG8_MMA
#undef PG8_WAIT_V
#undef PG8_WAIT_L
#undef PG8_BAR
#undef PG8_SCHED
}
}


#define LAS __attribute__((address_space(3)))
typedef unsigned short bf16_t;
typedef short bf16x8 __attribute__((ext_vector_type(8)));
typedef short s16x4 __attribute__((ext_vector_type(4)));
typedef short v4i16_t __attribute__((ext_vector_type(4)));
typedef float f32x4 __attribute__((ext_vector_type(4)));
typedef float f32x2 __attribute__((ext_vector_type(2)));
typedef float f32x16 __attribute__((ext_vector_type(16)));
typedef unsigned u32x4 __attribute__((ext_vector_type(4)));
typedef unsigned u32x2 __attribute__((ext_vector_type(2)));

constexpr int DM = 1024, NB = 8, SEQ = 2048, MP = NB * SEQ, SL = 32, MS = NB * SL, MT = MP + MS;
constexpr int PS = 3840, DFF = 4096, INCOLS = 3600;
constexpr int C_QA = 0, C_KA = 256, C_VA = 512, C_GA = 768, C_QB = 1024, C_KB = 1280, C_VB = 1536, C_GB = 1792, C_QC = 2048, C_KC = 2560, C_VC = 3072, C_LOW = 3584;
constexpr int NREL = 320;
constexpr float EPS = 1e-6f;
constexpr size_t WS_A = 0;
constexpr size_t WS_B = WS_A + (size_t)MT * DFF * 2;
constexpr size_t WS_C = WS_B + (size_t)MT * DM * 2;
constexpr size_t WS_WIN = WS_C + (size_t)MT * DM * 2;
constexpr size_t WS_WOUT = WS_WIN + (size_t)2 * PS * DM * 2;
constexpr size_t WS_WUP = WS_WOUT + (size_t)2 * DM * DM * 2;
constexpr size_t WS_WDN = WS_WUP + (size_t)2 * DFF * DM * 2;
constexpr size_t WS_LOWF = WS_WDN + (size_t)2 * DFF * DM * 2;
constexpr size_t WS_SS = WS_LOWF + (size_t)MT * 16 * 4;
constexpr size_t WS_G = WS_SS + (size_t)5 * MT * 4;
constexpr size_t WS_ROPE = WS_G + (size_t)1024 * 64 * 4;
constexpr size_t WS_CTL = WS_ROPE + (size_t)2080 * 64 * 4;
constexpr size_t CTL_BYTES = 16384;
constexpr size_t WS_END = WS_CTL + CTL_BYTES;
static_assert((size_t)2048 * 4096 * 4 <= (size_t)MT * DM * 2, "KVT fits region C");
constexpr size_t WS_CKB = WS_A + (size_t)MT * PS * 2;
constexpr size_t CACHE_ELEMS = (size_t)8 * 512 * 512;
static_assert(WS_CKB + 2 * CACHE_ELEMS * 2 <= WS_B, "cache copies fit behind PROJ");
static_assert(WS_END <= (size_t)256 * 1024 * 1024, "d_ws map");
constexpr size_t O_Y = 0, O_RETP = (size_t)MT * DM, O_GLAP = O_RETP + 262144, O_KP = O_GLAP + 262144, O_VP = O_KP + 4194304, O_RETS = O_VP + 4194304, O_GLAS = O_RETS + 262144,
                 O_KS = O_GLAS + 262144, O_VS = O_KS + 262144, O_END = O_VS + 262144;
constexpr int TS = 144;
constexpr int TILE_B = 64 * TS;
constexpr int WAVE_LDS = 2 * TILE_B;
constexpr int LDS_BIAS = 8 * WAVE_LDS;
constexpr int NREV = 384;
constexpr int LDS_BARST = LDS_BIAS + 8 * NREV * 4;
constexpr int LDS_BYTES = LDS_BARST + 16;
static_assert(LDS_BYTES <= 160 * 1024 && pg8::STAGE_BYTES <= LDS_BIAS, "LDS map");

struct Params { const float* in[18]; float* out; unsigned char* ws; };
__device__ __forceinline__ int lane_id_asm() { int l; asm volatile("v_mbcnt_lo_u32_b32 %0, -1, 0\n\tv_mbcnt_hi_u32_b32 %0, -1, %0" : "=v"(l)); return l; }
typedef const __attribute__((address_space(4))) char* kaptr_t;
__device__ __forceinline__ kaptr_t karg_base() { kaptr_t ka = (kaptr_t)__builtin_amdgcn_kernarg_segment_ptr(); asm volatile("" : "+s"(ka)); return ka; }
__device__ __forceinline__ const float* in_ptr(int i) { return *(const float* const __attribute__((address_space(4)))*)(karg_base() + 8 * i); }
__device__ __forceinline__ float* out_ptr() { return *(float* const __attribute__((address_space(4)))*)(karg_base() + 8 * 18); }
__device__ __forceinline__ unsigned char* ws_ptr() { return *(unsigned char* const __attribute__((address_space(4)))*)(karg_base() + 8 * 19); }

typedef float f32x2_t __attribute__((ext_vector_type(2))); typedef __bf16 bf16x2_t __attribute__((ext_vector_type(2)));
__device__ __forceinline__ unsigned pk2(float lo, float hi) { const f32x2_t v = {lo, hi}; const bf16x2_t b = __builtin_convertvector(v, bf16x2_t); return __builtin_bit_cast(unsigned, b); }
__device__ __forceinline__ float bflo(unsigned u) { return __uint_as_float(u << 16); }
__device__ __forceinline__ float bfhi(unsigned u) { return __uint_as_float(u & 0xffff0000u); }
__device__ __forceinline__ float bf2f(bf16_t h) { return __uint_as_float((unsigned)h << 16); }
__device__ __forceinline__ bf16_t f2bf(float f) { return (bf16_t)(pk2(f, 0.f) & 0xffffu); }
__device__ __forceinline__ int crow(int r, int hi) { return (r & 3) + 8 * (r >> 2) + 4 * hi; }
__device__ __forceinline__ float silu(float x) { return x / (1.0f + __expf(-x)); }
__device__ __forceinline__ f32x16 mfma32(bf16x8 a, bf16x8 b, f32x16 c) { return __builtin_amdgcn_mfma_f32_32x32x16_bf16(a, b, c, 0, 0, 0); }
__device__ __forceinline__ bf16x8 as_bf16x8(u32x4 v) { return __builtin_bit_cast(bf16x8, v); }
__device__ __forceinline__ f32x16 zero16() { f32x16 z;
#pragma unroll
    for (int i = 0; i < 16; ++i) z[i] = 0.f; return z; }
__device__ __forceinline__ s16x4 ds_tr(LAS const unsigned char* p) { return __builtin_bit_cast(s16x4, __builtin_amdgcn_ds_read_tr16_b64_v4i16((LAS v4i16_t*)p)); }
__device__ __forceinline__ bf16x8 tr_nat(LAS const unsigned char* tile, int k0, int cb, int lane) {
    const int kq = lane >> 5, g = (lane >> 4) & 1, q = (lane & 15) >> 2, p = lane & 3;
    LAS const unsigned char* a = tile + (k0 + 8 * kq + q) * TS + (cb + 16 * g + 4 * p) * 2;
    const s16x4 lo = ds_tr(a), hi = ds_tr(a + 4 * TS);
    return (bf16x8){lo[0], lo[1], lo[2], lo[3], hi[0], hi[1], hi[2], hi[3]};
}
template <int STR = TS> __device__ __forceinline__ bf16x8 tr_perm(LAS const unsigned char* tile, int k0, int cb, int lane) {
    const int kq = lane >> 5, g = (lane >> 4) & 1, q = (lane & 15) >> 2, p = lane & 3;
    LAS const unsigned char* a = tile + (k0 + 4 * kq + q) * STR + (cb + 16 * g + 4 * p) * 2;
    const s16x4 lo = ds_tr(a), hi = ds_tr(a + 8 * STR);
    return (bf16x8){lo[0], lo[1], lo[2], lo[3], hi[0], hi[1], hi[2], hi[3]};
}
__device__ __forceinline__ bf16x8 tr_perm_swz(LAS const unsigned char* tile, int k0, int cb, int lane) {
    const int kq = lane >> 5, g = (lane >> 4) & 1, q = (lane & 15) >> 2, p = lane & 3;
    const int row = k0 + 4 * kq + q, ob = ((cb + 16 * g + 4 * p) * 2) ^ ((row & 2) << 5);
    LAS const unsigned char* a = tile + row * 128 + ob;
    const s16x4 lo = ds_tr(a), hi = ds_tr(a + 8 * 128);
    return (bf16x8){lo[0], lo[1], lo[2], lo[3], hi[0], hi[1], hi[2], hi[3]};
}
__device__ __forceinline__ bf16x8 row_frag(LAS const unsigned char* tile, int r0, int ks, int lane) {
    return *(LAS const bf16x8*)(tile + (r0 + (lane & 31)) * TS + (16 * ks + 8 * (lane >> 5)) * 2);
}
__device__ __forceinline__ bf16x8 pack_step(const f32x16& x, int s) {
    u32x4 w; w.x = pk2(x[8 * s + 0], x[8 * s + 1]); w.y = pk2(x[8 * s + 2], x[8 * s + 3]); w.z = pk2(x[8 * s + 4], x[8 * s + 5]); w.w = pk2(x[8 * s + 6], x[8 * s + 7]);
    return as_bf16x8(w);
}
__device__ __forceinline__ void load_tile(LAS unsigned char* tile, const bf16_t* src, int pitch, int nvalid, int lane) {
#pragma unroll
    for (int it = 0; it < 8; ++it) {
        const int id = it * 64 + lane, row = id >> 3, ch = id & 7;
        u32x4 v = (u32x4){0u, 0u, 0u, 0u};
        if (row < nvalid) v = *(const u32x4*)(src + (size_t)row * pitch + ch * 8);
        *(LAS u32x4*)(tile + row * TS + ch * 16) = v;
    }
}
__device__ __forceinline__ void store_tile(LAS const unsigned char* tile, bf16_t* dst, int pitch, int nvalid, int lane) {
#pragma unroll
    for (int it = 0; it < 8; ++it) {
        const int id = it * 64 + lane, row = id >> 3, ch = id & 7;
        const u32x4 v = *(LAS const u32x4*)(tile + row * TS + ch * 16);
        if (row < nvalid) *(u32x4*)(dst + (size_t)row * pitch + ch * 8) = v;
    }
}
__device__ __forceinline__ void load_tile_f32(LAS unsigned char* tile, const float* src, int pitch, int lane) {
#pragma unroll
    for (int it = 0; it < 16; ++it) {
        const int id = it * 64 + lane, row = id >> 4, c4 = id & 15;
        const f32x4 v = *(const f32x4*)(src + (size_t)row * pitch + c4 * 4);
        u32x2 w; w.x = pk2(v[0], v[1]); w.y = pk2(v[2], v[3]);
        *(LAS u32x2*)(tile + row * TS + c4 * 8) = w;
    }
}
__device__ __forceinline__ void load_rot(const bf16_t* rp, const float* cs, int kq, float scale, bool valid, bf16x8 (&fr)[4]) {
    u32x4 c[4];
#pragma unroll
    for (int ks = 0; ks < 4; ++ks) c[ks] = valid ? *(const u32x4*)(rp + 16 * ks + 8 * kq) : (u32x4){0u, 0u, 0u, 0u};
#pragma unroll
    for (int g = 0; g < 2; ++g) {
        const float* cp = cs + 16 * g + 8 * kq;
        const f32x4 ca = *(const f32x4*)cp, cb = *(const f32x4*)(cp + 4), sa = *(const f32x4*)(cp + 32), sb = *(const f32x4*)(cp + 36);
        float o1[8], o2[8];
#pragma unroll
        for (int e = 0; e < 8; ++e) {
            const unsigned w1 = c[g][e >> 1], w2 = c[g + 2][e >> 1];
            const float x1 = (e & 1) ? bfhi(w1) : bflo(w1), x2 = (e & 1) ? bfhi(w2) : bflo(w2);
            const float cc = (e < 4) ? ca[e & 3] : cb[e & 3], sn = (e < 4) ? sa[e & 3] : sb[e & 3];
            o1[e] = (x1 * cc - x2 * sn) * scale; o2[e] = (x1 * sn + x2 * cc) * scale;
        }
        u32x4 a, b;
        a.x = pk2(o1[0], o1[1]); a.y = pk2(o1[2], o1[3]); a.z = pk2(o1[4], o1[5]); a.w = pk2(o1[6], o1[7]);
        b.x = pk2(o2[0], o2[1]); b.y = pk2(o2[2], o2[3]); b.z = pk2(o2[4], o2[5]); b.w = pk2(o2[6], o2[7]);
        fr[g] = as_bf16x8(a); fr[g + 2] = as_bf16x8(b);
    }
}

struct Ctx {
    int l, lane, kq, li;
    const bf16_t* proj; const float* lowf; const float* rope; bf16_t* cat; float* kvt; float* gdec; float* out;
    const float* wa2; const float* ba; const float* nw; const float* st; const bf16_t* ckb; const bf16_t* cvb;
};
__device__ __forceinline__ float ret_lg2(int h) { return __log2f(1.0f - exp2f(-5.0f - (float)h)); }

struct GlaGate {
    f32x4 lw[4]; float w[16]; float bias, run;
    template <int L> __device__ __forceinline__ void init(const Ctx& C, int m0, int h) {
#pragma unroll
        for (int q = 0; q < 4; ++q) lw[q] = (C.lane < L) ? *(const f32x4*)(C.lowf + (size_t)(m0 + C.lane) * 16 + 4 * q) : (f32x4){0.f, 0.f, 0.f, 0.f};
#pragma unroll
        for (int j = 0; j < 16; ++j) w[j] = C.wa2[j * 256 + h * 64 + C.lane];
        bias = C.ba[h * 64 + C.lane]; run = 0.f;
    }
    __device__ __forceinline__ float step(int s) {
        float z0 = bias, z1 = 0.f;
#pragma unroll
        for (int j = 0; j < 16; j += 2) {
            z0 += __int_as_float(__builtin_amdgcn_readlane(__float_as_int(lw[j >> 2][j & 3]), s)) * w[j];
            z1 += __int_as_float(__builtin_amdgcn_readlane(__float_as_int(lw[(j + 1) >> 2][(j + 1) & 3]), s)) * w[j + 1];
        }
        const float z = z0 + z1;
        const float lf = fminf(z, 0.f) - __logf(1.0f + __expf(-fabsf(z)));
        run += lf * (1.0f / 16.0f);
        return run;
    }
};

template <bool SAMPLE> __device__ __forceinline__ void kv_local(const Ctx& C, int type, int b, int n, int h, LAS unsigned char* wl) {
    constexpr int L = SAMPLE ? 32 : 64, NKS = L / 16;
    const int m0 = SAMPLE ? MP + b * SL : b * SEQ + n * 64;
    const int pidx0 = SAMPLE ? 2048 : n * 64;
    LAS unsigned char* tK = wl; LAS unsigned char* tV = wl + TILE_B;
    const int lane = C.lane, kq = C.kq, li = C.li;
    float gdk = 0.f;
    if (type == 0) {
        const float lg = ret_lg2(h);
#pragma unroll
        for (int rb = 0; rb < L / 32; ++rb) {
            const int s = 32 * rb + li;
            bf16x8 fr[4];
            load_rot(C.proj + (size_t)(m0 + s) * PS + C_KA + h * 64, C.rope + (size_t)(pidx0 + s) * 64, kq, 0.125f * __builtin_amdgcn_exp2f(lg * (float)(L - 1 - s)), true, fr);
#pragma unroll
            for (int ks = 0; ks < 4; ++ks) *(LAS bf16x8*)(tK + s * TS + (16 * ks + 8 * kq) * 2) = fr[ks];
        }
        load_tile(tV, C.proj + (size_t)m0 * PS + C_VA + h * 64, PS, L, lane);
    } else {
        load_tile(tK, C.proj + (size_t)m0 * PS + C_KB + h * 64, PS, L, lane);
        GlaGate gg; gg.init<L>(C, m0, h);
        if (!SAMPLE) {
            load_tile(tV, C.proj + (size_t)m0 * PS + C_QB + h * 64, PS, L, lane);
#pragma unroll 4
            for (int s = 0; s < L; ++s) {
                const float e = __expf(gg.step(s));
                LAS bf16_t* kp = (LAS bf16_t*)(tK + s * TS + lane * 2); LAS bf16_t* qp = (LAS bf16_t*)(tV + s * TS + lane * 2);
                *kp = f2bf(bf2f(*kp) / e); *qp = f2bf(bf2f(*qp) * 0.125f * e);
            }
            asm volatile("s_waitcnt lgkmcnt(0)" ::: "memory");
            store_tile(tV, (bf16_t*)C.proj + (size_t)m0 * PS + C_QB + h * 64, PS, L, lane);
            store_tile(tK, (bf16_t*)C.proj + (size_t)m0 * PS + C_KB + h * 64, PS, L, lane);
            asm volatile("s_waitcnt lgkmcnt(0)" ::: "memory");
            load_tile(tV, C.proj + (size_t)m0 * PS + C_VB + h * 64, PS, L, lane);
        } else {
            load_tile(tV, C.proj + (size_t)m0 * PS + C_VB + h * 64, PS, L, lane);
#pragma unroll 4
            for (int s = 0; s < L; ++s) {
                const float bs = gg.step(s);
                LAS bf16_t* kp = (LAS bf16_t*)(tK + s * TS + lane * 2);
                *kp = f2bf(bf2f(*kp) * __expf(-bs));
            }
        }
        gdk = __expf(gg.run);
    }
    f32x16 kv[2][2];
#pragma unroll
    for (int db = 0; db < 2; ++db)
#pragma unroll
        for (int kb = 0; kb < 2; ++kb) kv[db][kb] = zero16();
#pragma unroll
    for (int ks = 0; ks < NKS; ++ks) {
        bf16x8 a[2], bb[2];
#pragma unroll
        for (int db = 0; db < 2; ++db) a[db] = tr_nat(tV, 16 * ks, 32 * db, lane);
#pragma unroll
        for (int kb = 0; kb < 2; ++kb) bb[kb] = tr_nat(tK, 16 * ks, 32 * kb, lane);
#pragma unroll
        for (int db = 0; db < 2; ++db)
#pragma unroll
            for (int kb = 0; kb < 2; ++kb) kv[db][kb] = mfma32(a[db], bb[kb], kv[db][kb]);
    }
    if (type == 1) {
#pragma unroll
        for (int kb = 0; kb < 2; ++kb) { const float cs = __int_as_float(__builtin_amdgcn_ds_bpermute((32 * kb + li) * 4, __float_as_int(gdk)));
#pragma unroll
            for (int db = 0; db < 2; ++db) kv[db][kb] = kv[db][kb] * cs; }
    }
    if (!SAMPLE) {
        const int uidx = ((type * 8 + b) * 4 + h) * 32 + n;
        bf16_t* dst = (bf16_t*)C.kvt + (size_t)uidx * 4096;
#pragma unroll
        for (int db = 0; db < 2; ++db)
#pragma unroll
            for (int kb = 0; kb < 2; ++kb)
#pragma unroll
                for (int r = 0; r < 16; ++r) dst[(32 * db + crow(r, kq)) * 64 + 32 * kb + li] = f2bf(kv[db][kb][r]);
        if (type == 1) C.gdec[(size_t)(((b * 4 + h) * 32 + n)) * 64 + lane] = gdk;
    } else {
        const float* s0 = C.st + (size_t)((C.l * 8 + b) * 4 + h) * 4096;
        float* so = C.out + (type == 0 ? O_RETS : O_GLAS) + (size_t)((C.l * 8 + b) * 4 + h) * 4096;
        const float dret = exp2f(ret_lg2(h) * (float)L);
#pragma unroll
        for (int kb = 0; kb < 2; ++kb) {
            const int dk = 32 * kb + li;
            const float dec = (type == 0) ? dret : __int_as_float(__builtin_amdgcn_ds_bpermute(dk * 4, __float_as_int(gdk)));
#pragma unroll
            for (int db = 0; db < 2; ++db)
#pragma unroll
                for (int rr = 0; rr < 4; ++rr) {
                    const int dv = 32 * db + 8 * rr + 4 * kq;
                    const f32x4 o = *(const f32x4*)(s0 + dk * 64 + dv);
                    f32x4 nv;
#pragma unroll
                    for (int e = 0; e < 4; ++e) nv[e] = dec * o[e] + kv[db][kb][4 * rr + e];
                    *(f32x4*)(so + dk * 64 + dv) = nv;
                }
        }
    }
}

template <bool SAMPLE> __device__ __forceinline__ void mix_out(const Ctx& C, int type, int b, int n, int h, LAS unsigned char* wl) {
    constexpr int L = SAMPLE ? 32 : 64, NTB = L / 32;
    const int m0 = SAMPLE ? MP + b * SL : b * SEQ + n * 64;
    const int pidx0 = SAMPLE ? 2048 : n * 64;
    LAS unsigned char* t0 = wl; LAS unsigned char* t1 = wl + TILE_B;
    const int lane = C.lane, kq = C.kq, li = C.li;
    bf16x8 qfr[NTB][4];
    const float lg = ret_lg2(h);
    if (type == 0) {
#pragma unroll
        for (int tb = 0; tb < NTB; ++tb) {
            const int s = 32 * tb + li;
            load_rot(C.proj + (size_t)(m0 + s) * PS + C_QA + h * 64, C.rope + (size_t)(pidx0 + s) * 64, kq, __builtin_amdgcn_exp2f(lg * (float)(s + 1)), true, qfr[tb]);
        }
        load_tile(t0, C.proj + (size_t)m0 * PS + C_VA + h * 64, PS, L, lane);
    } else {
        load_tile(t0, C.proj + (size_t)m0 * PS + C_QB + h * 64, PS, L, lane);
        load_tile(t1, C.proj + (size_t)m0 * PS + C_KB + h * 64, PS, L, lane);
        if (SAMPLE) {
            GlaGate gg; gg.init<L>(C, m0, h);
#pragma unroll 4
            for (int s = 0; s < L; ++s) {
                const float e = __expf(gg.step(s));
                LAS bf16_t* qp = (LAS bf16_t*)(t0 + s * TS + lane * 2); LAS bf16_t* kp = (LAS bf16_t*)(t1 + s * TS + lane * 2);
                *qp = f2bf(bf2f(*qp) * 0.125f * e); *kp = f2bf(bf2f(*kp) / e);
            }
        }
        __builtin_amdgcn_sched_barrier(0);
#pragma unroll
        for (int tb = 0; tb < NTB; ++tb)
#pragma unroll
            for (int ks = 0; ks < 4; ++ks) qfr[tb][ks] = row_frag(t0, 32 * tb, ks, lane);
        asm volatile("s_waitcnt lgkmcnt(0)" ::: "memory");
        __builtin_amdgcn_sched_barrier(0);
        load_tile(t0, C.proj + (size_t)m0 * PS + C_VB + h * 64, PS, L, lane);
    }
    __builtin_amdgcn_sched_barrier(0);
    f32x16 o[2][NTB];
#pragma unroll
    for (int db = 0; db < 2; ++db)
#pragma unroll
        for (int tb = 0; tb < NTB; ++tb) o[db][tb] = zero16();
    {
        const int uidx = ((type * 8 + b) * 4 + h) * 32 + n;
        const bf16_t* sT = (const bf16_t*)C.kvt + (size_t)uidx * 4096;
        const float* s0 = C.st + (size_t)((C.l * 8 + b) * 4 + h) * 4096;
#pragma unroll
        for (int db = 0; db < 2; ++db)
#pragma unroll
            for (int ks = 0; ks < 4; ++ks) {
                const int dv = 32 * db + li, dk0 = 16 * ks + 8 * kq;
                bf16x8 sa;
                if (!SAMPLE) sa = as_bf16x8(*(const u32x4*)(sT + dv * 64 + dk0));
                else { float sv[8];
#pragma unroll
                    for (int e = 0; e < 8; ++e) sv[e] = s0[(dk0 + e) * 64 + dv];
                    u32x4 w; w.x = pk2(sv[0], sv[1]); w.y = pk2(sv[2], sv[3]); w.z = pk2(sv[4], sv[5]); w.w = pk2(sv[6], sv[7]);
                    sa = as_bf16x8(w); }
#pragma unroll
                for (int tb = 0; tb < NTB; ++tb) o[db][tb] = mfma32(sa, qfr[tb][ks], o[db][tb]);
            }
    }
    __builtin_amdgcn_sched_barrier(0);
#pragma unroll
    for (int sb = 0; sb < NTB; ++sb) {
        bf16x8 kfr[4];
        if (type == 0) load_rot(C.proj + (size_t)(m0 + 32 * sb + li) * PS + C_KA + h * 64, C.rope + (size_t)(pidx0 + 32 * sb + li) * 64, kq, 0.125f * __builtin_amdgcn_exp2f(-lg * (float)(32 * sb + li + 1)), true, kfr);
        else {
#pragma unroll
            for (int ks = 0; ks < 4; ++ks) kfr[ks] = row_frag(t1, 32 * sb, ks, lane);
        }
        f32x16 st[NTB];
#pragma unroll
        for (int tb = sb; tb < NTB; ++tb) {
            f32x16 a = zero16();
#pragma unroll
            for (int ks = 0; ks < 4; ++ks) a = mfma32(kfr[ks], qfr[tb][ks], a);
#pragma unroll
            for (int r = 0; r < 16; ++r) {
                const int s = 32 * sb + crow(r, kq), t = 32 * tb + li;
                a[r] = (t >= s) ? a[r] : 0.0f;
            }
            st[tb] = a;
        }
#pragma unroll
        for (int half = 0; half < 2; ++half) {
            bf16x8 va[2];
#pragma unroll
            for (int db = 0; db < 2; ++db) va[db] = tr_perm(t0, 32 * sb + 16 * half, 32 * db, lane);
#pragma unroll
            for (int tb = sb; tb < NTB; ++tb) {
                const bf16x8 pf = pack_step(st[tb], half);
#pragma unroll
                for (int db = 0; db < 2; ++db) o[db][tb] = mfma32(va[db], pf, o[db][tb]);
            }
        }
        __builtin_amdgcn_sched_barrier(0);
    }
    const float* nw = C.nw + h * 64;
    const int gcol = (type == 0 ? C_GA : C_GB) + h * 64;
#pragma unroll
    for (int tb = 0; tb < NTB; ++tb) {
        const int t = 32 * tb + li;
        float s1 = 0.f, s2 = 0.f;
#pragma unroll
        for (int db = 0; db < 2; ++db)
#pragma unroll
            for (int r = 0; r < 16; ++r) { const float x = o[db][tb][r]; s1 += x; s2 += x * x; }
        s1 += __shfl_xor(s1, 32); s2 += __shfl_xor(s2, 32);
        float mu = 0.f, rstd;
        if (type == 0) { mu = s1 * (1.0f / 64.0f); const float var = fmaxf(s2 * (1.0f / 64.0f) - mu * mu, 0.f); rstd = 1.0f / sqrtf(var + EPS); }
        else rstd = 1.0f / sqrtf(s2 * (1.0f / 64.0f) + EPS);
        const bf16_t* grow = C.proj + (size_t)(m0 + t) * PS + gcol;
        bf16_t* orow = C.cat + (size_t)(m0 + t) * DM + type * 256 + h * 64;
#pragma unroll
        for (int db = 0; db < 2; ++db)
#pragma unroll
            for (int rr = 0; rr < 4; ++rr) {
                const int dv = 32 * db + 8 * rr + 4 * kq;
                const u32x2 gw = *(const u32x2*)(grow + dv);
                const f32x4 wv = *(const f32x4*)(nw + dv);
                const float g0 = bflo(gw.x), g1 = bfhi(gw.x), g2 = bflo(gw.y), g3 = bfhi(gw.y);
                const float y0 = (o[db][tb][4 * rr + 0] - mu) * rstd * wv[0] * silu(g0), y1 = (o[db][tb][4 * rr + 1] - mu) * rstd * wv[1] * silu(g1);
                const float y2 = (o[db][tb][4 * rr + 2] - mu) * rstd * wv[2] * silu(g2), y3 = (o[db][tb][4 * rr + 3] - mu) * rstd * wv[3] * silu(g3);
                u32x2 w; w.x = pk2(y0, y1); w.y = pk2(y2, y3);
                *(u32x2*)(orow + dv) = w;
            }
    }
}

template <bool SAMPLE> __device__ __forceinline__ void attn_wave(const Ctx& C, int b, int n, int h, LAS unsigned char* wl, LAS const float* revT, float cb2) {
    constexpr int NTB = SAMPLE ? 1 : 2;
    constexpr float SC = 0.125f * 1.4426950408889634f;
    const int m0 = SAMPLE ? MP + b * SL : b * SEQ + n * 64;
    const int lane = C.lane, kq = C.kq, li = C.li;
    const int jt0 = SAMPLE ? 0 : (n < 8 ? 8 - n : 0);
#define ATT_SRC(jt, kp, vp, pitch, rmask) const bf16_t* kp; const bf16_t* vp; int pitch; int rmask = 63; \
    if (SAMPLE && (jt) < 8) { kp = C.ckb + (size_t)(b * 512 + 64 * (jt)) * 512 + h * 64; vp = C.cvb + (size_t)(b * 512 + 64 * (jt)) * 512 + h * 64; pitch = 512; } \
    else { const int kr0 = SAMPLE ? m0 : b * SEQ + (n - 8 + (jt)) * 64; kp = C.proj + (size_t)kr0 * PS + C_KC + h * 64; vp = kp + (C_VC - C_KC); pitch = PS; if (SAMPLE) rmask = 31; }
#define ATT_ISSUE(jt, kdst, vbuf) do { ATT_SRC(jt, kp_, vp_, pitch_, rmask_); \
    _Pragma("unroll") for (int sb = 0; sb < 2; ++sb) _Pragma("unroll") for (int ks = 0; ks < 4; ++ks) kdst[sb][ks] = *(const u32x4*)(kp_ + (size_t)((32 * sb + li) & rmask_) * pitch_ + 16 * ks + 8 * kq); \
    _Pragma("unroll") for (int it = 0; it < 8; ++it) __builtin_amdgcn_global_load_lds((const unsigned*)(vp_ + (size_t)((it * 8 + (lane >> 3)) & rmask_) * pitch_ + (((lane & 7) ^ (((lane >> 3) & 2) << 1)) * 8)), (LAS unsigned*)((vbuf) + it * 1024), 16, 0, 0); } while (0)
    bf16x8 qfr[NTB][4];
#pragma unroll
    for (int tb = 0; tb < NTB; ++tb)
#pragma unroll
        for (int ks = 0; ks < 4; ++ks) qfr[tb][ks] = as_bf16x8(*(const u32x4*)(C.proj + (size_t)(m0 + 32 * tb + li) * PS + C_QC + h * 64 + 16 * ks + 8 * kq));
    f32x16 o[2][NTB]; float mrun[NTB], lrun[NTB];
#pragma unroll
    for (int tb = 0; tb < NTB; ++tb) { mrun[tb] = -1e30f; lrun[tb] = 0.f;
#pragma unroll
        for (int db = 0; db < 2; ++db) o[db][tb] = zero16(); }
    u32x4 kcur[2][4], knext[2][4];
    ATT_ISSUE(jt0, kcur, wl + ((jt0 & 1) ? TILE_B : 0));
    for (int jt = jt0; jt <= 8; ++jt) {
        asm volatile("s_waitcnt vmcnt(0)" ::: "memory");
        __builtin_amdgcn_sched_barrier(0);
        LAS unsigned char* tV = wl + ((jt & 1) ? TILE_B : 0);
        if (jt < 8) { ATT_ISSUE(jt + 1, knext, wl + (((jt + 1) & 1) ? TILE_B : 0)); }
        __builtin_amdgcn_sched_barrier(0);
        const bool cst = jt <= 3;
#pragma unroll
        for (int sb = 0; sb < 2; ++sb) {
            if (SAMPLE && jt == 8 && sb == 1) continue;
#pragma unroll
            for (int tb = 0; tb < NTB; ++tb) {
                f32x16 a = zero16();
#pragma unroll
                for (int ks = 0; ks < 4; ++ks) a = mfma32(as_bf16x8(kcur[sb][ks]), qfr[tb][ks], a);
                if (!cst) {
                    const int dbase = (8 - jt) * 64 + 63 + 32 * tb + li - 32 * sb;
                    LAS const float* rp = revT + (382 - dbase + 4 * kq);
#pragma unroll
                    for (int r = 0; r < 16; ++r) a[r] = a[r] * SC + rp[(r & 3) + 8 * (r >> 2)];
                }
                float mx = -1e30f;
#pragma unroll
                for (int r = 0; r < 16; ++r) mx = fmaxf(mx, a[r]);
                if (cst) mx = mx * SC + cb2;
                mx = fmaxf(mx, __shfl_xor(mx, 32));
                const float mnew = fmaxf(mrun[tb], mx);
                const bool moved = __builtin_amdgcn_ballot_w64(mnew != mrun[tb]) != 0ull;
                const float alpha = __builtin_amdgcn_exp2f(mrun[tb] - mnew);
                mrun[tb] = mnew;
                float ps = 0.f;
                if (cst) { const float off = cb2 - mnew;
#pragma unroll
                    for (int r = 0; r < 16; ++r) { const float pp = __builtin_amdgcn_exp2f(a[r] * SC + off); a[r] = pp; ps += pp; } }
                else {
#pragma unroll
                    for (int r = 0; r < 16; ++r) { const float pp = __builtin_amdgcn_exp2f(a[r] - mnew); a[r] = pp; ps += pp; } }
                lrun[tb] = lrun[tb] * alpha + ps;
                if (moved) {
#pragma unroll
                    for (int db = 0; db < 2; ++db) o[db][tb] = o[db][tb] * alpha;
                }
#pragma unroll
                for (int half = 0; half < 2; ++half) {
                    const bf16x8 pf = pack_step(a, half);
#pragma unroll
                    for (int db = 0; db < 2; ++db) o[db][tb] = mfma32(tr_perm_swz(tV, 32 * sb + 16 * half, 32 * db, lane), pf, o[db][tb]);
                }
            }
        }
#pragma unroll
        for (int sb = 0; sb < 2; ++sb)
#pragma unroll
            for (int ks = 0; ks < 4; ++ks) kcur[sb][ks] = knext[sb][ks];
    }
#pragma unroll
    for (int tb = 0; tb < NTB; ++tb) {
        const float lt = lrun[tb] + __shfl_xor(lrun[tb], 32), inv = 1.0f / lt;
        bf16_t* orow = C.cat + (size_t)(m0 + 32 * tb + li) * DM + 512 + h * 64;
#pragma unroll
        for (int db = 0; db < 2; ++db)
#pragma unroll
            for (int rr = 0; rr < 4; ++rr) {
                u32x2 w; w.x = pk2(o[db][tb][4 * rr] * inv, o[db][tb][4 * rr + 1] * inv); w.y = pk2(o[db][tb][4 * rr + 2] * inv, o[db][tb][4 * rr + 3] * inv);
                *(u32x2*)(orow + 32 * db + 8 * rr + 4 * kq) = w;
            }
    }
#undef ATT_ISSUE
#undef ATT_SRC
}

__device__ __forceinline__ void conv_cache(const float* ck, const float* cv, bf16_t* dst, int l, int gt, int NGT) {
    for (int i = gt; i < (int)(2 * CACHE_ELEMS / 8); i += NGT) {
        const bool isv = i >= (int)(CACHE_ELEMS / 8); const int j = isv ? i - (int)(CACHE_ELEMS / 8) : i;
        const float* s = (isv ? cv : ck) + (size_t)l * CACHE_ELEMS + (size_t)j * 8;
        const f32x4 x = *(const f32x4*)s, y = *(const f32x4*)(s + 4);
        u32x4 w; w.x = pk2(x[0], x[1]); w.y = pk2(x[2], x[3]); w.z = pk2(y[0], y[1]); w.w = pk2(y[2], y[3]);
        *(u32x4*)(dst + (size_t)i * 8) = w;
    }
}

__device__ __forceinline__ int win_src(int n) { return n < 2048 ? n : (n < 3584 ? n + 16 : (n < 3600 ? n - 1536 : -1)); }
__device__ __forceinline__ void tr_item(const float* W, int K, int Nsrc, bf16_t* WT, int kb, int nb, bool inmap, const float* kscale, LAS float* scr, int lane) {
    const int k0 = 64 * kb, n0 = 32 * nb, n = n0 + (lane & 31), sc = inmap ? win_src(n) : n;
    float wv[32];
#pragma unroll
    for (int i = 0; i < 32; ++i) { const int kk = 2 * i + (lane >> 5); wv[i] = (sc >= 0) ? W[(size_t)(k0 + kk) * Nsrc + sc] : 0.f; }
    if (kscale) {
#pragma unroll
        for (int i = 0; i < 32; ++i) wv[i] *= kscale[k0 + 2 * i + (lane >> 5)];
    }
#pragma unroll
    for (int i = 0; i < 32; ++i) scr[(2 * i + (lane >> 5)) * 33 + (lane & 31)] = wv[i];
    asm volatile("s_waitcnt lgkmcnt(0)" ::: "memory");
    const int c = lane & 7;
#pragma unroll
    for (int j = 0; j < 4; ++j) { const int nn = (lane >> 3) + 8 * j; const LAS float* s = scr + (8 * c) * 33 + nn;
        u32x4 o; o.x = pk2(s[0 * 33], s[1 * 33]); o.y = pk2(s[2 * 33], s[3 * 33]); o.z = pk2(s[4 * 33], s[5 * 33]); o.w = pk2(s[6 * 33], s[7 * 33]);
        *(u32x4*)(WT + (size_t)(n0 + nn) * K + k0 + 8 * c) = o; }
    asm volatile("s_waitcnt lgkmcnt(0)" ::: "memory");
}


enum { SK_IN = 0, SK_RES = 1, SK_UP = 2 };
struct SArgs {
    const bf16_t* A; const bf16_t* Bt; int K, nunits;
    bf16_t* obf; int ldo;
    const float* ss_in; float* ss_out;
    const bf16_t* xold; float* xr;
    float* lowf; float* ksout; float* vsout;
};
template <int KIND> __device__ __forceinline__ void sample_gemm(LAS unsigned char* lds, const SArgs& a, int ubeg, int ustep, int wave, int lane) {
    const int kq = lane >> 5, li = lane & 31, K = a.K, kw = K >> 3, kbeg = wave * kw;
    for (int u = ubeg; u < a.nunits; u += ustep) {
        const int row0 = 64 * (u & 3), col0 = 64 * (u >> 2);
        f32x16 acc[2][2];
#pragma unroll
        for (int rb = 0; rb < 2; ++rb)
#pragma unroll
            for (int cb = 0; cb < 2; ++cb) acc[rb][cb] = zero16();
        const bf16_t* ap = a.A + (size_t)(row0 + li) * K + kbeg + 8 * kq;
        const bf16_t* bp = a.Bt + (size_t)(col0 + li) * K + kbeg + 8 * kq;
        u32x4 af[4][2], bv[4][2], an[4][2], bn[4][2];
#define SG_LOAD(dsta, dstb, k) _Pragma("unroll") for (int s = 0; s < 4; ++s) _Pragma("unroll") for (int h = 0; h < 2; ++h) { dsta[s][h] = *(const u32x4*)(ap + (size_t)(32 * h) * K + (k) + 16 * s); dstb[s][h] = *(const u32x4*)(bp + (size_t)(32 * h) * K + (k) + 16 * s); }
        SG_LOAD(af, bv, 0);
        for (int k = 0; k < kw; k += 64) {
            if (k + 64 < kw) { SG_LOAD(an, bn, k + 64); }
#pragma unroll
            for (int s = 0; s < 4; ++s)
#pragma unroll
                for (int rb = 0; rb < 2; ++rb)
#pragma unroll
                    for (int cb = 0; cb < 2; ++cb) acc[rb][cb] = mfma32(as_bf16x8(af[s][rb]), as_bf16x8(bv[s][cb]), acc[rb][cb]);
#pragma unroll
            for (int s = 0; s < 4; ++s)
#pragma unroll
                for (int h = 0; h < 2; ++h) { af[s][h] = an[s][h]; bv[s][h] = bn[s][h]; }
        }
#undef SG_LOAD
        LAS float* wp = (LAS float*)(lds + wave * WAVE_LDS);
#pragma unroll
        for (int rb = 0; rb < 2; ++rb)
#pragma unroll
            for (int cb = 0; cb < 2; ++cb)
#pragma unroll
                for (int r = 0; r < 16; ++r) wp[(32 * rb + crow(r, kq)) * 64 + 32 * cb + li] = acc[rb][cb][r];
        __syncthreads();
        const int t = wave * 64 + lane, row = t >> 3, c8 = (t & 7) * 8;
        float v[8];
#pragma unroll
        for (int e = 0; e < 8; ++e) v[e] = 0.f;
#pragma unroll
        for (int w = 0; w < 8; ++w) {
            const f32x4 x = *(LAS const f32x4*)(lds + w * WAVE_LDS + (row * 64 + c8) * 4), y = *(LAS const f32x4*)(lds + w * WAVE_LDS + (row * 64 + c8) * 4 + 16);
#pragma unroll
            for (int e = 0; e < 4; ++e) { v[e] += x[e]; v[4 + e] += y[e]; }
        }
        const int r = row0 + row, c = col0 + c8;
        if (KIND == SK_IN || KIND == SK_UP) {
            const float rs = 1.0f / sqrtf(a.ss_in[r] * (1.0f / 1024.0f) + EPS);
#pragma unroll
            for (int e = 0; e < 8; ++e) { v[e] *= rs; if (KIND == SK_UP) { const float q = fmaxf(v[e], 0.f); v[e] = q * q; } }
        }
        if (KIND == SK_RES) {
            const u32x4 xw = *(const u32x4*)(a.xold + (size_t)r * 1024 + c);
            float sq = 0.f;
            v[0] += bflo(xw.x); v[1] += bfhi(xw.x); v[2] += bflo(xw.y); v[3] += bfhi(xw.y); v[4] += bflo(xw.z); v[5] += bfhi(xw.z); v[6] += bflo(xw.w); v[7] += bfhi(xw.w);
#pragma unroll
            for (int e = 0; e < 8; ++e) sq += v[e] * v[e];
            if (a.xr) { float* xn = a.xr + (size_t)r * 1024 + c;
                *(f32x4*)xn = (f32x4){v[0], v[1], v[2], v[3]}; *(f32x4*)(xn + 4) = (f32x4){v[4], v[5], v[6], v[7]}; }
            sq += __shfl_xor(sq, 1); sq += __shfl_xor(sq, 2); sq += __shfl_xor(sq, 4);
            if ((t & 7) == 0) atomicAdd(a.ss_out + r, sq);
        }
        if (a.obf) { u32x4 w; w.x = pk2(v[0], v[1]); w.y = pk2(v[2], v[3]); w.z = pk2(v[4], v[5]); w.w = pk2(v[6], v[7]); *(u32x4*)(a.obf + (size_t)r * a.ldo + c) = w; }
        if (KIND == SK_IN) {
            float* d = nullptr;
            if (c >= C_KC && c < C_VC) d = a.ksout + (size_t)r * 512 + (c - C_KC);
            else if (c >= C_VC && c < C_LOW) d = a.vsout + (size_t)r * 512 + (c - C_VC);
            else if (c >= C_LOW && c < C_LOW + 16) d = a.lowf + (size_t)r * 16 + (c - C_LOW);
            if (d) { *(f32x4*)d = (f32x4){v[0], v[1], v[2], v[3]}; *(f32x4*)(d + 4) = (f32x4){v[4], v[5], v[6], v[7]}; }
        }
        __syncthreads();
    }
}
__device__ __forceinline__ void sample_share(int nwg, int G, int bx, int& ubeg, int& ustep) { const int nfull = nwg % G; if (nfull == 0) { ubeg = bx; ustep = G; } else if (bx >= nfull) { ubeg = bx - nfull; ustep = G - nfull; } else { ubeg = 1 << 30; ustep = 1; } }

#define XB_TMO      128
#define XB_XCNT(j)  (256  + 64 * (j))
#define XB_XSUB(j)  (1280 + 64 * (j))
#define XB_XGEN(j)  (2304 + 64 * (j))
#define XB_TOP      3328
#define XB_TOPGEN   3392
#define XCD_BAR_WORDS 3456
#define XB_SPIN_CAP (1u << 18)

__device__ __forceinline__ unsigned xb_ld(unsigned* p)              { return __hip_atomic_load(p, __ATOMIC_RELAXED, __HIP_MEMORY_SCOPE_AGENT); }
__device__ __forceinline__ unsigned xb_add(unsigned* p, unsigned v) { return __hip_atomic_fetch_add(p, v, __ATOMIC_RELAXED, __HIP_MEMORY_SCOPE_AGENT); }
__device__ __forceinline__ unsigned xb_xcc_id() { return (unsigned)__builtin_amdgcn_s_getreg((3 << 11) | 20) & 0xFu; }
#define XB_SPIN(cond, bar) do { unsigned _sp = 0; while (cond) { __builtin_amdgcn_s_sleep(1); \
    if ((++_sp & 255u) == 0u) { if (xb_ld(&(bar)[XB_TMO])) break; if (_sp > XB_SPIN_CAP) { atomicAdd(&(bar)[XB_TMO], 1u); break; } } } } while (0)

struct XcdBarrier {
    unsigned* bar; unsigned x; bool wave0;
    volatile LAS unsigned* st;
};

__device__ __forceinline__ XcdBarrier xcd_barrier_post(unsigned* bar, volatile LAS unsigned* st) {
    XcdBarrier b; b.bar = bar; b.x = xb_xcc_id(); b.st = st;
    if (threadIdx.x == 0) (void)xb_add(&bar[XB_XCNT(b.x)], 1u);
    return b;
}
__device__ __forceinline__ void xcd_barrier_complete(unsigned* bar, unsigned x, unsigned& nloc, unsigned& nx) {
    const unsigned G = gridDim.x * gridDim.y * gridDim.z;
    unsigned sum, cnt, mine, sp = 0u;
    for (;;) {
        sum = 0u; cnt = 0u; mine = 0u;
#pragma unroll
        for (unsigned j = 0; j < 16; ++j) { const unsigned c = xb_ld(&bar[XB_XCNT(j)]); sum += c; cnt += (c > 0u) ? 1u : 0u; mine = (j == x) ? c : mine; }
        if (sum == G) break;
        __builtin_amdgcn_s_sleep(1);
        if ((++sp & 255u) == 0u) { if (xb_ld(&bar[XB_TMO])) break; if (sp > XB_SPIN_CAP) { atomicAdd(&bar[XB_TMO], 1u); break; } }
    }
    nloc = mine > 0u ? mine : 1u; nx = cnt > 0u ? cnt : 1u;
}

__device__ __forceinline__ void xcd_barrier(const XcdBarrier& b) {
    asm volatile("s_waitcnt vmcnt(0)" ::: "memory");
    __syncthreads();
    if (b.wave0 && lane_id_asm() == 0) {
        unsigned* bar = b.bar;
        __builtin_amdgcn_s_waitcnt(0);
        unsigned nloc = b.st[0], nx = b.st[1];
        if (nloc == 0u) { xcd_barrier_complete(bar, b.x, nloc, nx); b.st[0] = nloc; b.st[1] = nx; }
        const unsigned old = xb_add(&bar[XB_XSUB(b.x)], 1u);
        const unsigned gen = old / nloc;
        if (old + 1u == (gen + 1u) * nloc) {
            __builtin_amdgcn_fence(__ATOMIC_RELEASE, "agent");
            asm volatile("s_waitcnt vmcnt(0)" ::: "memory");
            const unsigned og = xb_add(&bar[XB_TOP], 1u);
            const unsigned tg = og / nx;
            if (og + 1u == (tg + 1u) * nx) xb_add(&bar[XB_TOPGEN], 1u);
            else XB_SPIN(xb_ld(&bar[XB_TOPGEN]) == tg, bar);
            __builtin_amdgcn_fence(__ATOMIC_ACQUIRE, "agent");
            xb_add(&bar[XB_XGEN(b.x)], 1u);
            asm volatile("s_waitcnt vmcnt(0)" ::: "memory");
        } else {
            XB_SPIN(xb_ld(&bar[XB_XGEN(b.x)]) == gen, bar);
            __builtin_amdgcn_fence(__ATOMIC_ACQUIRE, "agent");
            asm volatile("s_waitcnt vmcnt(0)" ::: "memory");
        }
    }
    __syncthreads();
}


__device__ __forceinline__ void tr_item128(const float* W, int K, int Nsrc, bf16_t* WT, int kb, int nb, const float* kscale, LAS float* scr, int lane) {
    const int k0 = 32 * kb, n0 = 128 * nb, n4 = (lane & 31) * 4;
    f32x4 wv[16];
#pragma unroll
    for (int i = 0; i < 16; ++i) wv[i] = *(const f32x4*)(W + (size_t)(k0 + 2 * i + (lane >> 5)) * Nsrc + n0 + n4);
    if (kscale) {
#pragma unroll
        for (int i = 0; i < 16; ++i) wv[i] = wv[i] * kscale[k0 + 2 * i + (lane >> 5)];
    }
#pragma unroll
    for (int i = 0; i < 16; ++i) { LAS float* d = scr + (2 * i + (lane >> 5)) * 129 + n4; d[0] = wv[i][0]; d[1] = wv[i][1]; d[2] = wv[i][2]; d[3] = wv[i][3]; }
    asm volatile("s_waitcnt lgkmcnt(0)" ::: "memory");
#pragma unroll
    for (int j = 0; j < 8; ++j) { const int id = j * 64 + lane, n = id >> 2, c = id & 3; const LAS float* s = scr + (8 * c) * 129 + n;
        u32x4 o; o.x = pk2(s[0 * 129], s[1 * 129]); o.y = pk2(s[2 * 129], s[3 * 129]); o.z = pk2(s[4 * 129], s[5 * 129]); o.w = pk2(s[6 * 129], s[7 * 129]);
        *(u32x4*)(WT + (size_t)(n0 + n) * K + k0 + 8 * c) = o; }
    asm volatile("s_waitcnt lgkmcnt(0)" ::: "memory");
}
constexpr int CONV_WGS = 16;

__global__ void __launch_bounds__(512, 2) hybrid_fwd(Params p) {
    extern __shared__ __attribute__((aligned(16))) unsigned char lds_raw[];
    cg::grid_group grid = cg::this_grid();
    LAS unsigned char* lds = (LAS unsigned char*)lds_raw;
    const int wave = __builtin_amdgcn_readfirstlane((int)threadIdx.x >> 6);
    const int G = gridDim.x, bx = blockIdx.x;
#define WSP(off) (ws_ptr() + (off))
#define LANE_TID() const int lane = lane_id_asm(); const int tid = wave * 64 + lane; (void)tid; int Gq = G, bxq = bx; asm volatile("" : "+s"(Gq), "+s"(bxq)); (void)Gq; (void)bxq
    LAS unsigned char* wl = lds + wave * WAVE_LDS;
    LAS float* biasT = (LAS float*)(lds + LDS_BIAS);
    if (threadIdx.x < 4) ((LAS unsigned*)(lds + LDS_BARST))[threadIdx.x] = 0u;
    __syncthreads();
    XcdBarrier xbar = xcd_barrier_post((unsigned*)WSP(WS_CTL), (volatile LAS unsigned*)(lds + LDS_BARST)); xbar.wave0 = (wave == 0);

    for (int rep = 0; rep < 1 + PROBE_P0X2; ++rep) {
        LANE_TID();
        unsigned char* ws = ws_ptr();
        bf16_t* XB = (bf16_t*)(ws + WS_B); bf16_t* WIN = (bf16_t*)(ws + WS_WIN); bf16_t* WOUT = (bf16_t*)(ws + WS_WOUT); bf16_t* WUP = (bf16_t*)(ws + WS_WUP); bf16_t* WDN = (bf16_t*)(ws + WS_WDN);
        float* SS = (float*)(ws + WS_SS); float* ROPE = (float*)(ws + WS_ROPE);
        const int gw = bx * 8 + wave, NGW = G * 8;
        LAS float* scr = (LAS float*)wl;
        constexpr int I_IN = 16 * (PS / 32), I_OUT = 16 * 32, I_UP = 16 * 128, I_DN = 64 * 32, I_L = I_IN + I_OUT + I_UP + I_DN;
        const bool split = (G == 256);
        for (int it = gw; it < 2 * I_L; it += NGW) {
            const int l = it / I_L; int r = it % I_L;
            if (split && r >= I_IN) continue;
            if (r < I_IN) { tr_item(in_ptr(9) + (size_t)l * DM * INCOLS, DM, INCOLS, WIN + (size_t)l * PS * DM, r / (PS / 32), r % (PS / 32), true, in_ptr(6) + l * DM, scr, lane); continue; } r -= I_IN;
            if (r < I_OUT) { tr_item(in_ptr(15) + (size_t)l * DM * DM, DM, DM, WOUT + (size_t)l * DM * DM, r / 32, r % 32, false, nullptr, scr, lane); continue; } r -= I_OUT;
            if (r < I_UP) { tr_item(in_ptr(16) + (size_t)l * DM * DFF, DM, DFF, WUP + (size_t)l * DFF * DM, r / 128, r % 128, false, in_ptr(7) + l * DM, scr, lane); continue; } r -= I_UP;
            tr_item(in_ptr(17) + (size_t)l * DFF * DM, DFF, DM, WDN + (size_t)l * DM * DFF, r / 32, r % 32, false, nullptr, scr, lane);
        }
        const float* x_prompt = in_ptr(0); const float* x_sample = in_ptr(1);
        for (int m0 = gw; m0 < MT; m0 += 2 * NGW) {
            f32x4 v[2][4]; float s[2];
#pragma unroll
            for (int q = 0; q < 2; ++q) {
                const int m = m0 + q * NGW; s[q] = 0.f;
                if (m < MT) {
                    const float* xrow = (m < MP) ? x_prompt + (size_t)m * DM : x_sample + (size_t)(m - MP) * DM;
                    const f32x4* xr = (const f32x4*)xrow + lane;
#pragma unroll
                    for (int j = 0; j < 4; ++j) v[q][j] = xr[64 * j];
                }
            }
#pragma unroll
            for (int q = 0; q < 2; ++q) {
                const int m = m0 + q * NGW;
                if (m < MT) {
#pragma unroll
                    for (int j = 0; j < 4; ++j) s[q] += (v[q][j][0] * v[q][j][0] + v[q][j][1] * v[q][j][1]) + (v[q][j][2] * v[q][j][2] + v[q][j][3] * v[q][j][3]);
#pragma unroll
                    for (int o = 1; o < 64; o <<= 1) s[q] += __shfl_xor(s[q], o);
                    u32x2* o8 = (u32x2*)(XB + (size_t)m * DM) + lane;
#pragma unroll
                    for (int j = 0; j < 4; ++j) { u32x2 w; w.x = pk2(v[q][j][0], v[q][j][1]); w.y = pk2(v[q][j][2], v[q][j][3]); o8[64 * j] = w; }
                    if (lane == 0) SS[m] = s[q];
                }
            }
        }
        const int gt = bx * 512 + tid, NGT = G * 512;
        for (int i = gt; i < 4 * MT; i += NGT) SS[MT + i] = 0.f;
        conv_cache(in_ptr(4), in_ptr(5), (bf16_t*)(ws + WS_CKB), 0, gt, NGT);
        for (int i = gt; i < 2080 * 32; i += NGT) {
            const int pi = i >> 5, f = i & 31; const int pos = pi < 2048 ? pi : 4096 + (pi - 2048);
            const float inv_freq = (float)exp(-(double)f * (9.210340371976184 / 32.0));
            const float ang = (float)pos * inv_freq;
            double rev = (double)ang * 0.15915494309189535; rev -= rint(rev);
            const float rf = (float)rev;
            ROPE[(size_t)pi * 64 + f] = __builtin_amdgcn_cosf(rf); ROPE[(size_t)pi * 64 + 32 + f] = __builtin_amdgcn_sinf(rf);
        }
    }
    if (G == 0x7fffffff) grid.sync();
    xcd_barrier(xbar);

    for (int l = 0; l < 2; ++l) {
        {
            LANE_TID();
            unsigned char* ws = ws_ptr();
            const bool split = (Gq == 256); const int GG = split ? Gq - CONV_WGS : Gq;
            if (split && bxq >= GG) {
                LAS float* scr = (LAS float*)(lds + wave * WAVE_LDS);
                constexpr int J_OUT = 32 * 8, J_UP = 32 * 32;
                for (int it = (bxq - GG) * 8 + wave; it < J_OUT + J_UP; it += CONV_WGS * 8) {
                    if (it < J_OUT) tr_item128(in_ptr(15) + (size_t)l * DM * DM, DM, DM, (bf16_t*)(ws + WS_WOUT) + (size_t)l * DM * DM, it / 8, it % 8, nullptr, scr, lane);
                    else { const int r = it - J_OUT; tr_item128(in_ptr(16) + (size_t)l * DM * DFF, DM, DFF, (bf16_t*)(ws + WS_WUP) + (size_t)l * DFF * DM, r / 32, r % 32, in_ptr(7) + l * DM, scr, lane); }
                }
            } else {
            pg8::Gemm g{(const bf16_t*)(ws + WS_B), (const bf16_t*)(ws + WS_WIN) + (size_t)l * PS * DM, MP, PS, DM}; pg8::StaticOrder S; S.init(MP, PS, GG, bxq);
            pg8::EpiIn E{(bf16_t*)(ws + WS_A), (float*)(ws + WS_LOWF), (const float*)(ws + WS_SS) + (size_t)(2 * l) * MT, out_ptr(), (long long)(O_KP + (size_t)l * 2097152), (long long)(O_VP + (size_t)l * 2097152), (long long)(O_KS + (size_t)l * 131072), (long long)(O_VS + (size_t)l * 131072)};
            pg8::gemm_phase<pg8::EpiIn, pg8::StaticOrder, true, true>(lds, g, S, E, tid);
            if (PROBE_IN2) pg8::gemm_phase<pg8::EpiIn, pg8::StaticOrder, true, true>(lds, g, S, E, tid);
            {
                float* outp = out_ptr();
                SArgs a{}; a.A = (const bf16_t*)(ws + WS_B) + (size_t)MP * DM; a.Bt = (const bf16_t*)(ws + WS_WIN) + (size_t)l * PS * DM; a.K = DM; a.nunits = 4 * 57;
                a.obf = (bf16_t*)(ws + WS_A) + (size_t)MP * PS; a.ldo = PS; a.ss_in = (const float*)(ws + WS_SS) + (size_t)(2 * l) * MT + MP; a.lowf = (float*)(ws + WS_LOWF) + (size_t)MP * 16;
                a.ksout = outp + O_KS + (size_t)l * 131072; a.vsout = outp + O_VS + (size_t)l * 131072;
                int ub, us; sample_share((MP / 256) * (PS / 256), GG, bxq, ub, us);
                sample_gemm<SK_IN>(lds, a, ub, us, wave, lane);
            }
            if (l == 1) conv_cache(in_ptr(4), in_ptr(5), (bf16_t*)(ws + WS_CKB), 1, bxq * 512 + tid, GG * 512);
            }
        }
        xcd_barrier(xbar);
        {
            LANE_TID();
            { const float* rb = in_ptr(14) + (size_t)l * 8 * NREL; for (int i = tid; i < 8 * NREV; i += 512) { const int hh = i / NREV, j = i % NREV; int k = 382 - j; k = k < 0 ? 0 : (k > NREL - 1 ? NREL - 1 : k); biasT[i] = rb[hh * NREL + k] * 1.4426950408889634f; } }
            __syncthreads();
        }
#define MAKE_CTX() LANE_TID(); int wv = wave; asm volatile("" : "+s"(wv)); unsigned char* ws = ws_ptr(); Ctx C; C.l = l; C.lane = lane; C.kq = lane >> 5; C.li = lane & 31; C.proj = (const bf16_t*)(ws + WS_A); C.lowf = (const float*)(ws + WS_LOWF); \
        C.rope = (const float*)(ws + WS_ROPE); C.cat = (bf16_t*)(out_ptr() + O_Y); C.kvt = (float*)(ws + WS_C); C.gdec = (float*)(ws + WS_G); C.out = out_ptr(); \
        C.wa2 = in_ptr(10) + (size_t)l * 16 * 256; C.ba = in_ptr(11) + l * 256; C.nw = (wv < 4 ? in_ptr(12) : in_ptr(13)) + l * 256; C.st = (wv < 4 ? in_ptr(2) : in_ptr(3)); C.ckb = (const bf16_t*)(ws + WS_CKB); C.cvb = C.ckb + CACHE_ELEMS; \
        __builtin_amdgcn_sched_barrier(0)
        for (int rep = 0; rep < 1 + PROBE_M1X2; ++rep)
        for (int u = bx; u < 256; u += G) {
            const int b = u & 7, n = u >> 3;
            for (int rk = 0; rk < 1 + PROBE_KVX2; ++rk) { MAKE_CTX(); kv_local<false>(C, wv >> 2, b, n, wv & 3, wl); }
            for (int ra = 0; ra < 1 + PROBE_ATX2; ++ra) { MAKE_CTX(); attn_wave<false>(C, b, n, wave, wl, biasT + wave * NREV, biasT[wave * NREV]); }
            if (n == 0) { MAKE_CTX(); attn_wave<true>(C, b, 0, wave, wl, biasT + wave * NREV, biasT[wave * NREV]); }
            if (n == 1) { MAKE_CTX(); mix_out<true>(C, wv >> 2, b, 0, wv & 3, wl); }
            if (n == 2) { MAKE_CTX(); kv_local<true>(C, wv >> 2, b, 0, wv & 3, wl); }
        }
        xcd_barrier(xbar);
        {
            LANE_TID();
            float* KVT = (float*)WSP(WS_C); const float* GDEC = (const float*)WSP(WS_G); float* outp = out_ptr();
            for (int it = bx * 512 + tid; it < 131072; it += G * 512) {
                const int seq = it >> 11, e2 = it & 2047, type = seq >> 5, b = (seq >> 2) & 7, h = seq & 3;
                const int dv = e2 >> 5, dk = (2 * e2) & 63;
                bf16_t* base = (bf16_t*)KVT + (size_t)seq * 32 * 4096 + 2 * e2;
                const float dret = exp2f(ret_lg2(h) * 64.0f);
                const float* gd = GDEC + (size_t)((b * 4 + h) * 32) * 64 + dk;
                unsigned kvr[32]; f32x2 dd[32];
#pragma unroll
                for (int c = 0; c < 32; ++c) kvr[c] = *(const unsigned*)(base + (size_t)c * 4096);
                if (type == 1) {
#pragma unroll
                    for (int c = 0; c < 32; ++c) dd[c] = *(const f32x2*)(gd + c * 64);
                } else {
#pragma unroll
                    for (int c = 0; c < 32; ++c) dd[c] = (f32x2){dret, dret};
                }
                f32x2 s = (f32x2){0.f, 0.f};
#pragma unroll
                for (int c = 0; c < 32; ++c) { *(unsigned*)(base + (size_t)c * 4096) = pk2(s[0], s[1]); s = dd[c] * s + (f32x2){bflo(kvr[c]), bfhi(kvr[c])}; }
                float* so = outp + (type == 0 ? O_RETP : O_GLAP) + (size_t)((l * 8 + b) * 4 + h) * 4096;
                so[dk * 64 + dv] = s[0]; so[(dk + 1) * 64 + dv] = s[1];
            }
        }
        xcd_barrier(xbar);
        for (int rep = 0; rep < 1 + PROBE_M3X2; ++rep)
        for (int u = bx; u < 256; u += G) { MAKE_CTX(); mix_out<false>(C, wv >> 2, u & 7, u >> 3, wv & 3, wl); }
        xcd_barrier(xbar);
        {
            LANE_TID();
            unsigned char* ws = ws_ptr(); const bf16_t* CATB = (const bf16_t*)(out_ptr() + O_Y);
            pg8::Gemm g{CATB, (const bf16_t*)(ws + WS_WOUT) + (size_t)l * DM * DM, MP, DM, DM}; pg8::StaticOrder S; S.init(MP, DM, Gq, bxq);
            pg8::EpiRes E{(const bf16_t*)(ws + WS_B), (float*)nullptr, (bf16_t*)(ws + WS_C), (float*)(ws + WS_SS) + (size_t)(2 * l + 1) * MT};
            pg8::gemm_phase<pg8::EpiRes, pg8::StaticOrder, true, true>(lds, g, S, E, tid);
            {
                SArgs a{}; a.A = CATB + (size_t)MP * DM; a.Bt = (const bf16_t*)(ws + WS_WOUT) + (size_t)l * DM * DM; a.K = DM; a.nunits = 4 * 16;
                a.obf = (bf16_t*)(ws + WS_C) + (size_t)MP * DM; a.ldo = DM; a.ss_out = (float*)(ws + WS_SS) + (size_t)(2 * l + 1) * MT + MP;
                a.xold = (const bf16_t*)(ws + WS_B) + (size_t)MP * DM; a.xr = nullptr;
                int ub, us; sample_share((MP / 256) * (DM / 256), Gq, bxq, ub, us);
                sample_gemm<SK_RES>(lds, a, ub, us, wave, lane);
                const int nsamp = a.nunits < Gq ? a.nunits : Gq;
                if (Gq == 256 && bxq >= nsamp) {
                    LAS float* scr = (LAS float*)(lds + wave * WAVE_LDS);
                    for (int it = (bxq - nsamp) * 8 + wave; it < 128 * 8; it += (Gq - nsamp) * 8)
                        tr_item128(in_ptr(17) + (size_t)l * DFF * DM, DFF, DM, (bf16_t*)(ws + WS_WDN) + (size_t)l * DM * DFF, it / 8, it % 8, nullptr, scr, lane);
                }
            }
        }
        xcd_barrier(xbar);
        {
            LANE_TID();
            unsigned char* ws = ws_ptr();
            pg8::Gemm g{(const bf16_t*)(ws + WS_C), (const bf16_t*)(ws + WS_WUP) + (size_t)l * DFF * DM, MP, DFF, DM}; pg8::StaticOrder S; S.init(MP, DFF, Gq, bxq);
            pg8::EpiUp E{(bf16_t*)(ws + WS_A), (const float*)(ws + WS_SS) + (size_t)(2 * l + 1) * MT, DFF};
            pg8::gemm_phase<pg8::EpiUp, pg8::StaticOrder, true, true>(lds, g, S, E, tid);
            if (PROBE_UP2) pg8::gemm_phase<pg8::EpiUp, pg8::StaticOrder, true, true>(lds, g, S, E, tid);
            if (PROBE_UP2B) { xcd_barrier(xbar); pg8::gemm_phase<pg8::EpiUp, pg8::StaticOrder, true, true>(lds, g, S, E, tid); }
            {
                SArgs a{}; a.A = (const bf16_t*)(ws + WS_C) + (size_t)MP * DM; a.Bt = (const bf16_t*)(ws + WS_WUP) + (size_t)l * DFF * DM; a.K = DM; a.nunits = 4 * 64;
                a.obf = (bf16_t*)(ws + WS_A) + (size_t)MP * DFF; a.ldo = DFF; a.ss_in = (const float*)(ws + WS_SS) + (size_t)(2 * l + 1) * MT + MP;
                int ub, us; sample_share((MP / 256) * (DFF / 256), Gq, bxq, ub, us);
                sample_gemm<SK_UP>(lds, a, ub, us, wave, lane);
            }
        }
        xcd_barrier(xbar);
        {
            LANE_TID();
            unsigned char* ws = ws_ptr(); float* XR = out_ptr() + O_Y;
            pg8::Gemm g{(const bf16_t*)(ws + WS_A), (const bf16_t*)(ws + WS_WDN) + (size_t)l * DM * DFF, MP, DM, DFF}; pg8::StaticOrder S; S.init(MP, DM, Gq, bxq);
            if (PROBE_DN2) { pg8::EpiUp E2{(bf16_t*)(ws + WS_C), (const float*)(ws + WS_SS) + (size_t)(2 * l + 1) * MT, DM}; pg8::gemm_phase<pg8::EpiUp, pg8::StaticOrder, true, true>(lds, g, S, E2, tid); }
            pg8::EpiRes E{(const bf16_t*)(ws + WS_C), (float*)nullptr, (bf16_t*)(ws + WS_B), (float*)(ws + WS_SS) + (size_t)(2 * l + 2) * MT};
            pg8::gemm_phase<pg8::EpiRes, pg8::StaticOrder, true, true>(lds, g, S, E, tid);
            {
                SArgs a{}; a.A = (const bf16_t*)(ws + WS_A) + (size_t)MP * DFF; a.Bt = (const bf16_t*)(ws + WS_WDN) + (size_t)l * DM * DFF; a.K = DFF; a.nunits = 4 * 16;
                a.obf = (bf16_t*)(ws + WS_B) + (size_t)MP * DM; a.ldo = DM; a.ss_out = (float*)(ws + WS_SS) + (size_t)(2 * l + 2) * MT + MP;
                a.xold = (const bf16_t*)(ws + WS_C) + (size_t)MP * DM; a.xr = nullptr;
                int ub, us; sample_share((MP / 256) * (DM / 256), Gq, bxq, ub, us);
                sample_gemm<SK_RES>(lds, a, ub, us, wave, lane);
            }
        }
        xcd_barrier(xbar);
    }
    for (int i = 0; i < PROBE_SYNCS; ++i) xcd_barrier(xbar);
    {
        LANE_TID();
        const int gw = bx * 8 + wave, NGW = G * 8;
        const float* fw = in_ptr(8); const float* SS = (const float*)WSP(WS_SS); float* Y = out_ptr() + O_Y; const bf16_t* XBF = (const bf16_t*)WSP(WS_B);
        f32x4 w4[4];
#pragma unroll
        for (int j = 0; j < 4; ++j) w4[j] = *((const f32x4*)fw + lane + 64 * j);
        for (int m0 = gw; m0 < MT; m0 += 2 * NGW) {
            u32x2 v[2][4]; float rs[2];
#pragma unroll
            for (int q = 0; q < 2; ++q) {
                const int m = m0 + q * NGW;
                if (m < MT) {
                    rs[q] = SS[(size_t)4 * MT + m];
                    const u32x2* xr = (const u32x2*)(XBF + (size_t)m * DM) + lane;
#pragma unroll
                    for (int j = 0; j < 4; ++j) v[q][j] = xr[64 * j];
                }
            }
#pragma unroll
            for (int q = 0; q < 2; ++q) {
                const int m = m0 + q * NGW;
                if (m < MT) {
                    const float r = 1.0f / sqrtf(rs[q] * (1.0f / 1024.0f) + EPS);
                    f32x4* yr = (f32x4*)(Y + (size_t)m * DM) + lane;
#pragma unroll
                    for (int j = 0; j < 4; ++j) { const f32x4 x = (f32x4){bflo(v[q][j].x), bfhi(v[q][j].x), bflo(v[q][j].y), bfhi(v[q][j].y)}; yr[64 * j] = x * r * w4[j]; }
                }
            }
        }
    }
}

extern "C" void kernel_launch(void* const* d_in, const int* in_sizes, int n_in, void* d_out, int out_size, void* d_ws, size_t ws_size, hipStream_t stream) {
    static int grid = 0;
    if (grid == 0) {
        if (n_in != 18 || (size_t)out_size != O_END || ws_size < WS_END) { fprintf(stderr, "kernel_launch: unexpected shapes: n_in %d out %d ws %zu (need %zu)\n", n_in, out_size, ws_size, (size_t)WS_END); grid = -1; return; }
        int dev = 0, cus = 0, per_cu = 0;
        hipGetDevice(&dev); hipDeviceGetAttribute(&cus, hipDeviceAttributeMultiprocessorCount, dev);
        if (hipFuncSetAttribute((const void*)hybrid_fwd, hipFuncAttributeMaxDynamicSharedMemorySize, LDS_BYTES) != hipSuccess) { fprintf(stderr, "kernel_launch: hipFuncSetAttribute failed\n"); }
        if (hipOccupancyMaxActiveBlocksPerMultiprocessor(&per_cu, (const void*)hybrid_fwd, 512, LDS_BYTES) != hipSuccess || per_cu < 1) { fprintf(stderr, "kernel_launch: occupancy query says %d\n", per_cu); per_cu = 1; }
        (void)hipGetLastError();
        grid = cus * per_cu;
        if (grid > 256) grid = 256;
    }
    if (grid < 0) return;
    if (hipMemsetAsync((unsigned char*)d_ws + WS_CTL, 0, CTL_BYTES, stream) != hipSuccess) { fprintf(stderr, "kernel_launch: memset of the barrier words failed\n"); return; }
    Params p{};
    for (int i = 0; i < 18; ++i) p.in[i] = (const float*)d_in[i];
    p.out = (float*)d_out; p.ws = (unsigned char*)d_ws;
    void* args[] = {&p};
    hipError_t e = hipLaunchCooperativeKernel((const void*)hybrid_fwd, dim3(grid), dim3(512), args, LDS_BYTES, stream);
    if (e != hipSuccess) fprintf(stderr, "kernel_launch: cooperative launch failed: %s (grid %d)\n", hipGetErrorString(e), grid);
}
```

```cpp
#include <hip/hip_runtime.h>
#include <hip/hip_cooperative_groups.h>
#include <cstdio>
#include <cstdint>
namespace cg = cooperative_groups;
#ifndef PROBE_UP2
#define PROBE_UP2 0
#endif
#ifndef PROBE_M1X2
#define PROBE_M1X2 0
#endif
#ifndef PROBE_P0X2
#define PROBE_P0X2 0
#endif
#ifndef PROBE_SYNCS
#define PROBE_SYNCS 0
#endif
#ifndef PROBE_IN2
#define PROBE_IN2 0
#endif
#ifndef PROBE_DN2
#define PROBE_DN2 0
#endif
#ifndef PROBE_UP2B
#define PROBE_UP2B 0
#endif
#ifndef PROBE_KVX2
#define PROBE_KVX2 0
#endif
#ifndef PROBE_ATX2
#define PROBE_ATX2 0
#endif
#ifndef PROBE_M3X2
#define PROBE_M3X2 0
#endif
namespace pg8 {
#define PG8_LAS __attribute__((address_space(3)))
typedef unsigned short bf16_t;
typedef short bf16x8 __attribute__((ext_vector_type(8)));
typedef float f32x4 __attribute__((ext_vector_type(4)));
typedef unsigned u32x4 __attribute__((ext_vector_type(4)));
constexpr int BM = 256, BK = 64, HALF = 128, HTB = HALF * BK * 2  , STAGE_BYTES = 8 * HTB, NXCD = 8, WGM = 8;

__host__ __device__ __forceinline__ int lds_byte(int r, int c) { const int st = (r >> 4) * 2 + (c >> 5), rr = r & 15, cc = c & 31, ob = rr * 64 + cc * 2; return st * 1024 + (ob ^ (((ob >> 9) & 1) << 5)); }
__host__ __device__ __forceinline__ void stage_rc(int b, int& R, int& C) { const int st = b / 1024, sb = b % 1024, swz = sb ^ (((sb >> 9) & 1) << 5); R = (st >> 1) * 16 + swz / 64; C = (st & 1) * 32 + (swz % 64) / 2; }
__host__ __device__ __forceinline__ int perm32(int rho) { const int n = rho >> 4, i = rho & 15; return 8 * (i >> 2) + 4 * n + (i & 3); }

struct Unit { int pm, pn; };
struct Gemm { const bf16_t* A; const bf16_t* Bt; int M, N, K; };

struct StaticOrder {
    int nM, nN, nwg, G, c;
    __host__ __device__ __forceinline__ void init(int M, int N, int G_, int c_) { nM = M / BM; nN = N / BM; nwg = nM * nN; G = G_; c = c_; }
    __host__ __device__ __forceinline__ bool next(int i, Unit& u) const {
        const long L = (long)i * G + c; if (L >= nwg) return false;
        int wgid = (int)L; { const int q = nwg / NXCD, r = nwg % NXCD, xcd = wgid % NXCD, off = wgid / NXCD; wgid = (xcd < r ? xcd * (q + 1) : r * (q + 1) + (xcd - r) * q) + off; }
        const int nig = WGM * nN, gid = wgid / nig, fm = gid * WGM, gsz = (nM - fm) < WGM ? (nM - fm) : WGM;
        u.pm = fm + ((wgid % nig) % gsz); u.pn = (wgid % nig) / gsz; return true;
    }
    __device__ __forceinline__ void a_ready(const Unit&) const {}
    __device__ __forceinline__ void done(const Unit&) const {}
};

__device__ __forceinline__ unsigned cvt_pk_bf16(float lo, float hi) { unsigned r; asm volatile("v_cvt_pk_bf16_f32 %0, %1, %2" : "=v"(r) : "v"(lo), "v"(hi)); return r; }
typedef float f32x2 __attribute__((ext_vector_type(2)));

typedef unsigned u32x2 __attribute__((ext_vector_type(2)));
constexpr int E_MP = 16384;
struct EpiIn {
    static constexpr bool PERM = true, AFTER_DRAIN = false;
    bf16_t* proj; float* lowf; const float* ss; float* out; long long okp, ovp, oks, ovs;
    __device__ __forceinline__ void operator()(const f32x4 (&acc)[2][2][4][2], const Unit& u, int wr, int wc, int fr, int fq) const {
        const int row0 = u.pm * BM + wr * 64 + fr, col0 = u.pn * BM + wc * 32 + 8 * fq;
        float* kv = nullptr; int rsub = 0, cbase = 0;
        if (u.pn >= 10 && u.pn < 14) {
            const bool isk = u.pn < 12; cbase = isk ? 2560 : 3072;
            if (u.pm >= 64) { kv = out + (isk ? oks : ovs); rsub = E_MP; }
            else if ((u.pm & 7) >= 6) { kv = out + (isk ? okp : ovp); rsub = 1536 * ((u.pm >> 3) + 1); }
        }
        const bool lowt = (u.pn == 14) && (wc == 0) && (fq < 2);
#pragma unroll
        for (int ai = 0; ai < 2; ++ai)
#pragma unroll
            for (int m = 0; m < 4; ++m) {
                const int r = row0 + ai * HALF + m * 16;
                const float rs = 1.0f / sqrtf(ss[r] * (1.0f / 1024.0f) + 1e-6f);
                bf16_t* rowp = proj + (size_t)r * 3840 + col0;
#pragma unroll
                for (int bj = 0; bj < 2; ++bj) {
                    const f32x4 v0 = acc[ai][bj][m][0] * rs, v1 = acc[ai][bj][m][1] * rs;
                    u32x4 w; w.x = cvt_pk_bf16(v0[0], v0[1]); w.y = cvt_pk_bf16(v0[2], v0[3]); w.z = cvt_pk_bf16(v1[0], v1[1]); w.w = cvt_pk_bf16(v1[2], v1[3]);
                    *(u32x4*)(rowp + bj * HALF) = w;
                    if (kv) { float* d = kv + (size_t)(r - rsub) * 512 + (col0 + bj * HALF - cbase); __builtin_nontemporal_store(v0, (f32x4*)d); __builtin_nontemporal_store(v1, (f32x4*)(d + 4)); }
                    if (lowt && bj == 0) { float* d = lowf + (size_t)r * 16 + 8 * fq; *(f32x4*)d = v0; *(f32x4*)(d + 4) = v1; }
                }
            }
    }
};
struct EpiRes {
    static constexpr bool PERM = true, AFTER_DRAIN = false;
    const bf16_t* xold; float* xr; bf16_t* xb; float* ss;
    __device__ __forceinline__ void operator()(const f32x4 (&acc)[2][2][4][2], const Unit& u, int wr, int wc, int fr, int fq) const {
        const int row0 = u.pm * BM + wr * 64 + fr, col0 = u.pn * BM + wc * 32 + 8 * fq;
#pragma unroll
        for (int ai = 0; ai < 2; ++ai)
#pragma unroll
            for (int m = 0; m < 4; ++m) {
                const int r = row0 + ai * HALF + m * 16;
                const bf16_t* xo = xold + (size_t)r * 1024 + col0;
                float sq = 0.f;
#pragma unroll
                for (int bj = 0; bj < 2; ++bj) {
                    const u32x4 xw = *(const u32x4*)(xo + bj * HALF);
                    f32x4 v0, v1;
                    v0[0] = __uint_as_float(xw.x << 16); v0[1] = __uint_as_float(xw.x & 0xffff0000u); v0[2] = __uint_as_float(xw.y << 16); v0[3] = __uint_as_float(xw.y & 0xffff0000u);
                    v1[0] = __uint_as_float(xw.z << 16); v1[1] = __uint_as_float(xw.z & 0xffff0000u); v1[2] = __uint_as_float(xw.w << 16); v1[3] = __uint_as_float(xw.w & 0xffff0000u);
                    v0 = v0 + acc[ai][bj][m][0]; v1 = v1 + acc[ai][bj][m][1];
                    if (xr) { float* xn = xr + (size_t)r * 1024 + col0 + bj * HALF; *(f32x4*)xn = v0; *(f32x4*)(xn + 4) = v1; }
                    sq += (v0[0] * v0[0] + v0[1] * v0[1]) + (v0[2] * v0[2] + v0[3] * v0[3]) + (v1[0] * v1[0] + v1[1] * v1[1]) + (v1[2] * v1[2] + v1[3] * v1[3]);
                    if (xb) { u32x4 w; w.x = cvt_pk_bf16(v0[0], v0[1]); w.y = cvt_pk_bf16(v0[2], v0[3]); w.z = cvt_pk_bf16(v1[0], v1[1]); w.w = cvt_pk_bf16(v1[2], v1[3]);
                        *(u32x4*)(xb + (size_t)r * 1024 + col0 + bj * HALF) = w; }
                }
                sq += __shfl_xor(sq, 16); sq += __shfl_xor(sq, 32);
                if (fq == 0) atomicAdd(ss + r, sq);
            }
    }
};
struct EpiUp {
    static constexpr bool PERM = true, AFTER_DRAIN = false;
    bf16_t* U; const float* ss; int ldu;
    __device__ __forceinline__ void operator()(const f32x4 (&acc)[2][2][4][2], const Unit& u, int wr, int wc, int fr, int fq) const {
        const int row0 = u.pm * BM + wr * 64 + fr, col0 = u.pn * BM + wc * 32 + 8 * fq;
#pragma unroll
        for (int ai = 0; ai < 2; ++ai)
#pragma unroll
            for (int m = 0; m < 4; ++m) {
                const int r = row0 + ai * HALF + m * 16;
                const float rs = 1.0f / sqrtf(ss[r] * (1.0f / 1024.0f) + 1e-6f);
                bf16_t* rowp = U + (size_t)r * ldu + col0;
#pragma unroll
                for (int bj = 0; bj < 2; ++bj) {
                    f32x4 v0 = acc[ai][bj][m][0] * rs, v1 = acc[ai][bj][m][1] * rs;
#pragma unroll
                    for (int e = 0; e < 4; ++e) { const float a = fmaxf(v0[e], 0.f), b = fmaxf(v1[e], 0.f); v0[e] = a * a; v1[e] = b * b; }
                    u32x4 w; w.x = cvt_pk_bf16(v0[0], v0[1]); w.y = cvt_pk_bf16(v0[2], v0[3]); w.z = cvt_pk_bf16(v1[0], v1[1]); w.w = cvt_pk_bf16(v1[2], v1[3]);
                    *(u32x4*)(rowp + bj * HALF) = w;
                }
            }
    }
};

template <class Epi, class Sched, bool ALIGN_EPI = false, bool SP2 = false>
__device__ __forceinline__ void gemm_phase(PG8_LAS unsigned char* lds, const Gemm g, const Sched& S, const Epi& E, const int tid_in) {
    int tid_ = tid_in; asm volatile("" : "+v"(tid_));
    const int tid = tid_, wid = __builtin_amdgcn_readfirstlane(tid >> 6), lane = tid & 63, wr = wid >> 2, wc = wid & 3, fr = lane & 15, fq = lane >> 4;
    const int K = g.K, nt = K / BK;
    unsigned voffA[2], voffB[2];
#pragma unroll
    for (int i = 0; i < 2; ++i) { int R, C; stage_rc(tid * 16 + i * 8192, R, C); const int Rb = Epi::PERM ? ((R & ~31) + perm32(R & 31)) : R;
        voffA[i] = (unsigned)(R * K + C) * 2u; voffB[i] = (unsigned)(Rb * K + C) * 2u; }
    const size_t kstep = (size_t)(BK * 2);
    const size_t hstep = (size_t)HALF * K * 2;
    const size_t tstep = 2 * hstep;
    const unsigned ldsw = (unsigned)wid * 1024u;
    const int aoff = lds_byte(wr * 64 + fr, fq * 8), boff = lds_byte(wc * 32 + fr, fq * 8);
#define PG8_SA(b, h) (((b) * 2 + (h)) * HTB)
#define PG8_SB(b, h) ((4 + (b) * 2 + (h)) * HTB)
#define PG8_STAGE(bufoff, gbase, voff) do { _Pragma("unroll") for (int _i = 0; _i < 2; ++_i) \
        __builtin_amdgcn_global_load_lds((const unsigned*)((const char*)(gbase) + (voff)[_i]), (PG8_LAS unsigned*)(lds + (bufoff) + ldsw + _i * 8192), 16, 0, 0); } while (0)
#define PG8_LDA(dst, b, h) do { _Pragma("unroll") for (int m = 0; m < 4; ++m) _Pragma("unroll") for (int k = 0; k < 2; ++k) dst[m][k] = *(const PG8_LAS bf16x8*)(lds + PG8_SA(b, h) + aoff + m * 2048 + k * 1024); } while (0)
#define PG8_LDB(dst, b, h) do { _Pragma("unroll") for (int n = 0; n < 2; ++n) _Pragma("unroll") for (int k = 0; k < 2; ++k) dst[n][k] = *(const PG8_LAS bf16x8*)(lds + PG8_SB(b, h) + boff + n * 2048 + k * 1024); } while (0)
#define PG8_MMA(ai, bj, At, Bt) do { __builtin_amdgcn_s_setprio(1); _Pragma("unroll") for (int m = 0; m < 4; ++m) _Pragma("unroll") for (int n = 0; n < 2; ++n) _Pragma("unroll") for (int k = 0; k < 2; ++k) \
        acc[ai][bj][m][n] = __builtin_amdgcn_mfma_f32_16x16x32_bf16(Bt[n][k], At[m][k], acc[ai][bj][m][n], 0, 0, 0); __builtin_amdgcn_s_setprio(0); } while (0)
#define PG8_WAIT_V(n) asm volatile("s_waitcnt vmcnt(" #n ")" ::: "memory")
#define PG8_WAIT_L(n) asm volatile("s_waitcnt lgkmcnt(" #n ")" ::: "memory")
#define PG8_BAR __builtin_amdgcn_s_barrier()
#define PG8_SCHED __builtin_amdgcn_sched_barrier(0)
    Unit cur, nxt; int ui = 0;
    if (!S.next(0, cur)) return;
    f32x4 acc[2][2][4][2];
#pragma unroll
    for (int a = 0; a < 2; ++a)
#pragma unroll
        for (int b = 0; b < 2; ++b)
#pragma unroll
            for (int m = 0; m < 4; ++m)
#pragma unroll
                for (int n = 0; n < 2; ++n) acc[a][b][m][n] = (f32x4){0.f, 0.f, 0.f, 0.f};
    bf16x8 At[4][2], B0[2][2], B1[2][2];
    const char* cA = (const char*)g.A + (size_t)cur.pm * tstep; const char* cB = (const char*)g.Bt + (size_t)cur.pn * tstep;
    S.a_ready(cur);
    if constexpr (SP2) {
        PG8_STAGE(PG8_SB(0, 0), cB, voffB); PG8_STAGE(PG8_SB(0, 1), cB + hstep, voffB); PG8_STAGE(PG8_SA(0, 0), cA, voffA); PG8_STAGE(PG8_SA(0, 1), cA + hstep, voffA);
        if (wr == 1) PG8_BAR;
        PG8_WAIT_V(2); PG8_BAR;
        PG8_STAGE(PG8_SB(1, 0), cB + kstep, voffB); PG8_STAGE(PG8_SA(1, 0), cA + kstep, voffA); PG8_STAGE(PG8_SB(1, 1), cB + hstep + kstep, voffB);
        PG8_WAIT_V(6); PG8_BAR;
    } else {
        PG8_STAGE(PG8_SB(0, 0), cB, voffB); PG8_STAGE(PG8_SA(0, 0), cA, voffA); PG8_STAGE(PG8_SB(0, 1), cB + hstep, voffB); PG8_STAGE(PG8_SA(0, 1), cA + hstep, voffA);
        if (wr == 1) PG8_BAR;
        PG8_WAIT_V(4); PG8_BAR;
        PG8_STAGE(PG8_SB(1, 0), cB + kstep, voffB); PG8_STAGE(PG8_SA(1, 0), cA + kstep, voffA); PG8_STAGE(PG8_SB(1, 1), cB + hstep + kstep, voffB);
        PG8_WAIT_V(6); PG8_BAR;
    }
    for (;;) {
        const bool has_next = S.next(ui + 1, nxt);
        const char* nA = has_next ? (const char*)g.A + (size_t)nxt.pm * tstep : cA; const char* nB = has_next ? (const char*)g.Bt + (size_t)nxt.pn * tstep : cB;
        for (int t = 0; t < nt; t += 2) {
            const bool last = (t == nt - 2);
            const char* a1 = cA + (size_t)(t + 1) * kstep;
            const char* a2 = last ? nA : cA + (size_t)(t + 2) * kstep; const char* b2 = last ? nB : cB + (size_t)(t + 2) * kstep;
            const char* a3 = a2 + kstep; const char* b3 = b2 + kstep;
            if (last && has_next) S.a_ready(nxt);
            if constexpr (SP2) {
            PG8_LDB(B0, 0, 0); PG8_LDB(B1, 0, 1); PG8_SCHED; PG8_LDA(At, 0, 0); PG8_STAGE(PG8_SA(1, 1), a1 + hstep, voffA);
            PG8_WAIT_V(8); PG8_WAIT_L(0); PG8_BAR; PG8_MMA(0, 0, At, B0); PG8_MMA(0, 1, At, B1); PG8_BAR; PG8_SCHED;
            PG8_LDA(At, 0, 1); PG8_STAGE(PG8_SB(0, 0), b2, voffB); PG8_STAGE(PG8_SB(0, 1), b2 + hstep, voffB); PG8_STAGE(PG8_SA(0, 0), a2, voffA);
            PG8_WAIT_V(8); PG8_WAIT_L(0); PG8_BAR; PG8_MMA(1, 0, At, B0); PG8_MMA(1, 1, At, B1); PG8_BAR; PG8_SCHED;
            PG8_LDB(B0, 1, 0); PG8_LDB(B1, 1, 1); PG8_SCHED; PG8_LDA(At, 1, 0); PG8_STAGE(PG8_SA(0, 1), a2 + hstep, voffA);
            PG8_WAIT_V(8); PG8_WAIT_L(0); PG8_BAR; PG8_MMA(0, 0, At, B0); PG8_MMA(0, 1, At, B1); PG8_BAR; PG8_SCHED;
            PG8_LDA(At, 1, 1); PG8_STAGE(PG8_SB(1, 0), b3, voffB); PG8_STAGE(PG8_SB(1, 1), b3 + hstep, voffB); PG8_STAGE(PG8_SA(1, 0), a3, voffA);
            PG8_WAIT_V(8); PG8_WAIT_L(0); PG8_BAR; PG8_MMA(1, 0, At, B0); PG8_MMA(1, 1, At, B1); PG8_BAR; PG8_SCHED;
            } else {
            PG8_LDB(B0, 0, 0); PG8_SCHED; PG8_LDA(At, 0, 0); PG8_STAGE(PG8_SA(1, 1), a1 + hstep, voffA);
            PG8_WAIT_L(8); PG8_BAR; PG8_WAIT_L(0); PG8_MMA(0, 0, At, B0); PG8_BAR; PG8_SCHED;
            PG8_LDB(B1, 0, 1); PG8_STAGE(PG8_SB(0, 0), b2, voffB);
            PG8_BAR; PG8_WAIT_L(0); PG8_MMA(0, 1, At, B1); PG8_BAR;
            PG8_LDA(At, 0, 1); PG8_STAGE(PG8_SA(0, 0), a2, voffA);
            PG8_BAR; PG8_WAIT_L(0); PG8_MMA(1, 0, At, B0); PG8_BAR; PG8_SCHED;
            PG8_STAGE(PG8_SB(0, 1), b2 + hstep, voffB);
            PG8_WAIT_V(6); PG8_BAR; PG8_MMA(1, 1, At, B1); PG8_BAR;
            PG8_LDB(B0, 1, 0); PG8_SCHED; PG8_LDA(At, 1, 0); PG8_STAGE(PG8_SA(0, 1), a2 + hstep, voffA);
            PG8_WAIT_L(8); PG8_BAR; PG8_WAIT_L(0); PG8_MMA(0, 0, At, B0); PG8_BAR; PG8_SCHED;
            PG8_LDB(B1, 1, 1); PG8_STAGE(PG8_SB(1, 0), b3, voffB);
            PG8_BAR; PG8_WAIT_L(0); PG8_MMA(0, 1, At, B1); PG8_BAR;
            PG8_LDA(At, 1, 1); PG8_STAGE(PG8_SA(1, 0), a3, voffA);
            PG8_BAR; PG8_WAIT_L(0); PG8_MMA(1, 0, At, B0); PG8_BAR; PG8_SCHED;
            PG8_STAGE(PG8_SB(1, 1), b3 + hstep, voffB);
            PG8_WAIT_V(6); PG8_BAR; PG8_MMA(1, 1, At, B1); PG8_BAR;
            }
        }
        if constexpr (ALIGN_EPI) { if (wr == 0) PG8_BAR; }
        if constexpr (!Epi::AFTER_DRAIN) { E(acc, cur, wr, wc, fr, fq); S.done(cur); }
        if (!has_next) break;
#pragma unroll
        for (int a = 0; a < 2; ++a)
#pragma unroll
            for (int b = 0; b < 2; ++b)
#pragma unroll
                for (int m = 0; m < 4; ++m)
#pragma unroll
                    for (int n = 0; n < 2; ++n) acc[a][b][m][n] = (f32x4){0.f, 0.f, 0.f, 0.f};
        cur = nxt; cA = nA; cB = nB; ++ui;
        if constexpr (ALIGN_EPI) { if (wr == 1) PG8_BAR; }
    }
    PG8_WAIT_V(0);
    if constexpr (!ALIGN_EPI) { if (wr == 0) PG8_BAR; }
    PG8_BAR;
    if constexpr (Epi::AFTER_DRAIN) { E.fused(acc, cur, wr, wc, fr, fq, lds, wid, lane); S.done(cur); }
#undef PG8_SA
#undef PG8_SB
#undef PG8_STAGE
#undef PG8_LDA
#undef PG8_LDB
#undef PG8_MMA
#undef PG8_WAIT_V
#undef PG8_WAIT_L
#undef PG8_BAR
#undef PG8_SCHED
}
}


#define LAS __attribute__((address_space(3)))
typedef unsigned short bf16_t;
typedef short bf16x8 __attribute__((ext_vector_type(8)));
typedef short s16x4 __attribute__((ext_vector_type(4)));
typedef short v4i16_t __attribute__((ext_vector_type(4)));
typedef float f32x4 __attribute__((ext_vector_type(4)));
typedef float f32x2 __attribute__((ext_vector_type(2)));
typedef float f32x16 __attribute__((ext_vector_type(16)));
typedef unsigned u32x4 __attribute__((ext_vector_type(4)));
typedef unsigned u32x2 __attribute__((ext_vector_type(2)));

constexpr int DM = 1024, NB = 8, SEQ = 2048, MP = NB * SEQ, SL = 32, MS = NB * SL, MT = MP + MS;
constexpr int PS = 3840, DFF = 4096, INCOLS = 3600;
constexpr int C_QA = 0, C_KA = 256, C_VA = 512, C_GA = 768, C_QB = 1024, C_KB = 1280, C_VB = 1536, C_GB = 1792, C_QC = 2048, C_KC = 2560, C_VC = 3072, C_LOW = 3584;
constexpr int NREL = 320;
constexpr float EPS = 1e-6f;
constexpr size_t WS_A = 0;
constexpr size_t WS_B = WS_A + (size_t)MT * DFF * 2;
constexpr size_t WS_C = WS_B + (size_t)MT * DM * 2;
constexpr size_t WS_WIN = WS_C + (size_t)MT * DM * 2;
constexpr size_t WS_WOUT = WS_WIN + (size_t)2 * PS * DM * 2;
constexpr size_t WS_WUP = WS_WOUT + (size_t)2 * DM * DM * 2;
constexpr size_t WS_WDN = WS_WUP + (size_t)2 * DFF * DM * 2;
constexpr size_t WS_LOWF = WS_WDN + (size_t)2 * DFF * DM * 2;
constexpr size_t WS_SS = WS_LOWF + (size_t)MT * 16 * 4;
constexpr size_t WS_G = WS_SS + (size_t)5 * MT * 4;
constexpr size_t WS_ROPE = WS_G + (size_t)1024 * 64 * 4;
constexpr size_t WS_CTL = WS_ROPE + (size_t)2080 * 64 * 4;
constexpr size_t CTL_BYTES = 16384;
constexpr size_t WS_END = WS_CTL + CTL_BYTES;
static_assert((size_t)2048 * 4096 * 4 <= (size_t)MT * DM * 2, "KVT fits region C");
constexpr size_t WS_CKB = WS_A + (size_t)MT * PS * 2;
constexpr size_t CACHE_ELEMS = (size_t)8 * 512 * 512;
static_assert(WS_CKB + 2 * CACHE_ELEMS * 2 <= WS_B, "cache copies fit behind PROJ");
static_assert(WS_END <= (size_t)256 * 1024 * 1024, "d_ws map");
constexpr size_t O_Y = 0, O_RETP = (size_t)MT * DM, O_GLAP = O_RETP + 262144, O_KP = O_GLAP + 262144, O_VP = O_KP + 4194304, O_RETS = O_VP + 4194304, O_GLAS = O_RETS + 262144,
                 O_KS = O_GLAS + 262144, O_VS = O_KS + 262144, O_END = O_VS + 262144;
constexpr int TS = 144;
constexpr int TILE_B = 64 * TS;
constexpr int WAVE_LDS = 2 * TILE_B;
constexpr int LDS_BIAS = 8 * WAVE_LDS;
constexpr int NREV = 384;
constexpr int LDS_BARST = LDS_BIAS + 8 * NREV * 4;
constexpr int LDS_BYTES = LDS_BARST + 16;
static_assert(LDS_BYTES <= 160 * 1024 && pg8::STAGE_BYTES <= LDS_BIAS, "LDS map");

struct Params { const float* in[18]; float* out; unsigned char* ws; };
__device__ __forceinline__ int lane_id_asm() { int l; asm volatile("v_mbcnt_lo_u32_b32 %0, -1, 0\n\tv_mbcnt_hi_u32_b32 %0, -1, %0" : "=v"(l)); return l; }
typedef const __attribute__((address_space(4))) char* kaptr_t;
__device__ __forceinline__ kaptr_t karg_base() { kaptr_t ka = (kaptr_t)__builtin_amdgcn_kernarg_segment_ptr(); asm volatile("" : "+s"(ka)); return ka; }
__device__ __forceinline__ const float* in_ptr(int i) { return *(const float* const __attribute__((address_space(4)))*)(karg_base() + 8 * i); }
__device__ __forceinline__ float* out_ptr() { return *(float* const __attribute__((address_space(4)))*)(karg_base() + 8 * 18); }
__device__ __forceinline__ unsigned char* ws_ptr() { return *(unsigned char* const __attribute__((address_space(4)))*)(karg_base() + 8 * 19); }

typedef float f32x2_t __attribute__((ext_vector_type(2))); typedef __bf16 bf16x2_t __attribute__((ext_vector_type(2)));
__device__ __forceinline__ unsigned pk2(float lo, float hi) { const f32x2_t v = {lo, hi}; const bf16x2_t b = __builtin_convertvector(v, bf16x2_t); return __builtin_bit_cast(unsigned, b); }
__device__ __forceinline__ float bflo(unsigned u) { return __uint_as_float(u << 16); }
__device__ __forceinline__ float bfhi(unsigned u) { return __uint_as_float(u & 0xffff0000u); }
__device__ __forceinline__ float bf2f(bf16_t h) { return __uint_as_float((unsigned)h << 16); }
__device__ __forceinline__ bf16_t f2bf(float f) { return (bf16_t)(pk2(f, 0.f) & 0xffffu); }
__device__ __forceinline__ int crow(int r, int hi) { return (r & 3) + 8 * (r >> 2) + 4 * hi; }
__device__ __forceinline__ float silu(float x) { return x / (1.0f + __expf(-x)); }
__device__ __forceinline__ f32x16 mfma32(bf16x8 a, bf16x8 b, f32x16 c) { return __builtin_amdgcn_mfma_f32_32x32x16_bf16(a, b, c, 0, 0, 0); }
__device__ __forceinline__ bf16x8 as_bf16x8(u32x4 v) { return __builtin_bit_cast(bf16x8, v); }
__device__ __forceinline__ f32x16 zero16() { f32x16 z;
#pragma unroll
    for (int i = 0; i < 16; ++i) z[i] = 0.f; return z; }
__device__ __forceinline__ s16x4 ds_tr(LAS const unsigned char* p) { return __builtin_bit_cast(s16x4, __builtin_amdgcn_ds_read_tr16_b64_v4i16((LAS v4i16_t*)p)); }
__device__ __forceinline__ bf16x8 tr_nat(LAS const unsigned char* tile, int k0, int cb, int lane) {
    const int kq = lane >> 5, g = (lane >> 4) & 1, q = (lane & 15) >> 2, p = lane & 3;
    LAS const unsigned char* a = tile + (k0 + 8 * kq + q) * TS + (cb + 16 * g + 4 * p) * 2;
    const s16x4 lo = ds_tr(a), hi = ds_tr(a + 4 * TS);
    return (bf16x8){lo[0], lo[1], lo[2], lo[3], hi[0], hi[1], hi[2], hi[3]};
}
template <int STR = TS> __device__ __forceinline__ bf16x8 tr_perm(LAS const unsigned char* tile, int k0, int cb, int lane) {
    const int kq = lane >> 5, g = (lane >> 4) & 1, q = (lane & 15) >> 2, p = lane & 3;
    LAS const unsigned char* a = tile + (k0 + 4 * kq + q) * STR + (cb + 16 * g + 4 * p) * 2;
    const s16x4 lo = ds_tr(a), hi = ds_tr(a + 8 * STR);
    return (bf16x8){lo[0], lo[1], lo[2], lo[3], hi[0], hi[1], hi[2], hi[3]};
}
__device__ __forceinline__ bf16x8 tr_perm_swz(LAS const unsigned char* tile, int k0, int cb, int lane) {
    const int kq = lane >> 5, g = (lane >> 4) & 1, q = (lane & 15) >> 2, p = lane & 3;
    const int row = k0 + 4 * kq + q, ob = ((cb + 16 * g + 4 * p) * 2) ^ ((row & 2) << 5);
    LAS const unsigned char* a = tile + row * 128 + ob;
    const s16x4 lo = ds_tr(a), hi = ds_tr(a + 8 * 128);
    return (bf16x8){lo[0], lo[1], lo[2], lo[3], hi[0], hi[1], hi[2], hi[3]};
}
__device__ __forceinline__ bf16x8 row_frag(LAS const unsigned char* tile, int r0, int ks, int lane) {
    return *(LAS const bf16x8*)(tile + (r0 + (lane & 31)) * TS + (16 * ks + 8 * (lane >> 5)) * 2);
}
__device__ __forceinline__ bf16x8 pack_step(const f32x16& x, int s) {
    u32x4 w; w.x = pk2(x[8 * s + 0], x[8 * s + 1]); w.y = pk2(x[8 * s + 2], x[8 * s + 3]); w.z = pk2(x[8 * s + 4], x[8 * s + 5]); w.w = pk2(x[8 * s + 6], x[8 * s + 7]);
    return as_bf16x8(w);
}
__device__ __forceinline__ void load_tile(LAS unsigned char* tile, const bf16_t* src, int pitch, int nvalid, int lane) {
#pragma unroll
    for (int it = 0; it < 8; ++it) {
        const int id = it * 64 + lane, row = id >> 3, ch = id & 7;
        u32x4 v = (u32x4){0u, 0u, 0u, 0u};
        if (row < nvalid) v = *(const u32x4*)(src + (size_t)row * pitch + ch * 8);
        *(LAS u32x4*)(tile + row * TS + ch * 16) = v;
    }
}
__device__ __forceinline__ void store_tile(LAS const unsigned char* tile, bf16_t* dst, int pitch, int nvalid, int lane) {
#pragma unroll
    for (int it = 0; it < 8; ++it) {
        const int id = it * 64 + lane, row = id >> 3, ch = id & 7;
        const u32x4 v = *(LAS const u32x4*)(tile + row * TS + ch * 16);
        if (row < nvalid) *(u32x4*)(dst + (size_t)row * pitch + ch * 8) = v;
    }
}
__device__ __forceinline__ void load_tile_f32(LAS unsigned char* tile, const float* src, int pitch, int lane) {
#pragma unroll
    for (int it = 0; it < 16; ++it) {
        const int id = it * 64 + lane, row = id >> 4, c4 = id & 15;
        const f32x4 v = *(const f32x4*)(src + (size_t)row * pitch + c4 * 4);
        u32x2 w; w.x = pk2(v[0], v[1]); w.y = pk2(v[2], v[3]);
        *(LAS u32x2*)(tile + row * TS + c4 * 8) = w;
    }
}
__device__ __forceinline__ void load_rot(const bf16_t* rp, const float* cs, int kq, float scale, bool valid, bf16x8 (&fr)[4]) {
    u32x4 c[4];
#pragma unroll
    for (int ks = 0; ks < 4; ++ks) c[ks] = valid ? *(const u32x4*)(rp + 16 * ks + 8 * kq) : (u32x4){0u, 0u, 0u, 0u};
#pragma unroll
    for (int g = 0; g < 2; ++g) {
        const float* cp = cs + 16 * g + 8 * kq;
        const f32x4 ca = *(const f32x4*)cp, cb = *(const f32x4*)(cp + 4), sa = *(const f32x4*)(cp + 32), sb = *(const f32x4*)(cp + 36);
        float o1[8], o2[8];
#pragma unroll
        for (int e = 0; e < 8; ++e) {
            const unsigned w1 = c[g][e >> 1], w2 = c[g + 2][e >> 1];
            const float x1 = (e & 1) ? bfhi(w1) : bflo(w1), x2 = (e & 1) ? bfhi(w2) : bflo(w2);
            const float cc = (e < 4) ? ca[e & 3] : cb[e & 3], sn = (e < 4) ? sa[e & 3] : sb[e & 3];
            o1[e] = (x1 * cc - x2 * sn) * scale; o2[e] = (x1 * sn + x2 * cc) * scale;
        }
        u32x4 a, b;
        a.x = pk2(o1[0], o1[1]); a.y = pk2(o1[2], o1[3]); a.z = pk2(o1[4], o1[5]); a.w = pk2(o1[6], o1[7]);
        b.x = pk2(o2[0], o2[1]); b.y = pk2(o2[2], o2[3]); b.z = pk2(o2[4], o2[5]); b.w = pk2(o2[6], o2[7]);
        fr[g] = as_bf16x8(a); fr[g + 2] = as_bf16x8(b);
    }
}

struct Ctx {
    int l, lane, kq, li;
    const bf16_t* proj; const float* lowf; const float* rope; bf16_t* cat; float* kvt; float* gdec; float* out;
    const float* wa2; const float* ba; const float* nw; const float* st; const bf16_t* ckb; const bf16_t* cvb;
};
__device__ __forceinline__ float ret_lg2(int h) { return __log2f(1.0f - exp2f(-5.0f - (float)h)); }

struct GlaGate {
    f32x4 lw[4]; float w[16]; float bias, run;
    template <int L> __device__ __forceinline__ void init(const Ctx& C, int m0, int h) {
#pragma unroll
        for (int q = 0; q < 4; ++q) lw[q] = (C.lane < L) ? *(const f32x4*)(C.lowf + (size_t)(m0 + C.lane) * 16 + 4 * q) : (f32x4){0.f, 0.f, 0.f, 0.f};
#pragma unroll
        for (int j = 0; j < 16; ++j) w[j] = C.wa2[j * 256 + h * 64 + C.lane];
        bias = C.ba[h * 64 + C.lane]; run = 0.f;
    }
    __device__ __forceinline__ float step(int s) {
        float z0 = bias, z1 = 0.f;
#pragma unroll
        for (int j = 0; j < 16; j += 2) {
            z0 += __int_as_float(__builtin_amdgcn_readlane(__float_as_int(lw[j >> 2][j & 3]), s)) * w[j];
            z1 += __int_as_float(__builtin_amdgcn_readlane(__float_as_int(lw[(j + 1) >> 2][(j + 1) & 3]), s)) * w[j + 1];
        }
        const float z = z0 + z1;
        const float lf = fminf(z, 0.f) - __logf(1.0f + __expf(-fabsf(z)));
        run += lf * (1.0f / 16.0f);
        return run;
    }
};

template <bool SAMPLE> __device__ __forceinline__ void kv_local(const Ctx& C, int type, int b, int n, int h, LAS unsigned char* wl) {
    constexpr int L = SAMPLE ? 32 : 64, NKS = L / 16;
    const int m0 = SAMPLE ? MP + b * SL : b * SEQ + n * 64;
    const int pidx0 = SAMPLE ? 2048 : n * 64;
    LAS unsigned char* tK = wl; LAS unsigned char* tV = wl + TILE_B;
    const int lane = C.lane, kq = C.kq, li = C.li;
    float gdk = 0.f;
    if (type == 0) {
        const float lg = ret_lg2(h);
#pragma unroll
        for (int rb = 0; rb < L / 32; ++rb) {
            const int s = 32 * rb + li;
            bf16x8 fr[4];
            load_rot(C.proj + (size_t)(m0 + s) * PS + C_KA + h * 64, C.rope + (size_t)(pidx0 + s) * 64, kq, 0.125f * __builtin_amdgcn_exp2f(lg * (float)(L - 1 - s)), true, fr);
#pragma unroll
            for (int ks = 0; ks < 4; ++ks) *(LAS bf16x8*)(tK + s * TS + (16 * ks + 8 * kq) * 2) = fr[ks];
        }
        load_tile(tV, C.proj + (size_t)m0 * PS + C_VA + h * 64, PS, L, lane);
    } else {
        load_tile(tK, C.proj + (size_t)m0 * PS + C_KB + h * 64, PS, L, lane);
        GlaGate gg; gg.init<L>(C, m0, h);
        if (!SAMPLE) {
            load_tile(tV, C.proj + (size_t)m0 * PS + C_QB + h * 64, PS, L, lane);
#pragma unroll 4
            for (int s = 0; s < L; ++s) {
                const float e = __expf(gg.step(s));
                LAS bf16_t* kp = (LAS bf16_t*)(tK + s * TS + lane * 2); LAS bf16_t* qp = (LAS bf16_t*)(tV + s * TS + lane * 2);
                *kp = f2bf(bf2f(*kp) / e); *qp = f2bf(bf2f(*qp) * 0.125f * e);
            }
            asm volatile("s_waitcnt lgkmcnt(0)" ::: "memory");
            store_tile(tV, (bf16_t*)C.proj + (size_t)m0 * PS + C_QB + h * 64, PS, L, lane);
            store_tile(tK, (bf16_t*)C.proj + (size_t)m0 * PS + C_KB + h * 64, PS, L, lane);
            asm volatile("s_waitcnt lgkmcnt(0)" ::: "memory");
            load_tile(tV, C.proj + (size_t)m0 * PS + C_VB + h * 64, PS, L, lane);
        } else {
            load_tile(tV, C.proj + (size_t)m0 * PS + C_VB + h * 64, PS, L, lane);
#pragma unroll 4
            for (int s = 0; s < L; ++s) {
                const float bs = gg.step(s);
                LAS bf16_t* kp = (LAS bf16_t*)(tK + s * TS + lane * 2);
                *kp = f2bf(bf2f(*kp) * __expf(-bs));
            }
        }
        gdk = __expf(gg.run);
    }
    f32x16 kv[2][2];
#pragma unroll
    for (int db = 0; db < 2; ++db)
#pragma unroll
        for (int kb = 0; kb < 2; ++kb) kv[db][kb] = zero16();
#pragma unroll
    for (int ks = 0; ks < NKS; ++ks) {
        bf16x8 a[2], bb[2];
#pragma unroll
        for (int db = 0; db < 2; ++db) a[db] = tr_nat(tV, 16 * ks, 32 * db, lane);
#pragma unroll
        for (int kb = 0; kb < 2; ++kb) bb[kb] = tr_nat(tK, 16 * ks, 32 * kb, lane);
#pragma unroll
        for (int db = 0; db < 2; ++db)
#pragma unroll
            for (int kb = 0; kb < 2; ++kb) kv[db][kb] = mfma32(a[db], bb[kb], kv[db][kb]);
    }
    if (type == 1) {
#pragma unroll
        for (int kb = 0; kb < 2; ++kb) { const float cs = __int_as_float(__builtin_amdgcn_ds_bpermute((32 * kb + li) * 4, __float_as_int(gdk)));
#pragma unroll
            for (int db = 0; db < 2; ++db) kv[db][kb] = kv[db][kb] * cs; }
    }
    if (!SAMPLE) {
        const int uidx = ((type * 8 + b) * 4 + h) * 32 + n;
        bf16_t* dst = (bf16_t*)C.kvt + (size_t)uidx * 4096;
#pragma unroll
        for (int db = 0; db < 2; ++db)
#pragma unroll
            for (int kb = 0; kb < 2; ++kb)
#pragma unroll
                for (int r = 0; r < 16; ++r) dst[(32 * db + crow(r, kq)) * 64 + 32 * kb + li] = f2bf(kv[db][kb][r]);
        if (type == 1) C.gdec[(size_t)(((b * 4 + h) * 32 + n)) * 64 + lane] = gdk;
    } else {
        const float* s0 = C.st + (size_t)((C.l * 8 + b) * 4 + h) * 4096;
        float* so = C.out + (type == 0 ? O_RETS : O_GLAS) + (size_t)((C.l * 8 + b) * 4 + h) * 4096;
        const float dret = exp2f(ret_lg2(h) * (float)L);
#pragma unroll
        for (int kb = 0; kb < 2; ++kb) {
            const int dk = 32 * kb + li;
            const float dec = (type == 0) ? dret : __int_as_float(__builtin_amdgcn_ds_bpermute(dk * 4, __float_as_int(gdk)));
#pragma unroll
            for (int db = 0; db < 2; ++db)
#pragma unroll
                for (int rr = 0; rr < 4; ++rr) {
                    const int dv = 32 * db + 8 * rr + 4 * kq;
                    const f32x4 o = *(const f32x4*)(s0 + dk * 64 + dv);
                    f32x4 nv;
#pragma unroll
                    for (int e = 0; e < 4; ++e) nv[e] = dec * o[e] + kv[db][kb][4 * rr + e];
                    *(f32x4*)(so + dk * 64 + dv) = nv;
                }
        }
    }
}

template <bool SAMPLE> __device__ __forceinline__ void mix_out(const Ctx& C, int type, int b, int n, int h, LAS unsigned char* wl) {
    constexpr int L = SAMPLE ? 32 : 64, NTB = L / 32;
    const int m0 = SAMPLE ? MP + b * SL : b * SEQ + n * 64;
    const int pidx0 = SAMPLE ? 2048 : n * 64;
    LAS unsigned char* t0 = wl; LAS unsigned char* t1 = wl + TILE_B;
    const int lane = C.lane, kq = C.kq, li = C.li;
    bf16x8 qfr[NTB][4];
    const float lg = ret_lg2(h);
    if (type == 0) {
#pragma unroll
        for (int tb = 0; tb < NTB; ++tb) {
            const int s = 32 * tb + li;
            load_rot(C.proj + (size_t)(m0 + s) * PS + C_QA + h * 64, C.rope + (size_t)(pidx0 + s) * 64, kq, __builtin_amdgcn_exp2f(lg * (float)(s + 1)), true, qfr[tb]);
        }
        load_tile(t0, C.proj + (size_t)m0 * PS + C_VA + h * 64, PS, L, lane);
    } else {
        load_tile(t0, C.proj + (size_t)m0 * PS + C_QB + h * 64, PS, L, lane);
        load_tile(t1, C.proj + (size_t)m0 * PS + C_KB + h * 64, PS, L, lane);
        if (SAMPLE) {
            GlaGate gg; gg.init<L>(C, m0, h);
#pragma unroll 4
            for (int s = 0; s < L; ++s) {
                const float e = __expf(gg.step(s));
                LAS bf16_t* qp = (LAS bf16_t*)(t0 + s * TS + lane * 2); LAS bf16_t* kp = (LAS bf16_t*)(t1 + s * TS + lane * 2);
                *qp = f2bf(bf2f(*qp) * 0.125f * e); *kp = f2bf(bf2f(*kp) / e);
            }
        }
        __builtin_amdgcn_sched_barrier(0);
#pragma unroll
        for (int tb = 0; tb < NTB; ++tb)
#pragma unroll
            for (int ks = 0; ks < 4; ++ks) qfr[tb][ks] = row_frag(t0, 32 * tb, ks, lane);
        asm volatile("s_waitcnt lgkmcnt(0)" ::: "memory");
        __builtin_amdgcn_sched_barrier(0);
        load_tile(t0, C.proj + (size_t)m0 * PS + C_VB + h * 64, PS, L, lane);
    }
    __builtin_amdgcn_sched_barrier(0);
    f32x16 o[2][NTB];
#pragma unroll
    for (int db = 0; db < 2; ++db)
#pragma unroll
        for (int tb = 0; tb < NTB; ++tb) o[db][tb] = zero16();
    {
        const int uidx = ((type * 8 + b) * 4 + h) * 32 + n;
        const bf16_t* sT = (const bf16_t*)C.kvt + (size_t)uidx * 4096;
        const float* s0 = C.st + (size_t)((C.l * 8 + b) * 4 + h) * 4096;
#pragma unroll
        for (int db = 0; db < 2; ++db)
#pragma unroll
            for (int ks = 0; ks < 4; ++ks) {
                const int dv = 32 * db + li, dk0 = 16 * ks + 8 * kq;
                bf16x8 sa;
                if (!SAMPLE) sa = as_bf16x8(*(const u32x4*)(sT + dv * 64 + dk0));
                else { float sv[8];
#pragma unroll
                    for (int e = 0; e < 8; ++e) sv[e] = s0[(dk0 + e) * 64 + dv];
                    u32x4 w; w.x = pk2(sv[0], sv[1]); w.y = pk2(sv[2], sv[3]); w.z = pk2(sv[4], sv[5]); w.w = pk2(sv[6], sv[7]);
                    sa = as_bf16x8(w); }
#pragma unroll
                for (int tb = 0; tb < NTB; ++tb) o[db][tb] = mfma32(sa, qfr[tb][ks], o[db][tb]);
            }
    }
    __builtin_amdgcn_sched_barrier(0);
#pragma unroll
    for (int sb = 0; sb < NTB; ++sb) {
        bf16x8 kfr[4];
        if (type == 0) load_rot(C.proj + (size_t)(m0 + 32 * sb + li) * PS + C_KA + h * 64, C.rope + (size_t)(pidx0 + 32 * sb + li) * 64, kq, 0.125f * __builtin_amdgcn_exp2f(-lg * (float)(32 * sb + li + 1)), true, kfr);
        else {
#pragma unroll
            for (int ks = 0; ks < 4; ++ks) kfr[ks] = row_frag(t1, 32 * sb, ks, lane);
        }
        f32x16 st[NTB];
#pragma unroll
        for (int tb = sb; tb < NTB; ++tb) {
            f32x16 a = zero16();
#pragma unroll
            for (int ks = 0; ks < 4; ++ks) a = mfma32(kfr[ks], qfr[tb][ks], a);
#pragma unroll
            for (int r = 0; r < 16; ++r) {
                const int s = 32 * sb + crow(r, kq), t = 32 * tb + li;
                a[r] = (t >= s) ? a[r] : 0.0f;
            }
            st[tb] = a;
        }
#pragma unroll
        for (int half = 0; half < 2; ++half) {
            bf16x8 va[2];
#pragma unroll
            for (int db = 0; db < 2; ++db) va[db] = tr_perm(t0, 32 * sb + 16 * half, 32 * db, lane);
#pragma unroll
            for (int tb = sb; tb < NTB; ++tb) {
                const bf16x8 pf = pack_step(st[tb], half);
#pragma unroll
                for (int db = 0; db < 2; ++db) o[db][tb] = mfma32(va[db], pf, o[db][tb]);
            }
        }
        __builtin_amdgcn_sched_barrier(0);
    }
    const float* nw = C.nw + h * 64;
    const int gcol = (type == 0 ? C_GA : C_GB) + h * 64;
#pragma unroll
    for (int tb = 0; tb < NTB; ++tb) {
        const int t = 32 * tb + li;
        float s1 = 0.f, s2 = 0.f;
#pragma unroll
        for (int db = 0; db < 2; ++db)
#pragma unroll
            for (int r = 0; r < 16; ++r) { const float x = o[db][tb][r]; s1 += x; s2 += x * x; }
        s1 += __shfl_xor(s1, 32); s2 += __shfl_xor(s2, 32);
        float mu = 0.f, rstd;
        if (type == 0) { mu = s1 * (1.0f / 64.0f); const float var = fmaxf(s2 * (1.0f / 64.0f) - mu * mu, 0.f); rstd = 1.0f / sqrtf(var + EPS); }
        else rstd = 1.0f / sqrtf(s2 * (1.0f / 64.0f) + EPS);
        const bf16_t* grow = C.proj + (size_t)(m0 + t) * PS + gcol;
        bf16_t* orow = C.cat + (size_t)(m0 + t) * DM + type * 256 + h * 64;
#pragma unroll
        for (int db = 0; db < 2; ++db)
#pragma unroll
            for (int rr = 0; rr < 4; ++rr) {
                const int dv = 32 * db + 8 * rr + 4 * kq;
                const u32x2 gw = *(const u32x2*)(grow + dv);
                const f32x4 wv = *(const f32x4*)(nw + dv);
                const float g0 = bflo(gw.x), g1 = bfhi(gw.x), g2 = bflo(gw.y), g3 = bfhi(gw.y);
                const float y0 = (o[db][tb][4 * rr + 0] - mu) * rstd * wv[0] * silu(g0), y1 = (o[db][tb][4 * rr + 1] - mu) * rstd * wv[1] * silu(g1);
                const float y2 = (o[db][tb][4 * rr + 2] - mu) * rstd * wv[2] * silu(g2), y3 = (o[db][tb][4 * rr + 3] - mu) * rstd * wv[3] * silu(g3);
                u32x2 w; w.x = pk2(y0, y1); w.y = pk2(y2, y3);
                *(u32x2*)(orow + dv) = w;
            }
    }
}

template <bool SAMPLE> __device__ __forceinline__ void attn_wave(const Ctx& C, int b, int n, int h, LAS unsigned char* wl, LAS const float* revT, float cb2) {
    constexpr int NTB = SAMPLE ? 1 : 2;
    constexpr float SC = 0.125f * 1.4426950408889634f;
    const int m0 = SAMPLE ? MP + b * SL : b * SEQ + n * 64;
    const int lane = C.lane, kq = C.kq, li = C.li;
    const int jt0 = SAMPLE ? 0 : (n < 8 ? 8 - n : 0);
#define ATT_SRC(jt, kp, vp, pitch, rmask) const bf16_t* kp; const bf16_t* vp; int pitch; int rmask = 63; \
    if (SAMPLE && (jt) < 8) { kp = C.ckb + (size_t)(b * 512 + 64 * (jt)) * 512 + h * 64; vp = C.cvb + (size_t)(b * 512 + 64 * (jt)) * 512 + h * 64; pitch = 512; } \
    else { const int kr0 = SAMPLE ? m0 : b * SEQ + (n - 8 + (jt)) * 64; kp = C.proj + (size_t)kr0 * PS + C_KC + h * 64; vp = kp + (C_VC - C_KC); pitch = PS; if (SAMPLE) rmask = 31; }
#define ATT_ISSUE(jt, kdst, vbuf) do { ATT_SRC(jt, kp_, vp_, pitch_, rmask_); \
    _Pragma("unroll") for (int sb = 0; sb < 2; ++sb) _Pragma("unroll") for (int ks = 0; ks < 4; ++ks) kdst[sb][ks] = *(const u32x4*)(kp_ + (size_t)((32 * sb + li) & rmask_) * pitch_ + 16 * ks + 8 * kq); \
    _Pragma("unroll") for (int it = 0; it < 8; ++it) __builtin_amdgcn_global_load_lds((const unsigned*)(vp_ + (size_t)((it * 8 + (lane >> 3)) & rmask_) * pitch_ + (((lane & 7) ^ (((lane >> 3) & 2) << 1)) * 8)), (LAS unsigned*)((vbuf) + it * 1024), 16, 0, 0); } while (0)
    bf16x8 qfr[NTB][4];
#pragma unroll
    for (int tb = 0; tb < NTB; ++tb)
#pragma unroll
        for (int ks = 0; ks < 4; ++ks) qfr[tb][ks] = as_bf16x8(*(const u32x4*)(C.proj + (size_t)(m0 + 32 * tb + li) * PS + C_QC + h * 64 + 16 * ks + 8 * kq));
    f32x16 o[2][NTB]; float mrun[NTB], lrun[NTB];
#pragma unroll
    for (int tb = 0; tb < NTB; ++tb) { mrun[tb] = -1e30f; lrun[tb] = 0.f;
#pragma unroll
        for (int db = 0; db < 2; ++db) o[db][tb] = zero16(); }
    u32x4 kcur[2][4], knext[2][4];
    ATT_ISSUE(jt0, kcur, wl + ((jt0 & 1) ? TILE_B : 0));
    for (int jt = jt0; jt <= 8; ++jt) {
        asm volatile("s_waitcnt vmcnt(0)" ::: "memory");
        __builtin_amdgcn_sched_barrier(0);
        LAS unsigned char* tV = wl + ((jt & 1) ? TILE_B : 0);
        if (jt < 8) { ATT_ISSUE(jt + 1, knext, wl + (((jt + 1) & 1) ? TILE_B : 0)); }
        __builtin_amdgcn_sched_barrier(0);
        const bool cst = jt <= 3;
#pragma unroll
        for (int sb = 0; sb < 2; ++sb) {
            if (SAMPLE && jt == 8 && sb == 1) continue;
#pragma unroll
            for (int tb = 0; tb < NTB; ++tb) {
                f32x16 a = zero16();
#pragma unroll
                for (int ks = 0; ks < 4; ++ks) a = mfma32(as_bf16x8(kcur[sb][ks]), qfr[tb][ks], a);
                if (!cst) {
                    const int dbase = (8 - jt) * 64 + 63 + 32 * tb + li - 32 * sb;
                    LAS const float* rp = revT + (382 - dbase + 4 * kq);
#pragma unroll
                    for (int r = 0; r < 16; ++r) a[r] = a[r] * SC + rp[(r & 3) + 8 * (r >> 2)];
                }
                float mx = -1e30f;
#pragma unroll
                for (int r = 0; r < 16; ++r) mx = fmaxf(mx, a[r]);
                if (cst) mx = mx * SC + cb2;
                mx = fmaxf(mx, __shfl_xor(mx, 32));
                const float mnew = fmaxf(mrun[tb], mx);
                const bool moved = __builtin_amdgcn_ballot_w64(mnew != mrun[tb]) != 0ull;
                const float alpha = __builtin_amdgcn_exp2f(mrun[tb] - mnew);
                mrun[tb] = mnew;
                float ps = 0.f;
                if (cst) { const float off = cb2 - mnew;
#pragma unroll
                    for (int r = 0; r < 16; ++r) { const float pp = __builtin_amdgcn_exp2f(a[r] * SC + off); a[r] = pp; ps += pp; } }
                else {
#pragma unroll
                    for (int r = 0; r < 16; ++r) { const float pp = __builtin_amdgcn_exp2f(a[r] - mnew); a[r] = pp; ps += pp; } }
                lrun[tb] = lrun[tb] * alpha + ps;
                if (moved) {
#pragma unroll
                    for (int db = 0; db < 2; ++db) o[db][tb] = o[db][tb] * alpha;
                }
#pragma unroll
                for (int half = 0; half < 2; ++half) {
                    const bf16x8 pf = pack_step(a, half);
#pragma unroll
                    for (int db = 0; db < 2; ++db) o[db][tb] = mfma32(tr_perm_swz(tV, 32 * sb + 16 * half, 32 * db, lane), pf, o[db][tb]);
                }
            }
        }
#pragma unroll
        for (int sb = 0; sb < 2; ++sb)
#pragma unroll
            for (int ks = 0; ks < 4; ++ks) kcur[sb][ks] = knext[sb][ks];
    }
#pragma unroll
    for (int tb = 0; tb < NTB; ++tb) {
        const float lt = lrun[tb] + __shfl_xor(lrun[tb], 32), inv = 1.0f / lt;
        bf16_t* orow = C.cat + (size_t)(m0 + 32 * tb + li) * DM + 512 + h * 64;
#pragma unroll
        for (int db = 0; db < 2; ++db)
#pragma unroll
            for (int rr = 0; rr < 4; ++rr) {
                u32x2 w; w.x = pk2(o[db][tb][4 * rr] * inv, o[db][tb][4 * rr + 1] * inv); w.y = pk2(o[db][tb][4 * rr + 2] * inv, o[db][tb][4 * rr + 3] * inv);
                *(u32x2*)(orow + 32 * db + 8 * rr + 4 * kq) = w;
            }
    }
#undef ATT_ISSUE
#undef ATT_SRC
}

__device__ __forceinline__ void conv_cache(const float* ck, const float* cv, bf16_t* dst, int l, int gt, int NGT) {
    for (int i = gt; i < (int)(2 * CACHE_ELEMS / 8); i += NGT) {
        const bool isv = i >= (int)(CACHE_ELEMS / 8); const int j = isv ? i - (int)(CACHE_ELEMS / 8) : i;
        const float* s = (isv ? cv : ck) + (size_t)l * CACHE_ELEMS + (size_t)j * 8;
        const f32x4 x = *(const f32x4*)s, y = *(const f32x4*)(s + 4);
        u32x4 w; w.x = pk2(x[0], x[1]); w.y = pk2(x[2], x[3]); w.z = pk2(y[0], y[1]); w.w = pk2(y[2], y[3]);
        *(u32x4*)(dst + (size_t)i * 8) = w;
    }
}

__device__ __forceinline__ int win_src(int n) { return n < 2048 ? n : (n < 3584 ? n + 16 : (n < 3600 ? n - 1536 : -1)); }
__device__ __forceinline__ void tr_item(const float* W, int K, int Nsrc, bf16_t* WT, int kb, int nb, bool inmap, const float* kscale, LAS float* scr, int lane) {
    const int k0 = 64 * kb, n0 = 32 * nb, n = n0 + (lane & 31), sc = inmap ? win_src(n) : n;
    float wv[32];
#pragma unroll
    for (int i = 0; i < 32; ++i) { const int kk = 2 * i + (lane >> 5); wv[i] = (sc >= 0) ? W[(size_t)(k0 + kk) * Nsrc + sc] : 0.f; }
    if (kscale) {
#pragma unroll
        for (int i = 0; i < 32; ++i) wv[i] *= kscale[k0 + 2 * i + (lane >> 5)];
    }
#pragma unroll
    for (int i = 0; i < 32; ++i) scr[(2 * i + (lane >> 5)) * 33 + (lane & 31)] = wv[i];
    asm volatile("s_waitcnt lgkmcnt(0)" ::: "memory");
    const int c = lane & 7;
#pragma unroll
    for (int j = 0; j < 4; ++j) { const int nn = (lane >> 3) + 8 * j; const LAS float* s = scr + (8 * c) * 33 + nn;
        u32x4 o; o.x = pk2(s[0 * 33], s[1 * 33]); o.y = pk2(s[2 * 33], s[3 * 33]); o.z = pk2(s[4 * 33], s[5 * 33]); o.w = pk2(s[6 * 33], s[7 * 33]);
        *(u32x4*)(WT + (size_t)(n0 + nn) * K + k0 + 8 * c) = o; }
    asm volatile("s_waitcnt lgkmcnt(0)" ::: "memory");
}


enum { SK_IN = 0, SK_RES = 1, SK_UP = 2 };
struct SArgs {
    const bf16_t* A; const bf16_t* Bt; int K, nunits;
    bf16_t* obf; int ldo;
    const float* ss_in; float* ss_out;
    const bf16_t* xold; float* xr;
    float* lowf; float* ksout; float* vsout;
};
template <int KIND> __device__ __forceinline__ void sample_gemm(LAS unsigned char* lds, const SArgs& a, int ubeg, int ustep, int wave, int lane) {
    const int kq = lane >> 5, li = lane & 31, K = a.K, kw = K >> 3, kbeg = wave * kw;
    for (int u = ubeg; u < a.nunits; u += ustep) {
        const int row0 = 64 * (u & 3), col0 = 64 * (u >> 2);
        f32x16 acc[2][2];
#pragma unroll
        for (int rb = 0; rb < 2; ++rb)
#pragma unroll
            for (int cb = 0; cb < 2; ++cb) acc[rb][cb] = zero16();
        const bf16_t* ap = a.A + (size_t)(row0 + li) * K + kbeg + 8 * kq;
        const bf16_t* bp = a.Bt + (size_t)(col0 + li) * K + kbeg + 8 * kq;
        u32x4 af[4][2], bv[4][2], an[4][2], bn[4][2];
#define SG_LOAD(dsta, dstb, k) _Pragma("unroll") for (int s = 0; s < 4; ++s) _Pragma("unroll") for (int h = 0; h < 2; ++h) { dsta[s][h] = *(const u32x4*)(ap + (size_t)(32 * h) * K + (k) + 16 * s); dstb[s][h] = *(const u32x4*)(bp + (size_t)(32 * h) * K + (k) + 16 * s); }
        SG_LOAD(af, bv, 0);
        for (int k = 0; k < kw; k += 64) {
            if (k + 64 < kw) { SG_LOAD(an, bn, k + 64); }
#pragma unroll
            for (int s = 0; s < 4; ++s)
#pragma unroll
                for (int rb = 0; rb < 2; ++rb)
#pragma unroll
                    for (int cb = 0; cb < 2; ++cb) acc[rb][cb] = mfma32(as_bf16x8(af[s][rb]), as_bf16x8(bv[s][cb]), acc[rb][cb]);
#pragma unroll
            for (int s = 0; s < 4; ++s)
#pragma unroll
                for (int h = 0; h < 2; ++h) { af[s][h] = an[s][h]; bv[s][h] = bn[s][h]; }
        }
#undef SG_LOAD
        LAS float* wp = (LAS float*)(lds + wave * WAVE_LDS);
#pragma unroll
        for (int rb = 0; rb < 2; ++rb)
#pragma unroll
            for (int cb = 0; cb < 2; ++cb)
#pragma unroll
                for (int r = 0; r < 16; ++r) wp[(32 * rb + crow(r, kq)) * 64 + 32 * cb + li] = acc[rb][cb][r];
        __syncthreads();
        const int t = wave * 64 + lane, row = t >> 3, c8 = (t & 7) * 8;
        float v[8];
#pragma unroll
        for (int e = 0; e < 8; ++e) v[e] = 0.f;
#pragma unroll
        for (int w = 0; w < 8; ++w) {
            const f32x4 x = *(LAS const f32x4*)(lds + w * WAVE_LDS + (row * 64 + c8) * 4), y = *(LAS const f32x4*)(lds + w * WAVE_LDS + (row * 64 + c8) * 4 + 16);
#pragma unroll
            for (int e = 0; e < 4; ++e) { v[e] += x[e]; v[4 + e] += y[e]; }
        }
        const int r = row0 + row, c = col0 + c8;
        if (KIND == SK_IN || KIND == SK_UP) {
            const float rs = 1.0f / sqrtf(a.ss_in[r] * (1.0f / 1024.0f) + EPS);
#pragma unroll
            for (int e = 0; e < 8; ++e) { v[e] *= rs; if (KIND == SK_UP) { const float q = fmaxf(v[e], 0.f); v[e] = q * q; } }
        }
        if (KIND == SK_RES) {
            const u32x4 xw = *(const u32x4*)(a.xold + (size_t)r * 1024 + c);
            float sq = 0.f;
            v[0] += bflo(xw.x); v[1] += bfhi(xw.x); v[2] += bflo(xw.y); v[3] += bfhi(xw.y); v[4] += bflo(xw.z); v[5] += bfhi(xw.z); v[6] += bflo(xw.w); v[7] += bfhi(xw.w);
#pragma unroll
            for (int e = 0; e < 8; ++e) sq += v[e] * v[e];
            if (a.xr) { float* xn = a.xr + (size_t)r * 1024 + c;
                *(f32x4*)xn = (f32x4){v[0], v[1], v[2], v[3]}; *(f32x4*)(xn + 4) = (f32x4){v[4], v[5], v[6], v[7]}; }
            sq += __shfl_xor(sq, 1); sq += __shfl_xor(sq, 2); sq += __shfl_xor(sq, 4);
            if ((t & 7) == 0) atomicAdd(a.ss_out + r, sq);
        }
        if (a.obf) { u32x4 w; w.x = pk2(v[0], v[1]); w.y = pk2(v[2], v[3]); w.z = pk2(v[4], v[5]); w.w = pk2(v[6], v[7]); *(u32x4*)(a.obf + (size_t)r * a.ldo + c) = w; }
        if (KIND == SK_IN) {
            float* d = nullptr;
            if (c >= C_KC && c < C_VC) d = a.ksout + (size_t)r * 512 + (c - C_KC);
            else if (c >= C_VC && c < C_LOW) d = a.vsout + (size_t)r * 512 + (c - C_VC);
            else if (c >= C_LOW && c < C_LOW + 16) d = a.lowf + (size_t)r * 16 + (c - C_LOW);
            if (d) { *(f32x4*)d = (f32x4){v[0], v[1], v[2], v[3]}; *(f32x4*)(d + 4) = (f32x4){v[4], v[5], v[6], v[7]}; }
        }
        __syncthreads();
    }
}
__device__ __forceinline__ void sample_share(int nwg, int G, int bx, int& ubeg, int& ustep) { const int nfull = nwg % G; if (nfull == 0) { ubeg = bx; ustep = G; } else if (bx >= nfull) { ubeg = bx - nfull; ustep = G - nfull; } else { ubeg = 1 << 30; ustep = 1; } }

#define XB_TMO      128
#define XB_XCNT(j)  (256  + 64 * (j))
#define XB_XSUB(j)  (1280 + 64 * (j))
#define XB_XGEN(j)  (2304 + 64 * (j))
#define XB_TOP      3328
#define XB_TOPGEN   3392
#define XCD_BAR_WORDS 3456
#define XB_SPIN_CAP (1u << 18)

__device__ __forceinline__ unsigned xb_ld(unsigned* p)              { return __hip_atomic_load(p, __ATOMIC_RELAXED, __HIP_MEMORY_SCOPE_AGENT); }
__device__ __forceinline__ unsigned xb_add(unsigned* p, unsigned v) { return __hip_atomic_fetch_add(p, v, __ATOMIC_RELAXED, __HIP_MEMORY_SCOPE_AGENT); }
__device__ __forceinline__ unsigned xb_xcc_id() { return (unsigned)__builtin_amdgcn_s_getreg((3 << 11) | 20) & 0xFu; }
#define XB_SPIN(cond, bar) do { unsigned _sp = 0; while (cond) { __builtin_amdgcn_s_sleep(1); \
    if ((++_sp & 255u) == 0u) { if (xb_ld(&(bar)[XB_TMO])) break; if (_sp > XB_SPIN_CAP) { atomicAdd(&(bar)[XB_TMO], 1u); break; } } } } while (0)

struct XcdBarrier {
    unsigned* bar; unsigned x; bool wave0;
    volatile LAS unsigned* st;
};

__device__ __forceinline__ XcdBarrier xcd_barrier_post(unsigned* bar, volatile LAS unsigned* st) {
    XcdBarrier b; b.bar = bar; b.x = xb_xcc_id(); b.st = st;
    if (threadIdx.x == 0) (void)xb_add(&bar[XB_XCNT(b.x)], 1u);
    return b;
}
__device__ __forceinline__ void xcd_barrier_complete(unsigned* bar, unsigned x, unsigned& nloc, unsigned& nx) {
    const unsigned G = gridDim.x * gridDim.y * gridDim.z;
    unsigned sum, cnt, mine, sp = 0u;
    for (;;) {
        sum = 0u; cnt = 0u; mine = 0u;
#pragma unroll
        for (unsigned j = 0; j < 16; ++j) { const unsigned c = xb_ld(&bar[XB_XCNT(j)]); sum += c; cnt += (c > 0u) ? 1u : 0u; mine = (j == x) ? c : mine; }
        if (sum == G) break;
        __builtin_amdgcn_s_sleep(1);
        if ((++sp & 255u) == 0u) { if (xb_ld(&bar[XB_TMO])) break; if (sp > XB_SPIN_CAP) { atomicAdd(&bar[XB_TMO], 1u); break; } }
    }
    nloc = mine > 0u ? mine : 1u; nx = cnt > 0u ? cnt : 1u;
}

__device__ __forceinline__ void xcd_barrier(const XcdBarrier& b) {
    asm volatile("s_waitcnt vmcnt(0)" ::: "memory");
    __syncthreads();
    if (b.wave0 && lane_id_asm() == 0) {
        unsigned* bar = b.bar;
        __builtin_amdgcn_s_waitcnt(0);
        unsigned nloc = b.st[0], nx = b.st[1];
        if (nloc == 0u) { xcd_barrier_complete(bar, b.x, nloc, nx); b.st[0] = nloc; b.st[1] = nx; }
        const unsigned old = xb_add(&bar[XB_XSUB(b.x)], 1u);
        const unsigned gen = old / nloc;
        if (old + 1u == (gen + 1u) * nloc) {
            __builtin_amdgcn_fence(__ATOMIC_RELEASE, "agent");
            asm volatile("s_waitcnt vmcnt(0)" ::: "memory");
            const unsigned og = xb_add(&bar[XB_TOP], 1u);
            const unsigned tg = og / nx;
            if (og + 1u == (tg + 1u) * nx) xb_add(&bar[XB_TOPGEN], 1u);
            else XB_SPIN(xb_ld(&bar[XB_TOPGEN]) == tg, bar);
            __builtin_amdgcn_fence(__ATOMIC_ACQUIRE, "agent");
            xb_add(&bar[XB_XGEN(b.x)], 1u);
            asm volatile("s_waitcnt vmcnt(0)" ::: "memory");
        } else {
            XB_SPIN(xb_ld(&bar[XB_XGEN(b.x)]) == gen, bar);
            __builtin_amdgcn_fence(__ATOMIC_ACQUIRE, "agent");
            asm volatile("s_waitcnt vmcnt(0)" ::: "memory");
        }
    }
    __syncthreads();
}


__device__ __forceinline__ void tr_item128(const float* W, int K, int Nsrc, bf16_t* WT, int kb, int nb, const float* kscale, LAS float* scr, int lane) {
    const int k0 = 32 * kb, n0 = 128 * nb, n4 = (lane & 31) * 4;
    f32x4 wv[16];
#pragma unroll
    for (int i = 0; i < 16; ++i) wv[i] = *(const f32x4*)(W + (size_t)(k0 + 2 * i + (lane >> 5)) * Nsrc + n0 + n4);
    if (kscale) {
#pragma unroll
        for (int i = 0; i < 16; ++i) wv[i] = wv[i] * kscale[k0 + 2 * i + (lane >> 5)];
    }
#pragma unroll
    for (int i = 0; i < 16; ++i) { LAS float* d = scr + (2 * i + (lane >> 5)) * 129 + n4; d[0] = wv[i][0]; d[1] = wv[i][1]; d[2] = wv[i][2]; d[3] = wv[i][3]; }
    asm volatile("s_waitcnt lgkmcnt(0)" ::: "memory");
#pragma unroll
    for (int j = 0; j < 8; ++j) { const int id = j * 64 + lane, n = id >> 2, c = id & 3; const LAS float* s = scr + (8 * c) * 129 + n;
        u32x4 o; o.x = pk2(s[0 * 129], s[1 * 129]); o.y = pk2(s[2 * 129], s[3 * 129]); o.z = pk2(s[4 * 129], s[5 * 129]); o.w = pk2(s[6 * 129], s[7 * 129]);
        *(u32x4*)(WT + (size_t)(n0 + n) * K + k0 + 8 * c) = o; }
    asm volatile("s_waitcnt lgkmcnt(0)" ::: "memory");
}
constexpr int CONV_WGS = 16;

__global__ void __launch_bounds__(512, 2) hybrid_fwd(Params p) {
    extern __shared__ __attribute__((aligned(16))) unsigned char lds_raw[];
    cg::grid_group grid = cg::this_grid();
    LAS unsigned char* lds = (LAS unsigned char*)lds_raw;
    const int wave = __builtin_amdgcn_readfirstlane((int)threadIdx.x >> 6);
    const int G = gridDim.x, bx = blockIdx.x;
#define WSP(off) (ws_ptr() + (off))
#define LANE_TID() const int lane = lane_id_asm(); const int tid = wave * 64 + lane; (void)tid; int Gq = G, bxq = bx; asm volatile("" : "+s"(Gq), "+s"(bxq)); (void)Gq; (void)bxq
    LAS unsigned char* wl = lds + wave * WAVE_LDS;
    LAS float* biasT = (LAS float*)(lds + LDS_BIAS);
    if (threadIdx.x < 4) ((LAS unsigned*)(lds + LDS_BARST))[threadIdx.x] = 0u;
    __syncthreads();
    XcdBarrier xbar = xcd_barrier_post((unsigned*)WSP(WS_CTL), (volatile LAS unsigned*)(lds + LDS_BARST)); xbar.wave0 = (wave == 0);

    for (int rep = 0; rep < 1 + PROBE_P0X2; ++rep) {
        LANE_TID();
        unsigned char* ws = ws_ptr();
        bf16_t* XB = (bf16_t*)(ws + WS_B); bf16_t* WIN = (bf16_t*)(ws + WS_WIN); bf16_t* WOUT = (bf16_t*)(ws + WS_WOUT); bf16_t* WUP = (bf16_t*)(ws + WS_WUP); bf16_t* WDN = (bf16_t*)(ws + WS_WDN);
        float* SS = (float*)(ws + WS_SS); float* ROPE = (float*)(ws + WS_ROPE);
        const int gw = bx * 8 + wave, NGW = G * 8;
        LAS float* scr = (LAS float*)wl;
        constexpr int I_IN = 16 * (PS / 32), I_OUT = 16 * 32, I_UP = 16 * 128, I_DN = 64 * 32, I_L = I_IN + I_OUT + I_UP + I_DN;
        const bool split = (G == 256);
        for (int it = gw; it < 2 * I_L; it += NGW) {
            const int l = it / I_L; int r = it % I_L;
            if (split && r >= I_IN) continue;
            if (r < I_IN) { tr_item(in_ptr(9) + (size_t)l * DM * INCOLS, DM, INCOLS, WIN + (size_t)l * PS * DM, r / (PS / 32), r % (PS / 32), true, in_ptr(6) + l * DM, scr, lane); continue; } r -= I_IN;
            if (r < I_OUT) { tr_item(in_ptr(15) + (size_t)l * DM * DM, DM, DM, WOUT + (size_t)l * DM * DM, r / 32, r % 32, false, nullptr, scr, lane); continue; } r -= I_OUT;
            if (r < I_UP) { tr_item(in_ptr(16) + (size_t)l * DM * DFF, DM, DFF, WUP + (size_t)l * DFF * DM, r / 128, r % 128, false, in_ptr(7) + l * DM, scr, lane); continue; } r -= I_UP;
            tr_item(in_ptr(17) + (size_t)l * DFF * DM, DFF, DM, WDN + (size_t)l * DM * DFF, r / 32, r % 32, false, nullptr, scr, lane);
        }
        const float* x_prompt = in_ptr(0); const float* x_sample = in_ptr(1);
        for (int m0 = gw; m0 < MT; m0 += 2 * NGW) {
            f32x4 v[2][4]; float s[2];
#pragma unroll
            for (int q = 0; q < 2; ++q) {
                const int m = m0 + q * NGW; s[q] = 0.f;
                if (m < MT) {
                    const float* xrow = (m < MP) ? x_prompt + (size_t)m * DM : x_sample + (size_t)(m - MP) * DM;
                    const f32x4* xr = (const f32x4*)xrow + lane;
#pragma unroll
                    for (int j = 0; j < 4; ++j) v[q][j] = xr[64 * j];
                }
            }
#pragma unroll
            for (int q = 0; q < 2; ++q) {
                const int m = m0 + q * NGW;
                if (m < MT) {
#pragma unroll
                    for (int j = 0; j < 4; ++j) s[q] += (v[q][j][0] * v[q][j][0] + v[q][j][1] * v[q][j][1]) + (v[q][j][2] * v[q][j][2] + v[q][j][3] * v[q][j][3]);
#pragma unroll
                    for (int o = 1; o < 64; o <<= 1) s[q] += __shfl_xor(s[q], o);
                    u32x2* o8 = (u32x2*)(XB + (size_t)m * DM) + lane;
#pragma unroll
                    for (int j = 0; j < 4; ++j) { u32x2 w; w.x = pk2(v[q][j][0], v[q][j][1]); w.y = pk2(v[q][j][2], v[q][j][3]); o8[64 * j] = w; }
                    if (lane == 0) SS[m] = s[q];
                }
            }
        }
        const int gt = bx * 512 + tid, NGT = G * 512;
        for (int i = gt; i < 4 * MT; i += NGT) SS[MT + i] = 0.f;
        conv_cache(in_ptr(4), in_ptr(5), (bf16_t*)(ws + WS_CKB), 0, gt, NGT);
        for (int i = gt; i < 2080 * 32; i += NGT) {
            const int pi = i >> 5, f = i & 31; const int pos = pi < 2048 ? pi : 4096 + (pi - 2048);
            const float inv_freq = (float)exp(-(double)f * (9.210340371976184 / 32.0));
            const float ang = (float)pos * inv_freq;
            double rev = (double)ang * 0.15915494309189535; rev -= rint(rev);
            const float rf = (float)rev;
            ROPE[(size_t)pi * 64 + f] = __builtin_amdgcn_cosf(rf); ROPE[(size_t)pi * 64 + 32 + f] = __builtin_amdgcn_sinf(rf);
        }
    }
    if (G == 0x7fffffff) grid.sync();
    xcd_barrier(xbar);

    for (int l = 0; l < 2; ++l) {
        {
            LANE_TID();
            unsigned char* ws = ws_ptr();
            const bool split = (Gq == 256); const int GG = split ? Gq - CONV_WGS : Gq;
            if (split && bxq >= GG) {
                LAS float* scr = (LAS float*)(lds + wave * WAVE_LDS);
                constexpr int J_OUT = 32 * 8, J_UP = 32 * 32;
                for (int it = (bxq - GG) * 8 + wave; it < J_OUT + J_UP; it += CONV_WGS * 8) {
                    if (it < J_OUT) tr_item128(in_ptr(15) + (size_t)l * DM * DM, DM, DM, (bf16_t*)(ws + WS_WOUT) + (size_t)l * DM * DM, it / 8, it % 8, nullptr, scr, lane);
                    else { const int r = it - J_OUT; tr_item128(in_ptr(16) + (size_t)l * DM * DFF, DM, DFF, (bf16_t*)(ws + WS_WUP) + (size_t)l * DFF * DM, r / 32, r % 32, in_ptr(7) + l * DM, scr, lane); }
                }
            } else {
            pg8::Gemm g{(const bf16_t*)(ws + WS_B), (const bf16_t*)(ws + WS_WIN) + (size_t)l * PS * DM, MP, PS, DM}; pg8::StaticOrder S; S.init(MP, PS, GG, bxq);
            pg8::EpiIn E{(bf16_t*)(ws + WS_A), (float*)(ws + WS_LOWF), (const float*)(ws + WS_SS) + (size_t)(2 * l) * MT, out_ptr(), (long long)(O_KP + (size_t)l * 2097152), (long long)(O_VP + (size_t)l * 2097152), (long long)(O_KS + (size_t)l * 131072), (long long)(O_VS + (size_t)l * 131072)};
            pg8::gemm_phase<pg8::EpiIn, pg8::StaticOrder, true, true>(lds, g, S, E, tid);
            if (PROBE_IN2) pg8::gemm_phase<pg8::EpiIn, pg8::StaticOrder, true, true>(lds, g, S, E, tid);
            {
                float* outp = out_ptr();
                SArgs a{}; a.A = (const bf16_t*)(ws + WS_B) + (size_t)MP * DM; a.Bt = (const bf16_t*)(ws + WS_WIN) + (size_t)l * PS * DM; a.K = DM; a.nunits = 4 * 57;
                a.obf = (bf16_t*)(ws + WS_A) + (size_t)MP * PS; a.ldo = PS; a.ss_in = (const float*)(ws + WS_SS) + (size_t)(2 * l) * MT + MP; a.lowf = (float*)(ws + WS_LOWF) + (size_t)MP * 16;
                a.ksout = outp + O_KS + (size_t)l * 131072; a.vsout = outp + O_VS + (size_t)l * 131072;
                int ub, us; sample_share((MP / 256) * (PS / 256), GG, bxq, ub, us);
                sample_gemm<SK_IN>(lds, a, ub, us, wave, lane);
            }
            if (l == 1) conv_cache(in_ptr(4), in_ptr(5), (bf16_t*)(ws + WS_CKB), 1, bxq * 512 + tid, GG * 512);
            }
        }
        xcd_barrier(xbar);
        {
            LANE_TID();
            { const float* rb = in_ptr(14) + (size_t)l * 8 * NREL; for (int i = tid; i < 8 * NREV; i += 512) { const int hh = i / NREV, j = i % NREV; int k = 382 - j; k = k < 0 ? 0 : (k > NREL - 1 ? NREL - 1 : k); biasT[i] = rb[hh * NREL + k] * 1.4426950408889634f; } }
            __syncthreads();
        }
#define MAKE_CTX() LANE_TID(); int wv = wave; asm volatile("" : "+s"(wv)); unsigned char* ws = ws_ptr(); Ctx C; C.l = l; C.lane = lane; C.kq = lane >> 5; C.li = lane & 31; C.proj = (const bf16_t*)(ws + WS_A); C.lowf = (const float*)(ws + WS_LOWF); \
        C.rope = (const float*)(ws + WS_ROPE); C.cat = (bf16_t*)(out_ptr() + O_Y); C.kvt = (float*)(ws + WS_C); C.gdec = (float*)(ws + WS_G); C.out = out_ptr(); \
        C.wa2 = in_ptr(10) + (size_t)l * 16 * 256; C.ba = in_ptr(11) + l * 256; C.nw = (wv < 4 ? in_ptr(12) : in_ptr(13)) + l * 256; C.st = (wv < 4 ? in_ptr(2) : in_ptr(3)); C.ckb = (const bf16_t*)(ws + WS_CKB); C.cvb = C.ckb + CACHE_ELEMS; \
        __builtin_amdgcn_sched_barrier(0)
        for (int rep = 0; rep < 1 + PROBE_M1X2; ++rep)
        for (int u = bx; u < 256; u += G) {
            const int b = u & 7, n = u >> 3;
            for (int rk = 0; rk < 1 + PROBE_KVX2; ++rk) { MAKE_CTX(); kv_local<false>(C, wv >> 2, b, n, wv & 3, wl); }
            for (int ra = 0; ra < 1 + PROBE_ATX2; ++ra) { MAKE_CTX(); attn_wave<false>(C, b, n, wave, wl, biasT + wave * NREV, biasT[wave * NREV]); }
            if (n == 0) { MAKE_CTX(); attn_wave<true>(C, b, 0, wave, wl, biasT + wave * NREV, biasT[wave * NREV]); }
            if (n == 1) { MAKE_CTX(); mix_out<true>(C, wv >> 2, b, 0, wv & 3, wl); }
            if (n == 2) { MAKE_CTX(); kv_local<true>(C, wv >> 2, b, 0, wv & 3, wl); }
        }
        xcd_barrier(xbar);
        {
            LANE_TID();
            float* KVT = (float*)WSP(WS_C); const float* GDEC = (const float*)WSP(WS_G); float* outp = out_ptr();
            for (int it = bx * 512 + tid; it < 131072; it += G * 512) {
                const int seq = it >> 11, e2 = it & 2047, type = seq >> 5, b = (seq >> 2) & 7, h = seq & 3;
                const int dv = e2 >> 5, dk = (2 * e2) & 63;
                bf16_t* base = (bf16_t*)KVT + (size_t)seq * 32 * 4096 + 2 * e2;
                const float dret = exp2f(ret_lg2(h) * 64.0f);
                const float* gd = GDEC + (size_t)((b * 4 + h) * 32) * 64 + dk;
                unsigned kvr[32]; f32x2 dd[32];
#pragma unroll
                for (int c = 0; c < 32; ++c) kvr[c] = *(const unsigned*)(base + (size_t)c * 4096);
                if (type == 1) {
#pragma unroll
                    for (int c = 0; c < 32; ++c) dd[c] = *(const f32x2*)(gd + c * 64);
                } else {
#pragma unroll
                    for (int c = 0; c < 32; ++c) dd[c] = (f32x2){dret, dret};
                }
                f32x2 s = (f32x2){0.f, 0.f};
#pragma unroll
                for (int c = 0; c < 32; ++c) { *(unsigned*)(base + (size_t)c * 4096) = pk2(s[0], s[1]); s = dd[c] * s + (f32x2){bflo(kvr[c]), bfhi(kvr[c])}; }
                float* so = outp + (type == 0 ? O_RETP : O_GLAP) + (size_t)((l * 8 + b) * 4 + h) * 4096;
                so[dk * 64 + dv] = s[0]; so[(dk + 1) * 64 + dv] = s[1];
            }
        }
        xcd_barrier(xbar);
        for (int rep = 0; rep < 1 + PROBE_M3X2; ++rep)
        for (int u = bx; u < 256; u += G) { MAKE_CTX(); mix_out<false>(C, wv >> 2, u & 7, u >> 3, wv & 3, wl); }
        xcd_barrier(xbar);
        {
            LANE_TID();
            unsigned char* ws = ws_ptr(); const bf16_t* CATB = (const bf16_t*)(out_ptr() + O_Y);
            pg8::Gemm g{CATB, (const bf16_t*)(ws + WS_WOUT) + (size_t)l * DM * DM, MP, DM, DM}; pg8::StaticOrder S; S.init(MP, DM, Gq, bxq);
            pg8::EpiRes E{(const bf16_t*)(ws + WS_B), (float*)nullptr, (bf16_t*)(ws + WS_C), (float*)(ws + WS_SS) + (size_t)(2 * l + 1) * MT};
            pg8::gemm_phase<pg8::EpiRes, pg8::StaticOrder, true, true>(lds, g, S, E, tid);
            {
                SArgs a{}; a.A = CATB + (size_t)MP * DM; a.Bt = (const bf16_t*)(ws + WS_WOUT) + (size_t)l * DM * DM; a.K = DM; a.nunits = 4 * 16;
                a.obf = (bf16_t*)(ws + WS_C) + (size_t)MP * DM; a.ldo = DM; a.ss_out = (float*)(ws + WS_SS) + (size_t)(2 * l + 1) * MT + MP;
                a.xold = (const bf16_t*)(ws + WS_B) + (size_t)MP * DM; a.xr = nullptr;
                int ub, us; sample_share((MP / 256) * (DM / 256), Gq, bxq, ub, us);
                sample_gemm<SK_RES>(lds, a, ub, us, wave, lane);
                const int nsamp = a.nunits < Gq ? a.nunits : Gq;
                if (Gq == 256 && bxq >= nsamp) {
                    LAS float* scr = (LAS float*)(lds + wave * WAVE_LDS);
                    for (int it = (bxq - nsamp) * 8 + wave; it < 128 * 8; it += (Gq - nsamp) * 8)
                        tr_item128(in_ptr(17) + (size_t)l * DFF * DM, DFF, DM, (bf16_t*)(ws + WS_WDN) + (size_t)l * DM * DFF, it / 8, it % 8, nullptr, scr, lane);
                }
            }
        }
        xcd_barrier(xbar);
        {
            LANE_TID();
            unsigned char* ws = ws_ptr();
            pg8::Gemm g{(const bf16_t*)(ws + WS_C), (const bf16_t*)(ws + WS_WUP) + (size_t)l * DFF * DM, MP, DFF, DM}; pg8::StaticOrder S; S.init(MP, DFF, Gq, bxq);
            pg8::EpiUp E{(bf16_t*)(ws + WS_A), (const float*)(ws + WS_SS) + (size_t)(2 * l + 1) * MT, DFF};
            pg8::gemm_phase<pg8::EpiUp, pg8::StaticOrder, true, true>(lds, g, S, E, tid);
            if (PROBE_UP2) pg8::gemm_phase<pg8::EpiUp, pg8::StaticOrder, true, true>(lds, g, S, E, tid);
            if (PROBE_UP2B) { xcd_barrier(xbar); pg8::gemm_phase<pg8::EpiUp, pg8::StaticOrder, true, true>(lds, g, S, E, tid); }
            {
                SArgs a{}; a.A = (const bf16_t*)(ws + WS_C) + (size_t)MP * DM; a.Bt = (const bf16_t*)(ws + WS_WUP) + (size_t)l * DFF * DM; a.K = DM; a.nunits = 4 * 64;
                a.obf = (bf16_t*)(ws + WS_A) + (size_t)MP * DFF; a.ldo = DFF; a.ss_in = (const float*)(ws + WS_SS) + (size_t)(2 * l + 1) * MT + MP;
                int ub, us; sample_share((MP / 256) * (DFF / 256), Gq, bxq, ub, us);
                sample_gemm<SK_UP>(lds, a, ub, us, wave, lane);
            }
        }
        xcd_barrier(xbar);
        {
            LANE_TID();
            unsigned char* ws = ws_ptr(); float* XR = out_ptr() + O_Y;
            pg8::Gemm g{(const bf16_t*)(ws + WS_A), (const bf16_t*)(ws + WS_WDN) + (size_t)l * DM * DFF, MP, DM, DFF}; pg8::StaticOrder S; S.init(MP, DM, Gq, bxq);
            if (PROBE_DN2) { pg8::EpiUp E2{(bf16_t*)(ws + WS_C), (const float*)(ws + WS_SS) + (size_t)(2 * l + 1) * MT, DM}; pg8::gemm_phase<pg8::EpiUp, pg8::StaticOrder, true, true>(lds, g, S, E2, tid); }
            pg8::EpiRes E{(const bf16_t*)(ws + WS_C), (float*)nullptr, (bf16_t*)(ws + WS_B), (float*)(ws + WS_SS) + (size_t)(2 * l + 2) * MT};
            pg8::gemm_phase<pg8::EpiRes, pg8::StaticOrder, true, true>(lds, g, S, E, tid);
            {
                SArgs a{}; a.A = (const bf16_t*)(ws + WS_A) + (size_t)MP * DFF; a.Bt = (const bf16_t*)(ws + WS_WDN) + (size_t)l * DM * DFF; a.K = DFF; a.nunits = 4 * 16;
                a.obf = (bf16_t*)(ws + WS_B) + (size_t)MP * DM; a.ldo = DM; a.ss_out = (float*)(ws + WS_SS) + (size_t)(2 * l + 2) * MT + MP;
                a.xold = (const bf16_t*)(ws + WS_C) + (size_t)MP * DM; a.xr = nullptr;
                int ub, us; sample_share((MP / 256) * (DM / 256), Gq, bxq, ub, us);
                sample_gemm<SK_RES>(lds, a, ub, us, wave, lane);
            }
        }
        xcd_barrier(xbar);
    }
    for (int i = 0; i < PROBE_SYNCS; ++i) xcd_barrier(xbar);
    {
        LANE_TID();
        const int gw = bx * 8 + wave, NGW = G * 8;
        const float* fw = in_ptr(8); const float* SS = (const float*)WSP(WS_SS); float* Y = out_ptr() + O_Y; const bf16_t* XBF = (const bf16_t*)WSP(WS_B);
        f32x4 w4[4];
#pragma unroll
        for (int j = 0; j < 4; ++j) w4[j] = *((const f32x4*)fw + lane + 64 * j);
        for (int m0 = gw; m0 < MT; m0 += 4 * NGW) {
            u32x2 v[4][4]; float rs[4];
#pragma unroll
            for (int q = 0; q < 4; ++q) {
                const int m = m0 + q * NGW;
                if (m < MT) {
                    rs[q] = SS[(size_t)4 * MT + m];
                    const u32x2* xr = (const u32x2*)(XBF + (size_t)m * DM) + lane;
#pragma unroll
                    for (int j = 0; j < 4; ++j) v[q][j] = xr[64 * j];
                }
            }
#pragma unroll
            for (int q = 0; q < 4; ++q) {
                const int m = m0 + q * NGW;
                if (m < MT) {
                    const float r = 1.0f / sqrtf(rs[q] * (1.0f / 1024.0f) + EPS);
                    f32x4* yr = (f32x4*)(Y + (size_t)m * DM) + lane;
#pragma unroll
                    for (int j = 0; j < 4; ++j) { const f32x4 x = (f32x4){bflo(v[q][j].x), bfhi(v[q][j].x), bflo(v[q][j].y), bfhi(v[q][j].y)}; __builtin_nontemporal_store(x * r * w4[j], &yr[64 * j]); }
                }
            }
        }
    }
}

extern "C" void kernel_launch(void* const* d_in, const int* in_sizes, int n_in, void* d_out, int out_size, void* d_ws, size_t ws_size, hipStream_t stream) {
    static int grid = 0;
    if (grid == 0) {
        if (n_in != 18 || (size_t)out_size != O_END || ws_size < WS_END) { fprintf(stderr, "kernel_launch: unexpected shapes: n_in %d out %d ws %zu (need %zu)\n", n_in, out_size, ws_size, (size_t)WS_END); grid = -1; return; }
        int dev = 0, cus = 0, per_cu = 0;
        hipGetDevice(&dev); hipDeviceGetAttribute(&cus, hipDeviceAttributeMultiprocessorCount, dev);
        if (hipFuncSetAttribute((const void*)hybrid_fwd, hipFuncAttributeMaxDynamicSharedMemorySize, LDS_BYTES) != hipSuccess) { fprintf(stderr, "kernel_launch: hipFuncSetAttribute failed\n"); }
        if (hipOccupancyMaxActiveBlocksPerMultiprocessor(&per_cu, (const void*)hybrid_fwd, 512, LDS_BYTES) != hipSuccess || per_cu < 1) { fprintf(stderr, "kernel_launch: occupancy query says %d\n", per_cu); per_cu = 1; }
        (void)hipGetLastError();
        grid = cus * per_cu;
        if (grid > 256) grid = 256;
    }
    if (grid < 0) return;
    if (hipMemsetAsync((unsigned char*)d_ws + WS_CTL, 0, CTL_BYTES, stream) != hipSuccess) { fprintf(stderr, "kernel_launch: memset of the barrier words failed\n"); return; }
    Params p{};
    for (int i = 0; i < 18; ++i) p.in[i] = (const float*)d_in[i];
    p.out = (float*)d_out; p.ws = (unsigned char*)d_ws;
    void* args[] = {&p};
    hipError_t e = hipLaunchCooperativeKernel((const void*)hybrid_fwd, dim3(grid), dim3(512), args, LDS_BYTES, stream);
    if (e != hipSuccess) fprintf(stderr, "kernel_launch: cooperative launch failed: %s (grid %d)\n", hipGetErrorString(e), grid);
}
```

```cpp
#include <hip/hip_runtime.h>
#include <hip/hip_cooperative_groups.h>
#include <cstdio>
#include <cstdint>
namespace cg = cooperative_groups;
#ifndef PROBE_UP2
#define PROBE_UP2 0
#endif
#ifndef PROBE_M1X2
#define PROBE_M1X2 0
#endif
#ifndef PROBE_P0X2
#define PROBE_P0X2 0
#endif
#ifndef PROBE_SYNCS
#define PROBE_SYNCS 0
#endif
#ifndef PROBE_IN2
#define PROBE_IN2 0
#endif
#ifndef PROBE_DN2
#define PROBE_DN2 0
#endif
#ifndef PROBE_UP2B
#define PROBE_UP2B 0
#endif
#ifndef PROBE_KVX2
#define PROBE_KVX2 0
#endif
#ifndef PROBE_ATX2
#define PROBE_ATX2 0
#endif
#ifndef PROBE_M3X2
#define PROBE_M3X2 0
#endif
namespace pg8 {
#define PG8_LAS __attribute__((address_space(3)))
typedef unsigned short bf16_t;
typedef short bf16x8 __attribute__((ext_vector_type(8)));
typedef float f32x4 __attribute__((ext_vector_type(4)));
typedef unsigned u32x4 __attribute__((ext_vector_type(4)));
constexpr int BM = 256, BK = 64, HALF = 128, HTB = HALF * BK * 2  , STAGE_BYTES = 8 * HTB, NXCD = 8, WGM = 8;

__host__ __device__ __forceinline__ int lds_byte(int r, int c) { const int st = (r >> 4) * 2 + (c >> 5), rr = r & 15, cc = c & 31, ob = rr * 64 + cc * 2; return st * 1024 + (ob ^ (((ob >> 9) & 1) << 5)); }
__host__ __device__ __forceinline__ void stage_rc(int b, int& R, int& C) { const int st = b / 1024, sb = b % 1024, swz = sb ^ (((sb >> 9) & 1) << 5); R = (st >> 1) * 16 + swz / 64; C = (st & 1) * 32 + (swz % 64) / 2; }
__host__ __device__ __forceinline__ int perm32(int rho) { const int n = rho >> 4, i = rho & 15; return 8 * (i >> 2) + 4 * n + (i & 3); }

struct Unit { int pm, pn; };
struct Gemm { const bf16_t* A; const bf16_t* Bt; int M, N, K; };

struct StaticOrder {
    int nM, nN, nwg, G, c;
    __host__ __device__ __forceinline__ void init(int M, int N, int G_, int c_) { nM = M / BM; nN = N / BM; nwg = nM * nN; G = G_; c = c_; }
    __host__ __device__ __forceinline__ bool next(int i, Unit& u) const {
        const long L = (long)i * G + c; if (L >= nwg) return false;
        int wgid = (int)L; { const int q = nwg / NXCD, r = nwg % NXCD, xcd = wgid % NXCD, off = wgid / NXCD; wgid = (xcd < r ? xcd * (q + 1) : r * (q + 1) + (xcd - r) * q) + off; }
        const int nig = WGM * nN, gid = wgid / nig, fm = gid * WGM, gsz = (nM - fm) < WGM ? (nM - fm) : WGM;
        u.pm = fm + ((wgid % nig) % gsz); u.pn = (wgid % nig) / gsz; return true;
    }
    __device__ __forceinline__ void a_ready(const Unit&) const {}
    __device__ __forceinline__ void done(const Unit&) const {}
};

__device__ __forceinline__ unsigned cvt_pk_bf16(float lo, float hi) { unsigned r; asm volatile("v_cvt_pk_bf16_f32 %0, %1, %2" : "=v"(r) : "v"(lo), "v"(hi)); return r; }
typedef float f32x2 __attribute__((ext_vector_type(2)));

typedef unsigned u32x2 __attribute__((ext_vector_type(2)));
constexpr int E_MP = 16384;
struct EpiIn {
    static constexpr bool PERM = true, AFTER_DRAIN = false;
    bf16_t* proj; float* lowf; const float* ss; float* out; long long okp, ovp, oks, ovs;
    __device__ __forceinline__ void operator()(const f32x4 (&acc)[2][2][4][2], const Unit& u, int wr, int wc, int fr, int fq) const {
        const int row0 = u.pm * BM + wr * 64 + fr, col0 = u.pn * BM + wc * 32 + 8 * fq;
        float* kv = nullptr; int rsub = 0, cbase = 0;
        if (u.pn >= 10 && u.pn < 14) {
            const bool isk = u.pn < 12; cbase = isk ? 2560 : 3072;
            if (u.pm >= 64) { kv = out + (isk ? oks : ovs); rsub = E_MP; }
            else if ((u.pm & 7) >= 6) { kv = out + (isk ? okp : ovp); rsub = 1536 * ((u.pm >> 3) + 1); }
        }
        const bool lowt = (u.pn == 14) && (wc == 0) && (fq < 2);
#pragma unroll
        for (int ai = 0; ai < 2; ++ai)
#pragma unroll
            for (int m = 0; m < 4; ++m) {
                const int r = row0 + ai * HALF + m * 16;
                const float rs = 1.0f / sqrtf(ss[r] * (1.0f / 1024.0f) + 1e-6f);
                bf16_t* rowp = proj + (size_t)r * 3840 + col0;
#pragma unroll
                for (int bj = 0; bj < 2; ++bj) {
                    const f32x4 v0 = acc[ai][bj][m][0] * rs, v1 = acc[ai][bj][m][1] * rs;
                    u32x4 w; w.x = cvt_pk_bf16(v0[0], v0[1]); w.y = cvt_pk_bf16(v0[2], v0[3]); w.z = cvt_pk_bf16(v1[0], v1[1]); w.w = cvt_pk_bf16(v1[2], v1[3]);
                    *(u32x4*)(rowp + bj * HALF) = w;
                    if (kv) { float* d = kv + (size_t)(r - rsub) * 512 + (col0 + bj * HALF - cbase); __builtin_nontemporal_store(v0, (f32x4*)d); __builtin_nontemporal_store(v1, (f32x4*)(d + 4)); }
                    if (lowt && bj == 0) { float* d = lowf + (size_t)r * 16 + 8 * fq; *(f32x4*)d = v0; *(f32x4*)(d + 4) = v1; }
                }
            }
    }
};
struct EpiRes {
    static constexpr bool PERM = true, AFTER_DRAIN = false;
    const bf16_t* xold; float* xr; bf16_t* xb; float* ss;
    __device__ __forceinline__ void operator()(const f32x4 (&acc)[2][2][4][2], const Unit& u, int wr, int wc, int fr, int fq) const {
        const int row0 = u.pm * BM + wr * 64 + fr, col0 = u.pn * BM + wc * 32 + 8 * fq;
#pragma unroll
        for (int ai = 0; ai < 2; ++ai)
#pragma unroll
            for (int m = 0; m < 4; ++m) {
                const int r = row0 + ai * HALF + m * 16;
                const bf16_t* xo = xold + (size_t)r * 1024 + col0;
                float sq = 0.f;
#pragma unroll
                for (int bj = 0; bj < 2; ++bj) {
                    const u32x4 xw = *(const u32x4*)(xo + bj * HALF);
                    f32x4 v0, v1;
                    v0[0] = __uint_as_float(xw.x << 16); v0[1] = __uint_as_float(xw.x & 0xffff0000u); v0[2] = __uint_as_float(xw.y << 16); v0[3] = __uint_as_float(xw.y & 0xffff0000u);
                    v1[0] = __uint_as_float(xw.z << 16); v1[1] = __uint_as_float(xw.z & 0xffff0000u); v1[2] = __uint_as_float(xw.w << 16); v1[3] = __uint_as_float(xw.w & 0xffff0000u);
                    v0 = v0 + acc[ai][bj][m][0]; v1 = v1 + acc[ai][bj][m][1];
                    if (xr) { float* xn = xr + (size_t)r * 1024 + col0 + bj * HALF; *(f32x4*)xn = v0; *(f32x4*)(xn + 4) = v1; }
                    sq += (v0[0] * v0[0] + v0[1] * v0[1]) + (v0[2] * v0[2] + v0[3] * v0[3]) + (v1[0] * v1[0] + v1[1] * v1[1]) + (v1[2] * v1[2] + v1[3] * v1[3]);
                    if (xb) { u32x4 w; w.x = cvt_pk_bf16(v0[0], v0[1]); w.y = cvt_pk_bf16(v0[2], v0[3]); w.z = cvt_pk_bf16(v1[0], v1[1]); w.w = cvt_pk_bf16(v1[2], v1[3]);
                        *(u32x4*)(xb + (size_t)r * 1024 + col0 + bj * HALF) = w; }
                }
                sq += __shfl_xor(sq, 16); sq += __shfl_xor(sq, 32);
                if (fq == 0) atomicAdd(ss + r, sq);
            }
    }
};
struct EpiUp {
    static constexpr bool PERM = true, AFTER_DRAIN = false;
    bf16_t* U; const float* ss; int ldu;
    __device__ __forceinline__ void operator()(const f32x4 (&acc)[2][2][4][2], const Unit& u, int wr, int wc, int fr, int fq) const {
        const int row0 = u.pm * BM + wr * 64 + fr, col0 = u.pn * BM + wc * 32 + 8 * fq;
#pragma unroll
        for (int ai = 0; ai < 2; ++ai)
#pragma unroll
            for (int m = 0; m < 4; ++m) {
                const int r = row0 + ai * HALF + m * 16;
                const float rs = 1.0f / sqrtf(ss[r] * (1.0f / 1024.0f) + 1e-6f);
                bf16_t* rowp = U + (size_t)r * ldu + col0;
#pragma unroll
                for (int bj = 0; bj < 2; ++bj) {
                    f32x4 v0 = acc[ai][bj][m][0] * rs, v1 = acc[ai][bj][m][1] * rs;
#pragma unroll
                    for (int e = 0; e < 4; ++e) { const float a = fmaxf(v0[e], 0.f), b = fmaxf(v1[e], 0.f); v0[e] = a * a; v1[e] = b * b; }
                    u32x4 w; w.x = cvt_pk_bf16(v0[0], v0[1]); w.y = cvt_pk_bf16(v0[2], v0[3]); w.z = cvt_pk_bf16(v1[0], v1[1]); w.w = cvt_pk_bf16(v1[2], v1[3]);
                    *(u32x4*)(rowp + bj * HALF) = w;
                }
            }
    }
};

template <class Epi, class Sched, bool ALIGN_EPI = false, bool SP2 = false>
__device__ __forceinline__ void gemm_phase(PG8_LAS unsigned char* lds, const Gemm g, const Sched& S, const Epi& E, const int tid_in) {
    int tid_ = tid_in; asm volatile("" : "+v"(tid_));
    const int tid = tid_, wid = __builtin_amdgcn_readfirstlane(tid >> 6), lane = tid & 63, wr = wid >> 2, wc = wid & 3, fr = lane & 15, fq = lane >> 4;
    const int K = g.K, nt = K / BK;
    unsigned voffA[2], voffB[2];
#pragma unroll
    for (int i = 0; i < 2; ++i) { int R, C; stage_rc(tid * 16 + i * 8192, R, C); const int Rb = Epi::PERM ? ((R & ~31) + perm32(R & 31)) : R;
        voffA[i] = (unsigned)(R * K + C) * 2u; voffB[i] = (unsigned)(Rb * K + C) * 2u; }
    const size_t kstep = (size_t)(BK * 2);
    const size_t hstep = (size_t)HALF * K * 2;
    const size_t tstep = 2 * hstep;
    const unsigned ldsw = (unsigned)wid * 1024u;
    const int aoff = lds_byte(wr * 64 + fr, fq * 8), boff = lds_byte(wc * 32 + fr, fq * 8);
#define PG8_SA(b, h) (((b) * 2 + (h)) * HTB)
#define PG8_SB(b, h) ((4 + (b) * 2 + (h)) * HTB)
#define PG8_STAGE(bufoff, gbase, voff) do { _Pragma("unroll") for (int _i = 0; _i < 2; ++_i) \
        __builtin_amdgcn_global_load_lds((const unsigned*)((const char*)(gbase) + (voff)[_i]), (PG8_LAS unsigned*)(lds + (bufoff) + ldsw + _i * 8192), 16, 0, 0); } while (0)
#define PG8_LDA(dst, b, h) do { _Pragma("unroll") for (int m = 0; m < 4; ++m) _Pragma("unroll") for (int k = 0; k < 2; ++k) dst[m][k] = *(const PG8_LAS bf16x8*)(lds + PG8_SA(b, h) + aoff + m * 2048 + k * 1024); } while (0)
#define PG8_LDB(dst, b, h) do { _Pragma("unroll") for (int n = 0; n < 2; ++n) _Pragma("unroll") for (int k = 0; k < 2; ++k) dst[n][k] = *(const PG8_LAS bf16x8*)(lds + PG8_SB(b, h) + boff + n * 2048 + k * 1024); } while (0)
#define PG8_MMA(ai, bj, At, Bt) do { __builtin_amdgcn_s_setprio(1); _Pragma("unroll") for (int m = 0; m < 4; ++m) _Pragma("unroll") for (int n = 0; n < 2; ++n) _Pragma("unroll") for (int k = 0; k < 2; ++k) \
        acc[ai][bj][m][n] = __builtin_amdgcn_mfma_f32_16x16x32_bf16(Bt[n][k], At[m][k], acc[ai][bj][m][n], 0, 0, 0); __builtin_amdgcn_s_setprio(0); } while (0)
#define PG8_WAIT_V(n) asm volatile("s_waitcnt vmcnt(" #n ")" ::: "memory")
#define PG8_WAIT_L(n) asm volatile("s_waitcnt lgkmcnt(" #n ")" ::: "memory")
#define PG8_BAR __builtin_amdgcn_s_barrier()
#define PG8_SCHED __builtin_amdgcn_sched_barrier(0)
    Unit cur, nxt; int ui = 0;
    if (!S.next(0, cur)) return;
    f32x4 acc[2][2][4][2];
#pragma unroll
    for (int a = 0; a < 2; ++a)
#pragma unroll
        for (int b = 0; b < 2; ++b)
#pragma unroll
            for (int m = 0; m < 4; ++m)
#pragma unroll
                for (int n = 0; n < 2; ++n) acc[a][b][m][n] = (f32x4){0.f, 0.f, 0.f, 0.f};
    bf16x8 At[4][2], B0[2][2], B1[2][2];
    const char* cA = (const char*)g.A + (size_t)cur.pm * tstep; const char* cB = (const char*)g.Bt + (size_t)cur.pn * tstep;
    S.a_ready(cur);
    if constexpr (SP2) {
        PG8_STAGE(PG8_SB(0, 0), cB, voffB); PG8_STAGE(PG8_SB(0, 1), cB + hstep, voffB); PG8_STAGE(PG8_SA(0, 0), cA, voffA); PG8_STAGE(PG8_SA(0, 1), cA + hstep, voffA);
        if (wr == 1) PG8_BAR;
        PG8_WAIT_V(2); PG8_BAR;
        PG8_STAGE(PG8_SB(1, 0), cB + kstep, voffB); PG8_STAGE(PG8_SA(1, 0), cA + kstep, voffA); PG8_STAGE(PG8_SB(1, 1), cB + hstep + kstep, voffB);
        PG8_WAIT_V(6); PG8_BAR;
    } else {
        PG8_STAGE(PG8_SB(0, 0), cB, voffB); PG8_STAGE(PG8_SA(0, 0), cA, voffA); PG8_STAGE(PG8_SB(0, 1), cB + hstep, voffB); PG8_STAGE(PG8_SA(0, 1), cA + hstep, voffA);
        if (wr == 1) PG8_BAR;
        PG8_WAIT_V(4); PG8_BAR;
        PG8_STAGE(PG8_SB(1, 0), cB + kstep, voffB); PG8_STAGE(PG8_SA(1, 0), cA + kstep, voffA); PG8_STAGE(PG8_SB(1, 1), cB + hstep + kstep, voffB);
        PG8_WAIT_V(6); PG8_BAR;
    }
    for (;;) {
        const bool has_next = S.next(ui + 1, nxt);
        const char* nA = has_next ? (const char*)g.A + (size_t)nxt.pm * tstep : cA; const char* nB = has_next ? (const char*)g.Bt + (size_t)nxt.pn * tstep : cB;
        for (int t = 0; t < nt; t += 2) {
            const bool last = (t == nt - 2);
            const char* a1 = cA + (size_t)(t + 1) * kstep;
            const char* a2 = last ? nA : cA + (size_t)(t + 2) * kstep; const char* b2 = last ? nB : cB + (size_t)(t + 2) * kstep;
            const char* a3 = a2 + kstep; const char* b3 = b2 + kstep;
            if (last && has_next) S.a_ready(nxt);
            if constexpr (SP2) {
            PG8_LDB(B0, 0, 0); PG8_LDB(B1, 0, 1); PG8_SCHED; PG8_LDA(At, 0, 0); PG8_STAGE(PG8_SA(1, 1), a1 + hstep, voffA);
            PG8_WAIT_V(8); PG8_WAIT_L(0); PG8_BAR; PG8_MMA(0, 0, At, B0); PG8_MMA(0, 1, At, B1); PG8_BAR; PG8_SCHED;
            PG8_LDA(At, 0, 1); PG8_STAGE(PG8_SB(0, 0), b2, voffB); PG8_STAGE(PG8_SB(0, 1), b2 + hstep, voffB); PG8_STAGE(PG8_SA(0, 0), a2, voffA);
            PG8_WAIT_V(8); PG8_WAIT_L(0); PG8_BAR; PG8_MMA(1, 0, At, B0); PG8_MMA(1, 1, At, B1); PG8_BAR; PG8_SCHED;
            PG8_LDB(B0, 1, 0); PG8_LDB(B1, 1, 1); PG8_SCHED; PG8_LDA(At, 1, 0); PG8_STAGE(PG8_SA(0, 1), a2 + hstep, voffA);
            PG8_WAIT_V(8); PG8_WAIT_L(0); PG8_BAR; PG8_MMA(0, 0, At, B0); PG8_MMA(0, 1, At, B1); PG8_BAR; PG8_SCHED;
            PG8_LDA(At, 1, 1); PG8_STAGE(PG8_SB(1, 0), b3, voffB); PG8_STAGE(PG8_SB(1, 1), b3 + hstep, voffB); PG8_STAGE(PG8_SA(1, 0), a3, voffA);
            PG8_WAIT_V(8); PG8_WAIT_L(0); PG8_BAR; PG8_MMA(1, 0, At, B0); PG8_MMA(1, 1, At, B1); PG8_BAR; PG8_SCHED;
            } else {
            PG8_LDB(B0, 0, 0); PG8_SCHED; PG8_LDA(At, 0, 0); PG8_STAGE(PG8_SA(1, 1), a1 + hstep, voffA);
            PG8_WAIT_L(8); PG8_BAR; PG8_WAIT_L(0); PG8_MMA(0, 0, At, B0); PG8_BAR; PG8_SCHED;
            PG8_LDB(B1, 0, 1); PG8_STAGE(PG8_SB(0, 0), b2, voffB);
            PG8_BAR; PG8_WAIT_L(0); PG8_MMA(0, 1, At, B1); PG8_BAR;
            PG8_LDA(At, 0, 1); PG8_STAGE(PG8_SA(0, 0), a2, voffA);
            PG8_BAR; PG8_WAIT_L(0); PG8_MMA(1, 0, At, B0); PG8_BAR; PG8_SCHED;
            PG8_STAGE(PG8_SB(0, 1), b2 + hstep, voffB);
            PG8_WAIT_V(6); PG8_BAR; PG8_MMA(1, 1, At, B1); PG8_BAR;
            PG8_LDB(B0, 1, 0); PG8_SCHED; PG8_LDA(At, 1, 0); PG8_STAGE(PG8_SA(0, 1), a2 + hstep, voffA);
            PG8_WAIT_L(8); PG8_BAR; PG8_WAIT_L(0); PG8_MMA(0, 0, At, B0); PG8_BAR; PG8_SCHED;
            PG8_LDB(B1, 1, 1); PG8_STAGE(PG8_SB(1, 0), b3, voffB);
            PG8_BAR; PG8_WAIT_L(0); PG8_MMA(0, 1, At, B1); PG8_BAR;
            PG8_LDA(At, 1, 1); PG8_STAGE(PG8_SA(1, 0), a3, voffA);
            PG8_BAR; PG8_WAIT_L(0); PG8_MMA(1, 0, At, B0); PG8_BAR; PG8_SCHED;
            PG8_STAGE(PG8_SB(1, 1), b3 + hstep, voffB);
            PG8_WAIT_V(6); PG8_BAR; PG8_MMA(1, 1, At, B1); PG8_BAR;
            }
        }
        if constexpr (ALIGN_EPI) { if (wr == 0) PG8_BAR; }
        if constexpr (!Epi::AFTER_DRAIN) { E(acc, cur, wr, wc, fr, fq); S.done(cur); }
        if (!has_next) break;
#pragma unroll
        for (int a = 0; a < 2; ++a)
#pragma unroll
            for (int b = 0; b < 2; ++b)
#pragma unroll
                for (int m = 0; m < 4; ++m)
#pragma unroll
                    for (int n = 0; n < 2; ++n) acc[a][b][m][n] = (f32x4){0.f, 0.f, 0.f, 0.f};
        cur = nxt; cA = nA; cB = nB; ++ui;
        if constexpr (ALIGN_EPI) { if (wr == 1) PG8_BAR; }
    }
    PG8_WAIT_V(0);
    if constexpr (!ALIGN_EPI) { if (wr == 0) PG8_BAR; }
    PG8_BAR;
    if constexpr (Epi::AFTER_DRAIN) { E.fused(acc, cur, wr, wc, fr, fq, lds, wid, lane); S.done(cur); }
#undef PG8_SA
#undef PG8_SB
#undef PG8_STAGE
#undef PG8_LDA
#undef PG8_LDB
#undef PG8_MMA
#undef PG8_WAIT_V
#undef PG8_WAIT_L
#undef PG8_BAR
#undef PG8_SCHED
}
}


#define LAS __attribute__((address_space(3)))
typedef unsigned short bf16_t;
typedef short bf16x8 __attribute__((ext_vector_type(8)));
typedef short s16x4 __attribute__((ext_vector_type(4)));
typedef short v4i16_t __attribute__((ext_vector_type(4)));
typedef float f32x4 __attribute__((ext_vector_type(4)));
typedef float f32x2 __attribute__((ext_vector_type(2)));
typedef float f32x16 __attribute__((ext_vector_type(16)));
typedef unsigned u32x4 __attribute__((ext_vector_type(4)));
typedef unsigned u32x2 __attribute__((ext_vector_type(2)));

constexpr int DM = 1024, NB = 8, SEQ = 2048, MP = NB * SEQ, SL = 32, MS = NB * SL, MT = MP + MS;
constexpr int PS = 3840, DFF = 4096, INCOLS = 3600;
constexpr int C_QA = 0, C_KA = 256, C_VA = 512, C_GA = 768, C_QB = 1024, C_KB = 1280, C_VB = 1536, C_GB = 1792, C_QC = 2048, C_KC = 2560, C_VC = 3072, C_LOW = 3584;
constexpr int NREL = 320;
constexpr float EPS = 1e-6f;
constexpr size_t WS_A = 0;
constexpr size_t WS_B = WS_A + (size_t)MT * DFF * 2;
constexpr size_t WS_C = WS_B + (size_t)MT * DM * 2;
constexpr size_t WS_WIN = WS_C + (size_t)MT * DM * 2;
constexpr size_t WS_WOUT = WS_WIN + (size_t)2 * PS * DM * 2;
constexpr size_t WS_WUP = WS_WOUT + (size_t)2 * DM * DM * 2;
constexpr size_t WS_WDN = WS_WUP + (size_t)2 * DFF * DM * 2;
constexpr size_t WS_LOWF = WS_WDN + (size_t)2 * DFF * DM * 2;
constexpr size_t WS_SS = WS_LOWF + (size_t)MT * 16 * 4;
constexpr size_t WS_G = WS_SS + (size_t)5 * MT * 4;
constexpr size_t WS_ROPE = WS_G + (size_t)1024 * 64 * 4;
constexpr size_t WS_CTL = WS_ROPE + (size_t)2080 * 64 * 4;
constexpr size_t CTL_BYTES = 16384;
constexpr size_t WS_END = WS_CTL + CTL_BYTES;
static_assert((size_t)2048 * 4096 * 4 <= (size_t)MT * DM * 2, "KVT fits region C");
constexpr size_t WS_CKB = WS_A + (size_t)MT * PS * 2;
constexpr size_t CACHE_ELEMS = (size_t)8 * 512 * 512;
static_assert(WS_CKB + 2 * CACHE_ELEMS * 2 <= WS_B, "cache copies fit behind PROJ");
static_assert(WS_END <= (size_t)256 * 1024 * 1024, "d_ws map");
constexpr size_t O_Y = 0, O_RETP = (size_t)MT * DM, O_GLAP = O_RETP + 262144, O_KP = O_GLAP + 262144, O_VP = O_KP + 4194304, O_RETS = O_VP + 4194304, O_GLAS = O_RETS + 262144,
                 O_KS = O_GLAS + 262144, O_VS = O_KS + 262144, O_END = O_VS + 262144;
constexpr int TS = 144;
constexpr int TILE_B = 64 * TS;
constexpr int WAVE_LDS = 2 * TILE_B;
constexpr int LDS_BIAS = 8 * WAVE_LDS;
constexpr int NREV = 384;
constexpr int LDS_BARST = LDS_BIAS + 8 * NREV * 4;
constexpr int LDS_BYTES = LDS_BARST + 16;
static_assert(LDS_BYTES <= 160 * 1024 && pg8::STAGE_BYTES <= LDS_BIAS, "LDS map");

struct Params { const float* in[18]; float* out; unsigned char* ws; };
__device__ __forceinline__ int lane_id_asm() { int l; asm volatile("v_mbcnt_lo_u32_b32 %0, -1, 0\n\tv_mbcnt_hi_u32_b32 %0, -1, %0" : "=v"(l)); return l; }
typedef const __attribute__((address_space(4))) char* kaptr_t;
__device__ __forceinline__ kaptr_t karg_base() { kaptr_t ka = (kaptr_t)__builtin_amdgcn_kernarg_segment_ptr(); asm volatile("" : "+s"(ka)); return ka; }
__device__ __forceinline__ const float* in_ptr(int i) { return *(const float* const __attribute__((address_space(4)))*)(karg_base() + 8 * i); }
__device__ __forceinline__ float* out_ptr() { return *(float* const __attribute__((address_space(4)))*)(karg_base() + 8 * 18); }
__device__ __forceinline__ unsigned char* ws_ptr() { return *(unsigned char* const __attribute__((address_space(4)))*)(karg_base() + 8 * 19); }

typedef float f32x2_t __attribute__((ext_vector_type(2))); typedef __bf16 bf16x2_t __attribute__((ext_vector_type(2)));
__device__ __forceinline__ unsigned pk2(float lo, float hi) { const f32x2_t v = {lo, hi}; const bf16x2_t b = __builtin_convertvector(v, bf16x2_t); return __builtin_bit_cast(unsigned, b); }
__device__ __forceinline__ float bflo(unsigned u) { return __uint_as_float(u << 16); }
__device__ __forceinline__ float bfhi(unsigned u) { return __uint_as_float(u & 0xffff0000u); }
__device__ __forceinline__ float bf2f(bf16_t h) { return __uint_as_float((unsigned)h << 16); }
__device__ __forceinline__ bf16_t f2bf(float f) { return (bf16_t)(pk2(f, 0.f) & 0xffffu); }
__device__ __forceinline__ int crow(int r, int hi) { return (r & 3) + 8 * (r >> 2) + 4 * hi; }
__device__ __forceinline__ float silu(float x) { return x / (1.0f + __expf(-x)); }
__device__ __forceinline__ f32x16 mfma32(bf16x8 a, bf16x8 b, f32x16 c) { return __builtin_amdgcn_mfma_f32_32x32x16_bf16(a, b, c, 0, 0, 0); }
__device__ __forceinline__ bf16x8 as_bf16x8(u32x4 v) { return __builtin_bit_cast(bf16x8, v); }
__device__ __forceinline__ f32x16 zero16() { f32x16 z;
#pragma unroll
    for (int i = 0; i < 16; ++i) z[i] = 0.f; return z; }
__device__ __forceinline__ s16x4 ds_tr(LAS const unsigned char* p) { return __builtin_bit_cast(s16x4, __builtin_amdgcn_ds_read_tr16_b64_v4i16((LAS v4i16_t*)p)); }
__device__ __forceinline__ bf16x8 tr_nat(LAS const unsigned char* tile, int k0, int cb, int lane) {
    const int kq = lane >> 5, g = (lane >> 4) & 1, q = (lane & 15) >> 2, p = lane & 3;
    LAS const unsigned char* a = tile + (k0 + 8 * kq + q) * TS + (cb + 16 * g + 4 * p) * 2;
    const s16x4 lo = ds_tr(a), hi = ds_tr(a + 4 * TS);
    return (bf16x8){lo[0], lo[1], lo[2], lo[3], hi[0], hi[1], hi[2], hi[3]};
}
template <int STR = TS> __device__ __forceinline__ bf16x8 tr_perm(LAS const unsigned char* tile, int k0, int cb, int lane) {
    const int kq = lane >> 5, g = (lane >> 4) & 1, q = (lane & 15) >> 2, p = lane & 3;
    LAS const unsigned char* a = tile + (k0 + 4 * kq + q) * STR + (cb + 16 * g + 4 * p) * 2;
    const s16x4 lo = ds_tr(a), hi = ds_tr(a + 8 * STR);
    return (bf16x8){lo[0], lo[1], lo[2], lo[3], hi[0], hi[1], hi[2], hi[3]};
}
__device__ __forceinline__ bf16x8 tr_perm_swz(LAS const unsigned char* tile, int k0, int cb, int lane) {
    const int kq = lane >> 5, g = (lane >> 4) & 1, q = (lane & 15) >> 2, p = lane & 3;
    const int row = k0 + 4 * kq + q, ob = ((cb + 16 * g + 4 * p) * 2) ^ ((row & 2) << 5);
    LAS const unsigned char* a = tile + row * 128 + ob;
    const s16x4 lo = ds_tr(a), hi = ds_tr(a + 8 * 128);
    return (bf16x8){lo[0], lo[1], lo[2], lo[3], hi[0], hi[1], hi[2], hi[3]};
}
__device__ __forceinline__ bf16x8 row_frag(LAS const unsigned char* tile, int r0, int ks, int lane) {
    return *(LAS const bf16x8*)(tile + (r0 + (lane & 31)) * TS + (16 * ks + 8 * (lane >> 5)) * 2);
}
__device__ __forceinline__ bf16x8 pack_step(const f32x16& x, int s) {
    u32x4 w; w.x = pk2(x[8 * s + 0], x[8 * s + 1]); w.y = pk2(x[8 * s + 2], x[8 * s + 3]); w.z = pk2(x[8 * s + 4], x[8 * s + 5]); w.w = pk2(x[8 * s + 6], x[8 * s + 7]);
    return as_bf16x8(w);
}
__device__ __forceinline__ void load_tile(LAS unsigned char* tile, const bf16_t* src, int pitch, int nvalid, int lane) {
#pragma unroll
    for (int it = 0; it < 8; ++it) {
        const int id = it * 64 + lane, row = id >> 3, ch = id & 7;
        u32x4 v = (u32x4){0u, 0u, 0u, 0u};
        if (row < nvalid) v = *(const u32x4*)(src + (size_t)row * pitch + ch * 8);
        *(LAS u32x4*)(tile + row * TS + ch * 16) = v;
    }
}
__device__ __forceinline__ void store_tile(LAS const unsigned char* tile, bf16_t* dst, int pitch, int nvalid, int lane) {
#pragma unroll
    for (int it = 0; it < 8; ++it) {
        const int id = it * 64 + lane, row = id >> 3, ch = id & 7;
        const u32x4 v = *(LAS const u32x4*)(tile + row * TS + ch * 16);
        if (row < nvalid) *(u32x4*)(dst + (size_t)row * pitch + ch * 8) = v;
    }
}
__device__ __forceinline__ void load_tile_f32(LAS unsigned char* tile, const float* src, int pitch, int lane) {
#pragma unroll
    for (int it = 0; it < 16; ++it) {
        const int id = it * 64 + lane, row = id >> 4, c4 = id & 15;
        const f32x4 v = *(const f32x4*)(src + (size_t)row * pitch + c4 * 4);
        u32x2 w; w.x = pk2(v[0], v[1]); w.y = pk2(v[2], v[3]);
        *(LAS u32x2*)(tile + row * TS + c4 * 8) = w;
    }
}
__device__ __forceinline__ void load_rot(const bf16_t* rp, const float* cs, int kq, float scale, bool valid, bf16x8 (&fr)[4]) {
    u32x4 c[4];
#pragma unroll
    for (int ks = 0; ks < 4; ++ks) c[ks] = valid ? *(const u32x4*)(rp + 16 * ks + 8 * kq) : (u32x4){0u, 0u, 0u, 0u};
#pragma unroll
    for (int g = 0; g < 2; ++g) {
        const float* cp = cs + 16 * g + 8 * kq;
        const f32x4 ca = *(const f32x4*)cp, cb = *(const f32x4*)(cp + 4), sa = *(const f32x4*)(cp + 32), sb = *(const f32x4*)(cp + 36);
        float o1[8], o2[8];
#pragma unroll
        for (int e = 0; e < 8; ++e) {
            const unsigned w1 = c[g][e >> 1], w2 = c[g + 2][e >> 1];
            const float x1 = (e & 1) ? bfhi(w1) : bflo(w1), x2 = (e & 1) ? bfhi(w2) : bflo(w2);
            const float cc = (e < 4) ? ca[e & 3] : cb[e & 3], sn = (e < 4) ? sa[e & 3] : sb[e & 3];
            o1[e] = (x1 * cc - x2 * sn) * scale; o2[e] = (x1 * sn + x2 * cc) * scale;
        }
        u32x4 a, b;
        a.x = pk2(o1[0], o1[1]); a.y = pk2(o1[2], o1[3]); a.z = pk2(o1[4], o1[5]); a.w = pk2(o1[6], o1[7]);
        b.x = pk2(o2[0], o2[1]); b.y = pk2(o2[2], o2[3]); b.z = pk2(o2[4], o2[5]); b.w = pk2(o2[6], o2[7]);
        fr[g] = as_bf16x8(a); fr[g + 2] = as_bf16x8(b);
    }
}

struct Ctx {
    int l, lane, kq, li;
    const bf16_t* proj; const float* lowf; const float* rope; bf16_t* cat; float* kvt; float* gdec; float* out;
    const float* wa2; const float* ba; const float* nw; const float* st; const bf16_t* ckb; const bf16_t* cvb;
};
__device__ __forceinline__ float ret_lg2(int h) { return __log2f(1.0f - exp2f(-5.0f - (float)h)); }

struct GlaGate {
    f32x4 lw[4]; float w[16]; float bias, run;
    template <int L> __device__ __forceinline__ void init(const Ctx& C, int m0, int h) {
#pragma unroll
        for (int q = 0; q < 4; ++q) lw[q] = (C.lane < L) ? *(const f32x4*)(C.lowf + (size_t)(m0 + C.lane) * 16 + 4 * q) : (f32x4){0.f, 0.f, 0.f, 0.f};
#pragma unroll
        for (int j = 0; j < 16; ++j) w[j] = C.wa2[j * 256 + h * 64 + C.lane];
        bias = C.ba[h * 64 + C.lane]; run = 0.f;
    }
    __device__ __forceinline__ float step(int s) {
        float z0 = bias, z1 = 0.f;
#pragma unroll
        for (int j = 0; j < 16; j += 2) {
            z0 += __int_as_float(__builtin_amdgcn_readlane(__float_as_int(lw[j >> 2][j & 3]), s)) * w[j];
            z1 += __int_as_float(__builtin_amdgcn_readlane(__float_as_int(lw[(j + 1) >> 2][(j + 1) & 3]), s)) * w[j + 1];
        }
        const float z = z0 + z1;
        const float lf = fminf(z, 0.f) - __logf(1.0f + __expf(-fabsf(z)));
        run += lf * (1.0f / 16.0f);
        return run;
    }
};

template <bool SAMPLE> __device__ __forceinline__ void kv_local(const Ctx& C, int type, int b, int n, int h, LAS unsigned char* wl) {
    constexpr int L = SAMPLE ? 32 : 64, NKS = L / 16;
    const int m0 = SAMPLE ? MP + b * SL : b * SEQ + n * 64;
    const int pidx0 = SAMPLE ? 2048 : n * 64;
    LAS unsigned char* tK = wl; LAS unsigned char* tV = wl + TILE_B;
    const int lane = C.lane, kq = C.kq, li = C.li;
    float gdk = 0.f;
    if (type == 0) {
        const float lg = ret_lg2(h);
#pragma unroll
        for (int rb = 0; rb < L / 32; ++rb) {
            const int s = 32 * rb + li;
            bf16x8 fr[4];
            load_rot(C.proj + (size_t)(m0 + s) * PS + C_KA + h * 64, C.rope + (size_t)(pidx0 + s) * 64, kq, 0.125f * __builtin_amdgcn_exp2f(lg * (float)(L - 1 - s)), true, fr);
#pragma unroll
            for (int ks = 0; ks < 4; ++ks) *(LAS bf16x8*)(tK + s * TS + (16 * ks + 8 * kq) * 2) = fr[ks];
        }
        load_tile(tV, C.proj + (size_t)m0 * PS + C_VA + h * 64, PS, L, lane);
    } else {
        load_tile(tK, C.proj + (size_t)m0 * PS + C_KB + h * 64, PS, L, lane);
        GlaGate gg; gg.init<L>(C, m0, h);
        if (!SAMPLE) {
            load_tile(tV, C.proj + (size_t)m0 * PS + C_QB + h * 64, PS, L, lane);
#pragma unroll 4
            for (int s = 0; s < L; ++s) {
                const float e = __expf(gg.step(s));
                LAS bf16_t* kp = (LAS bf16_t*)(tK + s * TS + lane * 2); LAS bf16_t* qp = (LAS bf16_t*)(tV + s * TS + lane * 2);
                *kp = f2bf(bf2f(*kp) / e); *qp = f2bf(bf2f(*qp) * 0.125f * e);
            }
            asm volatile("s_waitcnt lgkmcnt(0)" ::: "memory");
            store_tile(tV, (bf16_t*)C.proj + (size_t)m0 * PS + C_QB + h * 64, PS, L, lane);
            store_tile(tK, (bf16_t*)C.proj + (size_t)m0 * PS + C_KB + h * 64, PS, L, lane);
            asm volatile("s_waitcnt lgkmcnt(0)" ::: "memory");
            load_tile(tV, C.proj + (size_t)m0 * PS + C_VB + h * 64, PS, L, lane);
        } else {
            load_tile(tV, C.proj + (size_t)m0 * PS + C_VB + h * 64, PS, L, lane);
#pragma unroll 4
            for (int s = 0; s < L; ++s) {
                const float bs = gg.step(s);
                LAS bf16_t* kp = (LAS bf16_t*)(tK + s * TS + lane * 2);
                *kp = f2bf(bf2f(*kp) * __expf(-bs));
            }
        }
        gdk = __expf(gg.run);
    }
    f32x16 kv[2][2];
#pragma unroll
    for (int db = 0; db < 2; ++db)
#pragma unroll
        for (int kb = 0; kb < 2; ++kb) kv[db][kb] = zero16();
#pragma unroll
    for (int ks = 0; ks < NKS; ++ks) {
        bf16x8 a[2], bb[2];
#pragma unroll
        for (int db = 0; db < 2; ++db) a[db] = tr_nat(tV, 16 * ks, 32 * db, lane);
#pragma unroll
        for (int kb = 0; kb < 2; ++kb) bb[kb] = tr_nat(tK, 16 * ks, 32 * kb, lane);
#pragma unroll
        for (int db = 0; db < 2; ++db)
#pragma unroll
            for (int kb = 0; kb < 2; ++kb) kv[db][kb] = mfma32(a[db], bb[kb], kv[db][kb]);
    }
    if (type == 1) {
#pragma unroll
        for (int kb = 0; kb < 2; ++kb) { const float cs = __int_as_float(__builtin_amdgcn_ds_bpermute((32 * kb + li) * 4, __float_as_int(gdk)));
#pragma unroll
            for (int db = 0; db < 2; ++db) kv[db][kb] = kv[db][kb] * cs; }
    }
    if (!SAMPLE) {
        const int uidx = ((type * 8 + b) * 4 + h) * 32 + n;
        bf16_t* dst = (bf16_t*)C.kvt + (size_t)uidx * 4096;
#pragma unroll
        for (int db = 0; db < 2; ++db)
#pragma unroll
            for (int kb = 0; kb < 2; ++kb)
#pragma unroll
                for (int r = 0; r < 16; ++r) dst[(32 * db + crow(r, kq)) * 64 + 32 * kb + li] = f2bf(kv[db][kb][r]);
        if (type == 1) C.gdec[(size_t)(((b * 4 + h) * 32 + n)) * 64 + lane] = gdk;
    } else {
        const float* s0 = C.st + (size_t)((C.l * 8 + b) * 4 + h) * 4096;
        float* so = C.out + (type == 0 ? O_RETS : O_GLAS) + (size_t)((C.l * 8 + b) * 4 + h) * 4096;
        const float dret = exp2f(ret_lg2(h) * (float)L);
#pragma unroll
        for (int kb = 0; kb < 2; ++kb) {
            const int dk = 32 * kb + li;
            const float dec = (type == 0) ? dret : __int_as_float(__builtin_amdgcn_ds_bpermute(dk * 4, __float_as_int(gdk)));
#pragma unroll
            for (int db = 0; db < 2; ++db)
#pragma unroll
                for (int rr = 0; rr < 4; ++rr) {
                    const int dv = 32 * db + 8 * rr + 4 * kq;
                    const f32x4 o = *(const f32x4*)(s0 + dk * 64 + dv);
                    f32x4 nv;
#pragma unroll
                    for (int e = 0; e < 4; ++e) nv[e] = dec * o[e] + kv[db][kb][4 * rr + e];
                    *(f32x4*)(so + dk * 64 + dv) = nv;
                }
        }
    }
}

template <bool SAMPLE> __device__ __forceinline__ void mix_out(const Ctx& C, int type, int b, int n, int h, LAS unsigned char* wl) {
    constexpr int L = SAMPLE ? 32 : 64, NTB = L / 32;
    const int m0 = SAMPLE ? MP + b * SL : b * SEQ + n * 64;
    const int pidx0 = SAMPLE ? 2048 : n * 64;
    LAS unsigned char* t0 = wl; LAS unsigned char* t1 = wl + TILE_B;
    const int lane = C.lane, kq = C.kq, li = C.li;
    bf16x8 qfr[NTB][4];
    const float lg = ret_lg2(h);
    if (type == 0) {
#pragma unroll
        for (int tb = 0; tb < NTB; ++tb) {
            const int s = 32 * tb + li;
            load_rot(C.proj + (size_t)(m0 + s) * PS + C_QA + h * 64, C.rope + (size_t)(pidx0 + s) * 64, kq, __builtin_amdgcn_exp2f(lg * (float)(s + 1)), true, qfr[tb]);
        }
        load_tile(t0, C.proj + (size_t)m0 * PS + C_VA + h * 64, PS, L, lane);
    } else {
        load_tile(t0, C.proj + (size_t)m0 * PS + C_QB + h * 64, PS, L, lane);
        load_tile(t1, C.proj + (size_t)m0 * PS + C_KB + h * 64, PS, L, lane);
        if (SAMPLE) {
            GlaGate gg; gg.init<L>(C, m0, h);
#pragma unroll 4
            for (int s = 0; s < L; ++s) {
                const float e = __expf(gg.step(s));
                LAS bf16_t* qp = (LAS bf16_t*)(t0 + s * TS + lane * 2); LAS bf16_t* kp = (LAS bf16_t*)(t1 + s * TS + lane * 2);
                *qp = f2bf(bf2f(*qp) * 0.125f * e); *kp = f2bf(bf2f(*kp) / e);
            }
        }
        __builtin_amdgcn_sched_barrier(0);
#pragma unroll
        for (int tb = 0; tb < NTB; ++tb)
#pragma unroll
            for (int ks = 0; ks < 4; ++ks) qfr[tb][ks] = row_frag(t0, 32 * tb, ks, lane);
        asm volatile("s_waitcnt lgkmcnt(0)" ::: "memory");
        __builtin_amdgcn_sched_barrier(0);
        load_tile(t0, C.proj + (size_t)m0 * PS + C_VB + h * 64, PS, L, lane);
    }
    __builtin_amdgcn_sched_barrier(0);
    f32x16 o[2][NTB];
#pragma unroll
    for (int db = 0; db < 2; ++db)
#pragma unroll
        for (int tb = 0; tb < NTB; ++tb) o[db][tb] = zero16();
    {
        const int uidx = ((type * 8 + b) * 4 + h) * 32 + n;
        const bf16_t* sT = (const bf16_t*)C.kvt + (size_t)uidx * 4096;
        const float* s0 = C.st + (size_t)((C.l * 8 + b) * 4 + h) * 4096;
#pragma unroll
        for (int db = 0; db < 2; ++db)
#pragma unroll
            for (int ks = 0; ks < 4; ++ks) {
                const int dv = 32 * db + li, dk0 = 16 * ks + 8 * kq;
                bf16x8 sa;
                if (!SAMPLE) sa = as_bf16x8(*(const u32x4*)(sT + dv * 64 + dk0));
                else { float sv[8];
#pragma unroll
                    for (int e = 0; e < 8; ++e) sv[e] = s0[(dk0 + e) * 64 + dv];
                    u32x4 w; w.x = pk2(sv[0], sv[1]); w.y = pk2(sv[2], sv[3]); w.z = pk2(sv[4], sv[5]); w.w = pk2(sv[6], sv[7]);
                    sa = as_bf16x8(w); }
#pragma unroll
                for (int tb = 0; tb < NTB; ++tb) o[db][tb] = mfma32(sa, qfr[tb][ks], o[db][tb]);
            }
    }
    __builtin_amdgcn_sched_barrier(0);
#pragma unroll
    for (int sb = 0; sb < NTB; ++sb) {
        bf16x8 kfr[4];
        if (type == 0) load_rot(C.proj + (size_t)(m0 + 32 * sb + li) * PS + C_KA + h * 64, C.rope + (size_t)(pidx0 + 32 * sb + li) * 64, kq, 0.125f * __builtin_amdgcn_exp2f(-lg * (float)(32 * sb + li + 1)), true, kfr);
        else {
#pragma unroll
            for (int ks = 0; ks < 4; ++ks) kfr[ks] = row_frag(t1, 32 * sb, ks, lane);
        }
        f32x16 st[NTB];
#pragma unroll
        for (int tb = sb; tb < NTB; ++tb) {
            f32x16 a = zero16();
#pragma unroll
            for (int ks = 0; ks < 4; ++ks) a = mfma32(kfr[ks], qfr[tb][ks], a);
#pragma unroll
            for (int r = 0; r < 16; ++r) {
                const int s = 32 * sb + crow(r, kq), t = 32 * tb + li;
                a[r] = (t >= s) ? a[r] : 0.0f;
            }
            st[tb] = a;
        }
#pragma unroll
        for (int half = 0; half < 2; ++half) {
            bf16x8 va[2];
#pragma unroll
            for (int db = 0; db < 2; ++db) va[db] = tr_perm(t0, 32 * sb + 16 * half, 32 * db, lane);
#pragma unroll
            for (int tb = sb; tb < NTB; ++tb) {
                const bf16x8 pf = pack_step(st[tb], half);
#pragma unroll
                for (int db = 0; db < 2; ++db) o[db][tb] = mfma32(va[db], pf, o[db][tb]);
            }
        }
        __builtin_amdgcn_sched_barrier(0);
    }
    const float* nw = C.nw + h * 64;
    const int gcol = (type == 0 ? C_GA : C_GB) + h * 64;
#pragma unroll
    for (int tb = 0; tb < NTB; ++tb) {
        const int t = 32 * tb + li;
        float s1 = 0.f, s2 = 0.f;
#pragma unroll
        for (int db = 0; db < 2; ++db)
#pragma unroll
            for (int r = 0; r < 16; ++r) { const float x = o[db][tb][r]; s1 += x; s2 += x * x; }
        s1 += __shfl_xor(s1, 32); s2 += __shfl_xor(s2, 32);
        float mu = 0.f, rstd;
        if (type == 0) { mu = s1 * (1.0f / 64.0f); const float var = fmaxf(s2 * (1.0f / 64.0f) - mu * mu, 0.f); rstd = 1.0f / sqrtf(var + EPS); }
        else rstd = 1.0f / sqrtf(s2 * (1.0f / 64.0f) + EPS);
        const bf16_t* grow = C.proj + (size_t)(m0 + t) * PS + gcol;
        bf16_t* orow = C.cat + (size_t)(m0 + t) * DM + type * 256 + h * 64;
#pragma unroll
        for (int db = 0; db < 2; ++db)
#pragma unroll
            for (int rr = 0; rr < 4; ++rr) {
                const int dv = 32 * db + 8 * rr + 4 * kq;
                const u32x2 gw = *(const u32x2*)(grow + dv);
                const f32x4 wv = *(const f32x4*)(nw + dv);
                const float g0 = bflo(gw.x), g1 = bfhi(gw.x), g2 = bflo(gw.y), g3 = bfhi(gw.y);
                const float y0 = (o[db][tb][4 * rr + 0] - mu) * rstd * wv[0] * silu(g0), y1 = (o[db][tb][4 * rr + 1] - mu) * rstd * wv[1] * silu(g1);
                const float y2 = (o[db][tb][4 * rr + 2] - mu) * rstd * wv[2] * silu(g2), y3 = (o[db][tb][4 * rr + 3] - mu) * rstd * wv[3] * silu(g3);
                u32x2 w; w.x = pk2(y0, y1); w.y = pk2(y2, y3);
                *(u32x2*)(orow + dv) = w;
            }
    }
}

template <bool SAMPLE> __device__ __forceinline__ void attn_wave(const Ctx& C, int b, int n, int h, LAS unsigned char* wl, LAS const float* revT, float cb2) {
    constexpr int NTB = SAMPLE ? 1 : 2;
    constexpr float SC = 0.125f * 1.4426950408889634f;
    const int m0 = SAMPLE ? MP + b * SL : b * SEQ + n * 64;
    const int lane = C.lane, kq = C.kq, li = C.li;
    const int jt0 = SAMPLE ? 0 : (n < 8 ? 8 - n : 0);
#define ATT_SRC(jt, kp, vp, pitch, rmask) const bf16_t* kp; const bf16_t* vp; int pitch; int rmask = 63; \
    if (SAMPLE && (jt) < 8) { kp = C.ckb + (size_t)(b * 512 + 64 * (jt)) * 512 + h * 64; vp = C.cvb + (size_t)(b * 512 + 64 * (jt)) * 512 + h * 64; pitch = 512; } \
    else { const int kr0 = SAMPLE ? m0 : b * SEQ + (n - 8 + (jt)) * 64; kp = C.proj + (size_t)kr0 * PS + C_KC + h * 64; vp = kp + (C_VC - C_KC); pitch = PS; if (SAMPLE) rmask = 31; }
#define ATT_ISSUE(jt, kdst, vbuf) do { ATT_SRC(jt, kp_, vp_, pitch_, rmask_); \
    _Pragma("unroll") for (int sb = 0; sb < 2; ++sb) _Pragma("unroll") for (int ks = 0; ks < 4; ++ks) kdst[sb][ks] = *(const u32x4*)(kp_ + (size_t)((32 * sb + li) & rmask_) * pitch_ + 16 * ks + 8 * kq); \
    _Pragma("unroll") for (int it = 0; it < 8; ++it) __builtin_amdgcn_global_load_lds((const unsigned*)(vp_ + (size_t)((it * 8 + (lane >> 3)) & rmask_) * pitch_ + (((lane & 7) ^ (((lane >> 3) & 2) << 1)) * 8)), (LAS unsigned*)((vbuf) + it * 1024), 16, 0, 0); } while (0)
    bf16x8 qfr[NTB][4];
#pragma unroll
    for (int tb = 0; tb < NTB; ++tb)
#pragma unroll
        for (int ks = 0; ks < 4; ++ks) qfr[tb][ks] = as_bf16x8(*(const u32x4*)(C.proj + (size_t)(m0 + 32 * tb + li) * PS + C_QC + h * 64 + 16 * ks + 8 * kq));
    f32x16 o[2][NTB]; float mrun[NTB], lrun[NTB];
#pragma unroll
    for (int tb = 0; tb < NTB; ++tb) { mrun[tb] = -1e30f; lrun[tb] = 0.f;
#pragma unroll
        for (int db = 0; db < 2; ++db) o[db][tb] = zero16(); }
    u32x4 kcur[2][4], knext[2][4];
    ATT_ISSUE(jt0, kcur, wl + ((jt0 & 1) ? TILE_B : 0));
    for (int jt = jt0; jt <= 8; ++jt) {
        asm volatile("s_waitcnt vmcnt(0)" ::: "memory");
        __builtin_amdgcn_sched_barrier(0);
        LAS unsigned char* tV = wl + ((jt & 1) ? TILE_B : 0);
        if (jt < 8) { ATT_ISSUE(jt + 1, knext, wl + (((jt + 1) & 1) ? TILE_B : 0)); }
        __builtin_amdgcn_sched_barrier(0);
        const bool cst = jt <= 3;
#pragma unroll
        for (int sb = 0; sb < 2; ++sb) {
            if (SAMPLE && jt == 8 && sb == 1) continue;
#pragma unroll
            for (int tb = 0; tb < NTB; ++tb) {
                f32x16 a = zero16();
#pragma unroll
                for (int ks = 0; ks < 4; ++ks) a = mfma32(as_bf16x8(kcur[sb][ks]), qfr[tb][ks], a);
                if (!cst) {
                    const int dbase = (8 - jt) * 64 + 63 + 32 * tb + li - 32 * sb;
                    LAS const float* rp = revT + (382 - dbase + 4 * kq);
#pragma unroll
                    for (int r = 0; r < 16; ++r) a[r] = a[r] * SC + rp[(r & 3) + 8 * (r >> 2)];
                }
                float mx = -1e30f;
#pragma unroll
                for (int r = 0; r < 16; ++r) mx = fmaxf(mx, a[r]);
                if (cst) mx = mx * SC + cb2;
                mx = fmaxf(mx, __shfl_xor(mx, 32));
                const float mnew = fmaxf(mrun[tb], mx);
                const bool moved = __builtin_amdgcn_ballot_w64(mnew != mrun[tb]) != 0ull;
                const float alpha = __builtin_amdgcn_exp2f(mrun[tb] - mnew);
                mrun[tb] = mnew;
                float ps = 0.f;
                if (cst) { const float off = cb2 - mnew;
#pragma unroll
                    for (int r = 0; r < 16; ++r) { const float pp = __builtin_amdgcn_exp2f(a[r] * SC + off); a[r] = pp; ps += pp; } }
                else {
#pragma unroll
                    for (int r = 0; r < 16; ++r) { const float pp = __builtin_amdgcn_exp2f(a[r] - mnew); a[r] = pp; ps += pp; } }
                lrun[tb] = lrun[tb] * alpha + ps;
                if (moved) {
#pragma unroll
                    for (int db = 0; db < 2; ++db) o[db][tb] = o[db][tb] * alpha;
                }
#pragma unroll
                for (int half = 0; half < 2; ++half) {
                    const bf16x8 pf = pack_step(a, half);
#pragma unroll
                    for (int db = 0; db < 2; ++db) o[db][tb] = mfma32(tr_perm_swz(tV, 32 * sb + 16 * half, 32 * db, lane), pf, o[db][tb]);
                }
            }
        }
#pragma unroll
        for (int sb = 0; sb < 2; ++sb)
#pragma unroll
            for (int ks = 0; ks < 4; ++ks) kcur[sb][ks] = knext[sb][ks];
    }
#pragma unroll
    for (int tb = 0; tb < NTB; ++tb) {
        const float lt = lrun[tb] + __shfl_xor(lrun[tb], 32), inv = 1.0f / lt;
        bf16_t* orow = C.cat + (size_t)(m0 + 32 * tb + li) * DM + 512 + h * 64;
#pragma unroll
        for (int db = 0; db < 2; ++db)
#pragma unroll
            for (int rr = 0; rr < 4; ++rr) {
                u32x2 w; w.x = pk2(o[db][tb][4 * rr] * inv, o[db][tb][4 * rr + 1] * inv); w.y = pk2(o[db][tb][4 * rr + 2] * inv, o[db][tb][4 * rr + 3] * inv);
                *(u32x2*)(orow + 32 * db + 8 * rr + 4 * kq) = w;
            }
    }
#undef ATT_ISSUE
#undef ATT_SRC
}

__device__ __forceinline__ void conv_cache(const float* ck, const float* cv, bf16_t* dst, int l, int gt, int NGT) {
    for (int i = gt; i < (int)(2 * CACHE_ELEMS / 8); i += NGT) {
        const bool isv = i >= (int)(CACHE_ELEMS / 8); const int j = isv ? i - (int)(CACHE_ELEMS / 8) : i;
        const float* s = (isv ? cv : ck) + (size_t)l * CACHE_ELEMS + (size_t)j * 8;
        const f32x4 x = __builtin_nontemporal_load((const f32x4*)s), y = __builtin_nontemporal_load((const f32x4*)(s + 4));
        u32x4 w; w.x = pk2(x[0], x[1]); w.y = pk2(x[2], x[3]); w.z = pk2(y[0], y[1]); w.w = pk2(y[2], y[3]);
        *(u32x4*)(dst + (size_t)i * 8) = w;
    }
}

__device__ __forceinline__ int win_src(int n) { return n < 2048 ? n : (n < 3584 ? n + 16 : (n < 3600 ? n - 1536 : -1)); }
__device__ __forceinline__ void tr_item(const float* W, int K, int Nsrc, bf16_t* WT, int kb, int nb, bool inmap, const float* kscale, LAS float* scr, int lane) {
    const int k0 = 64 * kb, n0 = 32 * nb, n = n0 + (lane & 31), sc = inmap ? win_src(n) : n;
    float wv[32];
#pragma unroll
    for (int i = 0; i < 32; ++i) { const int kk = 2 * i + (lane >> 5); wv[i] = (sc >= 0) ? __builtin_nontemporal_load(W + (size_t)(k0 + kk) * Nsrc + sc) : 0.f; }
    if (kscale) {
#pragma unroll
        for (int i = 0; i < 32; ++i) wv[i] *= kscale[k0 + 2 * i + (lane >> 5)];
    }
#pragma unroll
    for (int i = 0; i < 32; ++i) scr[(2 * i + (lane >> 5)) * 33 + (lane & 31)] = wv[i];
    asm volatile("s_waitcnt lgkmcnt(0)" ::: "memory");
    const int c = lane & 7;
#pragma unroll
    for (int j = 0; j < 4; ++j) { const int nn = (lane >> 3) + 8 * j; const LAS float* s = scr + (8 * c) * 33 + nn;
        u32x4 o; o.x = pk2(s[0 * 33], s[1 * 33]); o.y = pk2(s[2 * 33], s[3 * 33]); o.z = pk2(s[4 * 33], s[5 * 33]); o.w = pk2(s[6 * 33], s[7 * 33]);
        *(u32x4*)(WT + (size_t)(n0 + nn) * K + k0 + 8 * c) = o; }
    asm volatile("s_waitcnt lgkmcnt(0)" ::: "memory");
}


enum { SK_IN = 0, SK_RES = 1, SK_UP = 2 };
struct SArgs {
    const bf16_t* A; const bf16_t* Bt; int K, nunits;
    bf16_t* obf; int ldo;
    const float* ss_in; float* ss_out;
    const bf16_t* xold; float* xr;
    float* lowf; float* ksout; float* vsout;
};
template <int KIND> __device__ __forceinline__ void sample_gemm(LAS unsigned char* lds, const SArgs& a, int ubeg, int ustep, int wave, int lane) {
    const int kq = lane >> 5, li = lane & 31, K = a.K, kw = K >> 3, kbeg = wave * kw;
    for (int u = ubeg; u < a.nunits; u += ustep) {
        const int row0 = 64 * (u & 3), col0 = 64 * (u >> 2);
        f32x16 acc[2][2];
#pragma unroll
        for (int rb = 0; rb < 2; ++rb)
#pragma unroll
            for (int cb = 0; cb < 2; ++cb) acc[rb][cb] = zero16();
        const bf16_t* ap = a.A + (size_t)(row0 + li) * K + kbeg + 8 * kq;
        const bf16_t* bp = a.Bt + (size_t)(col0 + li) * K + kbeg + 8 * kq;
        u32x4 af[4][2], bv[4][2], an[4][2], bn[4][2];
#define SG_LOAD(dsta, dstb, k) _Pragma("unroll") for (int s = 0; s < 4; ++s) _Pragma("unroll") for (int h = 0; h < 2; ++h) { dsta[s][h] = *(const u32x4*)(ap + (size_t)(32 * h) * K + (k) + 16 * s); dstb[s][h] = *(const u32x4*)(bp + (size_t)(32 * h) * K + (k) + 16 * s); }
        SG_LOAD(af, bv, 0);
        for (int k = 0; k < kw; k += 64) {
            if (k + 64 < kw) { SG_LOAD(an, bn, k + 64); }
#pragma unroll
            for (int s = 0; s < 4; ++s)
#pragma unroll
                for (int rb = 0; rb < 2; ++rb)
#pragma unroll
                    for (int cb = 0; cb < 2; ++cb) acc[rb][cb] = mfma32(as_bf16x8(af[s][rb]), as_bf16x8(bv[s][cb]), acc[rb][cb]);
#pragma unroll
            for (int s = 0; s < 4; ++s)
#pragma unroll
                for (int h = 0; h < 2; ++h) { af[s][h] = an[s][h]; bv[s][h] = bn[s][h]; }
        }
#undef SG_LOAD
        LAS float* wp = (LAS float*)(lds + wave * WAVE_LDS);
#pragma unroll
        for (int rb = 0; rb < 2; ++rb)
#pragma unroll
            for (int cb = 0; cb < 2; ++cb)
#pragma unroll
                for (int r = 0; r < 16; ++r) wp[(32 * rb + crow(r, kq)) * 64 + 32 * cb + li] = acc[rb][cb][r];
        __syncthreads();
        const int t = wave * 64 + lane, row = t >> 3, c8 = (t & 7) * 8;
        float v[8];
#pragma unroll
        for (int e = 0; e < 8; ++e) v[e] = 0.f;
#pragma unroll
        for (int w = 0; w < 8; ++w) {
            const f32x4 x = *(LAS const f32x4*)(lds + w * WAVE_LDS + (row * 64 + c8) * 4), y = *(LAS const f32x4*)(lds + w * WAVE_LDS + (row * 64 + c8) * 4 + 16);
#pragma unroll
            for (int e = 0; e < 4; ++e) { v[e] += x[e]; v[4 + e] += y[e]; }
        }
        const int r = row0 + row, c = col0 + c8;
        if (KIND == SK_IN || KIND == SK_UP) {
            const float rs = 1.0f / sqrtf(a.ss_in[r] * (1.0f / 1024.0f) + EPS);
#pragma unroll
            for (int e = 0; e < 8; ++e) { v[e] *= rs; if (KIND == SK_UP) { const float q = fmaxf(v[e], 0.f); v[e] = q * q; } }
        }
        if (KIND == SK_RES) {
            const u32x4 xw = *(const u32x4*)(a.xold + (size_t)r * 1024 + c);
            float sq = 0.f;
            v[0] += bflo(xw.x); v[1] += bfhi(xw.x); v[2] += bflo(xw.y); v[3] += bfhi(xw.y); v[4] += bflo(xw.z); v[5] += bfhi(xw.z); v[6] += bflo(xw.w); v[7] += bfhi(xw.w);
#pragma unroll
            for (int e = 0; e < 8; ++e) sq += v[e] * v[e];
            if (a.xr) { float* xn = a.xr + (size_t)r * 1024 + c;
                *(f32x4*)xn = (f32x4){v[0], v[1], v[2], v[3]}; *(f32x4*)(xn + 4) = (f32x4){v[4], v[5], v[6], v[7]}; }
            sq += __shfl_xor(sq, 1); sq += __shfl_xor(sq, 2); sq += __shfl_xor(sq, 4);
            if ((t & 7) == 0) atomicAdd(a.ss_out + r, sq);
        }
        if (a.obf) { u32x4 w; w.x = pk2(v[0], v[1]); w.y = pk2(v[2], v[3]); w.z = pk2(v[4], v[5]); w.w = pk2(v[6], v[7]); *(u32x4*)(a.obf + (size_t)r * a.ldo + c) = w; }
        if (KIND == SK_IN) {
            float* d = nullptr;
            if (c >= C_KC && c < C_VC) d = a.ksout + (size_t)r * 512 + (c - C_KC);
            else if (c >= C_VC && c < C_LOW) d = a.vsout + (size_t)r * 512 + (c - C_VC);
            else if (c >= C_LOW && c < C_LOW + 16) d = a.lowf + (size_t)r * 16 + (c - C_LOW);
            if (d) { *(f32x4*)d = (f32x4){v[0], v[1], v[2], v[3]}; *(f32x4*)(d + 4) = (f32x4){v[4], v[5], v[6], v[7]}; }
        }
        __syncthreads();
    }
}
__device__ __forceinline__ void sample_share(int nwg, int G, int bx, int& ubeg, int& ustep) { const int nfull = nwg % G; if (nfull == 0) { ubeg = bx; ustep = G; } else if (bx >= nfull) { ubeg = bx - nfull; ustep = G - nfull; } else { ubeg = 1 << 30; ustep = 1; } }

#define XB_TMO      128
#define XB_XCNT(j)  (256  + 64 * (j))
#define XB_XSUB(j)  (1280 + 64 * (j))
#define XB_XGEN(j)  (2304 + 64 * (j))
#define XB_TOP      3328
#define XB_TOPGEN   3392
#define XCD_BAR_WORDS 3456
#define XB_SPIN_CAP (1u << 18)

__device__ __forceinline__ unsigned xb_ld(unsigned* p)              { return __hip_atomic_load(p, __ATOMIC_RELAXED, __HIP_MEMORY_SCOPE_AGENT); }
__device__ __forceinline__ unsigned xb_add(unsigned* p, unsigned v) { return __hip_atomic_fetch_add(p, v, __ATOMIC_RELAXED, __HIP_MEMORY_SCOPE_AGENT); }
__device__ __forceinline__ unsigned xb_xcc_id() { return (unsigned)__builtin_amdgcn_s_getreg((3 << 11) | 20) & 0xFu; }
#define XB_SPIN(cond, bar) do { unsigned _sp = 0; while (cond) { __builtin_amdgcn_s_sleep(1); \
    if ((++_sp & 255u) == 0u) { if (xb_ld(&(bar)[XB_TMO])) break; if (_sp > XB_SPIN_CAP) { atomicAdd(&(bar)[XB_TMO], 1u); break; } } } } while (0)

struct XcdBarrier {
    unsigned* bar; unsigned x; bool wave0;
    volatile LAS unsigned* st;
};

__device__ __forceinline__ XcdBarrier xcd_barrier_post(unsigned* bar, volatile LAS unsigned* st) {
    XcdBarrier b; b.bar = bar; b.x = xb_xcc_id(); b.st = st;
    if (threadIdx.x == 0) (void)xb_add(&bar[XB_XCNT(b.x)], 1u);
    return b;
}
__device__ __forceinline__ void xcd_barrier_complete(unsigned* bar, unsigned x, unsigned& nloc, unsigned& nx) {
    const unsigned G = gridDim.x * gridDim.y * gridDim.z;
    unsigned sum, cnt, mine, sp = 0u;
    for (;;) {
        sum = 0u; cnt = 0u; mine = 0u;
#pragma unroll
        for (unsigned j = 0; j < 16; ++j) { const unsigned c = xb_ld(&bar[XB_XCNT(j)]); sum += c; cnt += (c > 0u) ? 1u : 0u; mine = (j == x) ? c : mine; }
        if (sum == G) break;
        __builtin_amdgcn_s_sleep(1);
        if ((++sp & 255u) == 0u) { if (xb_ld(&bar[XB_TMO])) break; if (sp > XB_SPIN_CAP) { atomicAdd(&bar[XB_TMO], 1u); break; } }
    }
    nloc = mine > 0u ? mine : 1u; nx = cnt > 0u ? cnt : 1u;
}

__device__ __forceinline__ void xcd_barrier(const XcdBarrier& b) {
    asm volatile("s_waitcnt vmcnt(0)" ::: "memory");
    __syncthreads();
    if (b.wave0 && lane_id_asm() == 0) {
        unsigned* bar = b.bar;
        __builtin_amdgcn_s_waitcnt(0);
        unsigned nloc = b.st[0], nx = b.st[1];
        if (nloc == 0u) { xcd_barrier_complete(bar, b.x, nloc, nx); b.st[0] = nloc; b.st[1] = nx; }
        const unsigned old = xb_add(&bar[XB_XSUB(b.x)], 1u);
        const unsigned gen = old / nloc;
        if (old + 1u == (gen + 1u) * nloc) {
            __builtin_amdgcn_fence(__ATOMIC_RELEASE, "agent");
            asm volatile("s_waitcnt vmcnt(0)" ::: "memory");
            const unsigned og = xb_add(&bar[XB_TOP], 1u);
            const unsigned tg = og / nx;
            if (og + 1u == (tg + 1u) * nx) xb_add(&bar[XB_TOPGEN], 1u);
            else XB_SPIN(xb_ld(&bar[XB_TOPGEN]) == tg, bar);
            __builtin_amdgcn_fence(__ATOMIC_ACQUIRE, "agent");
            xb_add(&bar[XB_XGEN(b.x)], 1u);
            asm volatile("s_waitcnt vmcnt(0)" ::: "memory");
        } else {
            XB_SPIN(xb_ld(&bar[XB_XGEN(b.x)]) == gen, bar);
            __builtin_amdgcn_fence(__ATOMIC_ACQUIRE, "agent");
            asm volatile("s_waitcnt vmcnt(0)" ::: "memory");
        }
    }
    __syncthreads();
}


__device__ __forceinline__ void tr_item128(const float* W, int K, int Nsrc, bf16_t* WT, int kb, int nb, const float* kscale, LAS float* scr, int lane) {
    const int k0 = 32 * kb, n0 = 128 * nb, n4 = (lane & 31) * 4;
    f32x4 wv[16];
#pragma unroll
    for (int i = 0; i < 16; ++i) wv[i] = __builtin_nontemporal_load((const f32x4*)(W + (size_t)(k0 + 2 * i + (lane >> 5)) * Nsrc + n0 + n4));
    if (kscale) {
#pragma unroll
        for (int i = 0; i < 16; ++i) wv[i] = wv[i] * kscale[k0 + 2 * i + (lane >> 5)];
    }
#pragma unroll
    for (int i = 0; i < 16; ++i) { LAS float* d = scr + (2 * i + (lane >> 5)) * 129 + n4; d[0] = wv[i][0]; d[1] = wv[i][1]; d[2] = wv[i][2]; d[3] = wv[i][3]; }
    asm volatile("s_waitcnt lgkmcnt(0)" ::: "memory");
#pragma unroll
    for (int j = 0; j < 8; ++j) { const int id = j * 64 + lane, n = id >> 2, c = id & 3; const LAS float* s = scr + (8 * c) * 129 + n;
        u32x4 o; o.x = pk2(s[0 * 129], s[1 * 129]); o.y = pk2(s[2 * 129], s[3 * 129]); o.z = pk2(s[4 * 129], s[5 * 129]); o.w = pk2(s[6 * 129], s[7 * 129]);
        *(u32x4*)(WT + (size_t)(n0 + n) * K + k0 + 8 * c) = o; }
    asm volatile("s_waitcnt lgkmcnt(0)" ::: "memory");
}
constexpr int CONV_WGS = 16;

__global__ void __launch_bounds__(512, 2) hybrid_fwd(Params p) {
    extern __shared__ __attribute__((aligned(16))) unsigned char lds_raw[];
    cg::grid_group grid = cg::this_grid();
    LAS unsigned char* lds = (LAS unsigned char*)lds_raw;
    const int wave = __builtin_amdgcn_readfirstlane((int)threadIdx.x >> 6);
    const int G = gridDim.x, bx = blockIdx.x;
#define WSP(off) (ws_ptr() + (off))
#define LANE_TID() const int lane = lane_id_asm(); const int tid = wave * 64 + lane; (void)tid; int Gq = G, bxq = bx; asm volatile("" : "+s"(Gq), "+s"(bxq)); (void)Gq; (void)bxq
    LAS unsigned char* wl = lds + wave * WAVE_LDS;
    LAS float* biasT = (LAS float*)(lds + LDS_BIAS);
    if (threadIdx.x < 4) ((LAS unsigned*)(lds + LDS_BARST))[threadIdx.x] = 0u;
    __syncthreads();
    XcdBarrier xbar = xcd_barrier_post((unsigned*)WSP(WS_CTL), (volatile LAS unsigned*)(lds + LDS_BARST)); xbar.wave0 = (wave == 0);

    for (int rep = 0; rep < 1 + PROBE_P0X2; ++rep) {
        LANE_TID();
        unsigned char* ws = ws_ptr();
        bf16_t* XB = (bf16_t*)(ws + WS_B); bf16_t* WIN = (bf16_t*)(ws + WS_WIN); bf16_t* WOUT = (bf16_t*)(ws + WS_WOUT); bf16_t* WUP = (bf16_t*)(ws + WS_WUP); bf16_t* WDN = (bf16_t*)(ws + WS_WDN);
        float* SS = (float*)(ws + WS_SS); float* ROPE = (float*)(ws + WS_ROPE);
        const int gw = bx * 8 + wave, NGW = G * 8;
        LAS float* scr = (LAS float*)wl;
        constexpr int I_IN = 16 * (PS / 32), I_OUT = 16 * 32, I_UP = 16 * 128, I_DN = 64 * 32, I_L = I_IN + I_OUT + I_UP + I_DN;
        const bool split = (G == 256);
        for (int it = gw; it < 2 * I_L; it += NGW) {
            const int l = it / I_L; int r = it % I_L;
            if (split && r >= I_IN) continue;
            if (r < I_IN) { tr_item(in_ptr(9) + (size_t)l * DM * INCOLS, DM, INCOLS, WIN + (size_t)l * PS * DM, r / (PS / 32), r % (PS / 32), true, in_ptr(6) + l * DM, scr, lane); continue; } r -= I_IN;
            if (r < I_OUT) { tr_item(in_ptr(15) + (size_t)l * DM * DM, DM, DM, WOUT + (size_t)l * DM * DM, r / 32, r % 32, false, nullptr, scr, lane); continue; } r -= I_OUT;
            if (r < I_UP) { tr_item(in_ptr(16) + (size_t)l * DM * DFF, DM, DFF, WUP + (size_t)l * DFF * DM, r / 128, r % 128, false, in_ptr(7) + l * DM, scr, lane); continue; } r -= I_UP;
            tr_item(in_ptr(17) + (size_t)l * DFF * DM, DFF, DM, WDN + (size_t)l * DM * DFF, r / 32, r % 32, false, nullptr, scr, lane);
        }
        const float* x_prompt = in_ptr(0); const float* x_sample = in_ptr(1);
        for (int m0 = gw; m0 < MT; m0 += 2 * NGW) {
            f32x4 v[2][4]; float s[2];
#pragma unroll
            for (int q = 0; q < 2; ++q) {
                const int m = m0 + q * NGW; s[q] = 0.f;
                if (m < MT) {
                    const float* xrow = (m < MP) ? x_prompt + (size_t)m * DM : x_sample + (size_t)(m - MP) * DM;
                    const f32x4* xr = (const f32x4*)xrow + lane;
#pragma unroll
                    for (int j = 0; j < 4; ++j) v[q][j] = __builtin_nontemporal_load(&xr[64 * j]);
                }
            }
#pragma unroll
            for (int q = 0; q < 2; ++q) {
                const int m = m0 + q * NGW;
                if (m < MT) {
#pragma unroll
                    for (int j = 0; j < 4; ++j) s[q] += (v[q][j][0] * v[q][j][0] + v[q][j][1] * v[q][j][1]) + (v[q][j][2] * v[q][j][2] + v[q][j][3] * v[q][j][3]);
#pragma unroll
                    for (int o = 1; o < 64; o <<= 1) s[q] += __shfl_xor(s[q], o);
                    u32x2* o8 = (u32x2*)(XB + (size_t)m * DM) + lane;
#pragma unroll
                    for (int j = 0; j < 4; ++j) { u32x2 w; w.x = pk2(v[q][j][0], v[q][j][1]); w.y = pk2(v[q][j][2], v[q][j][3]); o8[64 * j] = w; }
                    if (lane == 0) SS[m] = s[q];
                }
            }
        }
        const int gt = bx * 512 + tid, NGT = G * 512;
        for (int i = gt; i < 4 * MT; i += NGT) SS[MT + i] = 0.f;
        conv_cache(in_ptr(4), in_ptr(5), (bf16_t*)(ws + WS_CKB), 0, gt, NGT);
        for (int i = gt; i < 2080 * 32; i += NGT) {
            const int pi = i >> 5, f = i & 31; const int pos = pi < 2048 ? pi : 4096 + (pi - 2048);
            const float inv_freq = (float)exp(-(double)f * (9.210340371976184 / 32.0));
            const float ang = (float)pos * inv_freq;
            double rev = (double)ang * 0.15915494309189535; rev -= rint(rev);
            const float rf = (float)rev;
            ROPE[(size_t)pi * 64 + f] = __builtin_amdgcn_cosf(rf); ROPE[(size_t)pi * 64 + 32 + f] = __builtin_amdgcn_sinf(rf);
        }
    }
    if (G == 0x7fffffff) grid.sync();
    xcd_barrier(xbar);

    for (int l = 0; l < 2; ++l) {
        {
            LANE_TID();
            unsigned char* ws = ws_ptr();
            const bool split = (Gq == 256); const int GG = split ? Gq - CONV_WGS : Gq;
            if (split && bxq >= GG) {
                LAS float* scr = (LAS float*)(lds + wave * WAVE_LDS);
                constexpr int J_OUT = 32 * 8, J_UP = 32 * 32;
                for (int it = (bxq - GG) * 8 + wave; it < J_OUT + J_UP; it += CONV_WGS * 8) {
                    if (it < J_OUT) tr_item128(in_ptr(15) + (size_t)l * DM * DM, DM, DM, (bf16_t*)(ws + WS_WOUT) + (size_t)l * DM * DM, it / 8, it % 8, nullptr, scr, lane);
                    else { const int r = it - J_OUT; tr_item128(in_ptr(16) + (size_t)l * DM * DFF, DM, DFF, (bf16_t*)(ws + WS_WUP) + (size_t)l * DFF * DM, r / 32, r % 32, in_ptr(7) + l * DM, scr, lane); }
                }
            } else {
            pg8::Gemm g{(const bf16_t*)(ws + WS_B), (const bf16_t*)(ws + WS_WIN) + (size_t)l * PS * DM, MP, PS, DM}; pg8::StaticOrder S; S.init(MP, PS, GG, bxq);
            pg8::EpiIn E{(bf16_t*)(ws + WS_A), (float*)(ws + WS_LOWF), (const float*)(ws + WS_SS) + (size_t)(2 * l) * MT, out_ptr(), (long long)(O_KP + (size_t)l * 2097152), (long long)(O_VP + (size_t)l * 2097152), (long long)(O_KS + (size_t)l * 131072), (long long)(O_VS + (size_t)l * 131072)};
            pg8::gemm_phase<pg8::EpiIn, pg8::StaticOrder, true, true>(lds, g, S, E, tid);
            if (PROBE_IN2) pg8::gemm_phase<pg8::EpiIn, pg8::StaticOrder, true, true>(lds, g, S, E, tid);
            {
                float* outp = out_ptr();
                SArgs a{}; a.A = (const bf16_t*)(ws + WS_B) + (size_t)MP * DM; a.Bt = (const bf16_t*)(ws + WS_WIN) + (size_t)l * PS * DM; a.K = DM; a.nunits = 4 * 57;
                a.obf = (bf16_t*)(ws + WS_A) + (size_t)MP * PS; a.ldo = PS; a.ss_in = (const float*)(ws + WS_SS) + (size_t)(2 * l) * MT + MP; a.lowf = (float*)(ws + WS_LOWF) + (size_t)MP * 16;
                a.ksout = outp + O_KS + (size_t)l * 131072; a.vsout = outp + O_VS + (size_t)l * 131072;
                int ub, us; sample_share((MP / 256) * (PS / 256), GG, bxq, ub, us);
                sample_gemm<SK_IN>(lds, a, ub, us, wave, lane);
            }
            if (l == 1) conv_cache(in_ptr(4), in_ptr(5), (bf16_t*)(ws + WS_CKB), 1, bxq * 512 + tid, GG * 512);
            }
        }
        xcd_barrier(xbar);
        {
            LANE_TID();
            { const float* rb = in_ptr(14) + (size_t)l * 8 * NREL; for (int i = tid; i < 8 * NREV; i += 512) { const int hh = i / NREV, j = i % NREV; int k = 382 - j; k = k < 0 ? 0 : (k > NREL - 1 ? NREL - 1 : k); biasT[i] = rb[hh * NREL + k] * 1.4426950408889634f; } }
            __syncthreads();
        }
#define MAKE_CTX() LANE_TID(); int wv = wave; asm volatile("" : "+s"(wv)); unsigned char* ws = ws_ptr(); Ctx C; C.l = l; C.lane = lane; C.kq = lane >> 5; C.li = lane & 31; C.proj = (const bf16_t*)(ws + WS_A); C.lowf = (const float*)(ws + WS_LOWF); \
        C.rope = (const float*)(ws + WS_ROPE); C.cat = (bf16_t*)(out_ptr() + O_Y); C.kvt = (float*)(ws + WS_C); C.gdec = (float*)(ws + WS_G); C.out = out_ptr(); \
        C.wa2 = in_ptr(10) + (size_t)l * 16 * 256; C.ba = in_ptr(11) + l * 256; C.nw = (wv < 4 ? in_ptr(12) : in_ptr(13)) + l * 256; C.st = (wv < 4 ? in_ptr(2) : in_ptr(3)); C.ckb = (const bf16_t*)(ws + WS_CKB); C.cvb = C.ckb + CACHE_ELEMS; \
        __builtin_amdgcn_sched_barrier(0)
        for (int rep = 0; rep < 1 + PROBE_M1X2; ++rep)
        for (int u = bx; u < 256; u += G) {
            const int b = u & 7, n = u >> 3;
            for (int rk = 0; rk < 1 + PROBE_KVX2; ++rk) { MAKE_CTX(); kv_local<false>(C, wv >> 2, b, n, wv & 3, wl); }
            for (int ra = 0; ra < 1 + PROBE_ATX2; ++ra) { MAKE_CTX(); attn_wave<false>(C, b, n, wave, wl, biasT + wave * NREV, biasT[wave * NREV]); }
            if (n == 0) { MAKE_CTX(); attn_wave<true>(C, b, 0, wave, wl, biasT + wave * NREV, biasT[wave * NREV]); }
            if (n == 1) { MAKE_CTX(); mix_out<true>(C, wv >> 2, b, 0, wv & 3, wl); }
            if (n == 2) { MAKE_CTX(); kv_local<true>(C, wv >> 2, b, 0, wv & 3, wl); }
        }
        xcd_barrier(xbar);
        {
            LANE_TID();
            float* KVT = (float*)WSP(WS_C); const float* GDEC = (const float*)WSP(WS_G); float* outp = out_ptr();
            for (int it = bx * 512 + tid; it < 131072; it += G * 512) {
                const int seq = it >> 11, e2 = it & 2047, type = seq >> 5, b = (seq >> 2) & 7, h = seq & 3;
                const int dv = e2 >> 5, dk = (2 * e2) & 63;
                bf16_t* base = (bf16_t*)KVT + (size_t)seq * 32 * 4096 + 2 * e2;
                const float dret = exp2f(ret_lg2(h) * 64.0f);
                const float* gd = GDEC + (size_t)((b * 4 + h) * 32) * 64 + dk;
                unsigned kvr[32]; f32x2 dd[32];
#pragma unroll
                for (int c = 0; c < 32; ++c) kvr[c] = *(const unsigned*)(base + (size_t)c * 4096);
                if (type == 1) {
#pragma unroll
                    for (int c = 0; c < 32; ++c) dd[c] = *(const f32x2*)(gd + c * 64);
                } else {
#pragma unroll
                    for (int c = 0; c < 32; ++c) dd[c] = (f32x2){dret, dret};
                }
                f32x2 s = (f32x2){0.f, 0.f};
#pragma unroll
                for (int c = 0; c < 32; ++c) { *(unsigned*)(base + (size_t)c * 4096) = pk2(s[0], s[1]); s = dd[c] * s + (f32x2){bflo(kvr[c]), bfhi(kvr[c])}; }
                float* so = outp + (type == 0 ? O_RETP : O_GLAP) + (size_t)((l * 8 + b) * 4 + h) * 4096;
                so[dk * 64 + dv] = s[0]; so[(dk + 1) * 64 + dv] = s[1];
            }
        }
        xcd_barrier(xbar);
        for (int rep = 0; rep < 1 + PROBE_M3X2; ++rep)
        for (int u = bx; u < 256; u += G) { MAKE_CTX(); mix_out<false>(C, wv >> 2, u & 7, u >> 3, wv & 3, wl); }
        xcd_barrier(xbar);
        {
            LANE_TID();
            unsigned char* ws = ws_ptr(); const bf16_t* CATB = (const bf16_t*)(out_ptr() + O_Y);
            pg8::Gemm g{CATB, (const bf16_t*)(ws + WS_WOUT) + (size_t)l * DM * DM, MP, DM, DM}; pg8::StaticOrder S; S.init(MP, DM, Gq, bxq);
            pg8::EpiRes E{(const bf16_t*)(ws + WS_B), (float*)nullptr, (bf16_t*)(ws + WS_C), (float*)(ws + WS_SS) + (size_t)(2 * l + 1) * MT};
            pg8::gemm_phase<pg8::EpiRes, pg8::StaticOrder, true, true>(lds, g, S, E, tid);
            {
                SArgs a{}; a.A = CATB + (size_t)MP * DM; a.Bt = (const bf16_t*)(ws + WS_WOUT) + (size_t)l * DM * DM; a.K = DM; a.nunits = 4 * 16;
                a.obf = (bf16_t*)(ws + WS_C) + (size_t)MP * DM; a.ldo = DM; a.ss_out = (float*)(ws + WS_SS) + (size_t)(2 * l + 1) * MT + MP;
                a.xold = (const bf16_t*)(ws + WS_B) + (size_t)MP * DM; a.xr = nullptr;
                int ub, us; sample_share((MP / 256) * (DM / 256), Gq, bxq, ub, us);
                sample_gemm<SK_RES>(lds, a, ub, us, wave, lane);
                const int nsamp = a.nunits < Gq ? a.nunits : Gq;
                if (Gq == 256 && bxq >= nsamp) {
                    LAS float* scr = (LAS float*)(lds + wave * WAVE_LDS);
                    for (int it = (bxq - nsamp) * 8 + wave; it < 128 * 8; it += (Gq - nsamp) * 8)
                        tr_item128(in_ptr(17) + (size_t)l * DFF * DM, DFF, DM, (bf16_t*)(ws + WS_WDN) + (size_t)l * DM * DFF, it / 8, it % 8, nullptr, scr, lane);
                }
            }
        }
        xcd_barrier(xbar);
        {
            LANE_TID();
            unsigned char* ws = ws_ptr();
            pg8::Gemm g{(const bf16_t*)(ws + WS_C), (const bf16_t*)(ws + WS_WUP) + (size_t)l * DFF * DM, MP, DFF, DM}; pg8::StaticOrder S; S.init(MP, DFF, Gq, bxq);
            pg8::EpiUp E{(bf16_t*)(ws + WS_A), (const float*)(ws + WS_SS) + (size_t)(2 * l + 1) * MT, DFF};
            pg8::gemm_phase<pg8::EpiUp, pg8::StaticOrder, true, true>(lds, g, S, E, tid);
            if (PROBE_UP2) pg8::gemm_phase<pg8::EpiUp, pg8::StaticOrder, true, true>(lds, g, S, E, tid);
            if (PROBE_UP2B) { xcd_barrier(xbar); pg8::gemm_phase<pg8::EpiUp, pg8::StaticOrder, true, true>(lds, g, S, E, tid); }
            {
                SArgs a{}; a.A = (const bf16_t*)(ws + WS_C) + (size_t)MP * DM; a.Bt = (const bf16_t*)(ws + WS_WUP) + (size_t)l * DFF * DM; a.K = DM; a.nunits = 4 * 64;
                a.obf = (bf16_t*)(ws + WS_A) + (size_t)MP * DFF; a.ldo = DFF; a.ss_in = (const float*)(ws + WS_SS) + (size_t)(2 * l + 1) * MT + MP;
                int ub, us; sample_share((MP / 256) * (DFF / 256), Gq, bxq, ub, us);
                sample_gemm<SK_UP>(lds, a, ub, us, wave, lane);
            }
        }
        xcd_barrier(xbar);
        {
            LANE_TID();
            unsigned char* ws = ws_ptr(); float* XR = out_ptr() + O_Y;
            pg8::Gemm g{(const bf16_t*)(ws + WS_A), (const bf16_t*)(ws + WS_WDN) + (size_t)l * DM * DFF, MP, DM, DFF}; pg8::StaticOrder S; S.init(MP, DM, Gq, bxq);
            if (PROBE_DN2) { pg8::EpiUp E2{(bf16_t*)(ws + WS_C), (const float*)(ws + WS_SS) + (size_t)(2 * l + 1) * MT, DM}; pg8::gemm_phase<pg8::EpiUp, pg8::StaticOrder, true, true>(lds, g, S, E2, tid); }
            pg8::EpiRes E{(const bf16_t*)(ws + WS_C), (float*)nullptr, (bf16_t*)(ws + WS_B), (float*)(ws + WS_SS) + (size_t)(2 * l + 2) * MT};
            pg8::gemm_phase<pg8::EpiRes, pg8::StaticOrder, true, true>(lds, g, S, E, tid);
            {
                SArgs a{}; a.A = (const bf16_t*)(ws + WS_A) + (size_t)MP * DFF; a.Bt = (const bf16_t*)(ws + WS_WDN) + (size_t)l * DM * DFF; a.K = DFF; a.nunits = 4 * 16;
                a.obf = (bf16_t*)(ws + WS_B) + (size_t)MP * DM; a.ldo = DM; a.ss_out = (float*)(ws + WS_SS) + (size_t)(2 * l + 2) * MT + MP;
                a.xold = (const bf16_t*)(ws + WS_C) + (size_t)MP * DM; a.xr = nullptr;
                int ub, us; sample_share((MP / 256) * (DM / 256), Gq, bxq, ub, us);
                sample_gemm<SK_RES>(lds, a, ub, us, wave, lane);
            }
        }
        xcd_barrier(xbar);
    }
    for (int i = 0; i < PROBE_SYNCS; ++i) xcd_barrier(xbar);
    {
        LANE_TID();
        const int gw = bx * 8 + wave, NGW = G * 8;
        const float* fw = in_ptr(8); const float* SS = (const float*)WSP(WS_SS); float* Y = out_ptr() + O_Y; const bf16_t* XBF = (const bf16_t*)WSP(WS_B);
        f32x4 w4[4];
#pragma unroll
        for (int j = 0; j < 4; ++j) w4[j] = *((const f32x4*)fw + lane + 64 * j);
        for (int m0 = gw; m0 < MT; m0 += 4 * NGW) {
            u32x2 v[4][4]; float rs[4];
#pragma unroll
            for (int q = 0; q < 4; ++q) {
                const int m = m0 + q * NGW;
                if (m < MT) {
                    rs[q] = SS[(size_t)4 * MT + m];
                    const u32x2* xr = (const u32x2*)(XBF + (size_t)m * DM) + lane;
#pragma unroll
                    for (int j = 0; j < 4; ++j) v[q][j] = __builtin_nontemporal_load(&xr[64 * j]);
                }
            }
#pragma unroll
            for (int q = 0; q < 4; ++q) {
                const int m = m0 + q * NGW;
                if (m < MT) {
                    const float r = 1.0f / sqrtf(rs[q] * (1.0f / 1024.0f) + EPS);
                    f32x4* yr = (f32x4*)(Y + (size_t)m * DM) + lane;
#pragma unroll
                    for (int j = 0; j < 4; ++j) { const f32x4 x = (f32x4){bflo(v[q][j].x), bfhi(v[q][j].x), bflo(v[q][j].y), bfhi(v[q][j].y)}; __builtin_nontemporal_store(x * r * w4[j], &yr[64 * j]); }
                }
            }
        }
    }
}

extern "C" void kernel_launch(void* const* d_in, const int* in_sizes, int n_in, void* d_out, int out_size, void* d_ws, size_t ws_size, hipStream_t stream) {
    static int grid = 0;
    if (grid == 0) {
        if (n_in != 18 || (size_t)out_size != O_END || ws_size < WS_END) { fprintf(stderr, "kernel_launch: unexpected shapes: n_in %d out %d ws %zu (need %zu)\n", n_in, out_size, ws_size, (size_t)WS_END); grid = -1; return; }
        int dev = 0, cus = 0, per_cu = 0;
        hipGetDevice(&dev); hipDeviceGetAttribute(&cus, hipDeviceAttributeMultiprocessorCount, dev);
        if (hipFuncSetAttribute((const void*)hybrid_fwd, hipFuncAttributeMaxDynamicSharedMemorySize, LDS_BYTES) != hipSuccess) { fprintf(stderr, "kernel_launch: hipFuncSetAttribute failed\n"); }
        if (hipOccupancyMaxActiveBlocksPerMultiprocessor(&per_cu, (const void*)hybrid_fwd, 512, LDS_BYTES) != hipSuccess || per_cu < 1) { fprintf(stderr, "kernel_launch: occupancy query says %d\n", per_cu); per_cu = 1; }
        (void)hipGetLastError();
        grid = cus * per_cu;
        if (grid > 256) grid = 256;
    }
    if (grid < 0) return;
    if (hipMemsetAsync((unsigned char*)d_ws + WS_CTL, 0, CTL_BYTES, stream) != hipSuccess) { fprintf(stderr, "kernel_launch: memset of the barrier words failed\n"); return; }
    Params p{};
    for (int i = 0; i < 18; ++i) p.in[i] = (const float*)d_in[i];
    p.out = (float*)d_out; p.ws = (unsigned char*)d_ws;
    void* args[] = {&p};
    hipError_t e = hipLaunchCooperativeKernel((const void*)hybrid_fwd, dim3(grid), dim3(512), args, LDS_BYTES, stream);
    if (e != hipSuccess) fprintf(stderr, "kernel_launch: cooperative launch failed: %s (grid %d)\n", hipGetErrorString(e), grid);
}
```

```cpp
#include <hip/hip_runtime.h>
#include <hip/hip_cooperative_groups.h>
#include <cstdio>
#include <cstdint>
namespace cg = cooperative_groups;
#ifndef PROBE_UP2
#define PROBE_UP2 0
#endif
#ifndef PROBE_M1X2
#define PROBE_M1X2 0
#endif
#ifndef PROBE_P0X2
#define PROBE_P0X2 0
#endif
#ifndef PROBE_SYNCS
#define PROBE_SYNCS 0
#endif
#ifndef PROBE_IN2
#define PROBE_IN2 0
#endif
#ifndef PROBE_DN2
#define PROBE_DN2 0
#endif
#ifndef PROBE_UP2B
#define PROBE_UP2B 0
#endif
#ifndef PROBE_KVX2
#define PROBE_KVX2 0
#endif
#ifndef PROBE_ATX2
#define PROBE_ATX2 0
#endif
#ifndef PROBE_M3X2
#define PROBE_M3X2 0
#endif
namespace pg8 {
#define PG8_LAS __attribute__((address_space(3)))
typedef unsigned short bf16_t;
typedef short bf16x8 __attribute__((ext_vector_type(8)));
typedef float f32x4 __attribute__((ext_vector_type(4)));
typedef unsigned u32x4 __attribute__((ext_vector_type(4)));
constexpr int BM = 256, BK = 64, HALF = 128, HTB = HALF * BK * 2  , STAGE_BYTES = 8 * HTB, NXCD = 8, WGM = 8;

__host__ __device__ __forceinline__ int lds_byte(int r, int c) { const int st = (r >> 4) * 2 + (c >> 5), rr = r & 15, cc = c & 31, ob = rr * 64 + cc * 2; return st * 1024 + (ob ^ (((ob >> 9) & 1) << 5)); }
__host__ __device__ __forceinline__ void stage_rc(int b, int& R, int& C) { const int st = b / 1024, sb = b % 1024, swz = sb ^ (((sb >> 9) & 1) << 5); R = (st >> 1) * 16 + swz / 64; C = (st & 1) * 32 + (swz % 64) / 2; }
__host__ __device__ __forceinline__ int perm32(int rho) { const int n = rho >> 4, i = rho & 15; return 8 * (i >> 2) + 4 * n + (i & 3); }

struct Unit { int pm, pn; };
struct Gemm { const bf16_t* A; const bf16_t* Bt; int M, N, K; };

struct StaticOrder {
    int nM, nN, nwg, G, c;
    __host__ __device__ __forceinline__ void init(int M, int N, int G_, int c_) { nM = M / BM; nN = N / BM; nwg = nM * nN; G = G_; c = c_; }
    __host__ __device__ __forceinline__ bool next(int i, Unit& u) const {
        const long L = (long)i * G + c; if (L >= nwg) return false;
        int wgid = (int)L; { const int q = nwg / NXCD, r = nwg % NXCD, xcd = wgid % NXCD, off = wgid / NXCD; wgid = (xcd < r ? xcd * (q + 1) : r * (q + 1) + (xcd - r) * q) + off; }
        const int nig = WGM * nN, gid = wgid / nig, fm = gid * WGM, gsz = (nM - fm) < WGM ? (nM - fm) : WGM;
        u.pm = fm + ((wgid % nig) % gsz); u.pn = (wgid % nig) / gsz; return true;
    }
    __device__ __forceinline__ void a_ready(const Unit&) const {}
    __device__ __forceinline__ void done(const Unit&) const {}
};

__device__ __forceinline__ unsigned cvt_pk_bf16(float lo, float hi) { unsigned r; asm volatile("v_cvt_pk_bf16_f32 %0, %1, %2" : "=v"(r) : "v"(lo), "v"(hi)); return r; }
typedef float f32x2 __attribute__((ext_vector_type(2)));

typedef unsigned u32x2 __attribute__((ext_vector_type(2)));
constexpr int E_MP = 16384;
struct EpiIn {
    static constexpr bool PERM = true, AFTER_DRAIN = false;
    bf16_t* proj; float* lowf; const float* ss; float* out; long long okp, ovp, oks, ovs;
    __device__ __forceinline__ void operator()(const f32x4 (&acc)[2][2][4][2], const Unit& u, int wr, int wc, int fr, int fq) const {
        const int row0 = u.pm * BM + wr * 64 + fr, col0 = u.pn * BM + wc * 32 + 8 * fq;
        float* kv = nullptr; int rsub = 0, cbase = 0;
        if (u.pn >= 10 && u.pn < 14) {
            const bool isk = u.pn < 12; cbase = isk ? 2560 : 3072;
            if (u.pm >= 64) { kv = out + (isk ? oks : ovs); rsub = E_MP; }
            else if ((u.pm & 7) >= 6) { kv = out + (isk ? okp : ovp); rsub = 1536 * ((u.pm >> 3) + 1); }
        }
        const bool lowt = (u.pn == 14) && (wc == 0) && (fq < 2);
#pragma unroll
        for (int ai = 0; ai < 2; ++ai)
#pragma unroll
            for (int m = 0; m < 4; ++m) {
                const int r = row0 + ai * HALF + m * 16;
                const float rs = 1.0f / sqrtf(ss[r] * (1.0f / 1024.0f) + 1e-6f);
                bf16_t* rowp = proj + (size_t)r * 3840 + col0;
#pragma unroll
                for (int bj = 0; bj < 2; ++bj) {
                    const f32x4 v0 = acc[ai][bj][m][0] * rs, v1 = acc[ai][bj][m][1] * rs;
                    u32x4 w; w.x = cvt_pk_bf16(v0[0], v0[1]); w.y = cvt_pk_bf16(v0[2], v0[3]); w.z = cvt_pk_bf16(v1[0], v1[1]); w.w = cvt_pk_bf16(v1[2], v1[3]);
                    *(u32x4*)(rowp + bj * HALF) = w;
                    if (kv) { float* d = kv + (size_t)(r - rsub) * 512 + (col0 + bj * HALF - cbase); __builtin_nontemporal_store(v0, (f32x4*)d); __builtin_nontemporal_store(v1, (f32x4*)(d + 4)); }
                    if (lowt && bj == 0) { float* d = lowf + (size_t)r * 16 + 8 * fq; *(f32x4*)d = v0; *(f32x4*)(d + 4) = v1; }
                }
            }
    }
};
struct EpiRes {
    static constexpr bool PERM = true, AFTER_DRAIN = false;
    const bf16_t* xold; float* xr; bf16_t* xb; float* ss;
    __device__ __forceinline__ void operator()(const f32x4 (&acc)[2][2][4][2], const Unit& u, int wr, int wc, int fr, int fq) const {
        const int row0 = u.pm * BM + wr * 64 + fr, col0 = u.pn * BM + wc * 32 + 8 * fq;
#pragma unroll
        for (int ai = 0; ai < 2; ++ai)
#pragma unroll
            for (int m = 0; m < 4; ++m) {
                const int r = row0 + ai * HALF + m * 16;
                const bf16_t* xo = xold + (size_t)r * 1024 + col0;
                float sq = 0.f;
#pragma unroll
                for (int bj = 0; bj < 2; ++bj) {
                    const u32x4 xw = *(const u32x4*)(xo + bj * HALF);
                    f32x4 v0, v1;
                    v0[0] = __uint_as_float(xw.x << 16); v0[1] = __uint_as_float(xw.x & 0xffff0000u); v0[2] = __uint_as_float(xw.y << 16); v0[3] = __uint_as_float(xw.y & 0xffff0000u);
                    v1[0] = __uint_as_float(xw.z << 16); v1[1] = __uint_as_float(xw.z & 0xffff0000u); v1[2] = __uint_as_float(xw.w << 16); v1[3] = __uint_as_float(xw.w & 0xffff0000u);
                    v0 = v0 + acc[ai][bj][m][0]; v1 = v1 + acc[ai][bj][m][1];
                    if (xr) { float* xn = xr + (size_t)r * 1024 + col0 + bj * HALF; *(f32x4*)xn = v0; *(f32x4*)(xn + 4) = v1; }
                    sq += (v0[0] * v0[0] + v0[1] * v0[1]) + (v0[2] * v0[2] + v0[3] * v0[3]) + (v1[0] * v1[0] + v1[1] * v1[1]) + (v1[2] * v1[2] + v1[3] * v1[3]);
                    if (xb) { u32x4 w; w.x = cvt_pk_bf16(v0[0], v0[1]); w.y = cvt_pk_bf16(v0[2], v0[3]); w.z = cvt_pk_bf16(v1[0], v1[1]); w.w = cvt_pk_bf16(v1[2], v1[3]);
                        *(u32x4*)(xb + (size_t)r * 1024 + col0 + bj * HALF) = w; }
                }
                sq += __shfl_xor(sq, 16); sq += __shfl_xor(sq, 32);
                if (fq == 0) atomicAdd(ss + r, sq);
            }
    }
};
struct EpiUp {
    static constexpr bool PERM = true, AFTER_DRAIN = false;
    bf16_t* U; const float* ss; int ldu;
    __device__ __forceinline__ void operator()(const f32x4 (&acc)[2][2][4][2], const Unit& u, int wr, int wc, int fr, int fq) const {
        const int row0 = u.pm * BM + wr * 64 + fr, col0 = u.pn * BM + wc * 32 + 8 * fq;
#pragma unroll
        for (int ai = 0; ai < 2; ++ai)
#pragma unroll
            for (int m = 0; m < 4; ++m) {
                const int r = row0 + ai * HALF + m * 16;
                const float rs = 1.0f / sqrtf(ss[r] * (1.0f / 1024.0f) + 1e-6f);
                bf16_t* rowp = U + (size_t)r * ldu + col0;
#pragma unroll
                for (int bj = 0; bj < 2; ++bj) {
                    f32x4 v0 = acc[ai][bj][m][0] * rs, v1 = acc[ai][bj][m][1] * rs;
#pragma unroll
                    for (int e = 0; e < 4; ++e) { const float a = fmaxf(v0[e], 0.f), b = fmaxf(v1[e], 0.f); v0[e] = a * a; v1[e] = b * b; }
                    u32x4 w; w.x = cvt_pk_bf16(v0[0], v0[1]); w.y = cvt_pk_bf16(v0[2], v0[3]); w.z = cvt_pk_bf16(v1[0], v1[1]); w.w = cvt_pk_bf16(v1[2], v1[3]);
                    *(u32x4*)(rowp + bj * HALF) = w;
                }
            }
    }
};

template <class Epi, class Sched, bool ALIGN_EPI = false, bool SP2 = false>
__device__ __forceinline__ void gemm_phase(PG8_LAS unsigned char* lds, const Gemm g, const Sched& S, const Epi& E, const int tid_in) {
    int tid_ = tid_in; asm volatile("" : "+v"(tid_));
    const int tid = tid_, wid = __builtin_amdgcn_readfirstlane(tid >> 6), lane = tid & 63, wr = wid >> 2, wc = wid & 3, fr = lane & 15, fq = lane >> 4;
    const int K = g.K, nt = K / BK;
    unsigned voffA[2], voffB[2];
#pragma unroll
    for (int i = 0; i < 2; ++i) { int R, C; stage_rc(tid * 16 + i * 8192, R, C); const int Rb = Epi::PERM ? ((R & ~31) + perm32(R & 31)) : R;
        voffA[i] = (unsigned)(R * K + C) * 2u; voffB[i] = (unsigned)(Rb * K + C) * 2u; }
    const size_t kstep = (size_t)(BK * 2);
    const size_t hstep = (size_t)HALF * K * 2;
    const size_t tstep = 2 * hstep;
    const unsigned ldsw = (unsigned)wid * 1024u;
    const int aoff = lds_byte(wr * 64 + fr, fq * 8), boff = lds_byte(wc * 32 + fr, fq * 8);
#define PG8_SA(b, h) (((b) * 2 + (h)) * HTB)
#define PG8_SB(b, h) ((4 + (b) * 2 + (h)) * HTB)
#define PG8_STAGE(bufoff, gbase, voff) do { _Pragma("unroll") for (int _i = 0; _i < 2; ++_i) \
        __builtin_amdgcn_global_load_lds((const unsigned*)((const char*)(gbase) + (voff)[_i]), (PG8_LAS unsigned*)(lds + (bufoff) + ldsw + _i * 8192), 16, 0, 0); } while (0)
#define PG8_LDA(dst, b, h) do { _Pragma("unroll") for (int m = 0; m < 4; ++m) _Pragma("unroll") for (int k = 0; k < 2; ++k) dst[m][k] = *(const PG8_LAS bf16x8*)(lds + PG8_SA(b, h) + aoff + m * 2048 + k * 1024); } while (0)
#define PG8_LDB(dst, b, h) do { _Pragma("unroll") for (int n = 0; n < 2; ++n) _Pragma("unroll") for (int k = 0; k < 2; ++k) dst[n][k] = *(const PG8_LAS bf16x8*)(lds + PG8_SB(b, h) + boff + n * 2048 + k * 1024); } while (0)
#define PG8_MMA(ai, bj, At, Bt) do { __builtin_amdgcn_s_setprio(1); _Pragma("unroll") for (int m = 0; m < 4; ++m) _Pragma("unroll") for (int n = 0; n < 2; ++n) _Pragma("unroll") for (int k = 0; k < 2; ++k) \
        acc[ai][bj][m][n] = __builtin_amdgcn_mfma_f32_16x16x32_bf16(Bt[n][k], At[m][k], acc[ai][bj][m][n], 0, 0, 0); __builtin_amdgcn_s_setprio(0); } while (0)
#define PG8_WAIT_V(n) asm volatile("s_waitcnt vmcnt(" #n ")" ::: "memory")
#define PG8_WAIT_L(n) asm volatile("s_waitcnt lgkmcnt(" #n ")" ::: "memory")
#define PG8_BAR __builtin_amdgcn_s_barrier()
#define PG8_SCHED __builtin_amdgcn_sched_barrier(0)
    Unit cur, nxt; int ui = 0;
    if (!S.next(0, cur)) return;
    f32x4 acc[2][2][4][2];
#pragma unroll
    for (int a = 0; a < 2; ++a)
#pragma unroll
        for (int b = 0; b < 2; ++b)
#pragma unroll
            for (int m = 0; m < 4; ++m)
#pragma unroll
                for (int n = 0; n < 2; ++n) acc[a][b][m][n] = (f32x4){0.f, 0.f, 0.f, 0.f};
    bf16x8 At[4][2], B0[2][2], B1[2][2];
    const char* cA = (const char*)g.A + (size_t)cur.pm * tstep; const char* cB = (const char*)g.Bt + (size_t)cur.pn * tstep;
    S.a_ready(cur);
    if constexpr (SP2) {
        PG8_STAGE(PG8_SB(0, 0), cB, voffB); PG8_STAGE(PG8_SB(0, 1), cB + hstep, voffB); PG8_STAGE(PG8_SA(0, 0), cA, voffA); PG8_STAGE(PG8_SA(0, 1), cA + hstep, voffA);
        if (wr == 1) PG8_BAR;
        PG8_WAIT_V(2); PG8_BAR;
        PG8_STAGE(PG8_SB(1, 0), cB + kstep, voffB); PG8_STAGE(PG8_SA(1, 0), cA + kstep, voffA); PG8_STAGE(PG8_SB(1, 1), cB + hstep + kstep, voffB);
        PG8_WAIT_V(6); PG8_BAR;
    } else {
        PG8_STAGE(PG8_SB(0, 0), cB, voffB); PG8_STAGE(PG8_SA(0, 0), cA, voffA); PG8_STAGE(PG8_SB(0, 1), cB + hstep, voffB); PG8_STAGE(PG8_SA(0, 1), cA + hstep, voffA);
        if (wr == 1) PG8_BAR;
        PG8_WAIT_V(4); PG8_BAR;
        PG8_STAGE(PG8_SB(1, 0), cB + kstep, voffB); PG8_STAGE(PG8_SA(1, 0), cA + kstep, voffA); PG8_STAGE(PG8_SB(1, 1), cB + hstep + kstep, voffB);
        PG8_WAIT_V(6); PG8_BAR;
    }
    for (;;) {
        const bool has_next = S.next(ui + 1, nxt);
        const char* nA = has_next ? (const char*)g.A + (size_t)nxt.pm * tstep : cA; const char* nB = has_next ? (const char*)g.Bt + (size_t)nxt.pn * tstep : cB;
        for (int t = 0; t < nt; t += 2) {
            const bool last = (t == nt - 2);
            const char* a1 = cA + (size_t)(t + 1) * kstep;
            const char* a2 = last ? nA : cA + (size_t)(t + 2) * kstep; const char* b2 = last ? nB : cB + (size_t)(t + 2) * kstep;
            const char* a3 = a2 + kstep; const char* b3 = b2 + kstep;
            if (last && has_next) S.a_ready(nxt);
            if constexpr (SP2) {
            PG8_LDB(B0, 0, 0); PG8_LDB(B1, 0, 1); PG8_SCHED; PG8_LDA(At, 0, 0); PG8_STAGE(PG8_SA(1, 1), a1 + hstep, voffA);
            PG8_WAIT_V(8); PG8_WAIT_L(0); PG8_BAR; PG8_MMA(0, 0, At, B0); PG8_MMA(0, 1, At, B1); PG8_BAR; PG8_SCHED;
            PG8_LDA(At, 0, 1); PG8_STAGE(PG8_SB(0, 0), b2, voffB); PG8_STAGE(PG8_SB(0, 1), b2 + hstep, voffB); PG8_STAGE(PG8_SA(0, 0), a2, voffA);
            PG8_WAIT_V(8); PG8_WAIT_L(0); PG8_BAR; PG8_MMA(1, 0, At, B0); PG8_MMA(1, 1, At, B1); PG8_BAR; PG8_SCHED;
            PG8_LDB(B0, 1, 0); PG8_LDB(B1, 1, 1); PG8_SCHED; PG8_LDA(At, 1, 0); PG8_STAGE(PG8_SA(0, 1), a2 + hstep, voffA);
            PG8_WAIT_V(8); PG8_WAIT_L(0); PG8_BAR; PG8_MMA(0, 0, At, B0); PG8_MMA(0, 1, At, B1); PG8_BAR; PG8_SCHED;
            PG8_LDA(At, 1, 1); PG8_STAGE(PG8_SB(1, 0), b3, voffB); PG8_STAGE(PG8_SB(1, 1), b3 + hstep, voffB); PG8_STAGE(PG8_SA(1, 0), a3, voffA);
            PG8_WAIT_V(8); PG8_WAIT_L(0); PG8_BAR; PG8_MMA(1, 0, At, B0); PG8_MMA(1, 1, At, B1); PG8_BAR; PG8_SCHED;
            } else {
            PG8_LDB(B0, 0, 0); PG8_SCHED; PG8_LDA(At, 0, 0); PG8_STAGE(PG8_SA(1, 1), a1 + hstep, voffA);
            PG8_WAIT_L(8); PG8_BAR; PG8_WAIT_L(0); PG8_MMA(0, 0, At, B0); PG8_BAR; PG8_SCHED;
            PG8_LDB(B1, 0, 1); PG8_STAGE(PG8_SB(0, 0), b2, voffB);
            PG8_BAR; PG8_WAIT_L(0); PG8_MMA(0, 1, At, B1); PG8_BAR;
            PG8_LDA(At, 0, 1); PG8_STAGE(PG8_SA(0, 0), a2, voffA);
            PG8_BAR; PG8_WAIT_L(0); PG8_MMA(1, 0, At, B0); PG8_BAR; PG8_SCHED;
            PG8_STAGE(PG8_SB(0, 1), b2 + hstep, voffB);
            PG8_WAIT_V(6); PG8_BAR; PG8_MMA(1, 1, At, B1); PG8_BAR;
            PG8_LDB(B0, 1, 0); PG8_SCHED; PG8_LDA(At, 1, 0); PG8_STAGE(PG8_SA(0, 1), a2 + hstep, voffA);
            PG8_WAIT_L(8); PG8_BAR; PG8_WAIT_L(0); PG8_MMA(0, 0, At, B0); PG8_BAR; PG8_SCHED;
            PG8_LDB(B1, 1, 1); PG8_STAGE(PG8_SB(1, 0), b3, voffB);
            PG8_BAR; PG8_WAIT_L(0); PG8_MMA(0, 1, At, B1); PG8_BAR;
            PG8_LDA(At, 1, 1); PG8_STAGE(PG8_SA(1, 0), a3, voffA);
            PG8_BAR; PG8_WAIT_L(0); PG8_MMA(1, 0, At, B0); PG8_BAR; PG8_SCHED;
            PG8_STAGE(PG8_SB(1, 1), b3 + hstep, voffB);
            PG8_WAIT_V(6); PG8_BAR; PG8_MMA(1, 1, At, B1); PG8_BAR;
            }
        }
        if constexpr (ALIGN_EPI) { if (wr == 0) PG8_BAR; }
        if constexpr (!Epi::AFTER_DRAIN) { E(acc, cur, wr, wc, fr, fq); S.done(cur); }
        if (!has_next) break;
#pragma unroll
        for (int a = 0; a < 2; ++a)
#pragma unroll
            for (int b = 0; b < 2; ++b)
#pragma unroll
                for (int m = 0; m < 4; ++m)
#pragma unroll
                    for (int n = 0; n < 2; ++n) acc[a][b][m][n] = (f32x4){0.f, 0.f, 0.f, 0.f};
        cur = nxt; cA = nA; cB = nB; ++ui;
        if constexpr (ALIGN_EPI) { if (wr == 1) PG8_BAR; }
    }
    PG8_WAIT_V(0);
    if constexpr (!ALIGN_EPI) { if (wr == 0) PG8_BAR; }
    PG8_BAR;
    if constexpr (Epi::AFTER_DRAIN) { E.fused(acc, cur, wr, wc, fr, fq, lds, wid, lane); S.done(cur); }
#undef PG8_SA
#undef PG8_SB
#undef PG8_STAGE
#undef PG8_LDA
#undef PG8_LDB
#undef PG8_MMA
#undef PG8_WAIT_V
#undef PG8_WAIT_L
#undef PG8_BAR
#undef PG8_SCHED
}
}


#define LAS __attribute__((address_space(3)))
typedef unsigned short bf16_t;
typedef short bf16x8 __attribute__((ext_vector_type(8)));
typedef short s16x4 __attribute__((ext_vector_type(4)));
typedef short v4i16_t __attribute__((ext_vector_type(4)));
typedef float f32x4 __attribute__((ext_vector_type(4)));
typedef float f32x2 __attribute__((ext_vector_type(2)));
typedef float f32x16 __attribute__((ext_vector_type(16)));
typedef unsigned u32x4 __attribute__((ext_vector_type(4)));
typedef unsigned u32x2 __attribute__((ext_vector_type(2)));

constexpr int DM = 1024, NB = 8, SEQ = 2048, MP = NB * SEQ, SL = 32, MS = NB * SL, MT = MP + MS;
constexpr int PS = 3840, DFF = 4096, INCOLS = 3600;
constexpr int C_QA = 0, C_KA = 256, C_VA = 512, C_GA = 768, C_QB = 1024, C_KB = 1280, C_VB = 1536, C_GB = 1792, C_QC = 2048, C_KC = 2560, C_VC = 3072, C_LOW = 3584;
constexpr int NREL = 320;
constexpr float EPS = 1e-6f;
constexpr size_t WS_A = 0;
constexpr size_t WS_B = WS_A + (size_t)MT * DFF * 2;
constexpr size_t WS_C = WS_B + (size_t)MT * DM * 2;
constexpr size_t WS_WIN = WS_C + (size_t)MT * DM * 2;
constexpr size_t WS_WOUT = WS_WIN + (size_t)2 * PS * DM * 2;
constexpr size_t WS_WUP = WS_WOUT + (size_t)2 * DM * DM * 2;
constexpr size_t WS_WDN = WS_WUP + (size_t)2 * DFF * DM * 2;
constexpr size_t WS_LOWF = WS_WDN + (size_t)2 * DFF * DM * 2;
constexpr size_t WS_SS = WS_LOWF + (size_t)MT * 16 * 4;
constexpr size_t WS_G = WS_SS + (size_t)5 * MT * 4;
constexpr size_t WS_ROPE = WS_G + (size_t)1024 * 64 * 4;
constexpr size_t WS_CTL = WS_ROPE + (size_t)2080 * 64 * 4;
constexpr size_t CTL_BYTES = 16384;
constexpr size_t WS_END = WS_CTL + CTL_BYTES;
static_assert((size_t)2048 * 4096 * 4 <= (size_t)MT * DM * 2, "KVT fits region C");
constexpr size_t WS_CKB = WS_A + (size_t)MT * PS * 2;
constexpr size_t CACHE_ELEMS = (size_t)8 * 512 * 512;
static_assert(WS_CKB + 2 * CACHE_ELEMS * 2 <= WS_B, "cache copies fit behind PROJ");
static_assert(WS_END <= (size_t)256 * 1024 * 1024, "d_ws map");
constexpr size_t O_Y = 0, O_RETP = (size_t)MT * DM, O_GLAP = O_RETP + 262144, O_KP = O_GLAP + 262144, O_VP = O_KP + 4194304, O_RETS = O_VP + 4194304, O_GLAS = O_RETS + 262144,
                 O_KS = O_GLAS + 262144, O_VS = O_KS + 262144, O_END = O_VS + 262144;
constexpr int TS = 144;
constexpr int TILE_B = 64 * TS;
constexpr int WAVE_LDS = 2 * TILE_B;
constexpr int LDS_BIAS = 8 * WAVE_LDS;
constexpr int NREV = 384;
constexpr int LDS_BARST = LDS_BIAS + 8 * NREV * 4;
constexpr int LDS_BYTES = LDS_BARST + 16;
static_assert(LDS_BYTES <= 160 * 1024 && pg8::STAGE_BYTES <= LDS_BIAS, "LDS map");

struct Params { const float* in[18]; float* out; unsigned char* ws; };
__device__ __forceinline__ int lane_id_asm() { int l; asm volatile("v_mbcnt_lo_u32_b32 %0, -1, 0\n\tv_mbcnt_hi_u32_b32 %0, -1, %0" : "=v"(l)); return l; }
typedef const __attribute__((address_space(4))) char* kaptr_t;
__device__ __forceinline__ kaptr_t karg_base() { kaptr_t ka = (kaptr_t)__builtin_amdgcn_kernarg_segment_ptr(); asm volatile("" : "+s"(ka)); return ka; }
__device__ __forceinline__ const float* in_ptr(int i) { return *(const float* const __attribute__((address_space(4)))*)(karg_base() + 8 * i); }
__device__ __forceinline__ float* out_ptr() { return *(float* const __attribute__((address_space(4)))*)(karg_base() + 8 * 18); }
__device__ __forceinline__ unsigned char* ws_ptr() { return *(unsigned char* const __attribute__((address_space(4)))*)(karg_base() + 8 * 19); }

typedef float f32x2_t __attribute__((ext_vector_type(2))); typedef __bf16 bf16x2_t __attribute__((ext_vector_type(2)));
__device__ __forceinline__ unsigned pk2(float lo, float hi) { const f32x2_t v = {lo, hi}; const bf16x2_t b = __builtin_convertvector(v, bf16x2_t); return __builtin_bit_cast(unsigned, b); }
__device__ __forceinline__ float bflo(unsigned u) { return __uint_as_float(u << 16); }
__device__ __forceinline__ float bfhi(unsigned u) { return __uint_as_float(u & 0xffff0000u); }
__device__ __forceinline__ float bf2f(bf16_t h) { return __uint_as_float((unsigned)h << 16); }
__device__ __forceinline__ bf16_t f2bf(float f) { return (bf16_t)(pk2(f, 0.f) & 0xffffu); }
__device__ __forceinline__ int crow(int r, int hi) { return (r & 3) + 8 * (r >> 2) + 4 * hi; }
__device__ __forceinline__ float silu(float x) { return x / (1.0f + __expf(-x)); }
__device__ __forceinline__ f32x16 mfma32(bf16x8 a, bf16x8 b, f32x16 c) { return __builtin_amdgcn_mfma_f32_32x32x16_bf16(a, b, c, 0, 0, 0); }
__device__ __forceinline__ bf16x8 as_bf16x8(u32x4 v) { return __builtin_bit_cast(bf16x8, v); }
__device__ __forceinline__ f32x16 zero16() { f32x16 z;
#pragma unroll
    for (int i = 0; i < 16; ++i) z[i] = 0.f; return z; }
__device__ __forceinline__ s16x4 ds_tr(LAS const unsigned char* p) { return __builtin_bit_cast(s16x4, __builtin_amdgcn_ds_read_tr16_b64_v4i16((LAS v4i16_t*)p)); }
__device__ __forceinline__ bf16x8 tr_nat(LAS const unsigned char* tile, int k0, int cb, int lane) {
    const int kq = lane >> 5, g = (lane >> 4) & 1, q = (lane & 15) >> 2, p = lane & 3;
    LAS const unsigned char* a = tile + (k0 + 8 * kq + q) * TS + (cb + 16 * g + 4 * p) * 2;
    const s16x4 lo = ds_tr(a), hi = ds_tr(a + 4 * TS);
    return (bf16x8){lo[0], lo[1], lo[2], lo[3], hi[0], hi[1], hi[2], hi[3]};
}
template <int STR = TS> __device__ __forceinline__ bf16x8 tr_perm(LAS const unsigned char* tile, int k0, int cb, int lane) {
    const int kq = lane >> 5, g = (lane >> 4) & 1, q = (lane & 15) >> 2, p = lane & 3;
    LAS const unsigned char* a = tile + (k0 + 4 * kq + q) * STR + (cb + 16 * g + 4 * p) * 2;
    const s16x4 lo = ds_tr(a), hi = ds_tr(a + 8 * STR);
    return (bf16x8){lo[0], lo[1], lo[2], lo[3], hi[0], hi[1], hi[2], hi[3]};
}
__device__ __forceinline__ bf16x8 tr_perm_swz(LAS const unsigned char* tile, int k0, int cb, int lane) {
    const int kq = lane >> 5, g = (lane >> 4) & 1, q = (lane & 15) >> 2, p = lane & 3;
    const int row = k0 + 4 * kq + q, ob = ((cb + 16 * g + 4 * p) * 2) ^ ((row & 2) << 5);
    LAS const unsigned char* a = tile + row * 128 + ob;
    const s16x4 lo = ds_tr(a), hi = ds_tr(a + 8 * 128);
    return (bf16x8){lo[0], lo[1], lo[2], lo[3], hi[0], hi[1], hi[2], hi[3]};
}
__device__ __forceinline__ bf16x8 row_frag(LAS const unsigned char* tile, int r0, int ks, int lane) {
    return *(LAS const bf16x8*)(tile + (r0 + (lane & 31)) * TS + (16 * ks + 8 * (lane >> 5)) * 2);
}
__device__ __forceinline__ bf16x8 pack_step(const f32x16& x, int s) {
    u32x4 w; w.x = pk2(x[8 * s + 0], x[8 * s + 1]); w.y = pk2(x[8 * s + 2], x[8 * s + 3]); w.z = pk2(x[8 * s + 4], x[8 * s + 5]); w.w = pk2(x[8 * s + 6], x[8 * s + 7]);
    return as_bf16x8(w);
}
__device__ __forceinline__ void load_tile(LAS unsigned char* tile, const bf16_t* src, int pitch, int nvalid, int lane) {
#pragma unroll
    for (int it = 0; it < 8; ++it) {
        const int id = it * 64 + lane, row = id >> 3, ch = id & 7;
        u32x4 v = (u32x4){0u, 0u, 0u, 0u};
        if (row < nvalid) v = *(const u32x4*)(src + (size_t)row * pitch + ch * 8);
        *(LAS u32x4*)(tile + row * TS + ch * 16) = v;
    }
}
__device__ __forceinline__ void store_tile(LAS const unsigned char* tile, bf16_t* dst, int pitch, int nvalid, int lane) {
#pragma unroll
    for (int it = 0; it < 8; ++it) {
        const int id = it * 64 + lane, row = id >> 3, ch = id & 7;
        const u32x4 v = *(LAS const u32x4*)(tile + row * TS + ch * 16);
        if (row < nvalid) *(u32x4*)(dst + (size_t)row * pitch + ch * 8) = v;
    }
}
__device__ __forceinline__ void load_tile_f32(LAS unsigned char* tile, const float* src, int pitch, int lane) {
#pragma unroll
    for (int it = 0; it < 16; ++it) {
        const int id = it * 64 + lane, row = id >> 4, c4 = id & 15;
        const f32x4 v = *(const f32x4*)(src + (size_t)row * pitch + c4 * 4);
        u32x2 w; w.x = pk2(v[0], v[1]); w.y = pk2(v[2], v[3]);
        *(LAS u32x2*)(tile + row * TS + c4 * 8) = w;
    }
}
__device__ __forceinline__ void load_rot(const bf16_t* rp, const float* cs, int kq, float scale, bool valid, bf16x8 (&fr)[4]) {
    u32x4 c[4];
#pragma unroll
    for (int ks = 0; ks < 4; ++ks) c[ks] = valid ? *(const u32x4*)(rp + 16 * ks + 8 * kq) : (u32x4){0u, 0u, 0u, 0u};
#pragma unroll
    for (int g = 0; g < 2; ++g) {
        const float* cp = cs + 16 * g + 8 * kq;
        const f32x4 ca = *(const f32x4*)cp, cb = *(const f32x4*)(cp + 4), sa = *(const f32x4*)(cp + 32), sb = *(const f32x4*)(cp + 36);
        float o1[8], o2[8];
#pragma unroll
        for (int e = 0; e < 8; ++e) {
            const unsigned w1 = c[g][e >> 1], w2 = c[g + 2][e >> 1];
            const float x1 = (e & 1) ? bfhi(w1) : bflo(w1), x2 = (e & 1) ? bfhi(w2) : bflo(w2);
            const float cc = (e < 4) ? ca[e & 3] : cb[e & 3], sn = (e < 4) ? sa[e & 3] : sb[e & 3];
            o1[e] = (x1 * cc - x2 * sn) * scale; o2[e] = (x1 * sn + x2 * cc) * scale;
        }
        u32x4 a, b;
        a.x = pk2(o1[0], o1[1]); a.y = pk2(o1[2], o1[3]); a.z = pk2(o1[4], o1[5]); a.w = pk2(o1[6], o1[7]);
        b.x = pk2(o2[0], o2[1]); b.y = pk2(o2[2], o2[3]); b.z = pk2(o2[4], o2[5]); b.w = pk2(o2[6], o2[7]);
        fr[g] = as_bf16x8(a); fr[g + 2] = as_bf16x8(b);
    }
}

struct Ctx {
    int l, lane, kq, li;
    const bf16_t* proj; const float* lowf; const float* rope; bf16_t* cat; float* kvt; float* gdec; float* out;
    const float* wa2; const float* ba; const float* nw; const float* st; const bf16_t* ckb; const bf16_t* cvb;
};
__device__ __forceinline__ float ret_lg2(int h) { return __log2f(1.0f - exp2f(-5.0f - (float)h)); }

struct GlaGate {
    f32x4 lw[4]; float w[16]; float bias, run;
    template <int L> __device__ __forceinline__ void init(const Ctx& C, int m0, int h) {
#pragma unroll
        for (int q = 0; q < 4; ++q) lw[q] = (C.lane < L) ? *(const f32x4*)(C.lowf + (size_t)(m0 + C.lane) * 16 + 4 * q) : (f32x4){0.f, 0.f, 0.f, 0.f};
#pragma unroll
        for (int j = 0; j < 16; ++j) w[j] = C.wa2[j * 256 + h * 64 + C.lane];
        bias = C.ba[h * 64 + C.lane]; run = 0.f;
    }
    __device__ __forceinline__ float step(int s) {
        float z0 = bias, z1 = 0.f;
#pragma unroll
        for (int j = 0; j < 16; j += 2) {
            z0 += __int_as_float(__builtin_amdgcn_readlane(__float_as_int(lw[j >> 2][j & 3]), s)) * w[j];
            z1 += __int_as_float(__builtin_amdgcn_readlane(__float_as_int(lw[(j + 1) >> 2][(j + 1) & 3]), s)) * w[j + 1];
        }
        const float z = z0 + z1;
        const float lf = fminf(z, 0.f) - __logf(1.0f + __expf(-fabsf(z)));
        run += lf * (1.0f / 16.0f);
        return run;
    }
};

template <bool SAMPLE> __device__ __forceinline__ void kv_local(const Ctx& C, int type, int b, int n, int h, LAS unsigned char* wl) {
    constexpr int L = SAMPLE ? 32 : 64, NKS = L / 16;
    const int m0 = SAMPLE ? MP + b * SL : b * SEQ + n * 64;
    const int pidx0 = SAMPLE ? 2048 : n * 64;
    LAS unsigned char* tK = wl; LAS unsigned char* tV = wl + TILE_B;
    const int lane = C.lane, kq = C.kq, li = C.li;
    float gdk = 0.f;
    if (type == 0) {
        const float lg = ret_lg2(h);
#pragma unroll
        for (int rb = 0; rb < L / 32; ++rb) {
            const int s = 32 * rb + li;
            bf16x8 fr[4];
            load_rot(C.proj + (size_t)(m0 + s) * PS + C_KA + h * 64, C.rope + (size_t)(pidx0 + s) * 64, kq, 0.125f * __builtin_amdgcn_exp2f(lg * (float)(L - 1 - s)), true, fr);
#pragma unroll
            for (int ks = 0; ks < 4; ++ks) *(LAS bf16x8*)(tK + s * TS + (16 * ks + 8 * kq) * 2) = fr[ks];
        }
        load_tile(tV, C.proj + (size_t)m0 * PS + C_VA + h * 64, PS, L, lane);
    } else {
        load_tile(tK, C.proj + (size_t)m0 * PS + C_KB + h * 64, PS, L, lane);
        GlaGate gg; gg.init<L>(C, m0, h);
        if (!SAMPLE) {
            load_tile(tV, C.proj + (size_t)m0 * PS + C_QB + h * 64, PS, L, lane);
#pragma unroll 4
            for (int s = 0; s < L; ++s) {
                const float e = __expf(gg.step(s));
                LAS bf16_t* kp = (LAS bf16_t*)(tK + s * TS + lane * 2); LAS bf16_t* qp = (LAS bf16_t*)(tV + s * TS + lane * 2);
                *kp = f2bf(bf2f(*kp) / e); *qp = f2bf(bf2f(*qp) * 0.125f * e);
            }
            asm volatile("s_waitcnt lgkmcnt(0)" ::: "memory");
            store_tile(tV, (bf16_t*)C.proj + (size_t)m0 * PS + C_QB + h * 64, PS, L, lane);
            store_tile(tK, (bf16_t*)C.proj + (size_t)m0 * PS + C_KB + h * 64, PS, L, lane);
            asm volatile("s_waitcnt lgkmcnt(0)" ::: "memory");
            load_tile(tV, C.proj + (size_t)m0 * PS + C_VB + h * 64, PS, L, lane);
        } else {
            load_tile(tV, C.proj + (size_t)m0 * PS + C_VB + h * 64, PS, L, lane);
#pragma unroll 4
            for (int s = 0; s < L; ++s) {
                const float bs = gg.step(s);
                LAS bf16_t* kp = (LAS bf16_t*)(tK + s * TS + lane * 2);
                *kp = f2bf(bf2f(*kp) * __expf(-bs));
            }
        }
        gdk = __expf(gg.run);
    }
    f32x16 kv[2][2];
#pragma unroll
    for (int db = 0; db < 2; ++db)
#pragma unroll
        for (int kb = 0; kb < 2; ++kb) kv[db][kb] = zero16();
#pragma unroll
    for (int ks = 0; ks < NKS; ++ks) {
        bf16x8 a[2], bb[2];
#pragma unroll
        for (int db = 0; db < 2; ++db) a[db] = tr_nat(tV, 16 * ks, 32 * db, lane);
#pragma unroll
        for (int kb = 0; kb < 2; ++kb) bb[kb] = tr_nat(tK, 16 * ks, 32 * kb, lane);
#pragma unroll
        for (int db = 0; db < 2; ++db)
#pragma unroll
            for (int kb = 0; kb < 2; ++kb) kv[db][kb] = mfma32(a[db], bb[kb], kv[db][kb]);
    }
    if (type == 1) {
#pragma unroll
        for (int kb = 0; kb < 2; ++kb) { const float cs = __int_as_float(__builtin_amdgcn_ds_bpermute((32 * kb + li) * 4, __float_as_int(gdk)));
#pragma unroll
            for (int db = 0; db < 2; ++db) kv[db][kb] = kv[db][kb] * cs; }
    }
    if (!SAMPLE) {
        const int uidx = ((type * 8 + b) * 4 + h) * 32 + n;
        bf16_t* dst = (bf16_t*)C.kvt + (size_t)uidx * 4096;
#pragma unroll
        for (int db = 0; db < 2; ++db)
#pragma unroll
            for (int kb = 0; kb < 2; ++kb)
#pragma unroll
                for (int r = 0; r < 16; ++r) dst[(32 * db + crow(r, kq)) * 64 + 32 * kb + li] = f2bf(kv[db][kb][r]);
        if (type == 1) C.gdec[(size_t)(((b * 4 + h) * 32 + n)) * 64 + lane] = gdk;
    } else {
        const float* s0 = C.st + (size_t)((C.l * 8 + b) * 4 + h) * 4096;
        float* so = C.out + (type == 0 ? O_RETS : O_GLAS) + (size_t)((C.l * 8 + b) * 4 + h) * 4096;
        const float dret = exp2f(ret_lg2(h) * (float)L);
#pragma unroll
        for (int kb = 0; kb < 2; ++kb) {
            const int dk = 32 * kb + li;
            const float dec = (type == 0) ? dret : __int_as_float(__builtin_amdgcn_ds_bpermute(dk * 4, __float_as_int(gdk)));
#pragma unroll
            for (int db = 0; db < 2; ++db)
#pragma unroll
                for (int rr = 0; rr < 4; ++rr) {
                    const int dv = 32 * db + 8 * rr + 4 * kq;
                    const f32x4 o = *(const f32x4*)(s0 + dk * 64 + dv);
                    f32x4 nv;
#pragma unroll
                    for (int e = 0; e < 4; ++e) nv[e] = dec * o[e] + kv[db][kb][4 * rr + e];
                    *(f32x4*)(so + dk * 64 + dv) = nv;
                }
        }
    }
}

template <bool SAMPLE> __device__ __forceinline__ void mix_out(const Ctx& C, int type, int b, int n, int h, LAS unsigned char* wl) {
    constexpr int L = SAMPLE ? 32 : 64, NTB = L / 32;
    const int m0 = SAMPLE ? MP + b * SL : b * SEQ + n * 64;
    const int pidx0 = SAMPLE ? 2048 : n * 64;
    LAS unsigned char* t0 = wl; LAS unsigned char* t1 = wl + TILE_B;
    const int lane = C.lane, kq = C.kq, li = C.li;
    bf16x8 qfr[NTB][4];
    const float lg = ret_lg2(h);
    if (type == 0) {
#pragma unroll
        for (int tb = 0; tb < NTB; ++tb) {
            const int s = 32 * tb + li;
            load_rot(C.proj + (size_t)(m0 + s) * PS + C_QA + h * 64, C.rope + (size_t)(pidx0 + s) * 64, kq, __builtin_amdgcn_exp2f(lg * (float)(s + 1)), true, qfr[tb]);
        }
        load_tile(t0, C.proj + (size_t)m0 * PS + C_VA + h * 64, PS, L, lane);
    } else {
        load_tile(t0, C.proj + (size_t)m0 * PS + C_QB + h * 64, PS, L, lane);
        load_tile(t1, C.proj + (size_t)m0 * PS + C_KB + h * 64, PS, L, lane);
        if (SAMPLE) {
            GlaGate gg; gg.init<L>(C, m0, h);
#pragma unroll 4
            for (int s = 0; s < L; ++s) {
                const float e = __expf(gg.step(s));
                LAS bf16_t* qp = (LAS bf16_t*)(t0 + s * TS + lane * 2); LAS bf16_t* kp = (LAS bf16_t*)(t1 + s * TS + lane * 2);
                *qp = f2bf(bf2f(*qp) * 0.125f * e); *kp = f2bf(bf2f(*kp) / e);
            }
        }
        __builtin_amdgcn_sched_barrier(0);
#pragma unroll
        for (int tb = 0; tb < NTB; ++tb)
#pragma unroll
            for (int ks = 0; ks < 4; ++ks) qfr[tb][ks] = row_frag(t0, 32 * tb, ks, lane);
        asm volatile("s_waitcnt lgkmcnt(0)" ::: "memory");
        __builtin_amdgcn_sched_barrier(0);
        load_tile(t0, C.proj + (size_t)m0 * PS + C_VB + h * 64, PS, L, lane);
    }
    __builtin_amdgcn_sched_barrier(0);
    f32x16 o[2][NTB];
#pragma unroll
    for (int db = 0; db < 2; ++db)
#pragma unroll
        for (int tb = 0; tb < NTB; ++tb) o[db][tb] = zero16();
    {
        const int uidx = ((type * 8 + b) * 4 + h) * 32 + n;
        const bf16_t* sT = (const bf16_t*)C.kvt + (size_t)uidx * 4096;
        const float* s0 = C.st + (size_t)((C.l * 8 + b) * 4 + h) * 4096;
#pragma unroll
        for (int db = 0; db < 2; ++db)
#pragma unroll
            for (int ks = 0; ks < 4; ++ks) {
                const int dv = 32 * db + li, dk0 = 16 * ks + 8 * kq;
                bf16x8 sa;
                if (!SAMPLE) sa = as_bf16x8(*(const u32x4*)(sT + dv * 64 + dk0));
                else { float sv[8];
#pragma unroll
                    for (int e = 0; e < 8; ++e) sv[e] = s0[(dk0 + e) * 64 + dv];
                    u32x4 w; w.x = pk2(sv[0], sv[1]); w.y = pk2(sv[2], sv[3]); w.z = pk2(sv[4], sv[5]); w.w = pk2(sv[6], sv[7]);
                    sa = as_bf16x8(w); }
#pragma unroll
                for (int tb = 0; tb < NTB; ++tb) o[db][tb] = mfma32(sa, qfr[tb][ks], o[db][tb]);
            }
    }
    __builtin_amdgcn_sched_barrier(0);
#pragma unroll
    for (int sb = 0; sb < NTB; ++sb) {
        bf16x8 kfr[4];
        if (type == 0) load_rot(C.proj + (size_t)(m0 + 32 * sb + li) * PS + C_KA + h * 64, C.rope + (size_t)(pidx0 + 32 * sb + li) * 64, kq, 0.125f * __builtin_amdgcn_exp2f(-lg * (float)(32 * sb + li + 1)), true, kfr);
        else {
#pragma unroll
            for (int ks = 0; ks < 4; ++ks) kfr[ks] = row_frag(t1, 32 * sb, ks, lane);
        }
        f32x16 st[NTB];
#pragma unroll
        for (int tb = sb; tb < NTB; ++tb) {
            f32x16 a = zero16();
#pragma unroll
            for (int ks = 0; ks < 4; ++ks) a = mfma32(kfr[ks], qfr[tb][ks], a);
#pragma unroll
            for (int r = 0; r < 16; ++r) {
                const int s = 32 * sb + crow(r, kq), t = 32 * tb + li;
                a[r] = (t >= s) ? a[r] : 0.0f;
            }
            st[tb] = a;
        }
#pragma unroll
        for (int half = 0; half < 2; ++half) {
            bf16x8 va[2];
#pragma unroll
            for (int db = 0; db < 2; ++db) va[db] = tr_perm(t0, 32 * sb + 16 * half, 32 * db, lane);
#pragma unroll
            for (int tb = sb; tb < NTB; ++tb) {
                const bf16x8 pf = pack_step(st[tb], half);
#pragma unroll
                for (int db = 0; db < 2; ++db) o[db][tb] = mfma32(va[db], pf, o[db][tb]);
            }
        }
        __builtin_amdgcn_sched_barrier(0);
    }
    const float* nw = C.nw + h * 64;
    const int gcol = (type == 0 ? C_GA : C_GB) + h * 64;
#pragma unroll
    for (int tb = 0; tb < NTB; ++tb) {
        const int t = 32 * tb + li;
        float s1 = 0.f, s2 = 0.f;
#pragma unroll
        for (int db = 0; db < 2; ++db)
#pragma unroll
            for (int r = 0; r < 16; ++r) { const float x = o[db][tb][r]; s1 += x; s2 += x * x; }
        s1 += __shfl_xor(s1, 32); s2 += __shfl_xor(s2, 32);
        float mu = 0.f, rstd;
        if (type == 0) { mu = s1 * (1.0f / 64.0f); const float var = fmaxf(s2 * (1.0f / 64.0f) - mu * mu, 0.f); rstd = 1.0f / sqrtf(var + EPS); }
        else rstd = 1.0f / sqrtf(s2 * (1.0f / 64.0f) + EPS);
        const bf16_t* grow = C.proj + (size_t)(m0 + t) * PS + gcol;
        bf16_t* orow = C.cat + (size_t)(m0 + t) * DM + type * 256 + h * 64;
#pragma unroll
        for (int db = 0; db < 2; ++db)
#pragma unroll
            for (int rr = 0; rr < 4; ++rr) {
                const int dv = 32 * db + 8 * rr + 4 * kq;
                const u32x2 gw = *(const u32x2*)(grow + dv);
                const f32x4 wv = *(const f32x4*)(nw + dv);
                const float g0 = bflo(gw.x), g1 = bfhi(gw.x), g2 = bflo(gw.y), g3 = bfhi(gw.y);
                const float y0 = (o[db][tb][4 * rr + 0] - mu) * rstd * wv[0] * silu(g0), y1 = (o[db][tb][4 * rr + 1] - mu) * rstd * wv[1] * silu(g1);
                const float y2 = (o[db][tb][4 * rr + 2] - mu) * rstd * wv[2] * silu(g2), y3 = (o[db][tb][4 * rr + 3] - mu) * rstd * wv[3] * silu(g3);
                u32x2 w; w.x = pk2(y0, y1); w.y = pk2(y2, y3);
                *(u32x2*)(orow + dv) = w;
            }
    }
}

template <bool SAMPLE> __device__ __forceinline__ void attn_wave(const Ctx& C, int b, int n, int h, LAS unsigned char* wl, LAS const float* revT, float cb2) {
    constexpr int NTB = SAMPLE ? 1 : 2;
    constexpr float SC = 0.125f * 1.4426950408889634f;
    const int m0 = SAMPLE ? MP + b * SL : b * SEQ + n * 64;
    const int lane = C.lane, kq = C.kq, li = C.li;
    const int jt0 = SAMPLE ? 0 : (n < 8 ? 8 - n : 0);
#define ATT_SRC(jt, kp, vp, pitch, rmask) const bf16_t* kp; const bf16_t* vp; int pitch; int rmask = 63; \
    if (SAMPLE && (jt) < 8) { kp = C.ckb + (size_t)(b * 512 + 64 * (jt)) * 512 + h * 64; vp = C.cvb + (size_t)(b * 512 + 64 * (jt)) * 512 + h * 64; pitch = 512; } \
    else { const int kr0 = SAMPLE ? m0 : b * SEQ + (n - 8 + (jt)) * 64; kp = C.proj + (size_t)kr0 * PS + C_KC + h * 64; vp = kp + (C_VC - C_KC); pitch = PS; if (SAMPLE) rmask = 31; }
#define ATT_ISSUE(jt, kdst, vbuf) do { ATT_SRC(jt, kp_, vp_, pitch_, rmask_); \
    _Pragma("unroll") for (int sb = 0; sb < 2; ++sb) _Pragma("unroll") for (int ks = 0; ks < 4; ++ks) kdst[sb][ks] = *(const u32x4*)(kp_ + (size_t)((32 * sb + li) & rmask_) * pitch_ + 16 * ks + 8 * kq); \
    _Pragma("unroll") for (int it = 0; it < 8; ++it) __builtin_amdgcn_global_load_lds((const unsigned*)(vp_ + (size_t)((it * 8 + (lane >> 3)) & rmask_) * pitch_ + (((lane & 7) ^ (((lane >> 3) & 2) << 1)) * 8)), (LAS unsigned*)((vbuf) + it * 1024), 16, 0, 0); } while (0)
    bf16x8 qfr[NTB][4];
#pragma unroll
    for (int tb = 0; tb < NTB; ++tb)
#pragma unroll
        for (int ks = 0; ks < 4; ++ks) qfr[tb][ks] = as_bf16x8(*(const u32x4*)(C.proj + (size_t)(m0 + 32 * tb + li) * PS + C_QC + h * 64 + 16 * ks + 8 * kq));
    f32x16 o[2][NTB]; float mrun[NTB], lrun[NTB];
#pragma unroll
    for (int tb = 0; tb < NTB; ++tb) { mrun[tb] = -1e30f; lrun[tb] = 0.f;
#pragma unroll
        for (int db = 0; db < 2; ++db) o[db][tb] = zero16(); }
    u32x4 kcur[2][4], knext[2][4];
    ATT_ISSUE(jt0, kcur, wl + ((jt0 & 1) ? TILE_B : 0));
    for (int jt = jt0; jt <= 8; ++jt) {
        asm volatile("s_waitcnt vmcnt(0)" ::: "memory");
        __builtin_amdgcn_sched_barrier(0);
        LAS unsigned char* tV = wl + ((jt & 1) ? TILE_B : 0);
        if (jt < 8) { ATT_ISSUE(jt + 1, knext, wl + (((jt + 1) & 1) ? TILE_B : 0)); }
        __builtin_amdgcn_sched_barrier(0);
        const bool cst = jt <= 3;
#pragma unroll
        for (int sb = 0; sb < 2; ++sb) {
            if (SAMPLE && jt == 8 && sb == 1) continue;
#pragma unroll
            for (int tb = 0; tb < NTB; ++tb) {
                f32x16 a = zero16();
#pragma unroll
                for (int ks = 0; ks < 4; ++ks) a = mfma32(as_bf16x8(kcur[sb][ks]), qfr[tb][ks], a);
                if (!cst) {
                    const int dbase = (8 - jt) * 64 + 63 + 32 * tb + li - 32 * sb;
                    LAS const float* rp = revT + (382 - dbase + 4 * kq);
#pragma unroll
                    for (int r = 0; r < 16; ++r) a[r] = a[r] * SC + rp[(r & 3) + 8 * (r >> 2)];
                }
                float mx = -1e30f;
#pragma unroll
                for (int r = 0; r < 16; ++r) mx = fmaxf(mx, a[r]);
                if (cst) mx = mx * SC + cb2;
                mx = fmaxf(mx, __shfl_xor(mx, 32));
                const float mnew = fmaxf(mrun[tb], mx);
                const bool moved = __builtin_amdgcn_ballot_w64(mnew != mrun[tb]) != 0ull;
                const float alpha = __builtin_amdgcn_exp2f(mrun[tb] - mnew);
                mrun[tb] = mnew;
                float ps = 0.f;
                if (cst) { const float off = cb2 - mnew;
#pragma unroll
                    for (int r = 0; r < 16; ++r) { const float pp = __builtin_amdgcn_exp2f(a[r] * SC + off); a[r] = pp; ps += pp; } }
                else {
#pragma unroll
                    for (int r = 0; r < 16; ++r) { const float pp = __builtin_amdgcn_exp2f(a[r] - mnew); a[r] = pp; ps += pp; } }
                lrun[tb] = lrun[tb] * alpha + ps;
                if (moved) {
#pragma unroll
                    for (int db = 0; db < 2; ++db) o[db][tb] = o[db][tb] * alpha;
                }
#pragma unroll
                for (int half = 0; half < 2; ++half) {
                    const bf16x8 pf = pack_step(a, half);
#pragma unroll
                    for (int db = 0; db < 2; ++db) o[db][tb] = mfma32(tr_perm_swz(tV, 32 * sb + 16 * half, 32 * db, lane), pf, o[db][tb]);
                }
            }
        }
#pragma unroll
        for (int sb = 0; sb < 2; ++sb)
#pragma unroll
            for (int ks = 0; ks < 4; ++ks) kcur[sb][ks] = knext[sb][ks];
    }
#pragma unroll
    for (int tb = 0; tb < NTB; ++tb) {
        const float lt = lrun[tb] + __shfl_xor(lrun[tb], 32), inv = 1.0f / lt;
        bf16_t* orow = C.cat + (size_t)(m0 + 32 * tb + li) * DM + 512 + h * 64;
#pragma unroll
        for (int db = 0; db < 2; ++db)
#pragma unroll
            for (int rr = 0; rr < 4; ++rr) {
                u32x2 w; w.x = pk2(o[db][tb][4 * rr] * inv, o[db][tb][4 * rr + 1] * inv); w.y = pk2(o[db][tb][4 * rr + 2] * inv, o[db][tb][4 * rr + 3] * inv);
                *(u32x2*)(orow + 32 * db + 8 * rr + 4 * kq) = w;
            }
    }
#undef ATT_ISSUE
#undef ATT_SRC
}

__device__ __forceinline__ void conv_cache(const float* ck, const float* cv, bf16_t* dst, int l, int gt, int NGT) {
    for (int i = gt; i < (int)(2 * CACHE_ELEMS / 8); i += NGT) {
        const bool isv = i >= (int)(CACHE_ELEMS / 8); const int j = isv ? i - (int)(CACHE_ELEMS / 8) : i;
        const float* s = (isv ? cv : ck) + (size_t)l * CACHE_ELEMS + (size_t)j * 8;
        const f32x4 x = __builtin_nontemporal_load((const f32x4*)s), y = __builtin_nontemporal_load((const f32x4*)(s + 4));
        u32x4 w; w.x = pk2(x[0], x[1]); w.y = pk2(x[2], x[3]); w.z = pk2(y[0], y[1]); w.w = pk2(y[2], y[3]);
        *(u32x4*)(dst + (size_t)i * 8) = w;
    }
}

__device__ __forceinline__ int win_src(int n) { return n < 2048 ? n : (n < 3584 ? n + 16 : (n < 3600 ? n - 1536 : -1)); }
__device__ __forceinline__ void tr_item(const float* W, int K, int Nsrc, bf16_t* WT, int kb, int nb, bool inmap, const float* kscale, LAS float* scr, int lane) {
    const int k0 = 64 * kb, n0 = 32 * nb, n = n0 + (lane & 31), sc = inmap ? win_src(n) : n;
    float wv[32];
#pragma unroll
    for (int i = 0; i < 32; ++i) { const int kk = 2 * i + (lane >> 5); wv[i] = (sc >= 0) ? __builtin_nontemporal_load(W + (size_t)(k0 + kk) * Nsrc + sc) : 0.f; }
    if (kscale) {
#pragma unroll
        for (int i = 0; i < 32; ++i) wv[i] *= kscale[k0 + 2 * i + (lane >> 5)];
    }
#pragma unroll
    for (int i = 0; i < 32; ++i) scr[(2 * i + (lane >> 5)) * 33 + (lane & 31)] = wv[i];
    asm volatile("s_waitcnt lgkmcnt(0)" ::: "memory");
    const int c = lane & 7;
#pragma unroll
    for (int j = 0; j < 4; ++j) { const int nn = (lane >> 3) + 8 * j; const LAS float* s = scr + (8 * c) * 33 + nn;
        u32x4 o; o.x = pk2(s[0 * 33], s[1 * 33]); o.y = pk2(s[2 * 33], s[3 * 33]); o.z = pk2(s[4 * 33], s[5 * 33]); o.w = pk2(s[6 * 33], s[7 * 33]);
        *(u32x4*)(WT + (size_t)(n0 + nn) * K + k0 + 8 * c) = o; }
    asm volatile("s_waitcnt lgkmcnt(0)" ::: "memory");
}


enum { SK_IN = 0, SK_RES = 1, SK_UP = 2 };
struct SArgs {
    const bf16_t* A; const bf16_t* Bt; int K, nunits;
    bf16_t* obf; int ldo;
    const float* ss_in; float* ss_out;
    const bf16_t* xold; float* xr;
    float* lowf; float* ksout; float* vsout;
};
template <int KIND> __device__ __forceinline__ void sample_gemm(LAS unsigned char* lds, const SArgs& a, int ubeg, int ustep, int wave, int lane) {
    const int kq = lane >> 5, li = lane & 31, K = a.K, kw = K >> 3, kbeg = wave * kw;
    for (int u = ubeg; u < a.nunits; u += ustep) {
        const int row0 = 64 * (u & 3), col0 = 64 * (u >> 2);
        f32x16 acc[2][2];
#pragma unroll
        for (int rb = 0; rb < 2; ++rb)
#pragma unroll
            for (int cb = 0; cb < 2; ++cb) acc[rb][cb] = zero16();
        const bf16_t* ap = a.A + (size_t)(row0 + li) * K + kbeg + 8 * kq;
        const bf16_t* bp = a.Bt + (size_t)(col0 + li) * K + kbeg + 8 * kq;
        u32x4 af[4][2], bv[4][2], an[4][2], bn[4][2];
#define SG_LOAD(dsta, dstb, k) _Pragma("unroll") for (int s = 0; s < 4; ++s) _Pragma("unroll") for (int h = 0; h < 2; ++h) { dsta[s][h] = *(const u32x4*)(ap + (size_t)(32 * h) * K + (k) + 16 * s); dstb[s][h] = *(const u32x4*)(bp + (size_t)(32 * h) * K + (k) + 16 * s); }
        SG_LOAD(af, bv, 0);
        for (int k = 0; k < kw; k += 64) {
            if (k + 64 < kw) { SG_LOAD(an, bn, k + 64); }
#pragma unroll
            for (int s = 0; s < 4; ++s)
#pragma unroll
                for (int rb = 0; rb < 2; ++rb)
#pragma unroll
                    for (int cb = 0; cb < 2; ++cb) acc[rb][cb] = mfma32(as_bf16x8(af[s][rb]), as_bf16x8(bv[s][cb]), acc[rb][cb]);
#pragma unroll
            for (int s = 0; s < 4; ++s)
#pragma unroll
                for (int h = 0; h < 2; ++h) { af[s][h] = an[s][h]; bv[s][h] = bn[s][h]; }
        }
#undef SG_LOAD
        LAS float* wp = (LAS float*)(lds + wave * WAVE_LDS);
#pragma unroll
        for (int rb = 0; rb < 2; ++rb)
#pragma unroll
            for (int cb = 0; cb < 2; ++cb)
#pragma unroll
                for (int r = 0; r < 16; ++r) wp[(32 * rb + crow(r, kq)) * 64 + 32 * cb + li] = acc[rb][cb][r];
        __syncthreads();
        const int t = wave * 64 + lane, row = t >> 3, c8 = (t & 7) * 8;
        float v[8];
#pragma unroll
        for (int e = 0; e < 8; ++e) v[e] = 0.f;
#pragma unroll
        for (int w = 0; w < 8; ++w) {
            const f32x4 x = *(LAS const f32x4*)(lds + w * WAVE_LDS + (row * 64 + c8) * 4), y = *(LAS const f32x4*)(lds + w * WAVE_LDS + (row * 64 + c8) * 4 + 16);
#pragma unroll
            for (int e = 0; e < 4; ++e) { v[e] += x[e]; v[4 + e] += y[e]; }
        }
        const int r = row0 + row, c = col0 + c8;
        if (KIND == SK_IN || KIND == SK_UP) {
            const float rs = 1.0f / sqrtf(a.ss_in[r] * (1.0f / 1024.0f) + EPS);
#pragma unroll
            for (int e = 0; e < 8; ++e) { v[e] *= rs; if (KIND == SK_UP) { const float q = fmaxf(v[e], 0.f); v[e] = q * q; } }
        }
        if (KIND == SK_RES) {
            const u32x4 xw = *(const u32x4*)(a.xold + (size_t)r * 1024 + c);
            float sq = 0.f;
            v[0] += bflo(xw.x); v[1] += bfhi(xw.x); v[2] += bflo(xw.y); v[3] += bfhi(xw.y); v[4] += bflo(xw.z); v[5] += bfhi(xw.z); v[6] += bflo(xw.w); v[7] += bfhi(xw.w);
#pragma unroll
            for (int e = 0; e < 8; ++e) sq += v[e] * v[e];
            if (a.xr) { float* xn = a.xr + (size_t)r * 1024 + c;
                *(f32x4*)xn = (f32x4){v[0], v[1], v[2], v[3]}; *(f32x4*)(xn + 4) = (f32x4){v[4], v[5], v[6], v[7]}; }
            sq += __shfl_xor(sq, 1); sq += __shfl_xor(sq, 2); sq += __shfl_xor(sq, 4);
            if ((t & 7) == 0) atomicAdd(a.ss_out + r, sq);
        }
        if (a.obf) { u32x4 w; w.x = pk2(v[0], v[1]); w.y = pk2(v[2], v[3]); w.z = pk2(v[4], v[5]); w.w = pk2(v[6], v[7]); *(u32x4*)(a.obf + (size_t)r * a.ldo + c) = w; }
        if (KIND == SK_IN) {
            float* d = nullptr;
            if (c >= C_KC && c < C_VC) d = a.ksout + (size_t)r * 512 + (c - C_KC);
            else if (c >= C_VC && c < C_LOW) d = a.vsout + (size_t)r * 512 + (c - C_VC);
            else if (c >= C_LOW && c < C_LOW + 16) d = a.lowf + (size_t)r * 16 + (c - C_LOW);
            if (d) { *(f32x4*)d = (f32x4){v[0], v[1], v[2], v[3]}; *(f32x4*)(d + 4) = (f32x4){v[4], v[5], v[6], v[7]}; }
        }
        __syncthreads();
    }
}
__device__ __forceinline__ void sample_share(int nwg, int G, int bx, int& ubeg, int& ustep) { const int nfull = nwg % G; if (nfull == 0) { ubeg = bx; ustep = G; } else if (bx >= nfull) { ubeg = bx - nfull; ustep = G - nfull; } else { ubeg = 1 << 30; ustep = 1; } }

#define XB_TMO      128
#define XB_XCNT(j)  (256  + 64 * (j))
#define XB_XSUB(j)  (1280 + 64 * (j))
#define XB_XGEN(j)  (2304 + 64 * (j))
#define XB_TOP      3328
#define XB_TOPGEN   3392
#define XCD_BAR_WORDS 3456
#define XB_SPIN_CAP (1u << 18)

__device__ __forceinline__ unsigned xb_ld(unsigned* p)              { return __hip_atomic_load(p, __ATOMIC_RELAXED, __HIP_MEMORY_SCOPE_AGENT); }
__device__ __forceinline__ unsigned xb_add(unsigned* p, unsigned v) { return __hip_atomic_fetch_add(p, v, __ATOMIC_RELAXED, __HIP_MEMORY_SCOPE_AGENT); }
__device__ __forceinline__ unsigned xb_xcc_id() { return (unsigned)__builtin_amdgcn_s_getreg((3 << 11) | 20) & 0xFu; }
#define XB_SPIN(cond, bar) do { unsigned _sp = 0; while (cond) { __builtin_amdgcn_s_sleep(1); \
    if ((++_sp & 255u) == 0u) { if (xb_ld(&(bar)[XB_TMO])) break; if (_sp > XB_SPIN_CAP) { atomicAdd(&(bar)[XB_TMO], 1u); break; } } } } while (0)

struct XcdBarrier {
    unsigned* bar; unsigned x; bool wave0;
    volatile LAS unsigned* st;
};

__device__ __forceinline__ XcdBarrier xcd_barrier_post(unsigned* bar, volatile LAS unsigned* st) {
    XcdBarrier b; b.bar = bar; b.x = xb_xcc_id(); b.st = st;
    if (threadIdx.x == 0) (void)xb_add(&bar[XB_XCNT(b.x)], 1u);
    return b;
}
__device__ __forceinline__ void xcd_barrier_complete(unsigned* bar, unsigned x, unsigned& nloc, unsigned& nx) {
    const unsigned G = gridDim.x * gridDim.y * gridDim.z;
    unsigned sum, cnt, mine, sp = 0u;
    for (;;) {
        sum = 0u; cnt = 0u; mine = 0u;
#pragma unroll
        for (unsigned j = 0; j < 16; ++j) { const unsigned c = xb_ld(&bar[XB_XCNT(j)]); sum += c; cnt += (c > 0u) ? 1u : 0u; mine = (j == x) ? c : mine; }
        if (sum == G) break;
        __builtin_amdgcn_s_sleep(1);
        if ((++sp & 255u) == 0u) { if (xb_ld(&bar[XB_TMO])) break; if (sp > XB_SPIN_CAP) { atomicAdd(&bar[XB_TMO], 1u); break; } }
    }
    nloc = mine > 0u ? mine : 1u; nx = cnt > 0u ? cnt : 1u;
}

__device__ __forceinline__ void xcd_barrier(const XcdBarrier& b) {
    asm volatile("s_waitcnt vmcnt(0)" ::: "memory");
    __syncthreads();
    if (b.wave0 && lane_id_asm() == 0) {
        unsigned* bar = b.bar;
        __builtin_amdgcn_s_waitcnt(0);
        unsigned nloc = b.st[0], nx = b.st[1];
        if (nloc == 0u) { xcd_barrier_complete(bar, b.x, nloc, nx); b.st[0] = nloc; b.st[1] = nx; }
        const unsigned old = xb_add(&bar[XB_XSUB(b.x)], 1u);
        const unsigned gen = old / nloc;
        if (old + 1u == (gen + 1u) * nloc) {
            __builtin_amdgcn_fence(__ATOMIC_RELEASE, "agent");
            asm volatile("s_waitcnt vmcnt(0)" ::: "memory");
            const unsigned og = xb_add(&bar[XB_TOP], 1u);
            const unsigned tg = og / nx;
            if (og + 1u == (tg + 1u) * nx) xb_add(&bar[XB_TOPGEN], 1u);
            else XB_SPIN(xb_ld(&bar[XB_TOPGEN]) == tg, bar);
            __builtin_amdgcn_fence(__ATOMIC_ACQUIRE, "agent");
            xb_add(&bar[XB_XGEN(b.x)], 1u);
            asm volatile("s_waitcnt vmcnt(0)" ::: "memory");
        } else {
            XB_SPIN(xb_ld(&bar[XB_XGEN(b.x)]) == gen, bar);
            __builtin_amdgcn_fence(__ATOMIC_ACQUIRE, "agent");
            asm volatile("s_waitcnt vmcnt(0)" ::: "memory");
        }
    }
    __syncthreads();
}


__device__ __forceinline__ void tr_item128(const float* W, int K, int Nsrc, bf16_t* WT, int kb, int nb, const float* kscale, LAS float* scr, int lane) {
    const int k0 = 32 * kb, n0 = 128 * nb, n4 = (lane & 31) * 4;
    f32x4 wv[16];
#pragma unroll
    for (int i = 0; i < 16; ++i) wv[i] = __builtin_nontemporal_load((const f32x4*)(W + (size_t)(k0 + 2 * i + (lane >> 5)) * Nsrc + n0 + n4));
    if (kscale) {
#pragma unroll
        for (int i = 0; i < 16; ++i) wv[i] = wv[i] * kscale[k0 + 2 * i + (lane >> 5)];
    }
#pragma unroll
    for (int i = 0; i < 16; ++i) { LAS float* d = scr + (2 * i + (lane >> 5)) * 129 + n4; d[0] = wv[i][0]; d[1] = wv[i][1]; d[2] = wv[i][2]; d[3] = wv[i][3]; }
    asm volatile("s_waitcnt lgkmcnt(0)" ::: "memory");
#pragma unroll
    for (int j = 0; j < 8; ++j) { const int id = j * 64 + lane, n = id >> 2, c = id & 3; const LAS float* s = scr + (8 * c) * 129 + n;
        u32x4 o; o.x = pk2(s[0 * 129], s[1 * 129]); o.y = pk2(s[2 * 129], s[3 * 129]); o.z = pk2(s[4 * 129], s[5 * 129]); o.w = pk2(s[6 * 129], s[7 * 129]);
        *(u32x4*)(WT + (size_t)(n0 + n) * K + k0 + 8 * c) = o; }
    asm volatile("s_waitcnt lgkmcnt(0)" ::: "memory");
}
constexpr int CONV_WGS = 16;

__global__ void __launch_bounds__(512, 2) hybrid_fwd(Params p) {
    extern __shared__ __attribute__((aligned(16))) unsigned char lds_raw[];
    cg::grid_group grid = cg::this_grid();
    LAS unsigned char* lds = (LAS unsigned char*)lds_raw;
    const int wave = __builtin_amdgcn_readfirstlane((int)threadIdx.x >> 6);
    const int G = gridDim.x, bx = blockIdx.x;
#define WSP(off) (ws_ptr() + (off))
#define LANE_TID() const int lane = lane_id_asm(); const int tid = wave * 64 + lane; (void)tid; int Gq = G, bxq = bx; asm volatile("" : "+s"(Gq), "+s"(bxq)); (void)Gq; (void)bxq
    LAS unsigned char* wl = lds + wave * WAVE_LDS;
    LAS float* biasT = (LAS float*)(lds + LDS_BIAS);
    if (threadIdx.x < 4) ((LAS unsigned*)(lds + LDS_BARST))[threadIdx.x] = 0u;
    __syncthreads();
    XcdBarrier xbar = xcd_barrier_post((unsigned*)WSP(WS_CTL), (volatile LAS unsigned*)(lds + LDS_BARST)); xbar.wave0 = (wave == 0);

    for (int rep = 0; rep < 1 + PROBE_P0X2; ++rep) {
        LANE_TID();
        unsigned char* ws = ws_ptr();
        bf16_t* XB = (bf16_t*)(ws + WS_B); bf16_t* WIN = (bf16_t*)(ws + WS_WIN); bf16_t* WOUT = (bf16_t*)(ws + WS_WOUT); bf16_t* WUP = (bf16_t*)(ws + WS_WUP); bf16_t* WDN = (bf16_t*)(ws + WS_WDN);
        float* SS = (float*)(ws + WS_SS); float* ROPE = (float*)(ws + WS_ROPE);
        const int gw = bx * 8 + wave, NGW = G * 8;
        LAS float* scr = (LAS float*)wl;
        constexpr int I_IN = 16 * (PS / 32), I_OUT = 16 * 32, I_UP = 16 * 128, I_DN = 64 * 32, I_L = I_IN + I_OUT + I_UP + I_DN;
        const bool split = (G == 256);
        for (int it = gw; it < 2 * I_L; it += NGW) {
            const int l = it / I_L; int r = it % I_L;
            if (split && (r >= I_IN || l == 1)) continue;
            if (r < I_IN) { tr_item(in_ptr(9) + (size_t)l * DM * INCOLS, DM, INCOLS, WIN + (size_t)l * PS * DM, r / (PS / 32), r % (PS / 32), true, in_ptr(6) + l * DM, scr, lane); continue; } r -= I_IN;
            if (r < I_OUT) { tr_item(in_ptr(15) + (size_t)l * DM * DM, DM, DM, WOUT + (size_t)l * DM * DM, r / 32, r % 32, false, nullptr, scr, lane); continue; } r -= I_OUT;
            if (r < I_UP) { tr_item(in_ptr(16) + (size_t)l * DM * DFF, DM, DFF, WUP + (size_t)l * DFF * DM, r / 128, r % 128, false, in_ptr(7) + l * DM, scr, lane); continue; } r -= I_UP;
            tr_item(in_ptr(17) + (size_t)l * DFF * DM, DFF, DM, WDN + (size_t)l * DM * DFF, r / 32, r % 32, false, nullptr, scr, lane);
        }
        const float* x_prompt = in_ptr(0); const float* x_sample = in_ptr(1);
        for (int m0 = gw; m0 < MT; m0 += 2 * NGW) {
            f32x4 v[2][4]; float s[2];
#pragma unroll
            for (int q = 0; q < 2; ++q) {
                const int m = m0 + q * NGW; s[q] = 0.f;
                if (m < MT) {
                    const float* xrow = (m < MP) ? x_prompt + (size_t)m * DM : x_sample + (size_t)(m - MP) * DM;
                    const f32x4* xr = (const f32x4*)xrow + lane;
#pragma unroll
                    for (int j = 0; j < 4; ++j) v[q][j] = __builtin_nontemporal_load(&xr[64 * j]);
                }
            }
#pragma unroll
            for (int q = 0; q < 2; ++q) {
                const int m = m0 + q * NGW;
                if (m < MT) {
#pragma unroll
                    for (int j = 0; j < 4; ++j) s[q] += (v[q][j][0] * v[q][j][0] + v[q][j][1] * v[q][j][1]) + (v[q][j][2] * v[q][j][2] + v[q][j][3] * v[q][j][3]);
#pragma unroll
                    for (int o = 1; o < 64; o <<= 1) s[q] += __shfl_xor(s[q], o);
                    u32x2* o8 = (u32x2*)(XB + (size_t)m * DM) + lane;
#pragma unroll
                    for (int j = 0; j < 4; ++j) { u32x2 w; w.x = pk2(v[q][j][0], v[q][j][1]); w.y = pk2(v[q][j][2], v[q][j][3]); o8[64 * j] = w; }
                    if (lane == 0) SS[m] = s[q];
                }
            }
        }
        const int gt = bx * 512 + tid, NGT = G * 512;
        for (int i = gt; i < 4 * MT; i += NGT) SS[MT + i] = 0.f;
        if (!split) conv_cache(in_ptr(4), in_ptr(5), (bf16_t*)(ws + WS_CKB), 0, gt, NGT);
        for (int i = gt; i < 2080 * 32; i += NGT) {
            const int pi = i >> 5, f = i & 31; const int pos = pi < 2048 ? pi : 4096 + (pi - 2048);
            const float inv_freq = (float)exp(-(double)f * (9.210340371976184 / 32.0));
            const float ang = (float)pos * inv_freq;
            double rev = (double)ang * 0.15915494309189535; rev -= rint(rev);
            const float rf = (float)rev;
            ROPE[(size_t)pi * 64 + f] = __builtin_amdgcn_cosf(rf); ROPE[(size_t)pi * 64 + 32 + f] = __builtin_amdgcn_sinf(rf);
        }
    }
    if (G == 0x7fffffff) grid.sync();
    xcd_barrier(xbar);

    for (int l = 0; l < 2; ++l) {
        {
            LANE_TID();
            unsigned char* ws = ws_ptr();
            const bool split = (Gq == 256); const int GG = split ? Gq - CONV_WGS : Gq;
            if (split && bxq >= GG) {
                LAS float* scr = (LAS float*)(lds + wave * WAVE_LDS);
                constexpr int J_OUT = 32 * 8, J_UP = 32 * 32;
                for (int it = (bxq - GG) * 8 + wave; it < J_OUT + J_UP; it += CONV_WGS * 8) {
                    if (it < J_OUT) tr_item128(in_ptr(15) + (size_t)l * DM * DM, DM, DM, (bf16_t*)(ws + WS_WOUT) + (size_t)l * DM * DM, it / 8, it % 8, nullptr, scr, lane);
                    else { const int r = it - J_OUT; tr_item128(in_ptr(16) + (size_t)l * DM * DFF, DM, DFF, (bf16_t*)(ws + WS_WUP) + (size_t)l * DFF * DM, r / 32, r % 32, in_ptr(7) + l * DM, scr, lane); }
                }
                conv_cache(in_ptr(4), in_ptr(5), (bf16_t*)(ws + WS_CKB), l, (bxq - GG) * 512 + tid, CONV_WGS * 512);
            } else {
            pg8::Gemm g{(const bf16_t*)(ws + WS_B), (const bf16_t*)(ws + WS_WIN) + (size_t)l * PS * DM, MP, PS, DM}; pg8::StaticOrder S; S.init(MP, PS, GG, bxq);
            pg8::EpiIn E{(bf16_t*)(ws + WS_A), (float*)(ws + WS_LOWF), (const float*)(ws + WS_SS) + (size_t)(2 * l) * MT, out_ptr(), (long long)(O_KP + (size_t)l * 2097152), (long long)(O_VP + (size_t)l * 2097152), (long long)(O_KS + (size_t)l * 131072), (long long)(O_VS + (size_t)l * 131072)};
            pg8::gemm_phase<pg8::EpiIn, pg8::StaticOrder, true, true>(lds, g, S, E, tid);
            if (PROBE_IN2) pg8::gemm_phase<pg8::EpiIn, pg8::StaticOrder, true, true>(lds, g, S, E, tid);
            {
                float* outp = out_ptr();
                SArgs a{}; a.A = (const bf16_t*)(ws + WS_B) + (size_t)MP * DM; a.Bt = (const bf16_t*)(ws + WS_WIN) + (size_t)l * PS * DM; a.K = DM; a.nunits = 4 * 57;
                a.obf = (bf16_t*)(ws + WS_A) + (size_t)MP * PS; a.ldo = PS; a.ss_in = (const float*)(ws + WS_SS) + (size_t)(2 * l) * MT + MP; a.lowf = (float*)(ws + WS_LOWF) + (size_t)MP * 16;
                a.ksout = outp + O_KS + (size_t)l * 131072; a.vsout = outp + O_VS + (size_t)l * 131072;
                int ub, us; sample_share((MP / 256) * (PS / 256), GG, bxq, ub, us);
                sample_gemm<SK_IN>(lds, a, ub, us, wave, lane);
            }
            if (l == 1 && !split) conv_cache(in_ptr(4), in_ptr(5), (bf16_t*)(ws + WS_CKB), 1, bxq * 512 + tid, GG * 512);
            }
        }
        xcd_barrier(xbar);
        {
            LANE_TID();
            { const float* rb = in_ptr(14) + (size_t)l * 8 * NREL; for (int i = tid; i < 8 * NREV; i += 512) { const int hh = i / NREV, j = i % NREV; int k = 382 - j; k = k < 0 ? 0 : (k > NREL - 1 ? NREL - 1 : k); biasT[i] = rb[hh * NREL + k] * 1.4426950408889634f; } }
            __syncthreads();
        }
#define MAKE_CTX() LANE_TID(); int wv = wave; asm volatile("" : "+s"(wv)); unsigned char* ws = ws_ptr(); Ctx C; C.l = l; C.lane = lane; C.kq = lane >> 5; C.li = lane & 31; C.proj = (const bf16_t*)(ws + WS_A); C.lowf = (const float*)(ws + WS_LOWF); \
        C.rope = (const float*)(ws + WS_ROPE); C.cat = (bf16_t*)(out_ptr() + O_Y); C.kvt = (float*)(ws + WS_C); C.gdec = (float*)(ws + WS_G); C.out = out_ptr(); \
        C.wa2 = in_ptr(10) + (size_t)l * 16 * 256; C.ba = in_ptr(11) + l * 256; C.nw = (wv < 4 ? in_ptr(12) : in_ptr(13)) + l * 256; C.st = (wv < 4 ? in_ptr(2) : in_ptr(3)); C.ckb = (const bf16_t*)(ws + WS_CKB); C.cvb = C.ckb + CACHE_ELEMS; \
        __builtin_amdgcn_sched_barrier(0)
        for (int rep = 0; rep < 1 + PROBE_M1X2; ++rep)
        for (int u = bx; u < 256; u += G) {
            const int b = u & 7, n = u >> 3;
            for (int rk = 0; rk < 1 + PROBE_KVX2; ++rk) { MAKE_CTX(); kv_local<false>(C, wv >> 2, b, n, wv & 3, wl); }
            for (int ra = 0; ra < 1 + PROBE_ATX2; ++ra) { MAKE_CTX(); attn_wave<false>(C, b, n, wave, wl, biasT + wave * NREV, biasT[wave * NREV]); }
            if (n == 0) { MAKE_CTX(); attn_wave<true>(C, b, 0, wave, wl, biasT + wave * NREV, biasT[wave * NREV]); }
            if (n == 1) { MAKE_CTX(); mix_out<true>(C, wv >> 2, b, 0, wv & 3, wl); }
            if (n == 2) { MAKE_CTX(); kv_local<true>(C, wv >> 2, b, 0, wv & 3, wl); }
        }
        xcd_barrier(xbar);
        {
            LANE_TID();
            float* KVT = (float*)WSP(WS_C); const float* GDEC = (const float*)WSP(WS_G); float* outp = out_ptr();
            for (int it = bx * 512 + tid; it < 131072; it += G * 512) {
                const int seq = it >> 11, e2 = it & 2047, type = seq >> 5, b = (seq >> 2) & 7, h = seq & 3;
                const int dv = e2 >> 5, dk = (2 * e2) & 63;
                bf16_t* base = (bf16_t*)KVT + (size_t)seq * 32 * 4096 + 2 * e2;
                const float dret = exp2f(ret_lg2(h) * 64.0f);
                const float* gd = GDEC + (size_t)((b * 4 + h) * 32) * 64 + dk;
                unsigned kvr[32]; f32x2 dd[32];
#pragma unroll
                for (int c = 0; c < 32; ++c) kvr[c] = *(const unsigned*)(base + (size_t)c * 4096);
                if (type == 1) {
#pragma unroll
                    for (int c = 0; c < 32; ++c) dd[c] = *(const f32x2*)(gd + c * 64);
                } else {
#pragma unroll
                    for (int c = 0; c < 32; ++c) dd[c] = (f32x2){dret, dret};
                }
                f32x2 s = (f32x2){0.f, 0.f};
#pragma unroll
                for (int c = 0; c < 32; ++c) { *(unsigned*)(base + (size_t)c * 4096) = pk2(s[0], s[1]); s = dd[c] * s + (f32x2){bflo(kvr[c]), bfhi(kvr[c])}; }
                float* so = outp + (type == 0 ? O_RETP : O_GLAP) + (size_t)((l * 8 + b) * 4 + h) * 4096;
                so[dk * 64 + dv] = s[0]; so[(dk + 1) * 64 + dv] = s[1];
            }
        }
        xcd_barrier(xbar);
        for (int rep = 0; rep < 1 + PROBE_M3X2; ++rep)
        for (int u = bx; u < 256; u += G) { MAKE_CTX(); mix_out<false>(C, wv >> 2, u & 7, u >> 3, wv & 3, wl); }
        xcd_barrier(xbar);
        {
            LANE_TID();
            unsigned char* ws = ws_ptr(); const bf16_t* CATB = (const bf16_t*)(out_ptr() + O_Y);
            pg8::Gemm g{CATB, (const bf16_t*)(ws + WS_WOUT) + (size_t)l * DM * DM, MP, DM, DM}; pg8::StaticOrder S; S.init(MP, DM, Gq, bxq);
            pg8::EpiRes E{(const bf16_t*)(ws + WS_B), (float*)nullptr, (bf16_t*)(ws + WS_C), (float*)(ws + WS_SS) + (size_t)(2 * l + 1) * MT};
            pg8::gemm_phase<pg8::EpiRes, pg8::StaticOrder, true, true>(lds, g, S, E, tid);
            {
                SArgs a{}; a.A = CATB + (size_t)MP * DM; a.Bt = (const bf16_t*)(ws + WS_WOUT) + (size_t)l * DM * DM; a.K = DM; a.nunits = 4 * 16;
                a.obf = (bf16_t*)(ws + WS_C) + (size_t)MP * DM; a.ldo = DM; a.ss_out = (float*)(ws + WS_SS) + (size_t)(2 * l + 1) * MT + MP;
                a.xold = (const bf16_t*)(ws + WS_B) + (size_t)MP * DM; a.xr = nullptr;
                int ub, us; sample_share((MP / 256) * (DM / 256), Gq, bxq, ub, us);
                sample_gemm<SK_RES>(lds, a, ub, us, wave, lane);
                const int nsamp = a.nunits < Gq ? a.nunits : Gq;
                if (Gq == 256 && bxq >= nsamp) {
                    LAS float* scr = (LAS float*)(lds + wave * WAVE_LDS);
                    for (int it = (bxq - nsamp) * 8 + wave; it < 128 * 8; it += (Gq - nsamp) * 8)
                        tr_item128(in_ptr(17) + (size_t)l * DFF * DM, DFF, DM, (bf16_t*)(ws + WS_WDN) + (size_t)l * DM * DFF, it / 8, it % 8, nullptr, scr, lane);
                }
            }
        }
        xcd_barrier(xbar);
        {
            LANE_TID();
            unsigned char* ws = ws_ptr();
            pg8::Gemm g{(const bf16_t*)(ws + WS_C), (const bf16_t*)(ws + WS_WUP) + (size_t)l * DFF * DM, MP, DFF, DM}; pg8::StaticOrder S; S.init(MP, DFF, Gq, bxq);
            pg8::EpiUp E{(bf16_t*)(ws + WS_A), (const float*)(ws + WS_SS) + (size_t)(2 * l + 1) * MT, DFF};
            pg8::gemm_phase<pg8::EpiUp, pg8::StaticOrder, true, true>(lds, g, S, E, tid);
            if (PROBE_UP2) pg8::gemm_phase<pg8::EpiUp, pg8::StaticOrder, true, true>(lds, g, S, E, tid);
            if (PROBE_UP2B) { xcd_barrier(xbar); pg8::gemm_phase<pg8::EpiUp, pg8::StaticOrder, true, true>(lds, g, S, E, tid); }
            {
                SArgs a{}; a.A = (const bf16_t*)(ws + WS_C) + (size_t)MP * DM; a.Bt = (const bf16_t*)(ws + WS_WUP) + (size_t)l * DFF * DM; a.K = DM; a.nunits = 4 * 64;
                a.obf = (bf16_t*)(ws + WS_A) + (size_t)MP * DFF; a.ldo = DFF; a.ss_in = (const float*)(ws + WS_SS) + (size_t)(2 * l + 1) * MT + MP;
                int ub, us; sample_share((MP / 256) * (DFF / 256), Gq, bxq, ub, us);
                sample_gemm<SK_UP>(lds, a, ub, us, wave, lane);
            }
        }
        xcd_barrier(xbar);
        {
            LANE_TID();
            unsigned char* ws = ws_ptr(); float* XR = out_ptr() + O_Y;
            pg8::Gemm g{(const bf16_t*)(ws + WS_A), (const bf16_t*)(ws + WS_WDN) + (size_t)l * DM * DFF, MP, DM, DFF}; pg8::StaticOrder S; S.init(MP, DM, Gq, bxq);
            if (PROBE_DN2) { pg8::EpiUp E2{(bf16_t*)(ws + WS_C), (const float*)(ws + WS_SS) + (size_t)(2 * l + 1) * MT, DM}; pg8::gemm_phase<pg8::EpiUp, pg8::StaticOrder, true, true>(lds, g, S, E2, tid); }
            pg8::EpiRes E{(const bf16_t*)(ws + WS_C), (float*)nullptr, (bf16_t*)(ws + WS_B), (float*)(ws + WS_SS) + (size_t)(2 * l + 2) * MT};
            pg8::gemm_phase<pg8::EpiRes, pg8::StaticOrder, true, true>(lds, g, S, E, tid);
            {
                SArgs a{}; a.A = (const bf16_t*)(ws + WS_A) + (size_t)MP * DFF; a.Bt = (const bf16_t*)(ws + WS_WDN) + (size_t)l * DM * DFF; a.K = DFF; a.nunits = 4 * 16;
                a.obf = (bf16_t*)(ws + WS_B) + (size_t)MP * DM; a.ldo = DM; a.ss_out = (float*)(ws + WS_SS) + (size_t)(2 * l + 2) * MT + MP;
                a.xold = (const bf16_t*)(ws + WS_C) + (size_t)MP * DM; a.xr = nullptr;
                int ub, us; sample_share((MP / 256) * (DM / 256), Gq, bxq, ub, us);
                sample_gemm<SK_RES>(lds, a, ub, us, wave, lane);
                const int nsamp = a.nunits < Gq ? a.nunits : Gq;
                if (l == 0 && Gq == 256 && bxq >= nsamp) {
                    LAS float* scr = (LAS float*)(lds + wave * WAVE_LDS);
                    for (int it = (bxq - nsamp) * 8 + wave; it < 16 * (PS / 32); it += (Gq - nsamp) * 8)
                        tr_item(in_ptr(9) + (size_t)DM * INCOLS, DM, INCOLS, (bf16_t*)(ws + WS_WIN) + (size_t)PS * DM, it / (PS / 32), it % (PS / 32), true, in_ptr(6) + DM, scr, lane);
                }
            }
        }
        xcd_barrier(xbar);
    }
    for (int i = 0; i < PROBE_SYNCS; ++i) xcd_barrier(xbar);
    {
        LANE_TID();
        const int gw = bx * 8 + wave, NGW = G * 8;
        const float* fw = in_ptr(8); const float* SS = (const float*)WSP(WS_SS); float* Y = out_ptr() + O_Y; const bf16_t* XBF = (const bf16_t*)WSP(WS_B);
        f32x4 w4[4];
#pragma unroll
        for (int j = 0; j < 4; ++j) w4[j] = *((const f32x4*)fw + lane + 64 * j);
        for (int m0 = gw; m0 < MT; m0 += 4 * NGW) {
            u32x2 v[4][4]; float rs[4];
#pragma unroll
            for (int q = 0; q < 4; ++q) {
                const int m = m0 + q * NGW;
                if (m < MT) {
                    rs[q] = SS[(size_t)4 * MT + m];
                    const u32x2* xr = (const u32x2*)(XBF + (size_t)m * DM) + lane;
#pragma unroll
                    for (int j = 0; j < 4; ++j) v[q][j] = __builtin_nontemporal_load(&xr[64 * j]);
                }
            }
#pragma unroll
            for (int q = 0; q < 4; ++q) {
                const int m = m0 + q * NGW;
                if (m < MT) {
                    const float r = 1.0f / sqrtf(rs[q] * (1.0f / 1024.0f) + EPS);
                    f32x4* yr = (f32x4*)(Y + (size_t)m * DM) + lane;
#pragma unroll
                    for (int j = 0; j < 4; ++j) { const f32x4 x = (f32x4){bflo(v[q][j].x), bfhi(v[q][j].x), bflo(v[q][j].y), bfhi(v[q][j].y)}; __builtin_nontemporal_store(x * r * w4[j], &yr[64 * j]); }
                }
            }
        }
    }
}

extern "C" void kernel_launch(void* const* d_in, const int* in_sizes, int n_in, void* d_out, int out_size, void* d_ws, size_t ws_size, hipStream_t stream) {
    static int grid = 0;
    if (grid == 0) {
        if (n_in != 18 || (size_t)out_size != O_END || ws_size < WS_END) { fprintf(stderr, "kernel_launch: unexpected shapes: n_in %d out %d ws %zu (need %zu)\n", n_in, out_size, ws_size, (size_t)WS_END); grid = -1; return; }
        int dev = 0, cus = 0, per_cu = 0;
        hipGetDevice(&dev); hipDeviceGetAttribute(&cus, hipDeviceAttributeMultiprocessorCount, dev);
        if (hipFuncSetAttribute((const void*)hybrid_fwd, hipFuncAttributeMaxDynamicSharedMemorySize, LDS_BYTES) != hipSuccess) { fprintf(stderr, "kernel_launch: hipFuncSetAttribute failed\n"); }
        if (hipOccupancyMaxActiveBlocksPerMultiprocessor(&per_cu, (const void*)hybrid_fwd, 512, LDS_BYTES) != hipSuccess || per_cu < 1) { fprintf(stderr, "kernel_launch: occupancy query says %d\n", per_cu); per_cu = 1; }
        (void)hipGetLastError();
        grid = cus * per_cu;
        if (grid > 256) grid = 256;
    }
    if (grid < 0) return;
    if (hipMemsetAsync((unsigned char*)d_ws + WS_CTL, 0, CTL_BYTES, stream) != hipSuccess) { fprintf(stderr, "kernel_launch: memset of the barrier words failed\n"); return; }
    Params p{};
    for (int i = 0; i < 18; ++i) p.in[i] = (const float*)d_in[i];
    p.out = (float*)d_out; p.ws = (unsigned char*)d_ws;
    void* args[] = {&p};
    hipError_t e = hipLaunchCooperativeKernel((const void*)hybrid_fwd, dim3(grid), dim3(512), args, LDS_BYTES, stream);
    if (e != hipSuccess) fprintf(stderr, "kernel_launch: cooperative launch failed: %s (grid %d)\n", hipGetErrorString(e), grid);
}
```
